# Optimizing an MI355X kernel written in HIP

```python
import jax, jax.numpy as jnp
from jax import lax
import numpy as np

D_MODEL = 1024
BATCH = 8
SEQ = 2048
DEPTH = 1

D_MIX = D_MODEL
ATT_HEADS = 4
ATT_HEAD_DIM = 128
ROPE_DIM = ATT_HEAD_DIM // 4
NOPE_DIM = ATT_HEAD_DIM - ROPE_DIM
KV_LATENT = 128
IDX_HEADS = 8
IDX_DIM = 64
IDX_ROPE_DIM = IDX_DIM // 4
IDX_TOPK_MAX = 256
Q_BLOCK = 128
LRU_WIDTH = D_MIX - ATT_HEADS * ATT_HEAD_DIM
LRU_BLOCKS = 8
LRU_BLOCK_DIM = LRU_WIDTH // LRU_BLOCKS
CONV_WIDTH = 4
LRU_C = 8.0
ROPE_THETA = 500000.0
PLE_DIM = 256
PEER_HEADS = 8
PEER_NKEYS = 128
PEER_EXPERTS = PEER_NKEYS * PEER_NKEYS
PEER_QDIM = 256
PEER_HALF = PEER_QDIM // 2
PEER_TOPK = 16
TOKEN_CHUNK = 128
EPS = 1e-6
IN_SIZES = (ATT_HEADS * ATT_HEAD_DIM, KV_LATENT, ROPE_DIM, IDX_HEADS * IDX_DIM, IDX_DIM, IDX_HEADS, LRU_WIDTH, LRU_WIDTH)
IN_TOTAL = sum(IN_SIZES)

kernel_name = 'hybrid_dsa_rglru_peer_block'


def rmsnorm(x, g):
    xf = x.astype(jnp.float32)
    y = xf * lax.rsqrt(jnp.mean(xf * xf, axis=-1, keepdims=True) + EPS)
    return (y * g.astype(jnp.float32)).astype(x.dtype)


def rope_angles(positions, dim):
    inv = ROPE_THETA ** (-jnp.arange(0, dim, 2, dtype=jnp.float32) / dim)
    ang = positions.astype(jnp.float32)[..., None] * inv
    return jnp.cos(ang), jnp.sin(ang)


def apply_rope(x, cos, sin):
    x1, x2 = jnp.split(x.astype(jnp.float32), 2, axis=-1)
    return jnp.concatenate([x1 * cos - x2 * sin, x2 * cos + x1 * sin], axis=-1).astype(x.dtype)


def partial_rope(x, cos, sin, rot):
    return jnp.concatenate([apply_rope(x[..., :rot], cos, sin), x[..., rot:]], axis=-1)


def dsa_attention(q, c_kv, k_rope, iq, ik, iw, g_kv, w_uk, w_uv, cos_a, sin_a, cos_i, sin_i):
    B, S = q.shape[0], q.shape[1]
    q = q.reshape(B, S, ATT_HEADS, ATT_HEAD_DIM)
    q_rope = apply_rope(q[..., :ROPE_DIM], cos_a[:, :, None], sin_a[:, :, None])
    q_lat = jnp.einsum('bshn,hcn->bshc', q[..., ROPE_DIM:], w_uk)
    q_cat = jnp.concatenate([q_lat, q_rope], axis=-1)
    kv_cat = jnp.concatenate([rmsnorm(c_kv, g_kv), apply_rope(k_rope, cos_a, sin_a)], axis=-1)
    iq = partial_rope(iq.reshape(B, S, IDX_HEADS, IDX_DIM), cos_i[:, :, None], sin_i[:, :, None], IDX_ROPE_DIM)
    ik = partial_rope(ik, cos_i, sin_i, IDX_ROPE_DIM)
    iw = iw * (IDX_HEADS ** -0.5 * IDX_DIM ** -0.5)
    top_k = min(IDX_TOPK_MAX, S // 4)
    n_blocks = S // Q_BLOCK
    scale = ATT_HEAD_DIM ** -0.5
    key_pos = jnp.arange(S)

    def to_blocks(a):
        return a.reshape(B, n_blocks, Q_BLOCK, *a.shape[2:]).swapaxes(0, 1)

    def block(args):
        qc, iqb, iwb, start = args
        t_pos = start + jnp.arange(Q_BLOCK)
        rel = jax.nn.relu(jnp.einsum('bthd,bsd->bths', iqb, ik))
        score = jnp.einsum('bths,bth->bts', rel, iwb).astype(jnp.float32)
        causal = key_pos[None, :] <= t_pos[:, None]
        score = jnp.where(causal[None], score, -jnp.inf)
        _, sel = lax.top_k(score, top_k)
        kv_sel = jax.vmap(lambda kv, i: kv[i])(kv_cat, sel)
        logits = jnp.einsum('bthc,btkc->bthk', qc, kv_sel).astype(jnp.float32) * scale
        valid = sel <= t_pos[None, :, None]
        logits = jnp.where(valid[:, :, None, :], logits, -jnp.inf)
        probs = jax.nn.softmax(logits, axis=-1).astype(qc.dtype)
        o_lat = jnp.einsum('bthk,btkc->bthc', probs, kv_sel[..., :KV_LATENT])
        return jnp.einsum('bthc,hcd->bthd', o_lat, w_uv).reshape(B, Q_BLOCK, ATT_HEADS * ATT_HEAD_DIM)

    starts = jnp.arange(n_blocks, dtype=jnp.int32) * Q_BLOCK
    out = lax.map(block, (to_blocks(q_cat), to_blocks(iq), to_blocks(iw), starts))
    return out.swapaxes(0, 1).reshape(B, S, ATT_HEADS * ATT_HEAD_DIM)


def rg_lru_branch(xb, gate, conv_w, conv_b, w_rg, b_rg, w_ig, b_ig, lam):
    B, S, C = xb.shape
    xc = lax.conv_general_dilated(xb, conv_w[:, None, :], window_strides=(1,), padding=((CONV_WIDTH - 1, 0),),
                                  dimension_numbers=('NWC', 'WIO', 'NWC'), feature_group_count=C) + conv_b
    xblk = xc.reshape(B, S, LRU_BLOCKS, LRU_BLOCK_DIM)
    r = jax.nn.sigmoid(jnp.einsum('bsni,nio->bsno', xblk, w_rg).reshape(B, S, C) + b_rg)
    i = jax.nn.sigmoid(jnp.einsum('bsni,nio->bsno', xblk, w_ig).reshape(B, S, C) + b_ig)
    log_a = -LRU_C * r.astype(jnp.float32) * jax.nn.softplus(-lam.astype(jnp.float32))
    a = jnp.exp(log_a)
    b = jnp.sqrt(1.0 - jnp.exp(2.0 * log_a)) * (i * xc).astype(jnp.float32)

    def combine(left, right):
        a1, b1 = left
        a2, b2 = right
        return a1 * a2, a2 * b1 + b2

    _, h = lax.associative_scan(combine, (a, b), axis=1)
    return h.astype(xb.dtype) * jax.nn.gelu(gate)


def peer_ffn(h, w_pq, k1, k2, u_tab, v_tab):
    B, S, D = h.shape
    q = (h @ w_pq).reshape(B, S, PEER_HEADS, 2, PEER_HALF)
    s1 = jnp.einsum('bshd,hnd->bshn', q[..., 0, :], k1)
    s2 = jnp.einsum('bshd,hnd->bshn', q[..., 1, :], k2)
    v1, i1 = lax.top_k(s1, PEER_TOPK)
    v2, i2 = lax.top_k(s2, PEER_TOPK)
    cand = (v1[..., :, None] + v2[..., None, :]).reshape(B, S, PEER_HEADS, PEER_TOPK * PEER_TOPK)
    vals, flat = lax.top_k(cand, PEER_TOPK)
    e1 = jnp.take_along_axis(i1, flat // PEER_TOPK, axis=-1)
    e2 = jnp.take_along_axis(i2, flat % PEER_TOPK, axis=-1)
    experts = e1 * PEER_NKEYS + e2
    gates = jax.nn.softmax(vals.astype(jnp.float32), axis=-1).astype(h.dtype)
    n_chunks = (B * S) // TOKEN_CHUNK
    hc = h.reshape(n_chunks, TOKEN_CHUNK, D)
    ec = experts.reshape(n_chunks, TOKEN_CHUNK, PEER_HEADS * PEER_TOPK)
    gc = gates.reshape(n_chunks, TOKEN_CHUNK, PEER_HEADS * PEER_TOPK)

    def chunk(args):
        hx, e, g = args
        act = jax.nn.gelu(jnp.einsum('ckd,cd->ck', u_tab[e], hx), approximate=False)
        return jnp.einsum('ck,ckd->cd', g * act, v_tab[e])

    return lax.map(chunk, (hc, ec, gc)).reshape(B, S, D)


def setup_inputs(seed: int = 0) -> dict:
    key = jax.random.key(seed)
    ks = jax.random.split(key, 32)
    f32 = jnp.float32
    nrm = lambda k, shape, s: jax.random.normal(k, shape, f32) * s
    u = jax.random.uniform(ks[14], (DEPTH, LRU_WIDTH), f32, 0.9, 0.999)
    sg = u ** (1.0 / LRU_C)
    lam = jnp.log(sg) - jnp.log1p(-sg)
    return {
        'x': nrm(ks[0], (BATCH, SEQ, D_MODEL), 1.0),
        'p': nrm(ks[1], (DEPTH, BATCH, SEQ, PLE_DIM), 1.0),
        'positions': jnp.broadcast_to(jnp.arange(SEQ, dtype=jnp.int32), (BATCH, SEQ)),
        'g_mix': 1.0 + nrm(ks[2], (DEPTH, D_MODEL), 0.01),
        'w_in': nrm(ks[3], (DEPTH, D_MODEL, IN_TOTAL), D_MODEL ** -0.5),
        'g_kv': 1.0 + nrm(ks[4], (DEPTH, KV_LATENT), 0.01),
        'w_uk': nrm(ks[5], (DEPTH, ATT_HEADS, KV_LATENT, NOPE_DIM), KV_LATENT ** -0.5),
        'w_uv': nrm(ks[6], (DEPTH, ATT_HEADS, KV_LATENT, ATT_HEAD_DIM), KV_LATENT ** -0.5),
        'conv_w': nrm(ks[7], (DEPTH, CONV_WIDTH, LRU_WIDTH), CONV_WIDTH ** -0.5),
        'conv_b': nrm(ks[8], (DEPTH, LRU_WIDTH), 0.01),
        'w_rg': nrm(ks[9], (DEPTH, LRU_BLOCKS, LRU_BLOCK_DIM, LRU_BLOCK_DIM), LRU_BLOCK_DIM ** -0.5),
        'b_rg': nrm(ks[10], (DEPTH, LRU_WIDTH), 0.01),
        'w_ig': nrm(ks[11], (DEPTH, LRU_BLOCKS, LRU_BLOCK_DIM, LRU_BLOCK_DIM), LRU_BLOCK_DIM ** -0.5),
        'b_ig': nrm(ks[12], (DEPTH, LRU_WIDTH), 0.01),
        'lru_lambda': lam,
        'w_out': nrm(ks[13], (DEPTH, D_MIX, D_MODEL), D_MIX ** -0.5),
        'g_ffn': 1.0 + nrm(ks[15], (DEPTH, D_MODEL), 0.01),
        'w_pq': nrm(ks[16], (DEPTH, D_MODEL, PEER_HEADS * PEER_QDIM), D_MODEL ** -0.5),
        'peer_k1': nrm(ks[17], (DEPTH, PEER_HEADS, PEER_NKEYS, PEER_HALF), PEER_HALF ** -0.5),
        'peer_k2': nrm(ks[18], (DEPTH, PEER_HEADS, PEER_NKEYS, PEER_HALF), PEER_HALF ** -0.5),
        'peer_u': nrm(ks[19], (DEPTH, PEER_EXPERTS, D_MODEL), D_MODEL ** -0.5),
        'peer_v': nrm(ks[20], (DEPTH, PEER_EXPERTS, D_MODEL), (PEER_HEADS * PEER_TOPK) ** -0.5),
        'w_ple': nrm(ks[21], (DEPTH, PLE_DIM, D_MODEL), PLE_DIM ** -0.5),
        'w_ple_gate': nrm(ks[22], (DEPTH, D_MODEL, D_MODEL), D_MODEL ** -0.5),
        'g_final': 1.0 + nrm(ks[23], (D_MODEL,), 0.01),
    }


def reference(x, p, positions, g_mix, w_in, g_kv, w_uk, w_uv, conv_w, conv_b, w_rg, b_rg, w_ig, b_ig,
              lru_lambda, w_out, g_ffn, w_pq, peer_k1, peer_k2, peer_u, peer_v, w_ple, w_ple_gate, g_final):
    cos_a, sin_a = rope_angles(positions, ROPE_DIM)
    cos_i, sin_i = rope_angles(positions, IDX_ROPE_DIM)
    splits = [int(s) for s in np.cumsum(IN_SIZES)[:-1]]
    for i in range(DEPTH):
        h = rmsnorm(x, g_mix[i])
        q, c_kv, k_rope, iq, ik, iw, xb, gate = jnp.split(h @ w_in[i], splits, axis=-1)
        att = dsa_attention(q, c_kv, k_rope, iq, ik, iw, g_kv[i], w_uk[i], w_uv[i], cos_a, sin_a, cos_i, sin_i)
        rec = rg_lru_branch(xb, gate, conv_w[i], conv_b[i], w_rg[i], b_rg[i], w_ig[i], b_ig[i], lru_lambda[i])
        x = x + jnp.concatenate([att, rec], axis=-1) @ w_out[i]
        x = x + peer_ffn(rmsnorm(x, g_ffn[i]), w_pq[i], peer_k1[i], peer_k2[i], peer_u[i], peer_v[i])
        x = x + jax.nn.sigmoid(x @ w_ple_gate[i]) * (p[i] @ w_ple[i])
    return rmsnorm(x, g_final)
```

```cpp
#include <hip/hip_runtime.h>
#include <math.h>

#define T_TOK 16384
#define SEQ 2048
#define NB 8
#define DM 1024
#define INTOT 2280

__device__ __forceinline__ float wave_sum(float v) {
  for (int o = 32; o > 0; o >>= 1) v += __shfl_xor(v, o, 64);
  return v;
}
__device__ __forceinline__ float wave_max(float v) {
  for (int o = 32; o > 0; o >>= 1) v = fmaxf(v, __shfl_xor(v, o, 64));
  return v;
}
__device__ __forceinline__ float sigmoidf_(float x) { return 1.f / (1.f + expf(-x)); }
__device__ __forceinline__ float gelu_tanh(float x) {
  return 0.5f * x * (1.f + tanhf(0.7978845608028654f * (x + 0.044715f * x * x * x)));
}
__device__ __forceinline__ float gelu_erf(float x) { return 0.5f * x * (1.f + erff(x * 0.7071067811865476f)); }

__global__ void k_rmsnorm(const float* __restrict__ x, const float* __restrict__ g, float* __restrict__ out) {
  __shared__ float red[4];
  int row = blockIdx.x, tid = threadIdx.x;
  const float* xr = x + (size_t)row * DM;
  float v[4], s = 0.f;
  for (int i = 0; i < 4; ++i) { v[i] = xr[tid + i * 256]; s += v[i] * v[i]; }
  s = wave_sum(s);
  if ((tid & 63) == 0) red[tid >> 6] = s;
  __syncthreads();
  s = red[0] + red[1] + red[2] + red[3];
  float r = rsqrtf(s / DM + 1e-6f);
  for (int i = 0; i < 4; ++i) out[(size_t)row * DM + tid + i * 256] = v[i] * r * g[tid + i * 256];
}

__global__ void __launch_bounds__(256) k_gemm(const float* __restrict__ A, const float* __restrict__ B, float* __restrict__ C,
                       const float* __restrict__ R, int M, int N, int K) {
  __shared__ float sA[16][64 + 1];
  __shared__ float sB[16][64 + 1];
  int bm = blockIdx.y * 64, bn = blockIdx.x * 64, tid = threadIdx.x;
  int tr = tid / 16, tc = tid % 16;
  float acc[4][4] = {};
  for (int k0 = 0; k0 < K; k0 += 16) {
    for (int e = tid; e < 64 * 16; e += 256) {
      int r = e / 16, c = e % 16;
      sA[c][r] = (bm + r < M) ? A[(size_t)(bm + r) * K + k0 + c] : 0.f;
      int kr = e / 64, nc = e % 64;
      sB[kr][nc] = (bn + nc < N) ? B[(size_t)(k0 + kr) * N + bn + nc] : 0.f;
    }
    __syncthreads();
    for (int k = 0; k < 16; ++k) {
      float a[4], b[4];
      for (int i = 0; i < 4; ++i) a[i] = sA[k][tr * 4 + i];
      for (int j = 0; j < 4; ++j) b[j] = sB[k][tc * 4 + j];
      for (int i = 0; i < 4; ++i) for (int j = 0; j < 4; ++j) acc[i][j] += a[i] * b[j];
    }
    __syncthreads();
  }
  for (int i = 0; i < 4; ++i) for (int j = 0; j < 4; ++j) {
    int r = bm + tr * 4 + i, c = bn + tc * 4 + j;
    if (r < M && c < N) C[(size_t)r * N + c] = acc[i][j] + (R ? R[(size_t)r * N + c] : 0.f);
  }
}

__global__ void __launch_bounds__(256) k_post(const float* __restrict__ proj, const int* __restrict__ pos, const float* __restrict__ g_kv,
                       const float* __restrict__ w_uk, float* __restrict__ qcat, float* __restrict__ kv,
                       float* __restrict__ iq, float* __restrict__ ik, float* __restrict__ iw) {
  __shared__ float sp[1256];
  __shared__ float red[4];
  int t = blockIdx.x, tid = threadIdx.x;
  const float* pr = proj + (size_t)t * INTOT;
  for (int i = tid; i < 1256; i += 256) sp[i] = pr[i];
  __syncthreads();
  float p = (float)pos[t];
  for (int o = tid; o < 512; o += 256) {
    int h = o / 128, c = o % 128;
    const float* w = w_uk + ((size_t)h * 128 + c) * 96;
    float s = 0.f;
    for (int n = 0; n < 96; ++n) s += sp[h * 128 + 32 + n] * w[n];
    qcat[((size_t)t * 4 + h) * 160 + c] = s;
  }
  if (tid < 64) {
    int h = tid / 16, i = tid % 16;
    float inv = powf(500000.f, -(float)(2 * i) / 32.f);
    float ang = p * inv, cs = cosf(ang), sn = sinf(ang);
    float x1 = sp[h * 128 + i], x2 = sp[h * 128 + 16 + i];
    qcat[((size_t)t * 4 + h) * 160 + 128 + i] = x1 * cs - x2 * sn;
    qcat[((size_t)t * 4 + h) * 160 + 128 + 16 + i] = x2 * cs + x1 * sn;
  }
  {
    float v = (tid < 128) ? sp[512 + tid] : 0.f;
    float s = wave_sum(v * v);
    if ((tid & 63) == 0) red[tid >> 6] = s;
    __syncthreads();
    s = red[0] + red[1] + red[2] + red[3];
    float r = rsqrtf(s / 128.f + 1e-6f);
    if (tid < 128) kv[(size_t)t * 160 + tid] = v * r * g_kv[tid];
  }
  if (tid >= 128 && tid < 144) {
    int i = tid - 128;
    float inv = powf(500000.f, -(float)(2 * i) / 32.f);
    float ang = p * inv, cs = cosf(ang), sn = sinf(ang);
    float x1 = sp[640 + i], x2 = sp[640 + 16 + i];
    kv[(size_t)t * 160 + 128 + i] = x1 * cs - x2 * sn;
    kv[(size_t)t * 160 + 128 + 16 + i] = x2 * cs + x1 * sn;
  }
  for (int o = tid; o < 512; o += 256) {
    int h = o / 64, d = o % 64;
    float val;
    if (d < 16) {
      int i = d & 7;
      float inv = powf(500000.f, -(float)(2 * i) / 16.f);
      float ang = p * inv, cs = cosf(ang), sn = sinf(ang);
      float x1 = sp[672 + h * 64 + i], x2 = sp[672 + h * 64 + 8 + i];
      val = (d < 8) ? (x1 * cs - x2 * sn) : (x2 * cs + x1 * sn);
    } else val = sp[672 + h * 64 + d];
    iq[(size_t)t * 512 + o] = val;
  }
  if (tid < 64) {
    int d = tid;
    float val;
    if (d < 16) {
      int i = d & 7;
      float inv = powf(500000.f, -(float)(2 * i) / 16.f);
      float ang = p * inv, cs = cosf(ang), sn = sinf(ang);
      float x1 = sp[1184 + i], x2 = sp[1184 + 8 + i];
      val = (d < 8) ? (x1 * cs - x2 * sn) : (x2 * cs + x1 * sn);
    } else val = sp[1184 + d];
    ik[(size_t)t * 64 + d] = val;
  }
  if (tid < 8) iw[(size_t)t * 8 + tid] = sp[1248 + tid] * 0.04419417382415922f;
}

__global__ void __launch_bounds__(256) k_index(const float* __restrict__ iq, const float* __restrict__ ik, const float* __restrict__ iw,
                        int* __restrict__ sel) {
  __shared__ float sc[SEQ];
  __shared__ float sq[512];
  __shared__ float sw[8];
  __shared__ int cnt;
  int t = blockIdx.x, tid = threadIdx.x;
  int b = 0, tq = t;
  for (int i = tid; i < 512; i += 256) sq[i] = iq[(size_t)t * 512 + i];
  if (tid < 8) sw[tid] = iw[(size_t)t * 8 + tid];
  if (tid == 0) cnt = 0;
  __syncthreads();
  int nk = tq + 1;
  for (int s = tid; s < nk; s += 256) {
    const float* kr = ik + ((size_t)b * SEQ + s) * 64;
    float tot = 0.f;
#pragma unroll 1
    for (int h = 0; h < 8; ++h) {
      float d = 0.f;
#pragma unroll 8
      for (int e = 0; e < 64; ++e) d += sq[h * 64 + e] * kr[e];
      tot += fmaxf(d, 0.f) * sw[h];
    }
    sc[s] = tot;
  }
  __syncthreads();
  int* out = sel + (size_t)t * 256;
  if (nk <= 256) {
    out[tid] = (tid < nk) ? tid : -1;
    return;
  }
  for (int s = tid; s < nk; s += 256) {
    float v = sc[s];
    int rank = 0;
    for (int j = 0; j < nk; ++j) {
      float u = sc[j];
      rank += (u > v || (u == v && j < s)) ? 1 : 0;
    }
    if (rank < 256) out[rank] = s;
  }
}

__global__ void __launch_bounds__(256) k_attn(const float* __restrict__ qcat, const float* __restrict__ kv, const int* __restrict__ sel,
                       const float* __restrict__ w_uv, float* __restrict__ mix) {
  __shared__ float sq[4][160];
  __shared__ float sp[4][256];
  __shared__ float so[4][128];
  __shared__ int ssel[256];
  int t = blockIdx.x, tid = threadIdx.x, h = tid >> 6, lane = tid & 63;
  int b = 0;
  for (int i = tid; i < 640; i += 256) sq[i / 160][i % 160] = qcat[(size_t)t * 640 + i];
  ssel[tid] = sel[(size_t)t * 256 + tid];
  __syncthreads();
  float lg[4], mx = -INFINITY;
  for (int j = 0; j < 4; ++j) {
    int k = lane + j * 64, s = ssel[k];
    float d = -INFINITY;
    if (s >= 0) {
      const float* kr = kv + ((size_t)b * SEQ + s) * 160;
      d = 0.f;
      for (int e = 0; e < 160; ++e) d += sq[h][e] * kr[e];
      d *= 0.08838834764831845f;
    }
    lg[j] = d; mx = fmaxf(mx, d);
  }
  mx = wave_max(mx);
  float sum = 0.f;
  for (int j = 0; j < 4; ++j) { lg[j] = (lg[j] == -INFINITY) ? 0.f : expf(lg[j] - mx); sum += lg[j]; }
  sum = wave_sum(sum);
  for (int j = 0; j < 4; ++j) sp[h][lane + j * 64] = lg[j] / sum;
  __syncthreads();
  for (int cc = 0; cc < 2; ++cc) {
    int c = lane + cc * 64;
    float o = 0.f;
    for (int k = 0; k < 256; ++k) {
      int s = ssel[k];
      if (s >= 0) o += sp[h][k] * kv[((size_t)b * SEQ + s) * 160 + c];
    }
    so[h][c] = o;
  }
  __syncthreads();
  for (int dd = 0; dd < 2; ++dd) {
    int d = lane + dd * 64;
    float a = 0.f;
    for (int c = 0; c < 128; ++c) a += so[h][c] * w_uv[((size_t)h * 128 + c) * 128 + d];
    mix[(size_t)t * DM + h * 128 + d] = a;
  }
}

__global__ void __launch_bounds__(64) k_lru_gates(const float* __restrict__ proj, const float* __restrict__ conv_w, const float* __restrict__ conv_b,
                            const float* __restrict__ w_rg, const float* __restrict__ b_rg, const float* __restrict__ w_ig,
                            const float* __restrict__ b_ig, const float* __restrict__ lam, float* __restrict__ av,
                            float* __restrict__ bv) {
  __shared__ float xc[64];
  int t = blockIdx.x, n = blockIdx.y, o = threadIdx.x;
  int tq = t;
  int c = n * 64 + o;
  float s = conv_b[c];
  for (int w = 0; w < 4; ++w) {
    int tt = tq - 3 + w;
    if (tt >= 0) s += proj[(size_t)(t - 3 + w) * INTOT + 1256 + c] * conv_w[w * 512 + c];
  }
  xc[o] = s;
  __syncthreads();
  float r = b_rg[c], ig = b_ig[c];
#pragma unroll 4
  for (int i = 0; i < 64; ++i) {
    r += xc[i] * w_rg[((size_t)n * 64 + i) * 64 + o];
    ig += xc[i] * w_ig[((size_t)n * 64 + i) * 64 + o];
  }
  r = sigmoidf_(r); ig = sigmoidf_(ig);
  float l = lam[c];
  float sp = (-l > 20.f) ? -l : log1pf(expf(-l));
  float log_a = -8.f * r * sp;
  float a = expf(log_a);
  float bb = sqrtf(fmaxf(1.f - expf(2.f * log_a), 0.f)) * (ig * s);
  av[(size_t)t * 512 + c] = a;
  bv[(size_t)t * 512 + c] = bb;
}
__global__ void k_lru_scan(const float* __restrict__ av, const float* __restrict__ bv, const float* __restrict__ proj,
                           float* __restrict__ mix) {
  int idx = blockIdx.x * blockDim.x + threadIdx.x;
  int b = 0, c = idx;
  float h = 0.f;
  for (int s = 0; s < SEQ; ++s) {
    size_t t = (size_t)b * SEQ + s;
    h = av[t * 512 + c] * h + bv[t * 512 + c];
    float g = proj[t * INTOT + 1768 + c];
    mix[t * DM + 512 + c] = h * gelu_tanh(g);
  }
}

__global__ void __launch_bounds__(256) k_peer_route(const float* __restrict__ q, const float* __restrict__ k1, const float* __restrict__ k2,
                             int* __restrict__ experts, float* __restrict__ gates) {
  __shared__ float sq[256];
  __shared__ float s12[2][128];
  __shared__ float v12[2][16];
  __shared__ int i12[2][16];
  __shared__ float cand[256];
  __shared__ float tv[16];
  __shared__ int tf[16];
  int t = blockIdx.x, h = blockIdx.y, tid = threadIdx.x;
  sq[tid] = q[(size_t)t * 2048 + h * 256 + tid];
  __syncthreads();
  {
    int side = tid >> 7, n = tid & 127;
    const float* kr = (side ? k2 : k1) + ((size_t)h * 128 + n) * 128;
    float s = 0.f;
    for (int d = 0; d < 128; ++d) s += sq[side * 128 + d] * kr[d];
    s12[side][n] = s;
  }
  __syncthreads();
  {
    int side = tid >> 7, n = tid & 127;
    float v = s12[side][n];
    int rank = 0;
    for (int j = 0; j < 128; ++j) { float u = s12[side][j]; rank += (u > v || (u == v && j < n)) ? 1 : 0; }
    if (rank < 16) { v12[side][rank] = v; i12[side][rank] = n; }
  }
  __syncthreads();
  cand[tid] = v12[0][tid >> 4] + v12[1][tid & 15];
  __syncthreads();
  {
    float v = cand[tid];
    int rank = 0;
    for (int j = 0; j < 256; ++j) { float u = cand[j]; rank += (u > v || (u == v && j < tid)) ? 1 : 0; }
    if (rank < 16) { tv[rank] = v; tf[rank] = tid; }
  }
  __syncthreads();
  if (tid < 16) {
    float mx = tv[0];
    float sum = 0.f;
    for (int j = 0; j < 16; ++j) sum += expf(tv[j] - mx);
    float g = expf(tv[tid] - mx) / sum;
    int f = tf[tid];
    int e = i12[0][f >> 4] * 128 + i12[1][f & 15];
    experts[((size_t)t * 8 + h) * 16 + tid] = e;
    gates[((size_t)t * 8 + h) * 16 + tid] = g;
  }
}

__global__ void __launch_bounds__(256) k_peer_expert(const float* __restrict__ hf, const int* __restrict__ experts, const float* __restrict__ gates,
                              const float* __restrict__ u_tab, const float* __restrict__ v_tab, const float* __restrict__ x1,
                              float* __restrict__ x2) {
  __shared__ float red[4];
  __shared__ float coef[128];
  __shared__ int se[128];
  int t = blockIdx.x, tid = threadIdx.x;
  float hx[4];
  for (int i = 0; i < 4; ++i) hx[i] = hf[(size_t)t * DM + tid + i * 256];
  if (tid < 128) se[tid] = experts[(size_t)t * 128 + tid];
  __syncthreads();
  for (int k = 0; k < 128; ++k) {
    const float* ur = u_tab + (size_t)se[k] * DM;
    float s = 0.f;
    for (int i = 0; i < 4; ++i) s += ur[tid + i * 256] * hx[i];
    s = wave_sum(s);
    if ((tid & 63) == 0) red[tid >> 6] = s;
    __syncthreads();
    if (tid == 0) coef[k] = gelu_erf(red[0] + red[1] + red[2] + red[3]) * gates[(size_t)t * 128 + k];
    __syncthreads();
  }
  float acc[4] = {0.f, 0.f, 0.f, 0.f};
  for (int k = 0; k < 128; ++k) {
    const float* vr = v_tab + (size_t)se[k] * DM;
    float c = coef[k];
    for (int i = 0; i < 4; ++i) acc[i] += c * vr[tid + i * 256];
  }
  for (int i = 0; i < 4; ++i) x2[(size_t)t * DM + tid + i * 256] = x1[(size_t)t * DM + tid + i * 256] + acc[i];
}

__global__ void k_final(const float* __restrict__ x2, const float* __restrict__ gl, const float* __restrict__ ple,
                        const float* __restrict__ g, float* __restrict__ out) {
  __shared__ float red[4];
  int row = blockIdx.x, tid = threadIdx.x;
  float v[4], s = 0.f;
  for (int i = 0; i < 4; ++i) {
    size_t o = (size_t)row * DM + tid + i * 256;
    v[i] = x2[o] + sigmoidf_(gl[o]) * ple[o];
    s += v[i] * v[i];
  }
  s = wave_sum(s);
  if ((tid & 63) == 0) red[tid >> 6] = s;
  __syncthreads();
  s = red[0] + red[1] + red[2] + red[3];
  float r = rsqrtf(s / DM + 1e-6f);
  for (int i = 0; i < 4; ++i) out[(size_t)row * DM + tid + i * 256] = v[i] * r * g[tid + i * 256];
}

extern "C" void kernel_launch(void* const* d_in, const int* in_sizes, int n_in, void* d_out, int out_size, void* d_ws,
                              size_t ws_size, hipStream_t stream) {
  const float* x = (const float*)d_in[0];
  const float* p = (const float*)d_in[1];
  const int* pos = (const int*)d_in[2];
  const float* g_mix = (const float*)d_in[3];
  const float* w_in = (const float*)d_in[4];
  const float* g_kv = (const float*)d_in[5];
  const float* w_uk = (const float*)d_in[6];
  const float* w_uv = (const float*)d_in[7];
  const float* conv_w = (const float*)d_in[8];
  const float* conv_b = (const float*)d_in[9];
  const float* w_rg = (const float*)d_in[10];
  const float* b_rg = (const float*)d_in[11];
  const float* w_ig = (const float*)d_in[12];
  const float* b_ig = (const float*)d_in[13];
  const float* lam = (const float*)d_in[14];
  const float* w_out = (const float*)d_in[15];
  const float* g_ffn = (const float*)d_in[16];
  const float* w_pq = (const float*)d_in[17];
  const float* k1 = (const float*)d_in[18];
  const float* k2 = (const float*)d_in[19];
  const float* u_tab = (const float*)d_in[20];
  const float* v_tab = (const float*)d_in[21];
  const float* w_ple = (const float*)d_in[22];
  const float* w_gate = (const float*)d_in[23];
  const float* g_final = (const float*)d_in[24];
  float* out = (float*)d_out;

  char* ws = (char*)d_ws;
  size_t off = 0;
  auto alloc = [&](size_t bytes) { void* r = ws + off; off += (bytes + 255) & ~(size_t)255; return r; };
  const size_t T = SEQ;
  float* hn = (float*)alloc(T * DM * 4);
  float* proj = (float*)alloc(T * INTOT * 4);
  float* qcat = (float*)alloc(T * 640 * 4);
  float* kv = (float*)alloc(T * 160 * 4);
  float* iq = (float*)alloc(T * 512 * 4);
  float* ik = (float*)alloc(T * 64 * 4);
  float* iw = (float*)alloc(T * 8 * 4);
  int* sel = (int*)alloc(T * 256 * 4);
  float* mix = (float*)alloc(T * DM * 4);
  float* av = (float*)alloc(T * 512 * 4);
  float* bv = (float*)alloc(T * 512 * 4);
  float* x1 = (float*)alloc(T * DM * 4);
  float* hf = (float*)alloc(T * DM * 4);
  float* pq = (float*)alloc(T * 2048 * 4);
  int* experts = (int*)alloc(T * 128 * 4);
  float* gates = (float*)alloc(T * 128 * 4);
  float* x2 = (float*)alloc(T * DM * 4);
  float* gl = (float*)alloc(T * DM * 4);
  float* ple = (float*)alloc(T * DM * 4);

  for (int b = 0; b < NB; ++b) {
    const float* xs = x + (size_t)b * SEQ * DM;
    const float* ps = p + (size_t)b * SEQ * 256;
    const int* poss = pos + (size_t)b * SEQ;
    float* outs = out + (size_t)b * SEQ * DM;
    k_rmsnorm<<<T, 256, 0, stream>>>(xs, g_mix, hn);
    k_gemm<<<dim3((INTOT + 63) / 64, T / 64), 256, 0, stream>>>(hn, w_in, proj, nullptr, T, INTOT, DM);
    k_post<<<T, 256, 0, stream>>>(proj, poss, g_kv, w_uk, qcat, kv, iq, ik, iw);
    k_index<<<T, 256, 0, stream>>>(iq, ik, iw, sel);
    k_attn<<<T, 256, 0, stream>>>(qcat, kv, sel, w_uv, mix);
    k_lru_gates<<<dim3(T, 8), 64, 0, stream>>>(proj, conv_w, conv_b, w_rg, b_rg, w_ig, b_ig, lam, av, bv);
    k_lru_scan<<<512 / 64, 64, 0, stream>>>(av, bv, proj, mix);
    k_gemm<<<dim3(DM / 64, T / 64), 256, 0, stream>>>(mix, w_out, x1, xs, T, DM, DM);
    k_rmsnorm<<<T, 256, 0, stream>>>(x1, g_ffn, hf);
    k_gemm<<<dim3(2048 / 64, T / 64), 256, 0, stream>>>(hf, w_pq, pq, nullptr, T, 2048, DM);
    k_peer_route<<<dim3(T, 8), 256, 0, stream>>>(pq, k1, k2, experts, gates);
    k_peer_expert<<<T, 256, 0, stream>>>(hf, experts, gates, u_tab, v_tab, x1, x2);
    k_gemm<<<dim3(DM / 64, T / 64), 256, 0, stream>>>(x2, w_gate, gl, nullptr, T, DM, DM);
    k_gemm<<<dim3(DM / 64, T / 64), 256, 0, stream>>>(ps, w_ple, ple, nullptr, T, DM, 256);
    k_final<<<T, 256, 0, stream>>>(x2, gl, ple, g_final, outs);
  }
}
```

```cpp
#include <hip/hip_runtime.h>
#include <hip/hip_cooperative_groups.h>
#include <math.h>
#include <stdint.h>
#include <string.h>

#define T_TOK 16384
#define SEQ 2048
#define NB 8
#define DM 1024
#define INTOT 2280
#define N1 2560
#define LDS_BYTES 163840
#define PRESCALE 0.12751743f
#define IDXSCALE 0.04419417382415922f

typedef unsigned short u16;
typedef _Float16 f16;
typedef _Float16 f16x8 __attribute__((ext_vector_type(8)));
typedef _Float16 f16x4 __attribute__((ext_vector_type(4)));
typedef short s16x8 __attribute__((ext_vector_type(8)));
typedef short s16x4 __attribute__((ext_vector_type(4)));
typedef float fx4 __attribute__((ext_vector_type(4)));
typedef float fx16 __attribute__((ext_vector_type(16)));
#define LAS __attribute__((address_space(3)))
#if defined(__HIP_DEVICE_COMPILE__)
#define LDS_STORE(T, ptr, val) (*(LAS T*)(ptr) = (val))
#define LDS_ST_FX4(ptr, val) (*(LAS fx4*)(ptr) = (val))
#else
#define LDS_STORE(T, ptr, val) ((void)0)
#define LDS_ST_FX4(ptr, val) ((void)0)
#endif

__device__ __forceinline__ u16 f2bf(float f) {
  unsigned u = __float_as_uint(f);
  u += 0x7FFFu + ((u >> 16) & 1u);
  return (u16)(u >> 16);
}
__device__ __forceinline__ unsigned pack_bf2(float lo, float hi) { return (unsigned)f2bf(lo) | ((unsigned)f2bf(hi) << 16); }
__device__ __forceinline__ float bf2f(u16 v) { return __uint_as_float((unsigned)v << 16); }
__device__ __forceinline__ float bflo(unsigned v) { return __uint_as_float(v << 16); }
__device__ __forceinline__ float bfhi(unsigned v) { return __uint_as_float(v & 0xFFFF0000u); }
__device__ __forceinline__ unsigned pack_h2(float lo, float hi) {
  f16 a = (f16)lo, b = (f16)hi;
  return (unsigned)__builtin_bit_cast(unsigned short, a) | ((unsigned)__builtin_bit_cast(unsigned short, b) << 16);
}
__device__ __forceinline__ float wave_sum(float v) {
#pragma unroll
  for (int o = 32; o > 0; o >>= 1) v += __shfl_xor(v, o, 64);
  return v;
}
__device__ __forceinline__ float wave_max(float v) {
#pragma unroll
  for (int o = 32; o > 0; o >>= 1) v = fmaxf(v, __shfl_xor(v, o, 64));
  return v;
}
__device__ __forceinline__ float sigmoidf_(float x) { return 1.f / (1.f + __expf(-x)); }
__device__ __forceinline__ float gelu_tanh_f(float x) {
  const float u = 0.7978845608028654f * (x + 0.044715f * x * x * x);
  const float e = __expf(2.f * u);
  const float th = 1.f - 2.f / (e + 1.f);
  return 0.5f * x * (1.f + th);
}
__device__ __forceinline__ float gelu_erf_f(float x) { return 0.5f * x * (1.f + erff(x * 0.7071067811865476f)); }

struct P {
  const float* x; const float* p; const int* pos; const float* g_mix; const float* w_in; const float* g_kv;
  const float* w_uk; const float* w_uv; const float* conv_w; const float* conv_b; const float* w_rg; const float* b_rg;
  const float* w_ig; const float* b_ig; const float* lam; const float* w_out; const float* g_ffn; const float* w_pq;
  const float* k1; const float* k2; const float* u_tab; const float* v_tab; const float* w_ple; const float* w_gate;
  const float* g_final;
  float* out;
  u16* xb16; float* rstd_mix; float* ropeA; float* ropeI;
  u16* W1t; u16* WoutT; u16* WpqT; u16* WgT; u16* WpleT; u16* K1b; u16* K2b; u16* WrgT; u16* WigT;
  u16* Ub; u16* Vb; u16* p16;
  u16* qcat; u16* kv; u16* iqh; u16* ikh; float* iw; u16* xbr; u16* gate;
  u16* mix; u16* x1b; u16* pq; float* ss_ffn; float* ss_fin;
  int* experts; float* gates; u16* x2b; u16* pple;
  unsigned* ctr; unsigned* bar;
  int k1024, k256, pad0, pad1;
};
namespace pg8 {
#define PG8_LAS __attribute__((address_space(3)))
typedef unsigned short bf16_t;
typedef short bf16x8 __attribute__((ext_vector_type(8)));
typedef float f32x4 __attribute__((ext_vector_type(4)));
typedef unsigned u32x4 __attribute__((ext_vector_type(4)));
constexpr int BM = 256, BK = 64, HALF = 128, HTB = HALF * BK * 2  , STAGE_BYTES = 8 * HTB, NXCD = 8, WGM = 8;

__host__ __device__ __forceinline__ int lds_byte(int r, int c) { const int st = (r >> 4) * 2 + (c >> 5), rr = r & 15, cc = c & 31, ob = rr * 64 + cc * 2; return st * 1024 + (ob ^ (((ob >> 9) & 1) << 5)); }
__host__ __device__ __forceinline__ void stage_rc(int b, int& R, int& C) { const int st = b / 1024, sb = b % 1024, swz = sb ^ (((sb >> 9) & 1) << 5); R = (st >> 1) * 16 + swz / 64; C = (st & 1) * 32 + (swz % 64) / 2; }
__host__ __device__ __forceinline__ int perm32(int rho) { const int n = rho >> 4, i = rho & 15; return 8 * (i >> 2) + 4 * n + (i & 3); }

struct Unit { int pm, pn; };
struct Gemm { const bf16_t* A; const bf16_t* Bt; int M, N, K; };

struct StaticOrder {
    int nM, nN, nwg, G, c;
    __host__ __device__ void init(int M, int N, int G_, int c_) { nM = M / BM; nN = N / BM; nwg = nM * nN; G = G_; c = c_; }
    __host__ __device__ bool next(int i, Unit& u) const {
        const long L = (long)i * G + c; if (L >= nwg) return false;
        int wgid = (int)L; { const int q = nwg / NXCD, r = nwg % NXCD, xcd = wgid % NXCD, off = wgid / NXCD; wgid = (xcd < r ? xcd * (q + 1) : r * (q + 1) + (xcd - r) * q) + off; }
        const int nig = WGM * nN, gid = wgid / nig, fm = gid * WGM, gsz = (nM - fm) < WGM ? (nM - fm) : WGM;
        u.pm = fm + ((wgid % nig) % gsz); u.pn = (wgid % nig) / gsz; return true;
    }
    __device__ __forceinline__ void a_ready(const Unit&) const {}
    __device__ __forceinline__ void done(const Unit&) const {}
};
__device__ __forceinline__ unsigned cvt_pk_bf16(float lo, float hi) { unsigned r; asm volatile("v_cvt_pk_bf16_f32 %0, %1, %2" : "=v"(r) : "v"(lo), "v"(hi)); return r; }
typedef float f32x2 __attribute__((ext_vector_type(2)));
__device__ __forceinline__ f32x2 gelu_pk(f32x2 v) {
    const f32x2 av = __builtin_elementwise_abs(v), d = av * 0.2316418882f + 1.0f;
    f32x2 t; t.x = __builtin_amdgcn_rcpf(d.x); t.y = __builtin_amdgcn_rcpf(d.y);
    f32x2 q = t * 0.5307027145f + (-0.7265760135f); q = q * t + 0.7107068705f; q = q * t + (-0.142248368f); q = q * t + 0.127414796f; q = q * t;
    const f32x2 s = (v * v) * (-0.72134752044f);
    f32x2 e; e.x = __builtin_amdgcn_exp2f(s.x); e.y = __builtin_amdgcn_exp2f(s.y);
    const f32x2 m = v * (q * e), r = v - m;
    f32x2 o; o.x = v.x < 0.f ? m.x : r.x; o.y = v.y < 0.f ? m.y : r.y; return o;
}

template <class Epi, class Sched, bool STAMP = false>
__device__ __forceinline__ void gemm_phase(PG8_LAS unsigned char* lds, const Gemm g, const Sched& S, const Epi& E, unsigned long long* stamps) {
    const int tid = threadIdx.x, wid = __builtin_amdgcn_readfirstlane(tid >> 6), lane = tid & 63, wr = wid >> 2, wc = wid & 3, fr = lane & 15, fq = lane >> 4;
    const int K = g.K, nt = K / BK;
    int ts_lo = 0, ts_hi = 0, nts = 0; const unsigned long long rt_entry = STAMP ? (unsigned long long)wall_clock64() : 0ull;
#define PG8_STAMP() do { if (STAMP && wid == 0 && nts < 64) { const unsigned long long _c = (unsigned long long)clock64(); \
        ts_lo = (lane == nts) ? (int)(unsigned)_c : ts_lo; ts_hi = (lane == nts) ? (int)(unsigned)(_c >> 32) : ts_hi; ++nts; } } while (0)
    PG8_STAMP();
    unsigned voffA[2], voffB[2];
#pragma unroll
    for (int i = 0; i < 2; ++i) { int R, C; stage_rc(tid * 16 + i * 8192, R, C); const int Rb = Epi::PERM ? ((R & ~31) + perm32(R & 31)) : R;
        voffA[i] = (unsigned)(R * K + C) * 2u; voffB[i] = (unsigned)(Rb * K + C) * 2u; }
    const size_t kstep = (size_t)(BK * 2);
    const size_t hstep = (size_t)HALF * K * 2;
    const size_t tstep = 2 * hstep;
    const unsigned ldsw = (unsigned)wid * 1024u;
    const int aoff = lds_byte(wr * 64 + fr, fq * 8), boff = lds_byte(wc * 32 + fr, fq * 8);
#define PG8_SA(b, h) (((b) * 2 + (h)) * HTB)
#define PG8_SB(b, h) ((4 + (b) * 2 + (h)) * HTB)
#define PG8_STAGE(bufoff, gbase, voff) do { _Pragma("unroll") for (int _i = 0; _i < 2; ++_i) \
        __builtin_amdgcn_global_load_lds((const unsigned*)((const char*)(gbase) + (voff)[_i]), (PG8_LAS unsigned*)(lds + (bufoff) + ldsw + _i * 8192), 16, 0, 0); } while (0)
#define PG8_LDA(dst, b, h) do { _Pragma("unroll") for (int m = 0; m < 4; ++m) _Pragma("unroll") for (int k = 0; k < 2; ++k) dst[m][k] = *(const PG8_LAS bf16x8*)(lds + PG8_SA(b, h) + aoff + m * 2048 + k * 1024); } while (0)
#define PG8_LDB(dst, b, h) do { _Pragma("unroll") for (int n = 0; n < 2; ++n) _Pragma("unroll") for (int k = 0; k < 2; ++k) dst[n][k] = *(const PG8_LAS bf16x8*)(lds + PG8_SB(b, h) + boff + n * 2048 + k * 1024); } while (0)
#define PG8_MMA(ai, bj, At, Bt) do { __builtin_amdgcn_s_setprio(1); _Pragma("unroll") for (int m = 0; m < 4; ++m) _Pragma("unroll") for (int n = 0; n < 2; ++n) _Pragma("unroll") for (int k = 0; k < 2; ++k) \
        acc[ai][bj][m][n] = __builtin_amdgcn_mfma_f32_16x16x32_bf16(Bt[n][k], At[m][k], acc[ai][bj][m][n], 0, 0, 0); __builtin_amdgcn_s_setprio(0); } while (0)
#define PG8_WAIT_V(n) asm volatile("s_waitcnt vmcnt(" #n ")" ::: "memory")
#define PG8_WAIT_L(n) asm volatile("s_waitcnt lgkmcnt(" #n ")" ::: "memory")
#define PG8_BAR __builtin_amdgcn_s_barrier()
#define PG8_SCHED __builtin_amdgcn_sched_barrier(0)
    Unit cur, nxt; int ui = 0;
    if (!S.next(0, cur)) return;
    f32x4 acc[2][2][4][2];
#pragma unroll
    for (int a = 0; a < 2; ++a)
#pragma unroll
        for (int b = 0; b < 2; ++b)
#pragma unroll
            for (int m = 0; m < 4; ++m)
#pragma unroll
                for (int n = 0; n < 2; ++n) acc[a][b][m][n] = (f32x4){0.f, 0.f, 0.f, 0.f};
    bf16x8 At[4][2], B0[2][2], B1[2][2];
    const char* cA = (const char*)g.A + (size_t)cur.pm * tstep; const char* cB = (const char*)g.Bt + (size_t)cur.pn * tstep;
    S.a_ready(cur);
    PG8_STAGE(PG8_SB(0, 0), cB, voffB); PG8_STAGE(PG8_SA(0, 0), cA, voffA); PG8_STAGE(PG8_SB(0, 1), cB + hstep, voffB); PG8_STAGE(PG8_SA(0, 1), cA + hstep, voffA);
    if (wr == 1) PG8_BAR;
    PG8_WAIT_V(4); PG8_BAR;
    PG8_STAGE(PG8_SB(1, 0), cB + kstep, voffB); PG8_STAGE(PG8_SA(1, 0), cA + kstep, voffA); PG8_STAGE(PG8_SB(1, 1), cB + hstep + kstep, voffB);
    PG8_WAIT_V(6); PG8_BAR;
    PG8_STAMP();
    for (;;) {
        const bool has_next = S.next(ui + 1, nxt);
        const char* nA = has_next ? (const char*)g.A + (size_t)nxt.pm * tstep : cA; const char* nB = has_next ? (const char*)g.Bt + (size_t)nxt.pn * tstep : cB;
        for (int t = 0; t < nt; t += 2) {
            const bool last = (t == nt - 2);
            const char* a1 = cA + (size_t)(t + 1) * kstep;
            const char* a2 = last ? nA : cA + (size_t)(t + 2) * kstep; const char* b2 = last ? nB : cB + (size_t)(t + 2) * kstep;
            const char* a3 = a2 + kstep; const char* b3 = b2 + kstep;
            if (last && has_next) S.a_ready(nxt);
            PG8_LDB(B0, 0, 0); PG8_SCHED; PG8_LDA(At, 0, 0); PG8_STAGE(PG8_SA(1, 1), a1 + hstep, voffA);
            PG8_WAIT_L(8); PG8_BAR; PG8_WAIT_L(0); PG8_MMA(0, 0, At, B0); PG8_BAR; PG8_SCHED;
            PG8_LDB(B1, 0, 1); PG8_STAGE(PG8_SB(0, 0), b2, voffB);
            PG8_BAR; PG8_WAIT_L(0); PG8_MMA(0, 1, At, B1); PG8_BAR;
            PG8_LDA(At, 0, 1); PG8_STAGE(PG8_SA(0, 0), a2, voffA);
            PG8_BAR; PG8_WAIT_L(0); PG8_MMA(1, 0, At, B0); PG8_BAR; PG8_SCHED;
            PG8_STAGE(PG8_SB(0, 1), b2 + hstep, voffB);
            PG8_WAIT_V(6); PG8_BAR; PG8_MMA(1, 1, At, B1); PG8_BAR;
            PG8_LDB(B0, 1, 0); PG8_SCHED; PG8_LDA(At, 1, 0); PG8_STAGE(PG8_SA(0, 1), a2 + hstep, voffA);
            PG8_WAIT_L(8); PG8_BAR; PG8_WAIT_L(0); PG8_MMA(0, 0, At, B0); PG8_BAR; PG8_SCHED;
            PG8_LDB(B1, 1, 1); PG8_STAGE(PG8_SB(1, 0), b3, voffB);
            PG8_BAR; PG8_WAIT_L(0); PG8_MMA(0, 1, At, B1); PG8_BAR;
            PG8_LDA(At, 1, 1); PG8_STAGE(PG8_SA(1, 0), a3, voffA);
            PG8_BAR; PG8_WAIT_L(0); PG8_MMA(1, 0, At, B0); PG8_BAR; PG8_SCHED;
            PG8_STAGE(PG8_SB(1, 1), b3 + hstep, voffB);
            PG8_WAIT_V(6); PG8_BAR; PG8_MMA(1, 1, At, B1); PG8_BAR;
        }
        PG8_STAMP();
        if constexpr (!Epi::AFTER_DRAIN) { E(acc, cur, wr, wc, fr, fq); S.done(cur); }
        PG8_STAMP();
        if (!has_next) break;
#pragma unroll
        for (int a = 0; a < 2; ++a)
#pragma unroll
            for (int b = 0; b < 2; ++b)
#pragma unroll
                for (int m = 0; m < 4; ++m)
#pragma unroll
                    for (int n = 0; n < 2; ++n) acc[a][b][m][n] = (f32x4){0.f, 0.f, 0.f, 0.f};
        cur = nxt; cA = nA; cB = nB; ++ui;
    }
    PG8_WAIT_V(0);
    if (wr == 0) PG8_BAR;
    PG8_BAR;
    if constexpr (Epi::AFTER_DRAIN) { E.fused(acc, cur, wr, wc, fr, fq, lds, wid, lane); S.done(cur); }
    PG8_STAMP();
    if (STAMP && wid == 0) { stamps[lane] = lane < nts ? (((unsigned long long)(unsigned)ts_hi << 32) | (unsigned)ts_lo) : 0ull;
        if (lane == 62) stamps[62] = rt_entry; if (lane == 63) stamps[63] = (unsigned long long)wall_clock64(); }
#undef PG8_STAMP
#undef PG8_SA
#undef PG8_SB
#undef PG8_STAGE
#undef PG8_LDA
#undef PG8_LDB
#undef PG8_MMA
#undef PG8_WAIT_V
#undef PG8_WAIT_L
#undef PG8_BAR
#undef PG8_SCHED
}
}
__device__ __forceinline__ int w1_src(int n, float& mul) {
  mul = 1.f;
  if (n < 1024) { const int r = n - 512, h = r >> 6, d = r & 63;
    if (d < 16) { const int i = d >> 1, e = d & 1; return 672 + h * 64 + (e ? 8 + i : i); }
    return 672 + h * 64 + d; }
  if (n < 1536) return 1256 + (n - 1024);
  if (n < 2048) return 1768 + (n - 1536);
  if (n < 2176) { const int r = n - 2048, h = r >> 5, j = r & 31, i = j >> 1, e = j & 1; mul = PRESCALE; return h * 128 + (e ? 16 + i : i); }
  if (n < 2304) return 512 + (n - 2176);
  if (n < 2336) { const int j = n - 2304, i = j >> 1, e = j & 1; return 640 + (e ? 16 + i : i); }
  if (n < 2400) { const int d = n - 2336;
    if (d < 16) { const int i = d >> 1, e = d & 1; return 1184 + (e ? 8 + i : i); }
    return 1184 + d; }
  if (n < 2408) { mul = IDXSCALE; return 1248 + (n - 2400); }
  return -1;
}

__device__ void phase0_prep(const P& p) {
  const int tid = threadIdx.x, lane = tid & 63, wid = tid >> 6;
  const int gw = blockIdx.x * 8 + wid, nw = gridDim.x * 8;
  const int gt = blockIdx.x * 512 + tid, nt = gridDim.x * 512;
  for (int row = gw; row < T_TOK; row += nw) {
    const float4* xr = (const float4*)(p.x + (size_t)row * DM);
    uint2* xo = (uint2*)(p.xb16 + (size_t)row * DM);
    float ss = 0.f;
#pragma unroll
    for (int i = 0; i < 4; ++i) {
      const float4 v = xr[lane + 64 * i];
      ss += v.x * v.x + v.y * v.y + v.z * v.z + v.w * v.w;
      uint2 o; o.x = pack_bf2(v.x, v.y); o.y = pack_bf2(v.z, v.w);
      xo[lane + 64 * i] = o;
    }
    ss = wave_sum(ss);
    if (lane == 0) p.rstd_mix[row] = rsqrtf(ss * (1.f / DM) + 1e-6f);
    const float pos = (float)p.pos[row];
    if (lane < 16) {
      const float inv = powf(500000.f, -(float)(2 * lane) / 32.f);
      const float ang = pos * inv;
      p.ropeA[(size_t)row * 32 + lane] = cosf(ang);
      p.ropeA[(size_t)row * 32 + 16 + lane] = sinf(ang);
    } else if (lane < 24) {
      const int i = lane - 16;
      const float inv = powf(500000.f, -(float)(2 * i) / 16.f);
      const float ang = pos * inv;
      p.ropeI[(size_t)row * 16 + i] = cosf(ang);
      p.ropeI[(size_t)row * 16 + 8 + i] = sinf(ang);
    }
  }
  for (int i = gt; i < T_TOK * 256 / 4; i += nt) {
    const float4 v = ((const float4*)p.p)[i];
    uint2 o; o.x = pack_bf2(v.x, v.y); o.y = pack_bf2(v.z, v.w);
    ((uint2*)p.p16)[i] = o;
  }
  for (int i = gt; i < 16384 * 1024 / 4; i += nt) {
    const float4 v = ((const float4*)p.u_tab)[i];
    uint2 o; o.x = pack_bf2(v.x, v.y); o.y = pack_bf2(v.z, v.w);
    ((uint2*)p.Ub)[i] = o;
    const float4 w = ((const float4*)p.v_tab)[i];
    uint2 q; q.x = pack_bf2(w.x, w.y); q.y = pack_bf2(w.z, w.w);
    ((uint2*)p.Vb)[i] = q;
  }
  for (int idx = gt; idx < N1 * 1024; idx += nt) {
    const int n = idx >> 10, k = idx & 1023;
    float val;
    if (n < 512) {
      const int h = n >> 7, c = n & 127;
      const float* wr = p.w_in + (size_t)k * INTOT + h * 128 + 32;
      const float* uk = p.w_uk + (size_t)(h * 128 + c) * 96;
      float s = 0.f;
#pragma unroll 8
      for (int j = 0; j < 96; ++j) s += wr[j] * uk[j];
      val = s * PRESCALE;
    } else {
      float mul; const int src = w1_src(n, mul);
      val = (src < 0) ? 0.f : p.w_in[(size_t)k * INTOT + src] * mul;
    }
    p.W1t[idx] = f2bf(val * p.g_mix[k]);
  }
  for (int idx = gt; idx < 1024 * 1024; idx += nt) {
    const int n = idx >> 10, k = idx & 1023;
    float val;
    if (k < 512) {
      const int h = k >> 7;
      const float* uv = p.w_uv + (size_t)k * 128;
      const float* wo = p.w_out + (size_t)(h * 128) * 1024 + n;
      float s = 0.f;
#pragma unroll 8
      for (int d = 0; d < 128; ++d) s += uv[d] * wo[(size_t)d * 1024];
      val = s;
    } else val = p.w_out[(size_t)k * 1024 + n];
    p.WoutT[idx] = f2bf(val);
  }
  for (int idx = gt; idx < 2048 * 1024; idx += nt) {
    const int n = idx >> 10, k = idx & 1023;
    p.WpqT[idx] = f2bf(p.w_pq[(size_t)k * 2048 + n] * p.g_ffn[k]);
  }
  for (int idx = gt; idx < 1024 * 1024; idx += nt) {
    const int n = idx >> 10, k = idx & 1023;
    p.WgT[idx] = f2bf(p.w_gate[(size_t)k * 1024 + n]);
  }
  for (int idx = gt; idx < 1024 * 256; idx += nt) {
    const int n = idx >> 8, k = idx & 255;
    p.WpleT[idx] = f2bf(p.w_ple[(size_t)k * 1024 + n]);
  }
  for (int idx = gt; idx < 8 * 128 * 128; idx += nt) { p.K1b[idx] = f2bf(p.k1[idx]); p.K2b[idx] = f2bf(p.k2[idx]); }
  for (int idx = gt; idx < 8 * 64 * 64; idx += nt) {
    const int n = idx >> 12, o = (idx >> 6) & 63, i = idx & 63;
    p.WrgT[idx] = f2bf(p.w_rg[(size_t)n * 4096 + i * 64 + o]);
    p.WigT[idx] = f2bf(p.w_ig[(size_t)n * 4096 + i * 64 + o]);
  }
  for (int i = gt; i < T_TOK; i += nt) { p.ss_ffn[i] = 0.f; p.ss_fin[i] = 0.f; }
  if (gt < 64) p.ctr[gt] = 0u;
}
__device__ __forceinline__ pg8::f32x4 rope4(pg8::f32x4 a, const float* cs, const float* sn) {
  const float c0 = cs[0], s0 = sn[0], c1 = cs[1], s1 = sn[1];
  pg8::f32x4 o;
  o[0] = a[0] * c0 - a[1] * s0; o[1] = a[1] * c0 + a[0] * s0; o[2] = a[2] * c1 - a[3] * s1; o[3] = a[3] * c1 + a[2] * s1;
  return o;
}
struct Epi1 {
  static constexpr bool PERM = false, AFTER_DRAIN = false;
  P p; LAS float* xch;
  __device__ __forceinline__ void operator()(const pg8::f32x4 (&acc)[2][2][4][2], const pg8::Unit& u, int wr, int wc, int fr, int fq) const {
    const int pn = u.pn;
    const int rowb = u.pm * 256 + wr * 64 + fr;
    const int colb = wc * 32 + 4 * fq;
    float rs[2][4];
#pragma unroll
    for (int ai = 0; ai < 2; ++ai)
#pragma unroll
      for (int m = 0; m < 4; ++m) rs[ai][m] = p.rstd_mix[rowb + ai * 128 + m * 16];
    if (pn < 2) {
#pragma unroll
      for (int ai = 0; ai < 2; ++ai)
#pragma unroll
        for (int m = 0; m < 4; ++m) { const int row = rowb + ai * 128 + m * 16;
#pragma unroll
          for (int bj = 0; bj < 2; ++bj)
#pragma unroll
            for (int n = 0; n < 2; ++n) { const int col = pn * 256 + bj * 128 + colb + 16 * n; const int h = col >> 7, c = col & 127;
              const pg8::f32x4 v = acc[ai][bj][m][n] * rs[ai][m];
              uint2 o; o.x = pack_bf2(v[0], v[1]); o.y = pack_bf2(v[2], v[3]);
              *(uint2*)(p.qcat + ((size_t)row * 4 + h) * 160 + c) = o; } }
    } else if (pn < 4) {
#pragma unroll
      for (int ai = 0; ai < 2; ++ai)
#pragma unroll
        for (int m = 0; m < 4; ++m) { const int row = rowb + ai * 128 + m * 16;
#pragma unroll
          for (int bj = 0; bj < 2; ++bj)
#pragma unroll
            for (int n = 0; n < 2; ++n) { const int col = (pn - 2) * 256 + bj * 128 + colb + 16 * n; const int d = col & 63;
              pg8::f32x4 v = acc[ai][bj][m][n] * rs[ai][m];
              if (d < 16) { const float* cs = p.ropeI + (size_t)row * 16 + (d >> 1); v = rope4(v, cs, cs + 8); }
              uint2 o; o.x = pack_h2(v[0], v[1]); o.y = pack_h2(v[2], v[3]);
              *(uint2*)(p.iqh + (size_t)row * 512 + col) = o; } }
    } else if (pn < 8) {
      u16* dst = (pn < 6) ? p.xbr : p.gate;
      const int cb = (pn & 1) * 256;
#pragma unroll
      for (int ai = 0; ai < 2; ++ai)
#pragma unroll
        for (int m = 0; m < 4; ++m) { const int row = rowb + ai * 128 + m * 16;
#pragma unroll
          for (int bj = 0; bj < 2; ++bj)
#pragma unroll
            for (int n = 0; n < 2; ++n) { const int col = cb + bj * 128 + colb + 16 * n;
              const pg8::f32x4 v = acc[ai][bj][m][n] * rs[ai][m];
              uint2 o; o.x = pack_bf2(v[0], v[1]); o.y = pack_bf2(v[2], v[3]);
              *(uint2*)(dst + (size_t)row * 512 + col) = o; } }
    } else if (pn == 8) {
      float ps[2][4];
#pragma unroll
      for (int ai = 0; ai < 2; ++ai)
#pragma unroll
        for (int m = 0; m < 4; ++m) { const int row = rowb + ai * 128 + m * 16;
#pragma unroll
          for (int n = 0; n < 2; ++n) { const int col = colb + 16 * n; const int h = col >> 5, j0 = col & 31;
            pg8::f32x4 v = acc[ai][0][m][n] * rs[ai][m];
            const float* cs = p.ropeA + (size_t)row * 32 + (j0 >> 1); v = rope4(v, cs, cs + 16);
            uint2 o; o.x = pack_bf2(v[0], v[1]); o.y = pack_bf2(v[2], v[3]);
            *(uint2*)(p.qcat + ((size_t)row * 4 + h) * 160 + 128 + j0) = o; }
          float s = 0.f;
#pragma unroll
          for (int n = 0; n < 2; ++n) { const pg8::f32x4 v = acc[ai][1][m][n] * rs[ai][m]; s += v[0] * v[0] + v[1] * v[1] + v[2] * v[2] + v[3] * v[3]; }
          s += __shfl_xor(s, 16, 64); s += __shfl_xor(s, 32, 64);
          ps[ai][m] = s;
          if (fq == 0) xch[(wr * 4 + wc) * 128 + ai * 64 + m * 16 + fr] = s; }
      asm volatile("s_waitcnt lgkmcnt(0)" ::: "memory");
      __builtin_amdgcn_s_barrier();
      asm volatile("" ::: "memory");
#pragma unroll
      for (int ai = 0; ai < 2; ++ai)
#pragma unroll
        for (int m = 0; m < 4; ++m) { const int row = rowb + ai * 128 + m * 16; const int rr = ai * 64 + m * 16 + fr;
          const float tot = xch[(wr * 4 + 0) * 128 + rr] + xch[(wr * 4 + 1) * 128 + rr] + xch[(wr * 4 + 2) * 128 + rr] + xch[(wr * 4 + 3) * 128 + rr];
          const float rk = rsqrtf(tot * (1.f / 128.f) + 1e-6f) * rs[ai][m];
#pragma unroll
          for (int n = 0; n < 2; ++n) { const int c = colb + 16 * n;
            const float4 g = *(const float4*)(p.g_kv + c);
            const pg8::f32x4 v = acc[ai][1][m][n] * rk;
            uint2 o; o.x = pack_bf2(v[0] * g.x, v[1] * g.y); o.y = pack_bf2(v[2] * g.z, v[3] * g.w);
            *(uint2*)(p.kv + (size_t)row * 160 + c) = o; } }
      (void)ps;
    } else {
#pragma unroll
      for (int ai = 0; ai < 2; ++ai)
#pragma unroll
        for (int m = 0; m < 4; ++m) { const int row = rowb + ai * 128 + m * 16;
#pragma unroll
          for (int n = 0; n < 2; ++n) { const int col = colb + 16 * n;
            pg8::f32x4 v = acc[ai][0][m][n] * rs[ai][m];
            if (col < 32) {
              const float* cs = p.ropeA + (size_t)row * 32 + (col >> 1); v = rope4(v, cs, cs + 16);
              uint2 o; o.x = pack_bf2(v[0], v[1]); o.y = pack_bf2(v[2], v[3]);
              *(uint2*)(p.kv + (size_t)row * 160 + 128 + col) = o;
            } else if (col < 96) { const int d = col - 32;
              if (d < 16) { const float* cs = p.ropeI + (size_t)row * 16 + (d >> 1); v = rope4(v, cs, cs + 8); }
              uint2 o; o.x = pack_h2(v[0], v[1]); o.y = pack_h2(v[2], v[3]);
              *(uint2*)(p.ikh + (size_t)row * 64 + d) = o;
            } else if (col < 104) {
              *(float4*)(p.iw + (size_t)row * 8 + (col - 96)) = make_float4(v[0], v[1], v[2], v[3]);
            } } }
    }
  }
};

__device__ void phase1_gemm1(const P& p, LAS unsigned char* lds) {
  pg8::Gemm g; g.A = p.xb16; g.Bt = p.W1t; g.M = T_TOK; g.N = N1; g.K = p.k1024;
  pg8::StaticOrder S; S.init(T_TOK, N1, gridDim.x, blockIdx.x);
  Epi1 E; E.p = p; E.xch = (LAS float*)(lds + pg8::STAGE_BYTES);
  pg8::gemm_phase<Epi1, pg8::StaticOrder>(lds, g, S, E, nullptr);
}
#define L_MASK 131072
#define L_HIST 139264
#define L_CAND 147456
#define L_MISC 155648
#define KV_STRIDE 336
#define KV_TILE_BYTES (64 * KV_STRIDE)

__device__ __forceinline__ unsigned f2sort(float f) { const unsigned u = __float_as_uint(f); return (u & 0x80000000u) ? ~u : (u | 0x80000000u); }

__device__ __forceinline__ void index_scores(const P& p, LAS unsigned char* lds, int b, int tq0, int nkt, int wid, int lane) {
  const int fr = lane & 15, g = lane >> 4;
  const size_t qtok = (size_t)b * SEQ + tq0 + fr;
  f16x8 Bq[8][2];
  float w[8];
#pragma unroll
  for (int h = 0; h < 8; ++h) {
#pragma unroll
    for (int ks = 0; ks < 2; ++ks) Bq[h][ks] = *(const f16x8*)(p.iqh + qtok * 512 + h * 64 + ks * 32 + g * 8);
    w[h] = p.iw[qtok * 8 + h];
  }
  LAS float* sc = (LAS float*)lds;
  for (int kt = wid; kt < nkt; kt += 8) {
    const size_t ktok = (size_t)b * SEQ + kt * 16 + fr;
    const f16x8 A0 = *(const f16x8*)(p.ikh + ktok * 64 + g * 8);
    const f16x8 A1 = *(const f16x8*)(p.ikh + ktok * 64 + 32 + g * 8);
    fx4 tot = {0.f, 0.f, 0.f, 0.f};
#pragma unroll
    for (int h = 0; h < 8; ++h) {
      fx4 d = {0.f, 0.f, 0.f, 0.f};
      d = __builtin_amdgcn_mfma_f32_16x16x32_f16(A0, Bq[h][0], d, 0, 0, 0);
      d = __builtin_amdgcn_mfma_f32_16x16x32_f16(A1, Bq[h][1], d, 0, 0, 0);
#pragma unroll
      for (int r = 0; r < 4; ++r) tot[r] += w[h] * fmaxf(d[r], 0.f);
    }
    LDS_ST_FX4(sc + fr * 2048 + kt * 16 + 4 * g, tot);
  }
}

__device__ __forceinline__ void select_row(LAS float* row, int tq, LAS unsigned* mrow, LAS unsigned* hist, LAS unsigned* cand, int lane) {
  const int n = tq + 1;
  unsigned long long mybal = 0ull;
  if (n <= 256) {
#pragma unroll 4
    for (int j = 0; j < 32; ++j) {
      const unsigned long long bl = __ballot((j * 64 + lane) <= tq);
      if (lane == j) mybal = bl;
    }
  } else {
    const int nj = (tq >> 6) + 1;
    float vmin = INFINITY, vmax = -INFINITY;
#pragma unroll 4
    for (int j = 0; j < nj; ++j) {
      const int key = j * 64 + lane;
      const float x = row[key];
      if (key <= tq) { vmax = fmaxf(vmax, x); vmin = fminf(vmin, x); }
    }
    vmax = wave_max(vmax); vmin = -wave_max(-vmin);
    const float scale = (vmax > vmin) ? 255.5f / (vmax - vmin) : 0.f;
#pragma unroll
    for (int i = 0; i < 4; ++i) hist[lane * 4 + i] = 0u;
    asm volatile("s_waitcnt lgkmcnt(0)" ::: "memory");
#pragma unroll 4
    for (int j = 0; j < nj; ++j) {
      const int key = j * 64 + lane;
      const float x = row[key];
      if (key <= tq) {
        const int bk = min(255, (int)((x - vmin) * scale));
        __hip_atomic_fetch_add((LAS unsigned*)&hist[bk], 1u, __ATOMIC_RELAXED, __HIP_MEMORY_SCOPE_WAVEFRONT);
      }
    }
    asm volatile("s_waitcnt lgkmcnt(0)" ::: "memory");
    unsigned h40 = hist[255 - 4 * lane], h41 = hist[254 - 4 * lane], h42 = hist[253 - 4 * lane], h43 = hist[252 - 4 * lane];
    const unsigned mine = h40 + h41 + h42 + h43;
    unsigned incl = mine;
#pragma unroll
    for (int o = 1; o < 64; o <<= 1) { const unsigned t = __shfl_up(incl, o, 64); if (lane >= o) incl += t; }
    const unsigned excl = incl - mine;
    const unsigned long long cross = __ballot(excl < 256u && incl >= 256u);
    const int cl = __ffsll((long long)cross) - 1;
    int bsel; unsigned ab;
    {
      unsigned run = excl;
      if (run + h40 >= 256u) { bsel = 255 - 4 * lane; ab = run; }
      else { run += h40;
        if (run + h41 >= 256u) { bsel = 254 - 4 * lane; ab = run; }
        else { run += h41;
          if (run + h42 >= 256u) { bsel = 253 - 4 * lane; ab = run; }
          else { run += h42; bsel = 252 - 4 * lane; ab = run; } } }
    }
    const int Bsel = __shfl(bsel, cl, 64);
    const unsigned above = (unsigned)__shfl((int)ab, cl, 64);
    const unsigned need = 256u - above;
    unsigned cnt = 0;
#pragma unroll 2
    for (int j = 0; j < nj; ++j) {
      const int key = j * 64 + lane;
      const float x = row[key];
      const bool is = (key <= tq) && (min(255, (int)((x - vmin) * scale)) == Bsel);
      const unsigned long long bl = __ballot(is);
      if (bl) {
        const unsigned pos = cnt + __popcll(bl & ((1ull << lane) - 1ull));
        if (is && pos < 128u) { cand[2 * pos] = f2sort(x); cand[2 * pos + 1] = (unsigned)key; }
        cnt += __popcll(bl);
      }
    }
    asm volatile("s_waitcnt lgkmcnt(0)" ::: "memory");
    unsigned ustar = 0u, kstar = 0u;
    if (cnt <= 128u) {
      unsigned fu = 0u, fk = 0u; int found = 0;
      for (unsigned base = 0; base < cnt; base += 64) {
        const unsigned i = base + lane;
        const unsigned mu = (i < cnt) ? cand[2 * i] : 0u, mk = (i < cnt) ? cand[2 * i + 1] : 0u;
        unsigned rank = 0;
        for (unsigned q = 0; q < cnt; ++q) { const unsigned qu = cand[2 * q], qk = cand[2 * q + 1]; rank += (qu > mu || (qu == mu && qk < mk)) ? 1u : 0u; }
        if (i < cnt && rank == need - 1u) { fu = mu; fk = mk; found = 1; }
      }
      const unsigned long long fb = __ballot(found);
      const int fl = __ffsll((long long)fb) - 1;
      ustar = (unsigned)__shfl((int)fu, fl, 64); kstar = (unsigned)__shfl((int)fk, fl, 64);
    } else {
      unsigned prefix = 0u; unsigned needr = need;
      for (int bit = 31; bit >= 0; --bit) {
        const unsigned trial = prefix | (1u << bit);
        unsigned c = 0;
        for (int j = 0; j < nj; ++j) {
          const int key = j * 64 + lane;
          const float x = row[key];
          const bool inb = (key <= tq) && (min(255, (int)((x - vmin) * scale)) == Bsel);
          c += __popcll(__ballot(inb && (f2sort(x) >> bit) == (trial >> bit)));
        }
        if (c >= needr) prefix = trial; else needr -= c;
      }
      ustar = prefix;
      unsigned seen = 0; int done = 0;
      for (int j = 0; j < nj; ++j) {
        const int key = j * 64 + lane;
        const float x = row[key];
        const unsigned long long bl = __ballot((key <= tq) && f2sort(x) == ustar);
        const unsigned c = __popcll(bl);
        if (!done && seen + c >= needr) {
          unsigned long long m = bl; const unsigned k = needr - seen;
          int pos = 0;
          for (unsigned q = 0; q < k; ++q) { pos = __ffsll((long long)m) - 1; m &= m - 1ull; }
          kstar = (unsigned)(j * 64 + pos); done = 1;
        }
        seen += c;
      }
    }
#pragma unroll 4
    for (int j = 0; j < nj; ++j) {
      const int key = j * 64 + lane;
      const unsigned uu = f2sort(row[key]);
      const bool s = (key <= tq) && (uu > ustar || (uu == ustar && (unsigned)key <= kstar));
      const unsigned long long bl = __ballot(s);
      if (lane == j) mybal = bl;
    }
  }
  if (lane < 32) { mrow[2 * lane] = (unsigned)mybal; mrow[2 * lane + 1] = (unsigned)(mybal >> 32); }
}

__device__ __forceinline__ void attn_block(const P& p, LAS unsigned char* lds, int b, int t0, int wid, int lane, int tid) {
  const int fr = lane & 15, g = lane >> 4;
  const int h = wid >> 1, qs = wid & 1;
  const size_t qtok = (size_t)b * SEQ + t0 + qs * 16 + fr;
  s16x8 Qf[5];
#pragma unroll
  for (int ks = 0; ks < 5; ++ks) Qf[ks] = *(const s16x8*)(p.qcat + (qtok * 4 + h) * 160 + ks * 32 + g * 8);
  const int ntile = (t0 + 32 + 63) >> 6;
  const u16* kvb = p.kv + (size_t)b * SEQ * 160;
  LAS unsigned* mrow = (LAS unsigned*)(lds + L_MASK) + (qs * 16 + fr) * 64;
  fx4 O[8];
#pragma unroll
  for (int i = 0; i < 8; ++i) O[i] = (fx4){0.f, 0.f, 0.f, 0.f};
  float m_run = -INFINITY, l_run = 0.f;
  uint4 st0 = make_uint4(0, 0, 0, 0), st1 = st0, st2 = st0;
  const int c0i = tid, c1i = tid + 512, c2i = tid + 1024;
  const int lo0 = (c0i / 20) * KV_STRIDE + (c0i % 20) * 16, lo1 = (c1i / 20) * KV_STRIDE + (c1i % 20) * 16, lo2 = (c2i / 20) * KV_STRIDE + (c2i % 20) * 16;
#define G_LOAD(kt_) do { const uint4* src_ = (const uint4*)(kvb + (size_t)(kt_) * 64 * 160); st0 = src_[c0i]; st1 = src_[c1i]; if (c2i < 1280) st2 = src_[c2i]; } while (0)
#define L_STORE(buf_) do { LAS unsigned char* d_ = lds + (buf_) * KV_TILE_BYTES; LDS_STORE(uint4, d_ + lo0, st0); LDS_STORE(uint4, d_ + lo1, st1); if (c2i < 1280) LDS_STORE(uint4, d_ + lo2, st2); } while (0)
  G_LOAD(0); L_STORE(0);
  __syncthreads();
  for (int kt = 0; kt < ntile; ++kt) {
    const int buf = kt & 1;
    if (kt + 1 < ntile) G_LOAD(kt + 1);
    LAS unsigned char* kb = lds + buf * KV_TILE_BYTES;
#pragma unroll
    for (int ksub = 0; ksub < 2; ++ksub) {
      fx4 S[2];
#pragma unroll
      for (int sub = 0; sub < 2; ++sub) {
        fx4 a = {0.f, 0.f, 0.f, 0.f};
        const int krow = ksub * 32 + sub * 16 + fr;
#pragma unroll
        for (int ks = 0; ks < 5; ++ks) {
          const s16x8 Kf = *(LAS s16x8*)(kb + krow * KV_STRIDE + ks * 64 + g * 16);
          a = __builtin_amdgcn_mfma_f32_16x16x32_bf16(Kf, Qf[ks], a, 0, 0, 0);
        }
        S[sub] = a;
      }
      const unsigned mw = mrow[kt * 2 + ksub];
      float mx = -INFINITY;
#pragma unroll
      for (int sub = 0; sub < 2; ++sub)
#pragma unroll
        for (int r = 0; r < 4; ++r) { const int bit = sub * 16 + 4 * g + r; const float s = ((mw >> bit) & 1u) ? S[sub][r] : -INFINITY; S[sub][r] = s; mx = fmaxf(mx, s); }
      mx = fmaxf(mx, __shfl_xor(mx, 16, 64)); mx = fmaxf(mx, __shfl_xor(mx, 32, 64));
      const float m_new = fmaxf(m_run, mx);
      const float m_use = (m_new == -INFINITY) ? 0.f : m_new;
      const float alpha = exp2f(m_run - m_use);
      m_run = m_new;
      float psum = 0.f;
      s16x8 Pf;
#pragma unroll
      for (int sub = 0; sub < 2; ++sub)
#pragma unroll
        for (int r = 0; r < 4; ++r) { const float pv = exp2f(S[sub][r] - m_use); psum += pv; Pf[sub * 4 + r] = (short)f2bf(pv); }
      l_run = l_run * alpha + psum;
#pragma unroll
      for (int i = 0; i < 8; ++i) O[i] *= alpha;
      const int q4 = fr >> 2, p4 = fr & 3;
      LAS unsigned char* vb0 = kb + (ksub * 32 + 4 * g + q4) * KV_STRIDE + p4 * 8;
#pragma unroll
      for (int dvt = 0; dvt < 8; ++dvt) {
        const s16x4 v0 = __builtin_amdgcn_ds_read_tr16_b64_v4i16((LAS s16x4*)(vb0 + dvt * 32));
        const s16x4 v1 = __builtin_amdgcn_ds_read_tr16_b64_v4i16((LAS s16x4*)(vb0 + 16 * KV_STRIDE + dvt * 32));
        s16x8 Vf; Vf[0] = v0[0]; Vf[1] = v0[1]; Vf[2] = v0[2]; Vf[3] = v0[3]; Vf[4] = v1[0]; Vf[5] = v1[1]; Vf[6] = v1[2]; Vf[7] = v1[3];
        O[dvt] = __builtin_amdgcn_mfma_f32_16x16x32_bf16(Vf, Pf, O[dvt], 0, 0, 0);
      }
    }
    if (kt + 1 < ntile) L_STORE(buf ^ 1);
    __syncthreads();
  }
  float l_tot = l_run + __shfl_xor(l_run, 16, 64); l_tot += __shfl_xor(l_tot, 32, 64);
  const float inv = 1.f / l_tot;
  u16* dst = p.mix + qtok * 1024 + h * 128 + 4 * g;
#pragma unroll
  for (int dvt = 0; dvt < 8; ++dvt) {
    uint2 o; o.x = pack_bf2(O[dvt][0] * inv, O[dvt][1] * inv); o.y = pack_bf2(O[dvt][2] * inv, O[dvt][3] * inv);
    *(uint2*)(dst + dvt * 16) = o;
  }
}

#define LR_XCB 0
#define LR_XCF 18432
#define LR_A   51200
#define LR_B   83968
#define LR_SEG 116736
__device__ void lru_item(const P& p, LAS unsigned char* lds, int b, int blk, int tid) {
  const int lane = tid & 63, wid = tid >> 6, fr = lane & 15, g = lane >> 4;
  LAS u16* xcb = (LAS u16*)(lds + LR_XCB);
  LAS float* xcf = (LAS float*)(lds + LR_XCF);
  LAS float* a_s = (LAS float*)(lds + LR_A);
  LAS float* b_s = (LAS float*)(lds + LR_B);
  LAS float* segP = (LAS float*)(lds + LR_SEG);
  LAS float* segH = segP + 512;
  LAS float* carry = segH + 512;
  LAS float* Hprev = carry + 512;
  LAS float* cw = Hprev + 64;
  LAS float* cb = cw + 256;
  const int c0 = blk * 64;
  if (tid < 256) cw[tid] = p.conv_w[(tid >> 6) * 512 + c0 + (tid & 63)];
  if (tid < 64) { cb[tid] = p.conv_b[c0 + tid]; Hprev[tid] = 0.f; }
  float brg[4], big[4], spl[4];
#pragma unroll
  for (int nt = 0; nt < 4; ++nt) {
    const int c = c0 + nt * 16 + fr;
    brg[nt] = p.b_rg[c]; big[nt] = p.b_ig[c];
    const float l = p.lam[c];
    spl[nt] = (-l > 20.f) ? -l : log1pf(__expf(-l));
  }
  const u16* wrg = p.WrgT + (size_t)blk * 4096 + fr * 64 + g * 8;
  const u16* wig = p.WigT + (size_t)blk * 4096 + fr * 64 + g * 8;
  __syncthreads();
  const int tok_l = tid >> 2, cg = tid & 3;
  for (int s0 = 0; s0 < SEQ; s0 += 128) {
    {
      float acc[16];
#pragma unroll
      for (int i = 0; i < 16; ++i) acc[i] = cb[cg * 16 + i];
      const int s = s0 + tok_l;
#pragma unroll
      for (int w = 0; w < 4; ++w) {
        const int ss = s - 3 + w;
        if (ss >= 0) {
          const uint4* src = (const uint4*)(p.xbr + ((size_t)b * SEQ + ss) * 512 + c0 + cg * 16);
          const uint4 u0 = src[0], u1 = src[1];
          const unsigned uu[8] = {u0.x, u0.y, u0.z, u0.w, u1.x, u1.y, u1.z, u1.w};
#pragma unroll
          for (int i = 0; i < 8; ++i) { acc[2 * i] += bflo(uu[i]) * cw[w * 64 + cg * 16 + 2 * i]; acc[2 * i + 1] += bfhi(uu[i]) * cw[w * 64 + cg * 16 + 2 * i + 1]; }
        }
      }
#pragma unroll
      for (int i = 0; i < 16; i += 4) { const fx4 t4 = {acc[i], acc[i + 1], acc[i + 2], acc[i + 3]}; LDS_ST_FX4(xcf + tok_l * 64 + cg * 16 + i, t4); }
#pragma unroll
      for (int i = 0; i < 16; i += 4) { uint2 o; o.x = pack_bf2(acc[i], acc[i + 1]); o.y = pack_bf2(acc[i + 2], acc[i + 3]); LDS_STORE(uint2, xcb + tok_l * 72 + cg * 16 + i, o); }
    }
    __syncthreads();
    {
      const s16x8 A0 = *(LAS s16x8*)(xcb + (wid * 16 + fr) * 72 + g * 8);
      const s16x8 A1 = *(LAS s16x8*)(xcb + (wid * 16 + fr) * 72 + 32 + g * 8);
#pragma unroll
      for (int nt = 0; nt < 4; ++nt) {
        fx4 R = {0.f, 0.f, 0.f, 0.f}, I = {0.f, 0.f, 0.f, 0.f};
        const s16x8 br0 = *(const s16x8*)(wrg + nt * 1024), br1 = *(const s16x8*)(wrg + nt * 1024 + 32);
        const s16x8 bi0 = *(const s16x8*)(wig + nt * 1024), bi1 = *(const s16x8*)(wig + nt * 1024 + 32);
        R = __builtin_amdgcn_mfma_f32_16x16x32_bf16(A0, br0, R, 0, 0, 0);
        R = __builtin_amdgcn_mfma_f32_16x16x32_bf16(A1, br1, R, 0, 0, 0);
        I = __builtin_amdgcn_mfma_f32_16x16x32_bf16(A0, bi0, I, 0, 0, 0);
        I = __builtin_amdgcn_mfma_f32_16x16x32_bf16(A1, bi1, I, 0, 0, 0);
#pragma unroll
        for (int r = 0; r < 4; ++r) {
          const int tok = wid * 16 + 4 * g + r, o = nt * 16 + fr;
          const float rr = sigmoidf_(R[r] + brg[nt]), ii = sigmoidf_(I[r] + big[nt]);
          const float log_a = -8.f * rr * spl[nt];
          const float a = __expf(log_a);
          const float bb = sqrtf(fmaxf(1.f - a * a, 0.f)) * (ii * xcf[tok * 64 + o]);
          a_s[tok * 64 + o] = a; b_s[tok * 64 + o] = bb;
        }
      }
    }
    __syncthreads();
    {
      float hh = 0.f, pp = 1.f;
#pragma unroll
      for (int i = 0; i < 16; ++i) { const int tok = wid * 16 + i; const float a = a_s[tok * 64 + lane], bb = b_s[tok * 64 + lane];
        hh = a * hh + bb; pp *= a; b_s[tok * 64 + lane] = hh; a_s[tok * 64 + lane] = pp; }
      segP[wid * 64 + lane] = pp; segH[wid * 64 + lane] = hh;
    }
    __syncthreads();
    if (tid < 64) {
      float c = Hprev[tid];
#pragma unroll
      for (int sg = 0; sg < 8; ++sg) { carry[sg * 64 + tid] = c; c = segP[sg * 64 + tid] * c + segH[sg * 64 + tid]; }
      Hprev[tid] = c;
    }
    __syncthreads();
    {
      const size_t t = (size_t)b * SEQ + s0 + tok_l;
      const uint4* gsrc = (const uint4*)(p.gate + t * 512 + c0 + cg * 16);
      const uint4 g0 = gsrc[0], g1 = gsrc[1];
      const unsigned gg[8] = {g0.x, g0.y, g0.z, g0.w, g1.x, g1.y, g1.z, g1.w};
      unsigned oo[8];
#pragma unroll
      for (int i = 0; i < 8; ++i) {
        const int o0 = cg * 16 + 2 * i;
        const float cr0 = carry[(tok_l >> 4) * 64 + o0], cr1 = carry[(tok_l >> 4) * 64 + o0 + 1];
        const float h0 = b_s[tok_l * 64 + o0] + a_s[tok_l * 64 + o0] * cr0;
        const float h1 = b_s[tok_l * 64 + o0 + 1] + a_s[tok_l * 64 + o0 + 1] * cr1;
        oo[i] = pack_bf2(h0 * gelu_tanh_f(bflo(gg[i])), h1 * gelu_tanh_f(bfhi(gg[i])));
      }
      uint4* dst = (uint4*)(p.mix + t * 1024 + 512 + c0 + cg * 16);
      dst[0] = make_uint4(oo[0], oo[1], oo[2], oo[3]); dst[1] = make_uint4(oo[4], oo[5], oo[6], oo[7]);
    }
    __syncthreads();
  }
}

__device__ void phase2(const P& p, LAS unsigned char* lds) {
  const int tid = threadIdx.x, lane = tid & 63, wid = tid >> 6;
  LAS int* misc = (LAS int*)(lds + L_MISC);
  if (blockIdx.x < 64) lru_item(p, lds, blockIdx.x >> 3, blockIdx.x & 7, tid);
  for (;;) {
    __syncthreads();
    if (tid == 0) misc[0] = (int)atomicAdd(p.ctr, 1u);
    __syncthreads();
    const int a = misc[0];
    if (a >= 512) break;
    const int qb = 63 - (a >> 3), b = a & 7;
    const int t0 = qb * 32;
    for (int r = 0; r < 2; ++r) {
      const int tq0 = t0 + 16 * r;
      index_scores(p, lds, b, tq0, (tq0 >> 4) + 1, wid, lane);
      __syncthreads();
#pragma unroll 1
      for (int qq = 0; qq < 2; ++qq) {
        const int qi = wid * 2 + qq;
        select_row((LAS float*)lds + qi * 2048, tq0 + qi, (LAS unsigned*)(lds + L_MASK) + (r * 16 + qi) * 64,
                   (LAS unsigned*)(lds + L_HIST) + wid * 256, (LAS unsigned*)(lds + L_CAND) + wid * 256, lane);
      }
      __syncthreads();
    }
    attn_block(p, lds, b, t0, wid, lane, tid);
  }
}
struct Epi3 {
  static constexpr bool PERM = false, AFTER_DRAIN = false;
  P p;
  __device__ __forceinline__ void operator()(const pg8::f32x4 (&acc)[2][2][4][2], const pg8::Unit& u, int wr, int wc, int fr, int fq) const {
    const int rowb = u.pm * 256 + wr * 64 + fr;
    const int colb = u.pn * 256 + wc * 32 + 4 * fq;
#pragma unroll
    for (int ai = 0; ai < 2; ++ai)
#pragma unroll
      for (int m = 0; m < 4; ++m) { const int row = rowb + ai * 128 + m * 16;
        float s = 0.f;
#pragma unroll
        for (int bj = 0; bj < 2; ++bj)
#pragma unroll
          for (int n = 0; n < 2; ++n) { const int col = colb + bj * 128 + 16 * n;
            const float4 xr = *(const float4*)(p.x + (size_t)row * DM + col);
            const pg8::f32x4 a = acc[ai][bj][m][n];
            const float v0 = a[0] + xr.x, v1 = a[1] + xr.y, v2 = a[2] + xr.z, v3 = a[3] + xr.w;
            s += v0 * v0 + v1 * v1 + v2 * v2 + v3 * v3;
            *(float4*)(p.out + (size_t)row * DM + col) = make_float4(v0, v1, v2, v3);
            uint2 o; o.x = pack_bf2(v0, v1); o.y = pack_bf2(v2, v3);
            *(uint2*)(p.x1b + (size_t)row * DM + col) = o; }
        s += __shfl_xor(s, 16, 64); s += __shfl_xor(s, 32, 64);
        if (fq == 0) atomicAdd(p.ss_ffn + row, s); }
  }
};
__device__ void phase3_outproj(const P& p, LAS unsigned char* lds) {
  pg8::Gemm g; g.A = p.mix; g.Bt = p.WoutT; g.M = T_TOK; g.N = 1024; g.K = p.k1024;
  pg8::StaticOrder S; S.init(T_TOK, 1024, gridDim.x, blockIdx.x);
  Epi3 E; E.p = p;
  pg8::gemm_phase<Epi3, pg8::StaticOrder>(lds, g, S, E, nullptr);
}
struct Epi4 {
  static constexpr bool PERM = false, AFTER_DRAIN = false;
  P p;
  __device__ __forceinline__ void operator()(const pg8::f32x4 (&acc)[2][2][4][2], const pg8::Unit& u, int wr, int wc, int fr, int fq) const {
    const int rowb = u.pm * 256 + wr * 64 + fr;
    const int colb = u.pn * 256 + wc * 32 + 4 * fq;
#pragma unroll
    for (int ai = 0; ai < 2; ++ai)
#pragma unroll
      for (int m = 0; m < 4; ++m) { const int row = rowb + ai * 128 + m * 16;
        const float rs = rsqrtf(p.ss_ffn[row] * (1.f / DM) + 1e-6f);
#pragma unroll
        for (int bj = 0; bj < 2; ++bj)
#pragma unroll
          for (int n = 0; n < 2; ++n) { const int col = colb + bj * 128 + 16 * n;
            const pg8::f32x4 v = acc[ai][bj][m][n] * rs;
            uint2 o; o.x = pack_bf2(v[0], v[1]); o.y = pack_bf2(v[2], v[3]);
            *(uint2*)(p.pq + (size_t)row * 2048 + col) = o; } }
  }
};
__device__ void phase4_pq(const P& p, LAS unsigned char* lds) {
  pg8::Gemm g; g.A = p.x1b; g.Bt = p.WpqT; g.M = T_TOK; g.N = 2048; g.K = p.k1024;
  pg8::StaticOrder S; S.init(T_TOK, 2048, gridDim.x, blockIdx.x);
  Epi4 E; E.p = p;
  pg8::gemm_phase<Epi4, pg8::StaticOrder>(lds, g, S, E, nullptr);
}

#ifdef USE_SHFL_ROW
__device__ __forceinline__ unsigned row16_max_u32(unsigned x) {
  x = max(x, (unsigned)__shfl_xor((int)x, 1, 64)); x = max(x, (unsigned)__shfl_xor((int)x, 2, 64));
  x = max(x, (unsigned)__shfl_xor((int)x, 4, 64)); x = max(x, (unsigned)__shfl_xor((int)x, 8, 64)); return x; }
__device__ __forceinline__ float row16_sum_f32(float x) {
  x += __shfl_xor(x, 1, 64); x += __shfl_xor(x, 2, 64); x += __shfl_xor(x, 4, 64); x += __shfl_xor(x, 8, 64); return x; }
#else
#define DPP_U(x, ctrl) ((unsigned)__builtin_amdgcn_update_dpp(0, (int)(x), (ctrl), 0xF, 0xF, true))
__device__ __forceinline__ unsigned row16_max_u32(unsigned x) {
  x = max(x, DPP_U(x, 0xB1)); x = max(x, DPP_U(x, 0x4E)); x = max(x, DPP_U(x, 0x141)); x = max(x, DPP_U(x, 0x140)); return x; }
__device__ __forceinline__ float row16_sum_f32(float x) {
  x += __uint_as_float(DPP_U(__float_as_uint(x), 0xB1)); x += __uint_as_float(DPP_U(__float_as_uint(x), 0x4E));
  x += __uint_as_float(DPP_U(__float_as_uint(x), 0x141)); x += __uint_as_float(DPP_U(__float_as_uint(x), 0x140)); return x; }
#endif
__device__ __forceinline__ float sort2f(unsigned u) { const unsigned b = (u & 0x80000000u) ? (u & 0x7FFFFFFFu) : ~u; return __uint_as_float(b); }

__device__ void phase4b_route(const P& p, LAS unsigned char* lds) {
  const int tid = threadIdx.x, lane = tid & 63, wid = tid >> 6, fr = lane & 15, g = lane >> 4;
  LAS unsigned* topk = (LAS unsigned*)lds;
  const int nitems = (T_TOK / 64) * 8;
  for (int item = blockIdx.x; item < nitems; item += gridDim.x) {
    const int h = item & 7, tile = item >> 3;
    const int tok0 = tile * 64;
    {
      const int side = wid & 1, mt = wid >> 1;
      const size_t tok = (size_t)tok0 + mt * 16 + fr;
      const u16* qa = p.pq + tok * 2048 + h * 256 + side * 128 + g * 8;
      s16x8 A[4];
#pragma unroll
      for (int ks = 0; ks < 4; ++ks) A[ks] = *(const s16x8*)(qa + ks * 32);
      const u16* kb = (side ? p.K2b : p.K1b) + (size_t)h * 16384 + fr * 128 + g * 8;
      unsigned val[8][4];
#pragma unroll
      for (int nt = 0; nt < 8; ++nt) {
        fx4 acc = {0.f, 0.f, 0.f, 0.f};
#pragma unroll
        for (int ks = 0; ks < 4; ++ks) {
          const s16x8 B = *(const s16x8*)(kb + nt * 2048 + ks * 32);
          acc = __builtin_amdgcn_mfma_f32_16x16x32_bf16(A[ks], B, acc, 0, 0, 0);
        }
        const unsigned tag = 127u - (unsigned)(nt * 16 + fr);
#pragma unroll
        for (int r = 0; r < 4; ++r) val[nt][r] = (f2sort(acc[r]) & ~0x7Fu) | tag;
      }
#pragma unroll
      for (int r = 0; r < 4; ++r) {
        unsigned mine = 0u;
#pragma unroll 1
        for (int i = 0; i < 16; ++i) {
          unsigned m = max(max(max(val[0][r], val[1][r]), max(val[2][r], val[3][r])), max(max(val[4][r], val[5][r]), max(val[6][r], val[7][r])));
          m = row16_max_u32(m);
#pragma unroll
          for (int nt = 0; nt < 8; ++nt) val[nt][r] = (val[nt][r] == m) ? 0u : val[nt][r];
          if (fr == i) mine = m;
        }
        topk[((mt * 16 + 4 * g + r) * 2 + side) * 16 + fr] = mine;
      }
    }
    __syncthreads();
#pragma unroll 1
    for (int rd = 0; rd < 2; ++rd) {
      const int tl = wid * 8 + rd * 4 + g;
      LAS unsigned* t1 = topk + (tl * 2 + 0) * 16;
      LAS unsigned* t2 = topk + (tl * 2 + 1) * 16;
      unsigned cv[4];
#pragma unroll
      for (int j = 0; j < 4; ++j) {
        const int s = fr + 16 * j;
        int a, bb;
        if (s < 16) { a = 0; bb = s; } else if (s < 24) { a = 1; bb = s - 16; } else if (s < 29) { a = 2; bb = s - 24; } else if (s < 33) { a = 3; bb = s - 29; }
        else if (s < 36) { a = 4; bb = s - 33; } else if (s < 38) { a = 5; bb = s - 36; } else if (s < 40) { a = 6; bb = s - 38; } else if (s < 42) { a = 7; bb = s - 40; }
        else if (s < 50) { a = 8 + (s - 42); bb = 0; } else { a = -1; bb = 0; }
        unsigned key = 0u;
        if (a >= 0) {
          const float sum = sort2f(t1[a] & ~0x7Fu) + sort2f(t2[bb] & ~0x7Fu);
          key = (f2sort(sum) & ~0xFFu) | (unsigned)(255 - (a * 16 + bb));
        }
        cv[j] = key;
      }
      unsigned mine = 0u;
#pragma unroll 1
      for (int i = 0; i < 16; ++i) {
        unsigned m = max(max(cv[0], cv[1]), max(cv[2], cv[3]));
        m = row16_max_u32(m);
#pragma unroll
        for (int j = 0; j < 4; ++j) cv[j] = (cv[j] == m) ? 0u : cv[j];
        if (fr == i) mine = m;
      }
      const int flat = 255 - (int)(mine & 0xFFu);
      const int a = flat >> 4, bb = flat & 15;
      const unsigned k1 = t1[a], k2 = t2[bb];
      const float sum = sort2f(k1 & ~0x7Fu) + sort2f(k2 & ~0x7Fu);
      const unsigned m0 = (unsigned)__shfl((int)mine, lane & 48, 64);
      const int f0 = 255 - (int)(m0 & 0xFFu);
      const float s0 = sort2f(t1[f0 >> 4] & ~0x7Fu) + sort2f(t2[f0 & 15] & ~0x7Fu);
      const float ex = __expf(sum - s0);
      const float den = row16_sum_f32(ex);
      const int e = (127 - (int)(k1 & 0x7Fu)) * 128 + (127 - (int)(k2 & 0x7Fu));
      const size_t t = (size_t)tok0 + tl;
      p.experts[t * 128 + h * 16 + fr] = e;
      p.gates[t * 128 + h * 16 + fr] = ex / den;
    }
    __syncthreads();
  }
}
typedef __bf16 bf16x2_t __attribute__((ext_vector_type(2)));
__device__ __forceinline__ float dot2bf(unsigned a, unsigned b, float c) {
  return __builtin_amdgcn_fdot2_f32_bf16(__builtin_bit_cast(bf16x2_t, a), __builtin_bit_cast(bf16x2_t, b), c, false);
}
__device__ __forceinline__ int brev6(int x) { return (int)(__builtin_bitreverse32((unsigned)x) >> 26); }

__device__ void phase5_experts(const P& p) {
  const int tid = threadIdx.x, lane = tid & 63, wid = tid >> 6;
  const int gw = blockIdx.x * 8 + wid, nw = gridDim.x * 8;
  const int rl = brev6(lane);
  for (int t = gw; t < T_TOK; t += nw) {
    float* x1r = p.out + (size_t)t * DM;
    const float4 xa0 = *(const float4*)(x1r + 8 * lane), xa1 = *(const float4*)(x1r + 8 * lane + 4);
    const float4 xb0 = *(const float4*)(x1r + 512 + 8 * lane), xb1 = *(const float4*)(x1r + 512 + 8 * lane + 4);
    const float rs = rsqrtf(p.ss_ffn[t] * (1.f / DM) + 1e-6f);
    unsigned hfp[8];
    {
      const float4 ga0 = *(const float4*)(p.g_ffn + 8 * lane), ga1 = *(const float4*)(p.g_ffn + 8 * lane + 4);
      const float4 gb0 = *(const float4*)(p.g_ffn + 512 + 8 * lane), gb1 = *(const float4*)(p.g_ffn + 512 + 8 * lane + 4);
      hfp[0] = pack_bf2(xa0.x * rs * ga0.x, xa0.y * rs * ga0.y); hfp[1] = pack_bf2(xa0.z * rs * ga0.z, xa0.w * rs * ga0.w);
      hfp[2] = pack_bf2(xa1.x * rs * ga1.x, xa1.y * rs * ga1.y); hfp[3] = pack_bf2(xa1.z * rs * ga1.z, xa1.w * rs * ga1.w);
      hfp[4] = pack_bf2(xb0.x * rs * gb0.x, xb0.y * rs * gb0.y); hfp[5] = pack_bf2(xb0.z * rs * gb0.z, xb0.w * rs * gb0.w);
      hfp[6] = pack_bf2(xb1.x * rs * gb1.x, xb1.y * rs * gb1.y); hfp[7] = pack_bf2(xb1.z * rs * gb1.z, xb1.w * rs * gb1.w);
    }
    const int ev0 = p.experts[(size_t)t * 128 + lane], ev1 = p.experts[(size_t)t * 128 + 64 + lane];
    const float gv0 = p.gates[(size_t)t * 128 + lane], gv1 = p.gates[(size_t)t * 128 + 64 + lane];
    float cc[2];
#pragma unroll
    for (int half = 0; half < 2; ++half) {
      const int ev = half ? ev1 : ev0;
      float part[64];
#pragma unroll
      for (int s = 0; s < 64; ++s) {
        const int e = __builtin_amdgcn_readlane(ev, s);
        const u16* row = p.Ub + (size_t)e * DM;
        const uint4 r0 = *(const uint4*)(row + 8 * lane), r1 = *(const uint4*)(row + 512 + 8 * lane);
        float d = dot2bf(r0.x, hfp[0], 0.f);
        d = dot2bf(r0.y, hfp[1], d); d = dot2bf(r0.z, hfp[2], d); d = dot2bf(r0.w, hfp[3], d);
        d = dot2bf(r1.x, hfp[4], d); d = dot2bf(r1.y, hfp[5], d); d = dot2bf(r1.z, hfp[6], d); d = dot2bf(r1.w, hfp[7], d);
        part[s] = d;
      }
#pragma unroll
      for (int st = 0; st < 6; ++st) {
        const int o = 32 >> st, cnt = 64 >> st;
        const bool up = (lane & o) != 0;
#pragma unroll
        for (int i = 0; i < cnt / 2; ++i) {
          const float a = part[2 * i], b = part[2 * i + 1];
          const float send = up ? a : b, keep = up ? b : a;
          part[i] = keep + __shfl_xor(send, o, 64);
        }
      }
      const float gsel = __shfl(half ? gv1 : gv0, rl, 64);
      cc[half] = gelu_erf_f(part[0]) * gsel;
    }
    float acc[16];
#pragma unroll
    for (int i = 0; i < 16; ++i) acc[i] = 0.f;
#pragma unroll 1
    for (int half = 0; half < 2; ++half) {
      const int ev = half ? ev1 : ev0;
      const float cv = half ? cc[1] : cc[0];
#pragma unroll 8
      for (int s = 0; s < 64; ++s) {
        const int e = __builtin_amdgcn_readlane(ev, s);
        const float c = __builtin_bit_cast(float, __builtin_amdgcn_readlane(__builtin_bit_cast(int, cv), brev6(s)));
        const u16* row = p.Vb + (size_t)e * DM;
        const uint4 r0 = *(const uint4*)(row + 8 * lane), r1 = *(const uint4*)(row + 512 + 8 * lane);
        acc[0] += c * bflo(r0.x); acc[1] += c * bfhi(r0.x); acc[2] += c * bflo(r0.y); acc[3] += c * bfhi(r0.y);
        acc[4] += c * bflo(r0.z); acc[5] += c * bfhi(r0.z); acc[6] += c * bflo(r0.w); acc[7] += c * bfhi(r0.w);
        acc[8] += c * bflo(r1.x); acc[9] += c * bfhi(r1.x); acc[10] += c * bflo(r1.y); acc[11] += c * bfhi(r1.y);
        acc[12] += c * bflo(r1.z); acc[13] += c * bfhi(r1.z); acc[14] += c * bflo(r1.w); acc[15] += c * bfhi(r1.w);
      }
    }
    const float o0 = xa0.x + acc[0], o1 = xa0.y + acc[1], o2 = xa0.z + acc[2], o3 = xa0.w + acc[3];
    const float o4 = xa1.x + acc[4], o5 = xa1.y + acc[5], o6 = xa1.z + acc[6], o7 = xa1.w + acc[7];
    const float q0 = xb0.x + acc[8], q1 = xb0.y + acc[9], q2 = xb0.z + acc[10], q3 = xb0.w + acc[11];
    const float q4 = xb1.x + acc[12], q5 = xb1.y + acc[13], q6 = xb1.z + acc[14], q7 = xb1.w + acc[15];
    *(float4*)(x1r + 8 * lane) = make_float4(o0, o1, o2, o3); *(float4*)(x1r + 8 * lane + 4) = make_float4(o4, o5, o6, o7);
    *(float4*)(x1r + 512 + 8 * lane) = make_float4(q0, q1, q2, q3); *(float4*)(x1r + 512 + 8 * lane + 4) = make_float4(q4, q5, q6, q7);
    u16* x2r = p.x2b + (size_t)t * DM;
    *(uint4*)(x2r + 8 * lane) = make_uint4(pack_bf2(o0, o1), pack_bf2(o2, o3), pack_bf2(o4, o5), pack_bf2(o6, o7));
    *(uint4*)(x2r + 512 + 8 * lane) = make_uint4(pack_bf2(q0, q1), pack_bf2(q2, q3), pack_bf2(q4, q5), pack_bf2(q6, q7));
  }
}

struct Epi6a {
  static constexpr bool PERM = false, AFTER_DRAIN = false;
  P p;
  __device__ __forceinline__ void operator()(const pg8::f32x4 (&acc)[2][2][4][2], const pg8::Unit& u, int wr, int wc, int fr, int fq) const {
    const int rowb = u.pm * 256 + wr * 64 + fr;
    const int colb = u.pn * 256 + wc * 32 + 4 * fq;
#pragma unroll
    for (int ai = 0; ai < 2; ++ai)
#pragma unroll
      for (int m = 0; m < 4; ++m) { const int row = rowb + ai * 128 + m * 16;
#pragma unroll
        for (int bj = 0; bj < 2; ++bj)
#pragma unroll
          for (int n = 0; n < 2; ++n) { const int col = colb + bj * 128 + 16 * n;
            const pg8::f32x4 v = acc[ai][bj][m][n];
            uint2 o; o.x = pack_bf2(v[0], v[1]); o.y = pack_bf2(v[2], v[3]);
            *(uint2*)(p.pple + (size_t)row * DM + col) = o; } }
  }
};
struct Epi6b {
  static constexpr bool PERM = false, AFTER_DRAIN = false;
  P p;
  __device__ __forceinline__ void operator()(const pg8::f32x4 (&acc)[2][2][4][2], const pg8::Unit& u, int wr, int wc, int fr, int fq) const {
    const int rowb = u.pm * 256 + wr * 64 + fr;
    const int colb = u.pn * 256 + wc * 32 + 4 * fq;
#pragma unroll
    for (int ai = 0; ai < 2; ++ai)
#pragma unroll
      for (int m = 0; m < 4; ++m) { const int row = rowb + ai * 128 + m * 16;
        float s = 0.f;
#pragma unroll
        for (int bj = 0; bj < 2; ++bj)
#pragma unroll
          for (int n = 0; n < 2; ++n) { const int col = colb + bj * 128 + 16 * n;
            const float4 x2 = *(const float4*)(p.out + (size_t)row * DM + col);
            const uint2 pw = *(const uint2*)(p.pple + (size_t)row * DM + col);
            const pg8::f32x4 a = acc[ai][bj][m][n];
            const float v0 = x2.x + sigmoidf_(a[0]) * bflo(pw.x), v1 = x2.y + sigmoidf_(a[1]) * bfhi(pw.x);
            const float v2 = x2.z + sigmoidf_(a[2]) * bflo(pw.y), v3 = x2.w + sigmoidf_(a[3]) * bfhi(pw.y);
            s += v0 * v0 + v1 * v1 + v2 * v2 + v3 * v3;
            *(float4*)(p.out + (size_t)row * DM + col) = make_float4(v0, v1, v2, v3); }
        s += __shfl_xor(s, 16, 64); s += __shfl_xor(s, 32, 64);
        if (fq == 0) atomicAdd(p.ss_fin + row, s);
        asm volatile("" ::: "memory"); }
  }
};
__device__ void phase6_ple(const P& p, LAS unsigned char* lds) {
  { pg8::Gemm g; g.A = p.p16; g.Bt = p.WpleT; g.M = T_TOK; g.N = 1024; g.K = p.k256;
    pg8::StaticOrder S; S.init(T_TOK, 1024, gridDim.x, blockIdx.x);
    Epi6a E; E.p = p;
    pg8::gemm_phase<Epi6a, pg8::StaticOrder>(lds, g, S, E, nullptr); }
  { pg8::Gemm g; g.A = p.x2b; g.Bt = p.WgT; g.M = T_TOK; g.N = 1024; g.K = p.k1024;
    pg8::StaticOrder S; S.init(T_TOK, 1024, gridDim.x, blockIdx.x);
    Epi6b E; E.p = p;
    pg8::gemm_phase<Epi6b, pg8::StaticOrder>(lds, g, S, E, nullptr); }
}
__device__ void phase7_final(const P& p) {
  const int gt = blockIdx.x * 512 + threadIdx.x, nt = gridDim.x * 512;
  for (int i = gt; i < T_TOK * DM / 4; i += nt) {
    const int row = i >> 8, c4 = i & 255;
    const float rs = rsqrtf(p.ss_fin[row] * (1.f / DM) + 1e-6f);
    const float4 v = ((const float4*)p.out)[i];
    const float4 g = ((const float4*)p.g_final)[c4];
    ((float4*)p.out)[i] = make_float4(v.x * rs * g.x, v.y * rs * g.y, v.z * rs * g.z, v.w * rs * g.w);
  }
}
static void fill_params(P& p, void* const* d_in, void* d_out, void* d_ws, size_t ws_size, size_t* used) {
  p.x = (const float*)d_in[0]; p.p = (const float*)d_in[1]; p.pos = (const int*)d_in[2]; p.g_mix = (const float*)d_in[3];
  p.w_in = (const float*)d_in[4]; p.g_kv = (const float*)d_in[5]; p.w_uk = (const float*)d_in[6]; p.w_uv = (const float*)d_in[7];
  p.conv_w = (const float*)d_in[8]; p.conv_b = (const float*)d_in[9]; p.w_rg = (const float*)d_in[10]; p.b_rg = (const float*)d_in[11];
  p.w_ig = (const float*)d_in[12]; p.b_ig = (const float*)d_in[13]; p.lam = (const float*)d_in[14]; p.w_out = (const float*)d_in[15];
  p.g_ffn = (const float*)d_in[16]; p.w_pq = (const float*)d_in[17]; p.k1 = (const float*)d_in[18]; p.k2 = (const float*)d_in[19];
  p.u_tab = (const float*)d_in[20]; p.v_tab = (const float*)d_in[21]; p.w_ple = (const float*)d_in[22]; p.w_gate = (const float*)d_in[23];
  p.g_final = (const float*)d_in[24];
  p.out = (float*)d_out; p.k1024 = 1024; p.k256 = 256; p.pad0 = 0; p.pad1 = 0;
  char* ws = (char*)d_ws; size_t off = 0;
  auto alloc = [&](size_t bytes) { void* r = ws + off; off += (bytes + 255) & ~(size_t)255; return r; };
  const size_t T = T_TOK;
  p.bar = (unsigned*)alloc(16384);
  p.ctr = (unsigned*)alloc(256);
  p.rstd_mix = (float*)alloc(T * 4); p.ss_ffn = (float*)alloc(T * 4); p.ss_fin = (float*)alloc(T * 4);
  p.ropeA = (float*)alloc(T * 32 * 4); p.ropeI = (float*)alloc(T * 16 * 4);
  p.W1t = (u16*)alloc((size_t)N1 * 1024 * 2); p.WoutT = (u16*)alloc(1024 * 1024 * 2); p.WpqT = (u16*)alloc(2048 * 1024 * 2);
  p.WgT = (u16*)alloc(1024 * 1024 * 2); p.WpleT = (u16*)alloc(1024 * 256 * 2);
  p.K1b = (u16*)alloc(8 * 128 * 128 * 2); p.K2b = (u16*)alloc(8 * 128 * 128 * 2);
  p.WrgT = (u16*)alloc(8 * 64 * 64 * 2); p.WigT = (u16*)alloc(8 * 64 * 64 * 2);
  p.Ub = (u16*)alloc((size_t)16384 * 1024 * 2); p.Vb = (u16*)alloc((size_t)16384 * 1024 * 2);
  p.p16 = (u16*)alloc(T * 256 * 2);
  p.experts = (int*)alloc(T * 128 * 4); p.gates = (float*)alloc(T * 128 * 4);
  p.xb16 = (u16*)alloc(T * 1024 * 2); p.mix = p.xb16; p.x2b = p.xb16;
  char* rb = ws + off; size_t rboff = 0;
  auto allocB = [&](size_t bytes) { void* r = rb + rboff; rboff += (bytes + 255) & ~(size_t)255; return r; };
  p.qcat = (u16*)allocB(T * 640 * 2); p.kv = (u16*)allocB(T * 160 * 2); p.iqh = (u16*)allocB(T * 512 * 2); p.ikh = (u16*)allocB(T * 64 * 2);
  p.iw = (float*)allocB(T * 8 * 4); p.xbr = (u16*)allocB(T * 512 * 2); p.gate = (u16*)allocB(T * 512 * 2);
  size_t b1 = rboff; rboff = 0;
  p.x1b = (u16*)allocB(T * 1024 * 2); p.pq = (u16*)allocB(T * 2048 * 2); p.pple = p.x1b;
  size_t b2 = rboff;
  off += (b1 > b2 ? b1 : b2);
  *used = off;
}
__global__ void __launch_bounds__(512, 2) k_phase0(P p) { phase0_prep(p); }
#define PH_KERNEL(name, call) __global__ void __launch_bounds__(512, 2) name(P p) { \
  extern __shared__ __attribute__((aligned(16))) unsigned char smem[]; call; }
PH_KERNEL(k_phase1, phase1_gemm1(p, (LAS unsigned char*)smem))
PH_KERNEL(k_phase2, phase2(p, (LAS unsigned char*)smem))
PH_KERNEL(k_phase3, phase3_outproj(p, (LAS unsigned char*)smem))
PH_KERNEL(k_phase4, phase4_pq(p, (LAS unsigned char*)smem))
PH_KERNEL(k_phase4b, phase4b_route(p, (LAS unsigned char*)smem))
__global__ void __launch_bounds__(512, 2) k_phase5(P p) { phase5_experts(p); }
PH_KERNEL(k_phase6, phase6_ple(p, (LAS unsigned char*)smem))
__global__ void __launch_bounds__(512, 2) k_phase7(P p) { phase7_final(p); }

extern "C" void kernel_launch(void* const* d_in, const int* in_sizes, int n_in, void* d_out, int out_size, void* d_ws,
                              size_t ws_size, hipStream_t stream) {
  P p; memset(&p, 0, sizeof(p));
  size_t used = 0;
  fill_params(p, d_in, d_out, d_ws, ws_size, &used);
  static bool attr = false;
  if (!attr) {
    (void)hipFuncSetAttribute((const void*)k_phase1, hipFuncAttributeMaxDynamicSharedMemorySize, LDS_BYTES);
    (void)hipFuncSetAttribute((const void*)k_phase2, hipFuncAttributeMaxDynamicSharedMemorySize, LDS_BYTES);
    (void)hipFuncSetAttribute((const void*)k_phase3, hipFuncAttributeMaxDynamicSharedMemorySize, LDS_BYTES);
    (void)hipFuncSetAttribute((const void*)k_phase4, hipFuncAttributeMaxDynamicSharedMemorySize, LDS_BYTES);
    (void)hipFuncSetAttribute((const void*)k_phase4b, hipFuncAttributeMaxDynamicSharedMemorySize, LDS_BYTES);
    (void)hipFuncSetAttribute((const void*)k_phase6, hipFuncAttributeMaxDynamicSharedMemorySize, LDS_BYTES);
    attr = true; }
#ifndef SKIP_MASK
#define SKIP_MASK 0
#endif
  if (!(SKIP_MASK & 1)) k_phase0<<<256, 512, 0, stream>>>(p);
  if (!(SKIP_MASK & 2)) k_phase1<<<256, 512, LDS_BYTES, stream>>>(p);
  if (!(SKIP_MASK & 4)) k_phase2<<<256, 512, LDS_BYTES, stream>>>(p);
  if (!(SKIP_MASK & 8)) k_phase3<<<256, 512, LDS_BYTES, stream>>>(p);
  if (!(SKIP_MASK & 16)) k_phase4<<<256, 512, LDS_BYTES, stream>>>(p);
  if (!(SKIP_MASK & 32)) k_phase4b<<<256, 512, LDS_BYTES, stream>>>(p);
  if (!(SKIP_MASK & 64)) k_phase5<<<256, 512, 0, stream>>>(p);
  if (!(SKIP_MASK & 128)) k_phase6<<<256, 512, LDS_BYTES, stream>>>(p);
  if (!(SKIP_MASK & 256)) k_phase7<<<256, 512, 0, stream>>>(p);
}
```

```cpp
#define USE_XCD_BARRIER 1
#include <hip/hip_runtime.h>
#include <hip/hip_cooperative_groups.h>
#include <math.h>
#include <stdint.h>
#include <string.h>

#define T_TOK 16384
#define SEQ 2048
#define NB 8
#define DM 1024
#define INTOT 2280
#define N1 2560
#define LDS_BYTES 163840
#define PRESCALE 0.12751743f
#define IDXSCALE 0.04419417382415922f

typedef unsigned short u16;
typedef _Float16 f16;
typedef _Float16 f16x8 __attribute__((ext_vector_type(8)));
typedef _Float16 f16x4 __attribute__((ext_vector_type(4)));
typedef short s16x8 __attribute__((ext_vector_type(8)));
typedef short s16x4 __attribute__((ext_vector_type(4)));
typedef float fx4 __attribute__((ext_vector_type(4)));
typedef float fx16 __attribute__((ext_vector_type(16)));
typedef float fx2 __attribute__((ext_vector_type(2)));
#define LAS __attribute__((address_space(3)))
#if defined(__HIP_DEVICE_COMPILE__)
#define LDS_STORE(T, ptr, val) (*(LAS T*)(ptr) = (val))
#define LDS_ST_FX4(ptr, val) (*(LAS fx4*)(ptr) = (val))
#else
#define LDS_STORE(T, ptr, val) ((void)0)
#define LDS_ST_FX4(ptr, val) ((void)0)
#endif

__device__ __forceinline__ int mk_tid(int wid_s) {
  int l;
  asm volatile("v_mbcnt_lo_u32_b32 %0, -1, 0\n\tv_mbcnt_hi_u32_b32 %0, -1, %0" : "=v"(l));
  return wid_s * 64 + l;
}
__device__ __forceinline__ u16 f2bf(float f) {
  unsigned u = __float_as_uint(f);
  u += 0x7FFFu + ((u >> 16) & 1u);
  return (u16)(u >> 16);
}
__device__ __forceinline__ unsigned pack_bf2(float lo, float hi) { return (unsigned)f2bf(lo) | ((unsigned)f2bf(hi) << 16); }
__device__ __forceinline__ float bf2f(u16 v) { return __uint_as_float((unsigned)v << 16); }
__device__ __forceinline__ float bflo(unsigned v) { return __uint_as_float(v << 16); }
__device__ __forceinline__ float bfhi(unsigned v) { return __uint_as_float(v & 0xFFFF0000u); }
__device__ __forceinline__ unsigned pack_h2(float lo, float hi) {
  f16 a = (f16)lo, b = (f16)hi;
  return (unsigned)__builtin_bit_cast(unsigned short, a) | ((unsigned)__builtin_bit_cast(unsigned short, b) << 16);
}
__device__ __forceinline__ float wave_sum(float v) {
#pragma unroll
  for (int o = 32; o > 0; o >>= 1) v += __shfl_xor(v, o, 64);
  return v;
}
__device__ __forceinline__ float wave_max(float v) {
#pragma unroll
  for (int o = 32; o > 0; o >>= 1) v = fmaxf(v, __shfl_xor(v, o, 64));
  return v;
}
__device__ __forceinline__ float sigmoidf_(float x) { return 1.f / (1.f + __expf(-x)); }
__device__ __forceinline__ float gelu_tanh_f(float x) {
  const float u = 0.7978845608028654f * (x + 0.044715f * x * x * x);
  const float e = __expf(2.f * u);
  const float th = 1.f - 2.f / (e + 1.f);
  return 0.5f * x * (1.f + th);
}
__device__ __forceinline__ float gelu_erf_f(float x) { return 0.5f * x * (1.f + erff(x * 0.7071067811865476f)); }

struct P {
  const float* x; const float* p; const int* pos; const float* g_mix; const float* w_in; const float* g_kv;
  const float* w_uk; const float* w_uv; const float* conv_w; const float* conv_b; const float* w_rg; const float* b_rg;
  const float* w_ig; const float* b_ig; const float* lam; const float* w_out; const float* g_ffn; const float* w_pq;
  const float* k1; const float* k2; const float* u_tab; const float* v_tab; const float* w_ple; const float* w_gate;
  const float* g_final;
  float* out;
  u16* xb16; float* rstd_mix; float* ropeA; float* ropeI;
  u16* W1t; u16* WoutT; u16* WpqT; u16* WgT; u16* WpleT; u16* K1b; u16* K2b; u16* WrgT; u16* WigT;
  unsigned char* U8; unsigned char* V8; float* su; float* sv; u16* p16;
  u16* qcat; u16* kv; u16* iqh; u16* ikh; float* iw; u16* xbr; u16* gate;
  u16* mix; u16* x1b; u16* pq; float* ss_ffn; float* ss_fin;
  int* experts; float* gates; u16* x2b; u16* pple;
  unsigned* ctr; unsigned* bar;
  int k1024, k256, pad0, pad1;
};
namespace pg8 {
#define PG8_LAS __attribute__((address_space(3)))
typedef unsigned short bf16_t;
typedef short bf16x8 __attribute__((ext_vector_type(8)));
typedef float f32x4 __attribute__((ext_vector_type(4)));
typedef unsigned u32x4 __attribute__((ext_vector_type(4)));
constexpr int BM = 256, BK = 64, HALF = 128, HTB = HALF * BK * 2  , STAGE_BYTES = 8 * HTB, NXCD = 8, WGM = 8;

__host__ __device__ __forceinline__ int lds_byte(int r, int c) { const int st = (r >> 4) * 2 + (c >> 5), rr = r & 15, cc = c & 31, ob = rr * 64 + cc * 2; return st * 1024 + (ob ^ (((ob >> 9) & 1) << 5)); }
__host__ __device__ __forceinline__ void stage_rc(int b, int& R, int& C) { const int st = b / 1024, sb = b % 1024, swz = sb ^ (((sb >> 9) & 1) << 5); R = (st >> 1) * 16 + swz / 64; C = (st & 1) * 32 + (swz % 64) / 2; }
__host__ __device__ __forceinline__ int perm32(int rho) { const int n = rho >> 4, i = rho & 15; return 8 * (i >> 2) + 4 * n + (i & 3); }

struct Unit { int pm, pn; };
struct Gemm { const bf16_t* A; const bf16_t* Bt; int M, N, K; };

struct StaticOrder {
    int nM, nN, nwg, G, c;
    __host__ __device__ void init(int M, int N, int G_, int c_) { nM = M / BM; nN = N / BM; nwg = nM * nN; G = G_; c = c_; }
    __host__ __device__ bool next(int i, Unit& u) const {
        const long L = (long)i * G + c; if (L >= nwg) return false;
        int wgid = (int)L; { const int q = nwg / NXCD, r = nwg % NXCD, xcd = wgid % NXCD, off = wgid / NXCD; wgid = (xcd < r ? xcd * (q + 1) : r * (q + 1) + (xcd - r) * q) + off; }
        const int nig = WGM * nN, gid = wgid / nig, fm = gid * WGM, gsz = (nM - fm) < WGM ? (nM - fm) : WGM;
        u.pm = fm + ((wgid % nig) % gsz); u.pn = (wgid % nig) / gsz; return true;
    }
    __device__ __forceinline__ void a_ready(const Unit&) const {}
    __device__ __forceinline__ void done(const Unit&) const {}
};
__device__ __forceinline__ unsigned cvt_pk_bf16(float lo, float hi) { unsigned r; asm volatile("v_cvt_pk_bf16_f32 %0, %1, %2" : "=v"(r) : "v"(lo), "v"(hi)); return r; }
typedef float f32x2 __attribute__((ext_vector_type(2)));
__device__ __forceinline__ f32x2 gelu_pk(f32x2 v) {
    const f32x2 av = __builtin_elementwise_abs(v), d = av * 0.2316418882f + 1.0f;
    f32x2 t; t.x = __builtin_amdgcn_rcpf(d.x); t.y = __builtin_amdgcn_rcpf(d.y);
    f32x2 q = t * 0.5307027145f + (-0.7265760135f); q = q * t + 0.7107068705f; q = q * t + (-0.142248368f); q = q * t + 0.127414796f; q = q * t;
    const f32x2 s = (v * v) * (-0.72134752044f);
    f32x2 e; e.x = __builtin_amdgcn_exp2f(s.x); e.y = __builtin_amdgcn_exp2f(s.y);
    const f32x2 m = v * (q * e), r = v - m;
    f32x2 o; o.x = v.x < 0.f ? m.x : r.x; o.y = v.y < 0.f ? m.y : r.y; return o;
}

template <class Epi, class Sched, bool STAMP = false>
__device__ __forceinline__ void gemm_phase(PG8_LAS unsigned char* lds, const Gemm g, const Sched& S, const Epi& E, unsigned long long* stamps, int wid_s) {
    const int tid = mk_tid(wid_s), wid = __builtin_amdgcn_readfirstlane(tid >> 6), lane = tid & 63, wr = wid >> 2, wc = wid & 3, fr = lane & 15, fq = lane >> 4;
    const int K = g.K, nt = K / BK;
    int ts_lo = 0, ts_hi = 0, nts = 0; const unsigned long long rt_entry = STAMP ? (unsigned long long)wall_clock64() : 0ull;
#define PG8_STAMP() do { if (STAMP && wid == 0 && nts < 64) { const unsigned long long _c = (unsigned long long)clock64(); \
        ts_lo = (lane == nts) ? (int)(unsigned)_c : ts_lo; ts_hi = (lane == nts) ? (int)(unsigned)(_c >> 32) : ts_hi; ++nts; } } while (0)
    PG8_STAMP();
    unsigned voffA[2], voffB[2];
#pragma unroll
    for (int i = 0; i < 2; ++i) { int R, C; stage_rc(tid * 16 + i * 8192, R, C); const int Rb = Epi::PERM ? ((R & ~31) + perm32(R & 31)) : R;
        voffA[i] = (unsigned)(R * K + C) * 2u; voffB[i] = (unsigned)(Rb * K + C) * 2u; }
    const size_t kstep = (size_t)(BK * 2);
    const size_t hstep = (size_t)HALF * K * 2;
    const size_t tstep = 2 * hstep;
    const unsigned ldsw = (unsigned)wid * 1024u;
    const int aoff = lds_byte(wr * 64 + fr, fq * 8), boff = lds_byte(wc * 32 + fr, fq * 8);
#define PG8_SA(b, h) (((b) * 2 + (h)) * HTB)
#define PG8_SB(b, h) ((4 + (b) * 2 + (h)) * HTB)
#define PG8_STAGE(bufoff, gbase, voff) do { _Pragma("unroll") for (int _i = 0; _i < 2; ++_i) \
        __builtin_amdgcn_global_load_lds((const unsigned*)((const char*)(gbase) + (voff)[_i]), (PG8_LAS unsigned*)(lds + (bufoff) + ldsw + _i * 8192), 16, 0, 0); } while (0)
#define PG8_LDA(dst, b, h) do { _Pragma("unroll") for (int m = 0; m < 4; ++m) _Pragma("unroll") for (int k = 0; k < 2; ++k) dst[m][k] = *(const PG8_LAS bf16x8*)(lds + PG8_SA(b, h) + aoff + m * 2048 + k * 1024); } while (0)
#define PG8_LDB(dst, b, h) do { _Pragma("unroll") for (int n = 0; n < 2; ++n) _Pragma("unroll") for (int k = 0; k < 2; ++k) dst[n][k] = *(const PG8_LAS bf16x8*)(lds + PG8_SB(b, h) + boff + n * 2048 + k * 1024); } while (0)
#define PG8_MMA(ai, bj, At, Bt) do { __builtin_amdgcn_s_setprio(1); _Pragma("unroll") for (int m = 0; m < 4; ++m) _Pragma("unroll") for (int n = 0; n < 2; ++n) _Pragma("unroll") for (int k = 0; k < 2; ++k) \
        acc[ai][bj][m][n] = __builtin_amdgcn_mfma_f32_16x16x32_bf16(Bt[n][k], At[m][k], acc[ai][bj][m][n], 0, 0, 0); __builtin_amdgcn_s_setprio(0); } while (0)
#define PG8_WAIT_V(n) asm volatile("s_waitcnt vmcnt(" #n ")" ::: "memory")
#define PG8_WAIT_L(n) asm volatile("s_waitcnt lgkmcnt(" #n ")" ::: "memory")
#define PG8_BAR __builtin_amdgcn_s_barrier()
#define PG8_SCHED __builtin_amdgcn_sched_barrier(0)
    Unit cur, nxt; int ui = 0;
    if (!S.next(0, cur)) return;
    f32x4 acc[2][2][4][2];
#pragma unroll
    for (int a = 0; a < 2; ++a)
#pragma unroll
        for (int b = 0; b < 2; ++b)
#pragma unroll
            for (int m = 0; m < 4; ++m)
#pragma unroll
                for (int n = 0; n < 2; ++n) acc[a][b][m][n] = (f32x4){0.f, 0.f, 0.f, 0.f};
    bf16x8 At[4][2], B0[2][2], B1[2][2];
    const char* cA = (const char*)g.A + (size_t)cur.pm * tstep; const char* cB = (const char*)g.Bt + (size_t)cur.pn * tstep;
    S.a_ready(cur);
    PG8_STAGE(PG8_SB(0, 0), cB, voffB); PG8_STAGE(PG8_SA(0, 0), cA, voffA); PG8_STAGE(PG8_SB(0, 1), cB + hstep, voffB); PG8_STAGE(PG8_SA(0, 1), cA + hstep, voffA);
    if (wr == 1) PG8_BAR;
    PG8_WAIT_V(4); PG8_BAR;
    PG8_STAGE(PG8_SB(1, 0), cB + kstep, voffB); PG8_STAGE(PG8_SA(1, 0), cA + kstep, voffA); PG8_STAGE(PG8_SB(1, 1), cB + hstep + kstep, voffB);
    PG8_WAIT_V(6); PG8_BAR;
    PG8_STAMP();
    for (;;) {
        const bool has_next = S.next(ui + 1, nxt);
        const char* nA = has_next ? (const char*)g.A + (size_t)nxt.pm * tstep : cA; const char* nB = has_next ? (const char*)g.Bt + (size_t)nxt.pn * tstep : cB;
        for (int t = 0; t < nt; t += 2) {
            const bool last = (t == nt - 2);
            const char* a1 = cA + (size_t)(t + 1) * kstep;
            const char* a2 = last ? nA : cA + (size_t)(t + 2) * kstep; const char* b2 = last ? nB : cB + (size_t)(t + 2) * kstep;
            const char* a3 = a2 + kstep; const char* b3 = b2 + kstep;
            if (last && has_next) S.a_ready(nxt);
            PG8_LDB(B0, 0, 0); PG8_SCHED; PG8_LDA(At, 0, 0); PG8_STAGE(PG8_SA(1, 1), a1 + hstep, voffA);
            PG8_WAIT_L(8); PG8_BAR; PG8_WAIT_L(0); PG8_MMA(0, 0, At, B0); PG8_BAR; PG8_SCHED;
            PG8_LDB(B1, 0, 1); PG8_STAGE(PG8_SB(0, 0), b2, voffB);
            PG8_BAR; PG8_WAIT_L(0); PG8_MMA(0, 1, At, B1); PG8_BAR;
            PG8_LDA(At, 0, 1); PG8_STAGE(PG8_SA(0, 0), a2, voffA);
            PG8_BAR; PG8_WAIT_L(0); PG8_MMA(1, 0, At, B0); PG8_BAR; PG8_SCHED;
            PG8_STAGE(PG8_SB(0, 1), b2 + hstep, voffB);
            PG8_WAIT_V(6); PG8_BAR; PG8_MMA(1, 1, At, B1); PG8_BAR;
            PG8_LDB(B0, 1, 0); PG8_SCHED; PG8_LDA(At, 1, 0); PG8_STAGE(PG8_SA(0, 1), a2 + hstep, voffA);
            PG8_WAIT_L(8); PG8_BAR; PG8_WAIT_L(0); PG8_MMA(0, 0, At, B0); PG8_BAR; PG8_SCHED;
            PG8_LDB(B1, 1, 1); PG8_STAGE(PG8_SB(1, 0), b3, voffB);
            PG8_BAR; PG8_WAIT_L(0); PG8_MMA(0, 1, At, B1); PG8_BAR;
            PG8_LDA(At, 1, 1); PG8_STAGE(PG8_SA(1, 0), a3, voffA);
            PG8_BAR; PG8_WAIT_L(0); PG8_MMA(1, 0, At, B0); PG8_BAR; PG8_SCHED;
            PG8_STAGE(PG8_SB(1, 1), b3 + hstep, voffB);
            PG8_WAIT_V(6); PG8_BAR; PG8_MMA(1, 1, At, B1); PG8_BAR;
        }
        PG8_STAMP();
        if constexpr (!Epi::AFTER_DRAIN) { E(acc, cur, wr, wc, fr, fq); S.done(cur); }
        PG8_STAMP();
        if (!has_next) break;
#pragma unroll
        for (int a = 0; a < 2; ++a)
#pragma unroll
            for (int b = 0; b < 2; ++b)
#pragma unroll
                for (int m = 0; m < 4; ++m)
#pragma unroll
                    for (int n = 0; n < 2; ++n) acc[a][b][m][n] = (f32x4){0.f, 0.f, 0.f, 0.f};
        cur = nxt; cA = nA; cB = nB; ++ui;
    }
    PG8_WAIT_V(0);
    if (wr == 0) PG8_BAR;
    PG8_BAR;
    if constexpr (Epi::AFTER_DRAIN) { E.fused(acc, cur, wr, wc, fr, fq, lds, wid, lane); S.done(cur); }
    PG8_STAMP();
    if (STAMP && wid == 0) { stamps[lane] = lane < nts ? (((unsigned long long)(unsigned)ts_hi << 32) | (unsigned)ts_lo) : 0ull;
        if (lane == 62) stamps[62] = rt_entry; if (lane == 63) stamps[63] = (unsigned long long)wall_clock64(); }
#undef PG8_STAMP
#undef PG8_SA
#undef PG8_SB
#undef PG8_STAGE
#undef PG8_LDA
#undef PG8_LDB
#undef PG8_MMA
#undef PG8_WAIT_V
#undef PG8_WAIT_L
#undef PG8_BAR
#undef PG8_SCHED
}
}
__device__ __forceinline__ int w1_src(int n, float& mul) {
  mul = 1.f;
  if (n < 1024) { const int r = n - 512, h = r >> 6, d = r & 63;
    if (d < 16) { const int i = d >> 1, e = d & 1; return 672 + h * 64 + (e ? 8 + i : i); }
    return 672 + h * 64 + d; }
  if (n < 1536) return 1256 + (n - 1024);
  if (n < 2048) return 1768 + (n - 1536);
  if (n < 2176) { const int r = n - 2048, h = r >> 5, j = r & 31, i = j >> 1, e = j & 1; mul = PRESCALE; return h * 128 + (e ? 16 + i : i); }
  if (n < 2304) return 512 + (n - 2176);
  if (n < 2336) { const int j = n - 2304, i = j >> 1, e = j & 1; return 640 + (e ? 16 + i : i); }
  if (n < 2400) { const int d = n - 2336;
    if (d < 16) { const int i = d >> 1, e = d & 1; return 1184 + (e ? 8 + i : i); }
    return 1184 + d; }
  if (n < 2408) { mul = IDXSCALE; return 1248 + (n - 2400); }
  return -1;
}

template <int MODE>
__device__ __forceinline__ void tr_tile(LAS float* tl, const float* __restrict__ src, int ld_src, u16* __restrict__ dst, int ld_dst,
                                        int n0, int k0, int dk0, const float* __restrict__ kscale, int tid) {
  {
    const int nl = tid & 63, kq = tid >> 6;
    float mul = 1.f; int c = n0 + nl;
    if (MODE == 1) c = w1_src(n0 + nl, mul);
#pragma unroll
    for (int i = 0; i < 8; ++i) {
      const int k = k0 + kq * 8 + i;
      float v = 0.f;
      if (c >= 0) { v = src[(size_t)k * ld_src + c] * mul; if (kscale) v *= kscale[k]; }
      tl[(kq * 8 + i) * 65 + nl] = v;
    }
  }
  __syncthreads();
  {
    const int kc = tid & 7, nl = tid >> 3;
    float v[8];
#pragma unroll
    for (int j = 0; j < 8; ++j) v[j] = tl[(kc * 8 + j) * 65 + nl];
    *(uint4*)(dst + (size_t)(n0 + nl) * ld_dst + dk0 + kc * 8) = make_uint4(pack_bf2(v[0], v[1]), pack_bf2(v[2], v[3]), pack_bf2(v[4], v[5]), pack_bf2(v[6], v[7]));
  }
  __syncthreads();
}

__device__ __forceinline__ int q4fp8(float a, float b, float c, float d) {
  int w = __builtin_amdgcn_cvt_pk_fp8_f32(a, b, 0, false);
  return __builtin_amdgcn_cvt_pk_fp8_f32(c, d, w, true);
}

__device__ __forceinline__ void peer_row_fp8(const P& p, int row, int lane) {
  const int e = row & 16383; const bool isv = row >= 16384;
  const float4* src = (const float4*)((isv ? p.v_tab : p.u_tab) + (size_t)e * DM);
  float4 v[4];
  float amax = 0.f;
#pragma unroll
  for (int i = 0; i < 4; ++i) { v[i] = src[lane + 64 * i];
    amax = fmaxf(amax, fmaxf(fmaxf(fabsf(v[i].x), fabsf(v[i].y)), fmaxf(fabsf(v[i].z), fabsf(v[i].w)))); }
  amax = wave_max(amax);
  int ex = 0; const float m = frexpf(amax, &ex);
  const int k = (amax > 0.f) ? ((m > 0.75f) ? (2 - ex) : (3 - ex)) : 0;
  const float sc = ldexpf(1.f, k);
  unsigned w0 = 0u, w1 = 0u;
  w0 = __builtin_amdgcn_cvt_scalef32_pk_fp4_f32(w0, v[0].x * sc, v[0].y * sc, 1.0f, 0);
  w0 = __builtin_amdgcn_cvt_scalef32_pk_fp4_f32(w0, v[0].z * sc, v[0].w * sc, 1.0f, 1);
  w0 = __builtin_amdgcn_cvt_scalef32_pk_fp4_f32(w0, v[1].x * sc, v[1].y * sc, 1.0f, 2);
  w0 = __builtin_amdgcn_cvt_scalef32_pk_fp4_f32(w0, v[1].z * sc, v[1].w * sc, 1.0f, 3);
  w1 = __builtin_amdgcn_cvt_scalef32_pk_fp4_f32(w1, v[2].x * sc, v[2].y * sc, 1.0f, 0);
  w1 = __builtin_amdgcn_cvt_scalef32_pk_fp4_f32(w1, v[2].z * sc, v[2].w * sc, 1.0f, 1);
  w1 = __builtin_amdgcn_cvt_scalef32_pk_fp4_f32(w1, v[3].x * sc, v[3].y * sc, 1.0f, 2);
  w1 = __builtin_amdgcn_cvt_scalef32_pk_fp4_f32(w1, v[3].z * sc, v[3].w * sc, 1.0f, 3);
  *(uint2*)((isv ? p.V8 : p.U8) + (size_t)e * 512 + 8 * lane) = make_uint2(w0, w1);
  if (lane == 0) (isv ? p.sv : p.su)[e] = ldexpf(1.f, -k);
}

__device__ void phase0_prep(const P& p, LAS unsigned char* lds, int wid_s) {
  const int tid = mk_tid(wid_s), lane = tid & 63, wid = tid >> 6;
  const int gw = blockIdx.x * 8 + wid, nw = gridDim.x * 8;
  const int gt = blockIdx.x * 512 + tid, nt = gridDim.x * 512;
  LAS float* tl = (LAS float*)lds;
  for (int i = gt; i < T_TOK; i += nt) { p.ss_ffn[i] = 0.f; p.ss_fin[i] = 0.f; }
  if (gt < 64) p.ctr[gt] = 0u;
  for (int tile = blockIdx.x; tile < 1600; tile += gridDim.x) {
    if (tile < 512) { const int nt_ = tile >> 4, kt = tile & 15;
      tr_tile<1>(tl, p.w_in, INTOT, p.W1t, 1024, 512 + nt_ * 64, kt * 64, kt * 64, p.g_mix, tid);
    } else if (tile < 1024) { const int t2 = tile - 512, nt_ = t2 >> 4, kt = t2 & 15;
      tr_tile<0>(tl, p.w_pq, 2048, p.WpqT, 1024, nt_ * 64, kt * 64, kt * 64, p.g_ffn, tid);
    } else if (tile < 1280) { const int t2 = tile - 1024, nt_ = t2 >> 4, kt = t2 & 15;
      tr_tile<0>(tl, p.w_gate, 1024, p.WgT, 1024, nt_ * 64, kt * 64, kt * 64, nullptr, tid);
    } else if (tile < 1344) { const int t2 = tile - 1280, nt_ = t2 >> 2, kt = t2 & 3;
      tr_tile<0>(tl, p.w_ple, 1024, p.WpleT, 256, nt_ * 64, kt * 64, kt * 64, nullptr, tid);
    } else if (tile < 1472) { const int t2 = tile - 1344, nt_ = t2 >> 3, kt = t2 & 7;
      tr_tile<0>(tl, p.w_out, 1024, p.WoutT, 1024, nt_ * 64, 512 + kt * 64, 512 + kt * 64, nullptr, tid);
    } else if (tile < 1536) {
      const int t2 = tile - 1472, h = t2 >> 4, k0 = (t2 & 15) * 64;
      LAS float* sA = tl;
      LAS float* sB = tl + 64 * 97;
      for (int i = tid; i < 64 * 96; i += 512) { const int kk = i / 96, j = i % 96; sA[kk * 97 + j] = p.w_in[(size_t)(k0 + kk) * INTOT + h * 128 + 32 + j]; }
      for (int i = tid; i < 128 * 96; i += 512) { const int c = i / 96, j = i % 96; sB[j * 129 + c] = p.w_uk[(size_t)(h * 128 + c) * 96 + j]; }
      __syncthreads();
      const int c = tid & 127, kq = tid >> 7;
      float acc[16];
#pragma unroll
      for (int i = 0; i < 16; ++i) acc[i] = 0.f;
      for (int j = 0; j < 96; ++j) { const float b = sB[j * 129 + c];
#pragma unroll
        for (int i = 0; i < 16; ++i) acc[i] += sA[(kq * 16 + i) * 97 + j] * b; }
      unsigned o[8];
#pragma unroll
      for (int i = 0; i < 8; ++i) { const int k = k0 + kq * 16 + 2 * i; o[i] = pack_bf2(acc[2 * i] * PRESCALE * p.g_mix[k], acc[2 * i + 1] * PRESCALE * p.g_mix[k + 1]); }
      uint4* d = (uint4*)(p.W1t + (size_t)(h * 128 + c) * 1024 + k0 + kq * 16);
      d[0] = make_uint4(o[0], o[1], o[2], o[3]); d[1] = make_uint4(o[4], o[5], o[6], o[7]);
      __syncthreads();
    } else {
      const int t2 = tile - 1536, h = t2 >> 4, n0 = (t2 & 15) * 64;
      LAS float* sA = tl;
      LAS float* sB = tl + 128 * 65;
      for (int i = tid; i < 128 * 64; i += 512) { const int d = i >> 6, nl = i & 63; sA[d * 65 + nl] = p.w_out[(size_t)(h * 128 + d) * 1024 + n0 + nl]; }
      for (int i = tid; i < 128 * 128; i += 512) { const int c = i >> 7, d = i & 127; sB[d * 129 + c] = p.w_uv[(size_t)(h * 128 + c) * 128 + d]; }
      __syncthreads();
      const int c = tid & 127, nq = tid >> 7;
      float acc[16];
#pragma unroll
      for (int i = 0; i < 16; ++i) acc[i] = 0.f;
      for (int d = 0; d < 128; ++d) { const float b = sB[d * 129 + c];
#pragma unroll
        for (int i = 0; i < 16; ++i) acc[i] += sA[d * 65 + nq * 16 + i] * b; }
#pragma unroll
      for (int i = 0; i < 16; ++i) p.WoutT[(size_t)(n0 + nq * 16 + i) * 1024 + h * 128 + c] = f2bf(acc[i]);
      __syncthreads();
    }
  }
  for (int idx = gt; idx < 8 * 128 * 128; idx += nt) { p.K1b[idx] = f2bf(p.k1[idx]); p.K2b[idx] = f2bf(p.k2[idx]); }
  for (int idx = gt; idx < 8 * 64 * 64; idx += nt) {
    const int n = idx >> 12, o = (idx >> 6) & 63, i = idx & 63;
    p.WrgT[idx] = f2bf(p.w_rg[(size_t)n * 4096 + i * 64 + o]);
    p.WigT[idx] = f2bf(p.w_ig[(size_t)n * 4096 + i * 64 + o]);
  }
  for (int row = gw; row < T_TOK; row += nw) {
    const float4* xr = (const float4*)(p.x + (size_t)row * DM);
    uint2* xo = (uint2*)(p.xb16 + (size_t)row * DM);
    float ss = 0.f;
#pragma unroll
    for (int i = 0; i < 4; ++i) {
      const float4 v = xr[lane + 64 * i];
      ss += v.x * v.x + v.y * v.y + v.z * v.z + v.w * v.w;
      uint2 o; o.x = pack_bf2(v.x, v.y); o.y = pack_bf2(v.z, v.w);
      xo[lane + 64 * i] = o;
    }
    ss = wave_sum(ss);
    if (lane == 0) p.rstd_mix[row] = rsqrtf(ss * (1.f / DM) + 1e-6f);
    const float pos = (float)p.pos[row];
    if (lane < 16) {
      const float inv = powf(500000.f, -(float)(2 * lane) / 32.f);
      const float ang = pos * inv;
      p.ropeA[(size_t)row * 32 + lane] = cosf(ang);
      p.ropeA[(size_t)row * 32 + 16 + lane] = sinf(ang);
    } else if (lane < 24) {
      const int i = lane - 16;
      const float inv = powf(500000.f, -(float)(2 * i) / 16.f);
      const float ang = pos * inv;
      p.ropeI[(size_t)row * 16 + i] = cosf(ang);
      p.ropeI[(size_t)row * 16 + 8 + i] = sinf(ang);
    }
  }
  for (int i = gt; i < T_TOK * 256 / 4; i += nt) {
    const float4 v = ((const float4*)p.p)[i];
    uint2 o; o.x = pack_bf2(v.x, v.y); o.y = pack_bf2(v.z, v.w);
    ((uint2*)p.p16)[i] = o;
  }
  for (int row = gw; row < 16384; row += nw) peer_row_fp8(p, 16384 + row, lane);
}
__device__ __forceinline__ pg8::f32x4 rope4(pg8::f32x4 a, const float* cs, const float* sn) {
  const float c0 = cs[0], s0 = sn[0], c1 = cs[1], s1 = sn[1];
  pg8::f32x4 o;
  o[0] = a[0] * c0 - a[1] * s0; o[1] = a[1] * c0 + a[0] * s0; o[2] = a[2] * c1 - a[3] * s1; o[3] = a[3] * c1 + a[2] * s1;
  return o;
}
struct Epi1 {
  static constexpr bool PERM = false, AFTER_DRAIN = false;
  P p; LAS float* xch;
  __device__ __forceinline__ void operator()(const pg8::f32x4 (&acc)[2][2][4][2], const pg8::Unit& u, int wr, int wc, int fr_in, int fq_in) const {
    int fr = fr_in, fq = fq_in; asm volatile("" : "+v"(fr), "+v"(fq));
    const int pn = u.pn;
    const int rowb = u.pm * 256 + wr * 64 + fr;
    const int colb = wc * 32 + 4 * fq;
    float rs[2][4];
#pragma unroll
    for (int ai = 0; ai < 2; ++ai)
#pragma unroll
      for (int m = 0; m < 4; ++m) rs[ai][m] = p.rstd_mix[rowb + ai * 128 + m * 16];
    if (pn < 2) {
#pragma unroll
      for (int ai = 0; ai < 2; ++ai)
#pragma unroll
        for (int m = 0; m < 4; ++m) { const int row = rowb + ai * 128 + m * 16;
#pragma unroll
          for (int bj = 0; bj < 2; ++bj)
#pragma unroll
            for (int n = 0; n < 2; ++n) { const int col = pn * 256 + bj * 128 + colb + 16 * n; const int h = col >> 7, c = col & 127;
              const pg8::f32x4 v = acc[ai][bj][m][n] * rs[ai][m];
              uint2 o; o.x = pack_bf2(v[0], v[1]); o.y = pack_bf2(v[2], v[3]);
              *(uint2*)(p.qcat + ((size_t)row * 4 + h) * 160 + c) = o; } }
    } else if (pn < 4) {
#pragma unroll
      for (int ai = 0; ai < 2; ++ai)
#pragma unroll
        for (int m = 0; m < 4; ++m) { const int row = rowb + ai * 128 + m * 16;
#pragma unroll
          for (int bj = 0; bj < 2; ++bj)
#pragma unroll
            for (int n = 0; n < 2; ++n) { const int col = (pn - 2) * 256 + bj * 128 + colb + 16 * n; const int d = col & 63;
              pg8::f32x4 v = acc[ai][bj][m][n] * rs[ai][m];
              if (d < 16) { const float* cs = p.ropeI + (size_t)row * 16 + (d >> 1); v = rope4(v, cs, cs + 8); }
              uint2 o; o.x = pack_h2(v[0], v[1]); o.y = pack_h2(v[2], v[3]);
              *(uint2*)(p.iqh + (size_t)row * 512 + col) = o; } }
    } else if (pn < 8) {
      u16* dst = (pn < 6) ? p.xbr : p.gate;
      const int cb = (pn & 1) * 256;
#pragma unroll
      for (int ai = 0; ai < 2; ++ai)
#pragma unroll
        for (int m = 0; m < 4; ++m) { const int row = rowb + ai * 128 + m * 16;
#pragma unroll
          for (int bj = 0; bj < 2; ++bj)
#pragma unroll
            for (int n = 0; n < 2; ++n) { const int col = cb + bj * 128 + colb + 16 * n;
              const pg8::f32x4 v = acc[ai][bj][m][n] * rs[ai][m];
              uint2 o; o.x = pack_bf2(v[0], v[1]); o.y = pack_bf2(v[2], v[3]);
              *(uint2*)(dst + (size_t)row * 512 + col) = o; } }
    } else if (pn == 8) {
      float ps[2][4];
#pragma unroll
      for (int ai = 0; ai < 2; ++ai)
#pragma unroll
        for (int m = 0; m < 4; ++m) { const int row = rowb + ai * 128 + m * 16;
#pragma unroll
          for (int n = 0; n < 2; ++n) { const int col = colb + 16 * n; const int h = col >> 5, j0 = col & 31;
            pg8::f32x4 v = acc[ai][0][m][n] * rs[ai][m];
            const float* cs = p.ropeA + (size_t)row * 32 + (j0 >> 1); v = rope4(v, cs, cs + 16);
            uint2 o; o.x = pack_bf2(v[0], v[1]); o.y = pack_bf2(v[2], v[3]);
            *(uint2*)(p.qcat + ((size_t)row * 4 + h) * 160 + 128 + j0) = o; }
          float s = 0.f;
#pragma unroll
          for (int n = 0; n < 2; ++n) { const pg8::f32x4 v = acc[ai][1][m][n] * rs[ai][m]; s += v[0] * v[0] + v[1] * v[1] + v[2] * v[2] + v[3] * v[3]; }
          s += __shfl_xor(s, 16, 64); s += __shfl_xor(s, 32, 64);
          ps[ai][m] = s;
          if (fq == 0) xch[(wr * 4 + wc) * 128 + ai * 64 + m * 16 + fr] = s; }
      asm volatile("s_waitcnt lgkmcnt(0)" ::: "memory");
      __builtin_amdgcn_s_barrier();
      asm volatile("" ::: "memory");
#pragma unroll
      for (int ai = 0; ai < 2; ++ai)
#pragma unroll
        for (int m = 0; m < 4; ++m) { const int row = rowb + ai * 128 + m * 16; const int rr = ai * 64 + m * 16 + fr;
          const float tot = xch[(wr * 4 + 0) * 128 + rr] + xch[(wr * 4 + 1) * 128 + rr] + xch[(wr * 4 + 2) * 128 + rr] + xch[(wr * 4 + 3) * 128 + rr];
          const float rk = rsqrtf(tot * (1.f / 128.f) + 1e-6f) * rs[ai][m];
#pragma unroll
          for (int n = 0; n < 2; ++n) { const int c = colb + 16 * n;
            const float4 g = *(const float4*)(p.g_kv + c);
            const pg8::f32x4 v = acc[ai][1][m][n] * rk;
            uint2 o; o.x = pack_bf2(v[0] * g.x, v[1] * g.y); o.y = pack_bf2(v[2] * g.z, v[3] * g.w);
            *(uint2*)(p.kv + (size_t)row * 160 + c) = o; } }
      (void)ps;
    } else {
#pragma unroll
      for (int ai = 0; ai < 2; ++ai)
#pragma unroll
        for (int m = 0; m < 4; ++m) { const int row = rowb + ai * 128 + m * 16;
#pragma unroll
          for (int n = 0; n < 2; ++n) { const int col = colb + 16 * n;
            pg8::f32x4 v = acc[ai][0][m][n] * rs[ai][m];
            if (col < 32) {
              const float* cs = p.ropeA + (size_t)row * 32 + (col >> 1); v = rope4(v, cs, cs + 16);
              uint2 o; o.x = pack_bf2(v[0], v[1]); o.y = pack_bf2(v[2], v[3]);
              *(uint2*)(p.kv + (size_t)row * 160 + 128 + col) = o;
            } else if (col < 96) { const int d = col - 32;
              if (d < 16) { const float* cs = p.ropeI + (size_t)row * 16 + (d >> 1); v = rope4(v, cs, cs + 8); }
              uint2 o; o.x = pack_h2(v[0], v[1]); o.y = pack_h2(v[2], v[3]);
              *(uint2*)(p.ikh + (size_t)row * 64 + d) = o;
            } else if (col < 104) {
              *(float4*)(p.iw + (size_t)row * 8 + (col - 96)) = make_float4(v[0], v[1], v[2], v[3]);
            } } }
    }
  }
};

__device__ void phase1_gemm1(const P& p, LAS unsigned char* lds, int wid_s) {
  pg8::Gemm g; g.A = p.xb16; g.Bt = p.W1t; g.M = T_TOK; g.N = N1; g.K = p.k1024;
  pg8::StaticOrder S; S.init(T_TOK, N1, gridDim.x, blockIdx.x);
  Epi1 E; E.p = p; E.xch = (LAS float*)(lds + pg8::STAGE_BYTES);
  pg8::gemm_phase<Epi1, pg8::StaticOrder>(lds, g, S, E, nullptr, wid_s);
  const int nidle = 3 * (int)gridDim.x - 640;
  if (nidle > 0 && (int)blockIdx.x >= (int)gridDim.x - nidle) {
    const int tid = mk_tid(wid_s), lane = tid & 63;
    const int iw = ((int)blockIdx.x - ((int)gridDim.x - nidle)) * 8 + wid_s, niw = nidle * 8;
    for (int row = iw; row < 16384; row += niw) peer_row_fp8(p, row, lane);
  } else if (nidle <= 0) {
    const int tid = mk_tid(wid_s), lane = tid & 63;
    for (int row = blockIdx.x * 8 + wid_s; row < 16384; row += gridDim.x * 8) peer_row_fp8(p, row, lane);
  }
}
#define SC_STRIDE 2052
#define L_MASK 131328
#define L_HIST 139520
#define L_CAND 147712
#define L_MISC 156160
#define L_MM 156416
#define KV_STRIDE 336
#define KV_TILE_BYTES (64 * KV_STRIDE)

__device__ __forceinline__ float sort2f_(unsigned u) { const unsigned b = (u & 0x80000000u) ? (u & 0x7FFFFFFFu) : ~u; return __uint_as_float(b); }
__device__ __forceinline__ unsigned f2sort(float f) { const unsigned u = __float_as_uint(f); return (u & 0x80000000u) ? ~u : (u | 0x80000000u); }

__device__ __forceinline__ void index_scores(const P& p, LAS unsigned char* lds, int b, int tq0, int nkt, int wid, int lane) {
  const int fr = lane & 15, g = lane >> 4;
  const size_t qtok = (size_t)b * SEQ + tq0 + fr;
  f16x8 Bq[8][2];
  float w[8];
#pragma unroll
  for (int h = 0; h < 8; ++h) {
#pragma unroll
    for (int ks = 0; ks < 2; ++ks) Bq[h][ks] = *(const f16x8*)(p.iqh + qtok * 512 + h * 64 + ks * 32 + g * 8);
    w[h] = p.iw[qtok * 8 + h];
  }
  LAS float* sc = (LAS float*)lds;
  float rmax = -INFINITY, rmin = INFINITY;
  const int tqme = tq0 + fr;
  for (int kt = wid; kt < nkt; kt += 8) {
    const size_t ktok = (size_t)b * SEQ + kt * 16 + fr;
    const f16x8 A0 = *(const f16x8*)(p.ikh + ktok * 64 + g * 8);
    const f16x8 A1 = *(const f16x8*)(p.ikh + ktok * 64 + 32 + g * 8);
    fx4 tot = {0.f, 0.f, 0.f, 0.f};
#pragma unroll
    for (int h = 0; h < 8; ++h) {
      fx4 d = {0.f, 0.f, 0.f, 0.f};
      d = __builtin_amdgcn_mfma_f32_16x16x32_f16(A0, Bq[h][0], d, 0, 0, 0);
      d = __builtin_amdgcn_mfma_f32_16x16x32_f16(A1, Bq[h][1], d, 0, 0, 0);
#pragma unroll
      for (int r = 0; r < 4; ++r) tot[r] += w[h] * fmaxf(d[r], 0.f);
    }
    LDS_ST_FX4(sc + fr * SC_STRIDE + kt * 16 + 4 * g, tot);
#pragma unroll
    for (int r = 0; r < 4; ++r) { const bool ok = (kt * 16 + 4 * g + r) <= tqme; rmax = fmaxf(rmax, ok ? tot[r] : -INFINITY); rmin = fminf(rmin, ok ? tot[r] : INFINITY); }
  }
  rmax = fmaxf(rmax, __shfl_xor(rmax, 16, 64)); rmax = fmaxf(rmax, __shfl_xor(rmax, 32, 64));
  rmin = fminf(rmin, __shfl_xor(rmin, 16, 64)); rmin = fminf(rmin, __shfl_xor(rmin, 32, 64));
  if (g == 0) {
    LAS unsigned* mm = (LAS unsigned*)(lds + L_MM);
    if (rmax != -INFINITY) __hip_atomic_fetch_max(mm + 2 * fr, f2sort(rmax), __ATOMIC_RELAXED, __HIP_MEMORY_SCOPE_WORKGROUP);
    if (rmin != INFINITY) __hip_atomic_fetch_min(mm + 2 * fr + 1, f2sort(rmin), __ATOMIC_RELAXED, __HIP_MEMORY_SCOPE_WORKGROUP);
  }
}

#define DPP_F(x, ctrl) __uint_as_float((unsigned)__builtin_amdgcn_update_dpp(0, (int)__float_as_uint(x), (ctrl), 0xF, 0xF, true))
#define DPP_I(x, ctrl) ((unsigned)__builtin_amdgcn_update_dpp(0, (int)(x), (ctrl), 0xF, 0xF, true))
__device__ __forceinline__ float wave_max_dpp(float x) {
  x = fmaxf(x, DPP_F(x, 0xB1)); x = fmaxf(x, DPP_F(x, 0x4E)); x = fmaxf(x, DPP_F(x, 0x141)); x = fmaxf(x, DPP_F(x, 0x140));
  const int xi = (int)__float_as_uint(x);
  const float a = __uint_as_float((unsigned)__builtin_amdgcn_readlane(xi, 0)), b = __uint_as_float((unsigned)__builtin_amdgcn_readlane(xi, 16));
  const float c = __uint_as_float((unsigned)__builtin_amdgcn_readlane(xi, 32)), d = __uint_as_float((unsigned)__builtin_amdgcn_readlane(xi, 48));
  return fmaxf(fmaxf(a, b), fmaxf(c, d));
}
__device__ __forceinline__ unsigned row16_sum_u32(unsigned x) { x += DPP_I(x, 0xB1); x += DPP_I(x, 0x4E); x += DPP_I(x, 0x141); x += DPP_I(x, 0x140); return x; }

__device__ __forceinline__ void select_row(LAS float* row, int tq, LAS unsigned* mrow, LAS unsigned* hist, LAS unsigned* cand, int lane, int sflags, LAS unsigned* mmq) {
  const int n = tq + 1;
  unsigned long long mybal = 0ull;
  if (n <= 256) {
#pragma unroll 4
    for (int j = 0; j < 32; ++j) {
      const unsigned long long bl = __ballot((j * 64 + lane) <= tq);
      if (lane == j) mybal = bl;
    }
  } else {
    const float vmax = sort2f_(mmq[0]), vmin = sort2f_(mmq[1]);
    const int njb = ((tq >> 6) + 16) & ~15;
    const float scale = (vmax > vmin) ? 255.5f / (vmax - vmin) : 0.f;
#pragma unroll
    for (int i = 0; i < 4; ++i) hist[lane * 4 + i] = 0u;
    if (lane == 0) cand[256] = 0u;
#pragma unroll 1
    for (int jb = 0; jb < njb; jb += 16) {
      float v[16];
#pragma unroll
      for (int j = 0; j < 16; ++j) v[j] = row[(jb + j) * 64 + lane];
#pragma unroll
      for (int j = 0; j < 16; ++j) {
        const bool ok = ((jb + j) * 64 + lane) <= tq;
        const int bk = ok ? min(255, (int)((v[j] - vmin) * scale)) : lane;
        __hip_atomic_fetch_add((LAS unsigned*)&hist[bk], ok ? 1u : 0u, __ATOMIC_RELAXED, __HIP_MEMORY_SCOPE_WAVEFRONT);
      }
    }
    asm volatile("s_waitcnt lgkmcnt(0)" ::: "memory");
    const unsigned h40 = hist[255 - 4 * lane], h41 = hist[254 - 4 * lane], h42 = hist[253 - 4 * lane], h43 = hist[252 - 4 * lane];
    const unsigned mine = h40 + h41 + h42 + h43;
    const unsigned rsum = row16_sum_u32(mine);
    int Bsel = 0; unsigned above = 0u;
    {
      unsigned run = 0u; int R = 0;
#pragma unroll
      for (int r = 0; r < 4; ++r) { const unsigned s = (unsigned)__builtin_amdgcn_readlane((int)rsum, r * 16); if (run + s < 256u && R == r) { run += s; R = r + 1; } }
      if (R > 3) R = 3;
      int L = R * 16;
#pragma unroll 1
      for (int i = 0; i < 16; ++i) { const unsigned s = (unsigned)__builtin_amdgcn_readlane((int)mine, L); if (run + s >= 256u) break; run += s; ++L; }
      if (L > R * 16 + 15) L = R * 16 + 15;
      const unsigned b0 = (unsigned)__builtin_amdgcn_readlane((int)h40, L), b1 = (unsigned)__builtin_amdgcn_readlane((int)h41, L), b2 = (unsigned)__builtin_amdgcn_readlane((int)h42, L);
      if (run + b0 >= 256u) { Bsel = 255 - 4 * L; }
      else { run += b0;
        if (run + b1 >= 256u) { Bsel = 254 - 4 * L; }
        else { run += b1;
          if (run + b2 >= 256u) { Bsel = 253 - 4 * L; }
          else { run += b2; Bsel = 252 - 4 * L; } } }
      above = run;
    }
    const unsigned need = 256u - above;
    if (sflags & 4) { if (lane < 32) { mrow[2 * lane] = need + Bsel; mrow[2 * lane + 1] = 0u; } return; }
    unsigned cmask = 0u;
#pragma unroll 1
    for (int jb = 0; jb < njb; jb += 16) {
      float v[16];
#pragma unroll
      for (int j = 0; j < 16; ++j) v[j] = row[(jb + j) * 64 + lane];
#pragma unroll
      for (int j = 0; j < 16; ++j) {
        const bool is = (((jb + j) * 64 + lane) <= tq) && (min(255, (int)((v[j] - vmin) * scale)) == Bsel);
        cmask |= is ? (1u << (jb + j)) : 0u;
      }
    }
    while (cmask) {
      const int j = __ffs((int)cmask) - 1; cmask &= cmask - 1u;
      const int key = j * 64 + lane;
      const unsigned pos = __hip_atomic_fetch_add((LAS unsigned*)&cand[256], 1u, __ATOMIC_RELAXED, __HIP_MEMORY_SCOPE_WAVEFRONT);
      if (pos < 128u) { cand[2 * pos] = f2sort(row[key]); cand[2 * pos + 1] = (unsigned)key; }
    }
    asm volatile("s_waitcnt lgkmcnt(0)" ::: "memory");
    const unsigned cnt = (unsigned)__builtin_amdgcn_readfirstlane((int)cand[256]);
    if (sflags & 8) { if (lane < 32) { mrow[2 * lane] = cnt; mrow[2 * lane + 1] = 0u; } return; }
    unsigned ustar = 0u, kstar = 0u;
    if (cnt <= 64u) {
      const unsigned mu = (lane < (int)cnt) ? cand[2 * lane] : 0u, mk = (lane < (int)cnt) ? cand[2 * lane + 1] : 0xFFFFFFFFu;
      unsigned rank = 0;
      for (unsigned q = 0; q < cnt; ++q) {
        const unsigned qu = (unsigned)__builtin_amdgcn_readlane((int)mu, q), qk = (unsigned)__builtin_amdgcn_readlane((int)mk, q);
        rank += (qu > mu || (qu == mu && qk < mk)) ? 1u : 0u;
      }
      const unsigned long long fb = __ballot(lane < (int)cnt && rank == need - 1u);
      const int fl = __ffsll((long long)fb) - 1;
      ustar = (unsigned)__builtin_amdgcn_readlane((int)mu, fl); kstar = (unsigned)__builtin_amdgcn_readlane((int)mk, fl);
    } else if (cnt <= 128u) {
      unsigned fu = 0u, fk = 0u; int found = 0;
      for (unsigned base = 0; base < cnt; base += 64) {
        const unsigned i = base + lane;
        const unsigned mu = (i < cnt) ? cand[2 * i] : 0u, mk = (i < cnt) ? cand[2 * i + 1] : 0u;
        unsigned rank = 0;
#pragma unroll 4
        for (unsigned q = 0; q < cnt; ++q) { const unsigned qu = cand[2 * q], qk = cand[2 * q + 1]; rank += (qu > mu || (qu == mu && qk < mk)) ? 1u : 0u; }
        if (i < cnt && rank == need - 1u) { fu = mu; fk = mk; found = 1; }
      }
      const unsigned long long fb = __ballot(found);
      const int fl = __ffsll((long long)fb) - 1;
      ustar = (unsigned)__shfl((int)fu, fl, 64); kstar = (unsigned)__shfl((int)fk, fl, 64);
    } else {
      const int nj = (tq >> 6) + 1;
      unsigned prefix = 0u; unsigned needr = need;
      for (int bit = 31; bit >= 0; --bit) {
        const unsigned trial = prefix | (1u << bit);
        unsigned c = 0;
        for (int j = 0; j < nj; ++j) {
          const int key = j * 64 + lane;
          const float x = row[key];
          const bool inb = (key <= tq) && (min(255, (int)((x - vmin) * scale)) == Bsel);
          c += __popcll(__ballot(inb && (f2sort(x) >> bit) == (trial >> bit)));
        }
        if (c >= needr) prefix = trial; else needr -= c;
      }
      ustar = prefix;
      unsigned seen = 0; int done = 0;
      for (int j = 0; j < nj; ++j) {
        const int key = j * 64 + lane;
        const float x = row[key];
        const unsigned long long bl = __ballot((key <= tq) && f2sort(x) == ustar);
        const unsigned c = __popcll(bl);
        if (!done && seen + c >= needr) {
          unsigned long long m = bl; const unsigned k = needr - seen;
          int pos = 0;
          for (unsigned q = 0; q < k; ++q) { pos = __ffsll((long long)m) - 1; m &= m - 1ull; }
          kstar = (unsigned)(j * 64 + pos); done = 1;
        }
        seen += c;
      }
    }
#pragma unroll 1
    for (int jb = 0; jb < njb; jb += 16) {
      float v[16];
#pragma unroll
      for (int j = 0; j < 16; ++j) v[j] = row[(jb + j) * 64 + lane];
#pragma unroll
      for (int j = 0; j < 16; ++j) {
        const int key = (jb + j) * 64 + lane;
        const unsigned uu = f2sort(v[j]);
        const bool s = (key <= tq) && (uu > ustar || (uu == ustar && (unsigned)key <= kstar));
        const unsigned long long bl = __ballot(s);
        if (lane == jb + j) mybal = bl;
      }
    }
  }
  if (lane < 32) { mrow[2 * lane] = (unsigned)mybal; mrow[2 * lane + 1] = (unsigned)(mybal >> 32); }
}

__device__ __forceinline__ void attn_block(const P& p, LAS unsigned char* lds, int b, int t0, int wid, int lane, int tid) {
  const int fr = lane & 15, g = lane >> 4;
  const int h = wid >> 1, qs = wid & 1;
  const size_t qtok = (size_t)b * SEQ + t0 + qs * 16 + fr;
  s16x8 Qf[5];
#pragma unroll
  for (int ks = 0; ks < 5; ++ks) Qf[ks] = *(const s16x8*)(p.qcat + (qtok * 4 + h) * 160 + ks * 32 + g * 8);
  const int ntile = (t0 + 32 + 63) >> 6;
  const u16* kvb = p.kv + (size_t)b * SEQ * 160;
  LAS unsigned* mrow = (LAS unsigned*)(lds + L_MASK) + (qs * 16 + fr) * 64;
  fx4 O[8];
#pragma unroll
  for (int i = 0; i < 8; ++i) O[i] = (fx4){0.f, 0.f, 0.f, 0.f};
  float m_run = -INFINITY, l_run = 0.f;
  uint4 st0 = make_uint4(0, 0, 0, 0), st1 = st0, st2 = st0;
  const int c0i = tid, c1i = tid + 512, c2i = tid + 1024;
  const int lo0 = (c0i / 20) * KV_STRIDE + (c0i % 20) * 16, lo1 = (c1i / 20) * KV_STRIDE + (c1i % 20) * 16, lo2 = (c2i / 20) * KV_STRIDE + (c2i % 20) * 16;
#define G_LOAD(kt_) do { const uint4* src_ = (const uint4*)(kvb + (size_t)(kt_) * 64 * 160); st0 = src_[c0i]; st1 = src_[c1i]; if (c2i < 1280) st2 = src_[c2i]; } while (0)
#define L_STORE(buf_) do { LAS unsigned char* d_ = lds + (buf_) * KV_TILE_BYTES; LDS_STORE(uint4, d_ + lo0, st0); LDS_STORE(uint4, d_ + lo1, st1); if (c2i < 1280) LDS_STORE(uint4, d_ + lo2, st2); } while (0)
  G_LOAD(0); L_STORE(0);
  __syncthreads();
  for (int kt = 0; kt < ntile; ++kt) {
    const int buf = kt & 1;
    if (kt + 1 < ntile) G_LOAD(kt + 1);
    LAS unsigned char* kb = lds + buf * KV_TILE_BYTES;
#pragma unroll
    for (int ksub = 0; ksub < 2; ++ksub) {
      fx4 S[2];
#pragma unroll
      for (int sub = 0; sub < 2; ++sub) {
        fx4 a = {0.f, 0.f, 0.f, 0.f};
        const int krow = ksub * 32 + sub * 16 + fr;
#pragma unroll
        for (int ks = 0; ks < 5; ++ks) {
          const s16x8 Kf = *(LAS s16x8*)(kb + krow * KV_STRIDE + ks * 64 + g * 16);
          a = __builtin_amdgcn_mfma_f32_16x16x32_bf16(Kf, Qf[ks], a, 0, 0, 0);
        }
        S[sub] = a;
      }
      const unsigned mw = mrow[kt * 2 + ksub];
      float mx = -INFINITY;
#pragma unroll
      for (int sub = 0; sub < 2; ++sub)
#pragma unroll
        for (int r = 0; r < 4; ++r) { const int bit = sub * 16 + 4 * g + r; const float s = ((mw >> bit) & 1u) ? S[sub][r] : -INFINITY; S[sub][r] = s; mx = fmaxf(mx, s); }
      mx = fmaxf(mx, __shfl_xor(mx, 16, 64)); mx = fmaxf(mx, __shfl_xor(mx, 32, 64));
      const float m_new = fmaxf(m_run, mx);
      const float m_use = (m_new == -INFINITY) ? 0.f : m_new;
      const float alpha = exp2f(m_run - m_use);
      m_run = m_new;
      float psum = 0.f;
      s16x8 Pf;
#pragma unroll
      for (int sub = 0; sub < 2; ++sub)
#pragma unroll
        for (int r = 0; r < 4; ++r) { const float pv = exp2f(S[sub][r] - m_use); psum += pv; Pf[sub * 4 + r] = (short)f2bf(pv); }
      l_run = l_run * alpha + psum;
#pragma unroll
      for (int i = 0; i < 8; ++i) O[i] *= alpha;
      const int q4 = fr >> 2, p4 = fr & 3;
      LAS unsigned char* vb0 = kb + (ksub * 32 + 4 * g + q4) * KV_STRIDE + p4 * 8;
#pragma unroll
      for (int dvt = 0; dvt < 8; ++dvt) {
        const s16x4 v0 = __builtin_amdgcn_ds_read_tr16_b64_v4i16((LAS s16x4*)(vb0 + dvt * 32));
        const s16x4 v1 = __builtin_amdgcn_ds_read_tr16_b64_v4i16((LAS s16x4*)(vb0 + 16 * KV_STRIDE + dvt * 32));
        s16x8 Vf; Vf[0] = v0[0]; Vf[1] = v0[1]; Vf[2] = v0[2]; Vf[3] = v0[3]; Vf[4] = v1[0]; Vf[5] = v1[1]; Vf[6] = v1[2]; Vf[7] = v1[3];
        O[dvt] = __builtin_amdgcn_mfma_f32_16x16x32_bf16(Vf, Pf, O[dvt], 0, 0, 0);
      }
    }
    if (kt + 1 < ntile) L_STORE(buf ^ 1);
    __syncthreads();
  }
  float l_tot = l_run + __shfl_xor(l_run, 16, 64); l_tot += __shfl_xor(l_tot, 32, 64);
  const float inv = 1.f / l_tot;
  u16* dst = p.mix + qtok * 1024 + h * 128 + 4 * g;
#pragma unroll
  for (int dvt = 0; dvt < 8; ++dvt) {
    uint2 o; o.x = pack_bf2(O[dvt][0] * inv, O[dvt][1] * inv); o.y = pack_bf2(O[dvt][2] * inv, O[dvt][3] * inv);
    *(uint2*)(dst + dvt * 16) = o;
  }
}

#define LR_XCB 0
#define LR_XCF 18432
#define LR_A   51200
#define LR_B   83968
#define LR_SEG 116736
__device__ void lru_item(const P& p, LAS unsigned char* lds, int b, int blk, int tid) {
  const int lane = tid & 63, wid = tid >> 6, fr = lane & 15, g = lane >> 4;
  LAS u16* xcb = (LAS u16*)(lds + LR_XCB);
  LAS float* xcf = (LAS float*)(lds + LR_XCF);
  LAS float* a_s = (LAS float*)(lds + LR_A);
  LAS float* b_s = (LAS float*)(lds + LR_B);
  LAS float* segP = (LAS float*)(lds + LR_SEG);
  LAS float* segH = segP + 512;
  LAS float* carry = segH + 512;
  LAS float* Hprev = carry + 512;
  LAS float* cw = Hprev + 64;
  LAS float* cb = cw + 256;
  const int c0 = blk * 64;
  if (tid < 256) cw[tid] = p.conv_w[(tid >> 6) * 512 + c0 + (tid & 63)];
  if (tid < 64) { cb[tid] = p.conv_b[c0 + tid]; Hprev[tid] = 0.f; }
  float brg[4], big[4], spl[4];
#pragma unroll
  for (int nt = 0; nt < 4; ++nt) {
    const int c = c0 + nt * 16 + fr;
    brg[nt] = p.b_rg[c]; big[nt] = p.b_ig[c];
    const float l = p.lam[c];
    spl[nt] = (-l > 20.f) ? -l : log1pf(__expf(-l));
  }
  const u16* wrg = p.WrgT + (size_t)blk * 4096 + fr * 64 + g * 8;
  const u16* wig = p.WigT + (size_t)blk * 4096 + fr * 64 + g * 8;
  __syncthreads();
  const int tok_l = tid >> 2, cg = tid & 3;
  uint4 xr[4][2];
  const u16* xbase = p.xbr + (size_t)b * SEQ * 512 + c0 + cg * 16;
#define LRU_LOADX(S0) do { _Pragma("unroll") for (int w = 0; w < 4; ++w) { const int ss = (S0) + tok_l - 3 + w; \
      if (ss >= 0) { const uint4* src = (const uint4*)(xbase + (size_t)ss * 512); xr[w][0] = src[0]; xr[w][1] = src[1]; } \
      else { xr[w][0] = make_uint4(0, 0, 0, 0); xr[w][1] = xr[w][0]; } } } while (0)
  LRU_LOADX(0);
  for (int s0 = 0; s0 < SEQ; s0 += 128) {
    {
      float acc[16];
      { const fx4 b0 = *(LAS fx4*)(cb + cg * 16), b1 = *(LAS fx4*)(cb + cg * 16 + 4), b2 = *(LAS fx4*)(cb + cg * 16 + 8), b3 = *(LAS fx4*)(cb + cg * 16 + 12);
        acc[0] = b0[0]; acc[1] = b0[1]; acc[2] = b0[2]; acc[3] = b0[3]; acc[4] = b1[0]; acc[5] = b1[1]; acc[6] = b1[2]; acc[7] = b1[3];
        acc[8] = b2[0]; acc[9] = b2[1]; acc[10] = b2[2]; acc[11] = b2[3]; acc[12] = b3[0]; acc[13] = b3[1]; acc[14] = b3[2]; acc[15] = b3[3]; }
#pragma unroll
      for (int w = 0; w < 4; ++w) {
        const unsigned uu[8] = {xr[w][0].x, xr[w][0].y, xr[w][0].z, xr[w][0].w, xr[w][1].x, xr[w][1].y, xr[w][1].z, xr[w][1].w};
#pragma unroll
        for (int q = 0; q < 4; ++q) { const fx4 wv = *(LAS fx4*)(cw + w * 64 + cg * 16 + 4 * q);
          acc[4 * q] += bflo(uu[2 * q]) * wv[0]; acc[4 * q + 1] += bfhi(uu[2 * q]) * wv[1]; acc[4 * q + 2] += bflo(uu[2 * q + 1]) * wv[2]; acc[4 * q + 3] += bfhi(uu[2 * q + 1]) * wv[3]; }
      }
#pragma unroll
      for (int i = 0; i < 16; i += 4) { const fx4 t4 = {acc[i], acc[i + 1], acc[i + 2], acc[i + 3]}; LDS_ST_FX4(xcf + tok_l * 64 + cg * 16 + i, t4); }
#pragma unroll
      for (int i = 0; i < 16; i += 4) { uint2 o; o.x = pack_bf2(acc[i], acc[i + 1]); o.y = pack_bf2(acc[i + 2], acc[i + 3]); LDS_STORE(uint2, xcb + tok_l * 72 + cg * 16 + i, o); }
    }
    const size_t t = (size_t)b * SEQ + s0 + tok_l;
    const uint4* gsrc = (const uint4*)(p.gate + t * 512 + c0 + cg * 16);
    const uint4 g0 = gsrc[0], g1 = gsrc[1];
    if (s0 + 128 < SEQ) LRU_LOADX(s0 + 128);
    __syncthreads();
    {
      const s16x8 A0 = *(LAS s16x8*)(xcb + (wid * 16 + fr) * 72 + g * 8);
      const s16x8 A1 = *(LAS s16x8*)(xcb + (wid * 16 + fr) * 72 + 32 + g * 8);
#pragma unroll
      for (int nt = 0; nt < 4; ++nt) {
        fx4 R = {0.f, 0.f, 0.f, 0.f}, I = {0.f, 0.f, 0.f, 0.f};
        const s16x8 br0 = *(const s16x8*)(wrg + nt * 1024), br1 = *(const s16x8*)(wrg + nt * 1024 + 32);
        const s16x8 bi0 = *(const s16x8*)(wig + nt * 1024), bi1 = *(const s16x8*)(wig + nt * 1024 + 32);
        R = __builtin_amdgcn_mfma_f32_16x16x32_bf16(A0, br0, R, 0, 0, 0);
        R = __builtin_amdgcn_mfma_f32_16x16x32_bf16(A1, br1, R, 0, 0, 0);
        I = __builtin_amdgcn_mfma_f32_16x16x32_bf16(A0, bi0, I, 0, 0, 0);
        I = __builtin_amdgcn_mfma_f32_16x16x32_bf16(A1, bi1, I, 0, 0, 0);
#pragma unroll
        for (int r = 0; r < 4; ++r) {
          const int tok = wid * 16 + 4 * g + r, o = nt * 16 + fr;
          const float rr = sigmoidf_(R[r] + brg[nt]), ii = sigmoidf_(I[r] + big[nt]);
          const float log_a = -8.f * rr * spl[nt];
          const float a = __expf(log_a);
          const float bb = sqrtf(fmaxf(1.f - a * a, 0.f)) * (ii * xcf[tok * 64 + o]);
          a_s[tok * 64 + o] = a; b_s[tok * 64 + o] = bb;
        }
      }
    }
    __syncthreads();
    {
      float av[16], bv[16];
#pragma unroll
      for (int i = 0; i < 16; ++i) { av[i] = a_s[(wid * 16 + i) * 64 + lane]; bv[i] = b_s[(wid * 16 + i) * 64 + lane]; }
      float hh = 0.f, pp = 1.f;
#pragma unroll
      for (int i = 0; i < 16; ++i) { hh = av[i] * hh + bv[i]; pp *= av[i]; bv[i] = hh; av[i] = pp; }
#pragma unroll
      for (int i = 0; i < 16; ++i) { b_s[(wid * 16 + i) * 64 + lane] = bv[i]; a_s[(wid * 16 + i) * 64 + lane] = av[i]; }
      segP[wid * 64 + lane] = pp; segH[wid * 64 + lane] = hh;
    }
    __syncthreads();
    if (tid < 64) {
      float sp_[8], sh_[8];
#pragma unroll
      for (int sg = 0; sg < 8; ++sg) { sp_[sg] = segP[sg * 64 + tid]; sh_[sg] = segH[sg * 64 + tid]; }
      float c = Hprev[tid];
#pragma unroll
      for (int sg = 0; sg < 8; ++sg) { carry[sg * 64 + tid] = c; c = sp_[sg] * c + sh_[sg]; }
      Hprev[tid] = c;
    }
    __syncthreads();
    {
      const unsigned gg[8] = {g0.x, g0.y, g0.z, g0.w, g1.x, g1.y, g1.z, g1.w};
      unsigned oo[8];
#pragma unroll
      for (int q = 0; q < 4; ++q) {
        const int o0 = cg * 16 + 4 * q;
        const fx4 cr = *(LAS fx4*)(carry + (tok_l >> 4) * 64 + o0), hl = *(LAS fx4*)(b_s + tok_l * 64 + o0), pl = *(LAS fx4*)(a_s + tok_l * 64 + o0);
        const float h0 = hl[0] + pl[0] * cr[0], h1 = hl[1] + pl[1] * cr[1], h2 = hl[2] + pl[2] * cr[2], h3 = hl[3] + pl[3] * cr[3];
        oo[2 * q] = pack_bf2(h0 * gelu_tanh_f(bflo(gg[2 * q])), h1 * gelu_tanh_f(bfhi(gg[2 * q])));
        oo[2 * q + 1] = pack_bf2(h2 * gelu_tanh_f(bflo(gg[2 * q + 1])), h3 * gelu_tanh_f(bfhi(gg[2 * q + 1])));
      }
      uint4* dst = (uint4*)(p.mix + t * 1024 + 512 + c0 + cg * 16);
      dst[0] = make_uint4(oo[0], oo[1], oo[2], oo[3]); dst[1] = make_uint4(oo[4], oo[5], oo[6], oo[7]);
    }
    __syncthreads();
  }
#undef LRU_LOADX
}

__device__ void phase2(const P& p, LAS unsigned char* lds, int wid_s) {
  const int tid = mk_tid(wid_s), lane = tid & 63, wid = tid >> 6;
  LAS int* misc = (LAS int*)(lds + L_MISC);
  const int flags = p.pad0;
  if (!(flags & 1) && blockIdx.x < 64) lru_item(p, lds, blockIdx.x >> 3, blockIdx.x & 7, tid);
  if (flags & 2) return;
  for (;;) {
    __syncthreads();
    if (tid == 0) misc[0] = (int)atomicAdd(p.ctr, 1u);
    __syncthreads();
    const int a = misc[0];
    if (a >= 512) break;
    const int qb = 63 - (a >> 3), b = a & 7;
    const int t0 = qb * 32;
    for (int r = 0; r < 2; ++r) {
      const int tq0 = t0 + 16 * r;
      if (tid < 16) { LAS unsigned* mm = (LAS unsigned*)(lds + L_MM); mm[2 * tid] = 0u; mm[2 * tid + 1] = 0xFFFFFFFFu; }
      __syncthreads();
      if (!(flags & 16)) index_scores(p, lds, b, tq0, (tq0 >> 4) + 1, wid, lane);
      __syncthreads();
#pragma unroll 1
      for (int qq = 0; qq < ((flags & 4) ? 0 : 2); ++qq) {
        const int qi = wid * 2 + qq;
        select_row((LAS float*)lds + qi * SC_STRIDE, tq0 + qi, (LAS unsigned*)(lds + L_MASK) + (r * 16 + qi) * 64,
                   (LAS unsigned*)(lds + L_HIST) + wid * 256, (LAS unsigned*)(lds + L_CAND) + wid * 260, lane, p.pad1, (LAS unsigned*)(lds + L_MM) + 2 * qi);
      }
      __syncthreads();
    }
    if (!(flags & 8)) attn_block(p, lds, b, t0, wid, lane, tid);
  }
}
struct Epi3 {
  static constexpr bool PERM = false, AFTER_DRAIN = false;
  P p;
  __device__ __forceinline__ void operator()(const pg8::f32x4 (&acc)[2][2][4][2], const pg8::Unit& u, int wr, int wc, int fr_in, int fq_in) const {
    int fr = fr_in, fq = fq_in; asm volatile("" : "+v"(fr), "+v"(fq));
    const int rowb = u.pm * 256 + wr * 64 + fr;
    const int colb = u.pn * 256 + wc * 32 + 4 * fq;
#pragma unroll
    for (int ai = 0; ai < 2; ++ai)
#pragma unroll
      for (int m = 0; m < 4; ++m) { const int row = rowb + ai * 128 + m * 16;
        float s = 0.f;
#pragma unroll
        for (int bj = 0; bj < 2; ++bj)
#pragma unroll
          for (int n = 0; n < 2; ++n) { const int col = colb + bj * 128 + 16 * n;
            const float4 xr = *(const float4*)(p.x + (size_t)row * DM + col);
            const pg8::f32x4 a = acc[ai][bj][m][n];
            const float v0 = a[0] + xr.x, v1 = a[1] + xr.y, v2 = a[2] + xr.z, v3 = a[3] + xr.w;
            s += v0 * v0 + v1 * v1 + v2 * v2 + v3 * v3;
            uint2 o; o.x = pack_bf2(v0, v1); o.y = pack_bf2(v2, v3);
            *(uint2*)(p.x1b + (size_t)row * DM + col) = o; }
        s += __shfl_xor(s, 16, 64); s += __shfl_xor(s, 32, 64);
        if (fq == 0) atomicAdd(p.ss_ffn + row, s); }
  }
};
__device__ void phase3_outproj(const P& p, LAS unsigned char* lds, int wid_s) {
  pg8::Gemm g; g.A = p.mix; g.Bt = p.WoutT; g.M = T_TOK; g.N = 1024; g.K = p.k1024;
  pg8::StaticOrder S; S.init(T_TOK, 1024, gridDim.x, blockIdx.x);
  Epi3 E; E.p = p;
  pg8::gemm_phase<Epi3, pg8::StaticOrder>(lds, g, S, E, nullptr, wid_s);
}
struct Epi4 {
  static constexpr bool PERM = false, AFTER_DRAIN = false;
  P p;
  __device__ __forceinline__ void operator()(const pg8::f32x4 (&acc)[2][2][4][2], const pg8::Unit& u, int wr, int wc, int fr_in, int fq_in) const {
    int fr = fr_in, fq = fq_in; asm volatile("" : "+v"(fr), "+v"(fq));
    const int rowb = u.pm * 256 + wr * 64 + fr;
    const int colb = u.pn * 256 + wc * 32 + 4 * fq;
#pragma unroll
    for (int ai = 0; ai < 2; ++ai)
#pragma unroll
      for (int m = 0; m < 4; ++m) { const int row = rowb + ai * 128 + m * 16;
        const float rs = rsqrtf(p.ss_ffn[row] * (1.f / DM) + 1e-6f);
#pragma unroll
        for (int bj = 0; bj < 2; ++bj)
#pragma unroll
          for (int n = 0; n < 2; ++n) { const int col = colb + bj * 128 + 16 * n;
            const pg8::f32x4 v = acc[ai][bj][m][n] * rs;
            uint2 o; o.x = pack_bf2(v[0], v[1]); o.y = pack_bf2(v[2], v[3]);
            *(uint2*)(p.pq + (size_t)row * 2048 + col) = o; } }
  }
};
__device__ void phase4_pq(const P& p, LAS unsigned char* lds, int wid_s) {
  pg8::Gemm g; g.A = p.x1b; g.Bt = p.WpqT; g.M = T_TOK; g.N = 2048; g.K = p.k1024;
  pg8::StaticOrder S; S.init(T_TOK, 2048, gridDim.x, blockIdx.x);
  Epi4 E; E.p = p;
  pg8::gemm_phase<Epi4, pg8::StaticOrder>(lds, g, S, E, nullptr, wid_s);
}

#ifdef USE_SHFL_ROW
__device__ __forceinline__ unsigned row16_max_u32(unsigned x) {
  x = max(x, (unsigned)__shfl_xor((int)x, 1, 64)); x = max(x, (unsigned)__shfl_xor((int)x, 2, 64));
  x = max(x, (unsigned)__shfl_xor((int)x, 4, 64)); x = max(x, (unsigned)__shfl_xor((int)x, 8, 64)); return x; }
__device__ __forceinline__ float row16_sum_f32(float x) {
  x += __shfl_xor(x, 1, 64); x += __shfl_xor(x, 2, 64); x += __shfl_xor(x, 4, 64); x += __shfl_xor(x, 8, 64); return x; }
#else
#define DPP_U(x, ctrl) ((unsigned)__builtin_amdgcn_update_dpp(0, (int)(x), (ctrl), 0xF, 0xF, true))
__device__ __forceinline__ unsigned row16_max_u32(unsigned x) {
  x = max(x, DPP_U(x, 0xB1)); x = max(x, DPP_U(x, 0x4E)); x = max(x, DPP_U(x, 0x141)); x = max(x, DPP_U(x, 0x140)); return x; }
__device__ __forceinline__ float row16_sum_f32(float x) {
  x += __uint_as_float(DPP_U(__float_as_uint(x), 0xB1)); x += __uint_as_float(DPP_U(__float_as_uint(x), 0x4E));
  x += __uint_as_float(DPP_U(__float_as_uint(x), 0x141)); x += __uint_as_float(DPP_U(__float_as_uint(x), 0x140)); return x; }
#endif
__device__ __forceinline__ float sort2f(unsigned u) { const unsigned b = (u & 0x80000000u) ? (u & 0x7FFFFFFFu) : ~u; return __uint_as_float(b); }

#define RT_KOFF 8192
#define RT_KSTR 136
__device__ void phase4b_route(const P& p, LAS unsigned char* lds, int wid_s) {
  const int tid = mk_tid(wid_s), lane = tid & 63, wid = tid >> 6, fr = lane & 15, g = lane >> 4;
  LAS unsigned* topk = (LAS unsigned*)lds;
  LAS u16* kimg = (LAS u16*)(lds + RT_KOFF);
  const int nitems = (T_TOK / 64) * 8;
  int hloaded = -1;
  for (int item = blockIdx.x; item < nitems; item += gridDim.x) {
    const int h = item & 7, tile = item >> 3;
    const int tok0 = tile * 64;
    if (h != hloaded) {
      __syncthreads();
      for (int i = tid; i < 2 * 128 * 16; i += 512) { const int side = i >> 11, r = (i >> 4) & 127, c = i & 15;
        const uint4 v = *(const uint4*)((side ? p.K2b : p.K1b) + (size_t)h * 16384 + r * 128 + c * 8);
        LDS_STORE(uint4, kimg + (side * 128 + r) * RT_KSTR + c * 8, v); }
      hloaded = h;
      __syncthreads();
    }
    {
      const int side = wid & 1, mt = wid >> 1;
      const size_t tok = (size_t)tok0 + mt * 16 + fr;
      const u16* qa = p.pq + tok * 2048 + h * 256 + side * 128 + g * 8;
      s16x8 A[4];
#pragma unroll
      for (int ks = 0; ks < 4; ++ks) A[ks] = *(const s16x8*)(qa + ks * 32);
      LAS u16* kb = kimg + (side * 128 + fr) * RT_KSTR + g * 8;
      unsigned val[8][4];
#pragma unroll
      for (int nt = 0; nt < 8; ++nt) {
        fx4 acc = {0.f, 0.f, 0.f, 0.f};
#pragma unroll
        for (int ks = 0; ks < 4; ++ks) {
          const s16x8 B = *(LAS s16x8*)(kb + nt * 16 * RT_KSTR + ks * 32);
          acc = __builtin_amdgcn_mfma_f32_16x16x32_bf16(A[ks], B, acc, 0, 0, 0);
        }
        const unsigned tag = 127u - (unsigned)(nt * 16 + fr);
#pragma unroll
        for (int r = 0; r < 4; ++r) val[nt][r] = (f2sort(acc[r]) & ~0x7Fu) | tag;
      }
      unsigned mine[4] = {0u, 0u, 0u, 0u};
#pragma unroll 1
      for (int i = 0; i < 16; ++i) {
        unsigned m[4];
#pragma unroll
        for (int r = 0; r < 4; ++r) m[r] = max(max(max(val[0][r], val[1][r]), max(val[2][r], val[3][r])), max(max(val[4][r], val[5][r]), max(val[6][r], val[7][r])));
#pragma unroll
        for (int r = 0; r < 4; ++r) m[r] = max(m[r], DPP_U(m[r], 0xB1));
#pragma unroll
        for (int r = 0; r < 4; ++r) m[r] = max(m[r], DPP_U(m[r], 0x4E));
#pragma unroll
        for (int r = 0; r < 4; ++r) m[r] = max(m[r], DPP_U(m[r], 0x141));
#pragma unroll
        for (int r = 0; r < 4; ++r) m[r] = max(m[r], DPP_U(m[r], 0x140));
#pragma unroll
        for (int r = 0; r < 4; ++r) {
#pragma unroll
          for (int nt = 0; nt < 8; ++nt) val[nt][r] = (val[nt][r] == m[r]) ? 0u : val[nt][r];
          if (fr == i) mine[r] = m[r];
        }
      }
#pragma unroll
      for (int r = 0; r < 4; ++r) topk[((mt * 16 + 4 * g + r) * 2 + side) * 16 + fr] = mine[r];
    }
    __syncthreads();
#pragma unroll 1
    for (int rd = 0; rd < 2; ++rd) {
      const int tl = wid * 8 + rd * 4 + g;
      LAS unsigned* t1 = topk + (tl * 2 + 0) * 16;
      LAS unsigned* t2 = topk + (tl * 2 + 1) * 16;
      unsigned cv[4];
#pragma unroll
      for (int j = 0; j < 4; ++j) {
        const int s = fr + 16 * j;
        int a, bb;
        if (s < 16) { a = 0; bb = s; } else if (s < 24) { a = 1; bb = s - 16; } else if (s < 29) { a = 2; bb = s - 24; } else if (s < 33) { a = 3; bb = s - 29; }
        else if (s < 36) { a = 4; bb = s - 33; } else if (s < 38) { a = 5; bb = s - 36; } else if (s < 40) { a = 6; bb = s - 38; } else if (s < 42) { a = 7; bb = s - 40; }
        else if (s < 50) { a = 8 + (s - 42); bb = 0; } else { a = -1; bb = 0; }
        unsigned key = 0u;
        if (a >= 0) {
          const float sum = sort2f(t1[a] & ~0x7Fu) + sort2f(t2[bb] & ~0x7Fu);
          key = (f2sort(sum) & ~0xFFu) | (unsigned)(255 - (a * 16 + bb));
        }
        cv[j] = key;
      }
      unsigned mine = 0u;
#pragma unroll 1
      for (int i = 0; i < 16; ++i) {
        unsigned m = max(max(cv[0], cv[1]), max(cv[2], cv[3]));
        m = row16_max_u32(m);
#pragma unroll
        for (int j = 0; j < 4; ++j) cv[j] = (cv[j] == m) ? 0u : cv[j];
        if (fr == i) mine = m;
      }
      const int flat = 255 - (int)(mine & 0xFFu);
      const int a = flat >> 4, bb = flat & 15;
      const unsigned k1 = t1[a], k2 = t2[bb];
      const float sum = sort2f(k1 & ~0x7Fu) + sort2f(k2 & ~0x7Fu);
      const unsigned m0 = (unsigned)__shfl((int)mine, lane & 48, 64);
      const int f0 = 255 - (int)(m0 & 0xFFu);
      const float s0 = sort2f(t1[f0 >> 4] & ~0x7Fu) + sort2f(t2[f0 & 15] & ~0x7Fu);
      const float ex = __expf(sum - s0);
      const float den = row16_sum_f32(ex);
      const int e = (127 - (int)(k1 & 0x7Fu)) * 128 + (127 - (int)(k2 & 0x7Fu));
      const size_t t = (size_t)tok0 + tl;
      p.experts[t * 128 + h * 16 + fr] = e;
      p.gates[t * 128 + h * 16 + fr] = ex / den;
    }
    __syncthreads();
  }
}
#define FP8_LO(w) __builtin_amdgcn_cvt_pk_f32_fp8((int)(w), false)
#define FP8_HI(w) __builtin_amdgcn_cvt_pk_f32_fp8((int)(w), true)
#define P5_LIST_WORDS (4 * 128 * 3)
#define P5_WAVE_WORDS (P5_LIST_WORDS + 128)
__device__ __forceinline__ float gelu_erf_fast(float v) {
  const float av = fabsf(v), t = __builtin_amdgcn_rcpf(av * 0.2316418882f + 1.0f);
  float q = t * 0.5307027145f + (-0.7265760135f); q = q * t + 0.7107068705f; q = q * t + (-0.142248368f); q = q * t + 0.127414796f; q = q * t;
  const float e = __builtin_amdgcn_exp2f((v * v) * (-0.72134752044f));
  const float m = v * (q * e);
  return v < 0.f ? m : v - m;
}
__device__ __forceinline__ float dot16_fp8(const uint4 r, const float (&h)[16]) {
  fx2 a; float d;
  a = FP8_LO(r.x); d = a.x * h[0] + a.y * h[1]; a = FP8_HI(r.x); d += a.x * h[2] + a.y * h[3];
  a = FP8_LO(r.y); d += a.x * h[4] + a.y * h[5]; a = FP8_HI(r.y); d += a.x * h[6] + a.y * h[7];
  a = FP8_LO(r.z); d += a.x * h[8] + a.y * h[9]; a = FP8_HI(r.z); d += a.x * h[10] + a.y * h[11];
  a = FP8_LO(r.w); d += a.x * h[12] + a.y * h[13]; a = FP8_HI(r.w); d += a.x * h[14] + a.y * h[15];
  return d;
}
#define FP4_B(w, b) __builtin_amdgcn_cvt_scalef32_pk_f32_fp4((w), 1.0f, (b))
__device__ __forceinline__ void axpy16_fp8(const float c, const uint2 r, float (&acc)[16]) {
  fx2 a;
  a = FP4_B(r.x, 0); acc[0] += c * a.x; acc[1] += c * a.y; a = FP4_B(r.x, 1); acc[2] += c * a.x; acc[3] += c * a.y;
  a = FP4_B(r.x, 2); acc[4] += c * a.x; acc[5] += c * a.y; a = FP4_B(r.x, 3); acc[6] += c * a.x; acc[7] += c * a.y;
  a = FP4_B(r.y, 0); acc[8] += c * a.x; acc[9] += c * a.y; a = FP4_B(r.y, 1); acc[10] += c * a.x; acc[11] += c * a.y;
  a = FP4_B(r.y, 2); acc[12] += c * a.x; acc[13] += c * a.y; a = FP4_B(r.y, 3); acc[14] += c * a.x; acc[15] += c * a.y;
}
#define DPPF(x, ctrl) __uint_as_float((unsigned)__builtin_amdgcn_update_dpp(0, (int)__float_as_uint(x), (ctrl), 0xF, 0xF, true))
typedef __bf16 bf16x2_t __attribute__((ext_vector_type(2)));
__device__ __forceinline__ float xsum32(float x) { const unsigned xi = __float_as_uint(x); const auto r = __builtin_amdgcn_permlane32_swap(xi, xi, false, false); return __uint_as_float(r[0]) + __uint_as_float(r[1]); }
__device__ __forceinline__ float xsum16(float x) { const unsigned xi = __float_as_uint(x); const auto r = __builtin_amdgcn_permlane16_swap(xi, xi, false, false); return __uint_as_float(r[0]) + __uint_as_float(r[1]); }
__device__ __forceinline__ float dot16_fp8_bf16(const uint2 r, const unsigned (&h)[8]) {
  float d;
  d = __builtin_amdgcn_fdot2_f32_bf16(__builtin_amdgcn_cvt_scalef32_pk_bf16_fp4(r.x, 1.0f, 0), __builtin_bit_cast(bf16x2_t, h[0]), 0.f, false);
  d = __builtin_amdgcn_fdot2_f32_bf16(__builtin_amdgcn_cvt_scalef32_pk_bf16_fp4(r.x, 1.0f, 1), __builtin_bit_cast(bf16x2_t, h[1]), d, false);
  d = __builtin_amdgcn_fdot2_f32_bf16(__builtin_amdgcn_cvt_scalef32_pk_bf16_fp4(r.x, 1.0f, 2), __builtin_bit_cast(bf16x2_t, h[2]), d, false);
  d = __builtin_amdgcn_fdot2_f32_bf16(__builtin_amdgcn_cvt_scalef32_pk_bf16_fp4(r.x, 1.0f, 3), __builtin_bit_cast(bf16x2_t, h[3]), d, false);
  d = __builtin_amdgcn_fdot2_f32_bf16(__builtin_amdgcn_cvt_scalef32_pk_bf16_fp4(r.y, 1.0f, 0), __builtin_bit_cast(bf16x2_t, h[4]), d, false);
  d = __builtin_amdgcn_fdot2_f32_bf16(__builtin_amdgcn_cvt_scalef32_pk_bf16_fp4(r.y, 1.0f, 1), __builtin_bit_cast(bf16x2_t, h[5]), d, false);
  d = __builtin_amdgcn_fdot2_f32_bf16(__builtin_amdgcn_cvt_scalef32_pk_bf16_fp4(r.y, 1.0f, 2), __builtin_bit_cast(bf16x2_t, h[6]), d, false);
  d = __builtin_amdgcn_fdot2_f32_bf16(__builtin_amdgcn_cvt_scalef32_pk_bf16_fp4(r.y, 1.0f, 3), __builtin_bit_cast(bf16x2_t, h[7]), d, false);
  return d;
}
struct P5Set { uint2 ru0, ru1, ru2, ru3, rv0, rv1, rv2, rv3; float sume, cgme; };
__device__ __forceinline__ void p5_issue(const P& p, P5Set& S, int bid, LAS unsigned* wl, int lane, __amdgpu_buffer_rsrc_t rsU, __amdgpu_buffer_rsrc_t rsV) {
  const int j = bid >> 5, s = (bid & 31) * 4;
  LAS unsigned* lst = wl + j * 384;
  const int sl = s + (lane & 3);
  const unsigned eme = lst[3 * sl]; S.sume = __uint_as_float(lst[3 * sl + 1]); S.cgme = __uint_as_float(lst[3 * sl + 2]);
  const int em_ = (p.pad1 & 4) ? 1023 : 0x7FFFFFFF;
  const int e0 = __builtin_amdgcn_readlane((int)eme, 0) & em_, e1 = __builtin_amdgcn_readlane((int)eme, 1) & em_, e2 = __builtin_amdgcn_readlane((int)eme, 2) & em_, e3 = __builtin_amdgcn_readlane((int)eme, 3) & em_;
  const int l16 = 8 * lane;
  typedef unsigned v2u_ __attribute__((ext_vector_type(2)));
#define P5_LD(dst, rs, e) do { const v2u_ t_ = __builtin_amdgcn_raw_buffer_load_b64(rs, l16, (e) * 512, 0); dst = make_uint2(t_.x, t_.y); } while (0)
  P5_LD(S.ru0, rsU, e0); P5_LD(S.ru1, rsU, e1); P5_LD(S.ru2, rsU, e2); P5_LD(S.ru3, rsU, e3);
  P5_LD(S.rv0, rsV, e0); P5_LD(S.rv1, rsV, e1); P5_LD(S.rv2, rsV, e2); P5_LD(S.rv3, rsV, e3);
#undef P5_LD
}
__device__ __forceinline__ void p5_compute(const P5Set& S, LAS unsigned* ent, const unsigned (&hfp)[8], float (&acc)[16], int lane, int pf) {
  float d0 = dot16_fp8_bf16(S.ru0, hfp), d1 = dot16_fp8_bf16(S.ru1, hfp), d2 = dot16_fp8_bf16(S.ru2, hfp), d3 = dot16_fp8_bf16(S.ru3, hfp);
  {
    const bool up1 = (lane & 1) != 0;
    const float s01 = up1 ? d0 : d1, k01 = up1 ? d1 : d0, s23 = up1 ? d2 : d3, k23 = up1 ? d3 : d2;
    const float a = k01 + DPPF(s01, 0xB1), b = k23 + DPPF(s23, 0xB1);
    const bool up2 = (lane & 2) != 0;
    const float sab = up2 ? a : b, kab = up2 ? b : a;
    d0 = kab + DPPF(sab, 0x4E);
    d0 += DPPF(d0, 0x124); d0 += DPPF(d0, 0x128);
    d0 = xsum16(d0); d0 = xsum32(d0);
  }
  const float cme = gelu_erf_fast(d0 * S.sume) * S.cgme;
  const float c0 = __uint_as_float((unsigned)__builtin_amdgcn_readlane((int)__float_as_uint(cme), 0));
  const float c1 = __uint_as_float((unsigned)__builtin_amdgcn_readlane((int)__float_as_uint(cme), 1));
  const float c2 = __uint_as_float((unsigned)__builtin_amdgcn_readlane((int)__float_as_uint(cme), 2));
  const float c3 = __uint_as_float((unsigned)__builtin_amdgcn_readlane((int)__float_as_uint(cme), 3));
  (void)pf; (void)ent;
  axpy16_fp8(c0, S.rv0, acc); axpy16_fp8(c1, S.rv1, acc); axpy16_fp8(c2, S.rv2, acc); axpy16_fp8(c3, S.rv3, acc);
}
#define P5_COMPUTE(S, bid) do { const int j_ = (bid) >> 5; LAS unsigned* ent_ = wl + j_ * 384 + 12 * ((bid) & 31); \
    if (j_ == 0) p5_compute(S, ent_, hfp[0], acc[0], lane, p.pad1); else if (j_ == 1) p5_compute(S, ent_, hfp[1], acc[1], lane, p.pad1); \
    else if (j_ == 2) p5_compute(S, ent_, hfp[2], acc[2], lane, p.pad1); else p5_compute(S, ent_, hfp[3], acc[3], lane, p.pad1); } while (0)

__device__ __forceinline__ void rank128(int k0, int k1, int lane, int& r0, int& r1) {
  r0 = 0; r1 = 0;
#pragma unroll 8
  for (int i = 0; i < 64; ++i) {
    const int a = __builtin_amdgcn_readlane(k0, i), b = __builtin_amdgcn_readlane(k1, i);
    r0 += ((a < k0) || (a == k0 && i < lane)) ? 1 : 0;
    r0 += (b < k0) ? 1 : 0;
    r1 += (a <= k1) ? 1 : 0;
    r1 += ((b < k1) || (b == k1 && i < lane)) ? 1 : 0;
  }
}

__device__ void phase5_experts(const P& p, LAS unsigned char* lds, int wid_s) {
  const int tid = mk_tid(wid_s), lane_in = tid & 63, wid = wid_s;
  const int gw = blockIdx.x * 8 + wid;
  LAS unsigned* wl = (LAS unsigned*)lds + wid * P5_WAVE_WORDS;
  const __amdgpu_buffer_rsrc_t rsU = __builtin_amdgcn_make_buffer_rsrc(p.U8, 0, 8 << 20, 0x00020000), rsV = __builtin_amdgcn_make_buffer_rsrc(p.V8, 0, 8 << 20, 0x00020000);
  LAS unsigned* ord = wl + P5_LIST_WORDS;
#pragma unroll 1
  for (int sweep = 0; sweep < 2; ++sweep) {
    const int tb = (sweep * 2048 + gw) * 4;
    int lane = lane_in; asm volatile("" : "+v"(lane));
    unsigned hfp[4][8];
    float acc[4][16];
#pragma unroll 1
    for (int j = 0; j < 4; ++j) {
      const size_t t = (size_t)tb + j;
      const int e0 = p.experts[t * 128 + lane], e1 = p.experts[t * 128 + 64 + lane];
      const float g0 = p.gates[t * 128 + lane], g1 = p.gates[t * 128 + 64 + lane];
      const float su0 = p.su[e0], su1 = p.su[e1], sv0 = p.sv[e0], sv1 = p.sv[e1];
      int r0, r1;
      if (p.pad1 & 2) { r0 = lane; r1 = lane + 64; } else rank128(e0, e1, lane, r0, r1);
      LAS unsigned* lst = wl + j * 384;
      lst[3 * r0] = (unsigned)e0; lst[3 * r0 + 1] = __float_as_uint(su0); lst[3 * r0 + 2] = __float_as_uint(g0 * sv0);
      lst[3 * r1] = (unsigned)e1; lst[3 * r1 + 1] = __float_as_uint(su1); lst[3 * r1 + 2] = __float_as_uint(g1 * sv1);
    }
    asm volatile("s_waitcnt lgkmcnt(0)" ::: "memory");
#pragma unroll
    for (int j = 0; j < 4; ++j) {
      const size_t t = (size_t)tb + j;
      const u16* x1r = p.x1b + t * DM;
      const float rs = rsqrtf(p.ss_ffn[t] * (1.f / DM) + 1e-6f);
#pragma unroll
      for (int i = 0; i < 4; ++i) { const uint2 xw = *(const uint2*)(x1r + 256 * i + 4 * lane); const float4 xv = make_float4(bflo(xw.x), bfhi(xw.x), bflo(xw.y), bfhi(xw.y)); const float4 g = *(const float4*)(p.g_ffn + 256 * i + 4 * lane);
        hfp[j][2 * i] = pack_bf2(xv.x * rs * g.x, xv.y * rs * g.y); hfp[j][2 * i + 1] = pack_bf2(xv.z * rs * g.z, xv.w * rs * g.w); }
#pragma unroll
      for (int i = 0; i < 16; ++i) acc[j][i] = 0.f;
    }
    asm volatile("s_waitcnt lgkmcnt(0)" ::: "memory");
    if (!(p.pad1 & 1)) {
      P5Set A, B, C, D;
      p5_issue(p, A, 0 * 32 + 0, wl, lane, rsU, rsV);
      p5_issue(p, B, 1 * 32 + 0, wl, lane, rsU, rsV);
      p5_issue(p, C, 2 * 32 + 0, wl, lane, rsU, rsV);
#pragma unroll 1
      for (int c = 0; c < 32; ++c) {
        const int cn = min(c + 1, 31);
        p5_issue(p, D, 3 * 32 + c, wl, lane, rsU, rsV);
        p5_compute(A, nullptr, hfp[0], acc[0], lane, 0);
        p5_issue(p, A, 0 * 32 + cn, wl, lane, rsU, rsV);
        p5_compute(B, nullptr, hfp[1], acc[1], lane, 0);
        p5_issue(p, B, 1 * 32 + cn, wl, lane, rsU, rsV);
        p5_compute(C, nullptr, hfp[2], acc[2], lane, 0);
        p5_issue(p, C, 2 * 32 + cn, wl, lane, rsU, rsV);
        p5_compute(D, nullptr, hfp[3], acc[3], lane, 0);
      }
      asm volatile("s_waitcnt vmcnt(0)" ::: "memory");
    }
    int lane_e = lane; asm volatile("" : "+v"(lane_e));
#pragma unroll
    for (int j = 0; j < 4; ++j) {
      const u16* x1r = p.x1b + ((size_t)tb + j) * DM; u16* x2r = p.x2b + ((size_t)tb + j) * DM;
#pragma unroll
      for (int i = 0; i < 4; ++i) {
        const uint2 xw = *(const uint2*)(x1r + 256 * i + 4 * lane_e);
        *(uint2*)(x2r + 256 * i + 4 * lane_e) = make_uint2(pack_bf2(bflo(xw.x) + acc[j][4 * i], bfhi(xw.x) + acc[j][4 * i + 1]), pack_bf2(bflo(xw.y) + acc[j][4 * i + 2], bfhi(xw.y) + acc[j][4 * i + 3]));
      }
    }
  }
}

struct Epi6a {
  static constexpr bool PERM = false, AFTER_DRAIN = false;
  P p;
  __device__ __forceinline__ void operator()(const pg8::f32x4 (&acc)[2][2][4][2], const pg8::Unit& u, int wr, int wc, int fr_in, int fq_in) const {
    int fr = fr_in, fq = fq_in; asm volatile("" : "+v"(fr), "+v"(fq));
    const int rowb = u.pm * 256 + wr * 64 + fr;
    const int colb = u.pn * 256 + wc * 32 + 4 * fq;
#pragma unroll
    for (int ai = 0; ai < 2; ++ai)
#pragma unroll
      for (int m = 0; m < 4; ++m) { const int row = rowb + ai * 128 + m * 16;
#pragma unroll
        for (int bj = 0; bj < 2; ++bj)
#pragma unroll
          for (int n = 0; n < 2; ++n) { const int col = colb + bj * 128 + 16 * n;
            const pg8::f32x4 v = acc[ai][bj][m][n];
            uint2 o; o.x = pack_bf2(v[0], v[1]); o.y = pack_bf2(v[2], v[3]);
            *(uint2*)(p.pple + (size_t)row * DM + col) = o; } }
  }
};
struct Epi6b {
  static constexpr bool PERM = false, AFTER_DRAIN = false;
  P p;
  __device__ __forceinline__ void operator()(const pg8::f32x4 (&acc)[2][2][4][2], const pg8::Unit& u, int wr, int wc, int fr_in, int fq_in) const {
    int fr = fr_in, fq = fq_in; asm volatile("" : "+v"(fr), "+v"(fq));
    const int rowb = u.pm * 256 + wr * 64 + fr;
    const int colb = u.pn * 256 + wc * 32 + 4 * fq;
#pragma unroll
    for (int ai = 0; ai < 2; ++ai)
#pragma unroll
      for (int m = 0; m < 4; ++m) { const int row = rowb + ai * 128 + m * 16;
        float s = 0.f;
#pragma unroll
        for (int bj = 0; bj < 2; ++bj)
#pragma unroll
          for (int n = 0; n < 2; ++n) { const int col = colb + bj * 128 + 16 * n;
            const uint2 x2w = *(const uint2*)(p.x2b + (size_t)row * DM + col); const float4 x2 = make_float4(bflo(x2w.x), bfhi(x2w.x), bflo(x2w.y), bfhi(x2w.y));
            const uint2 pw = *(const uint2*)(p.pple + (size_t)row * DM + col);
            const pg8::f32x4 a = acc[ai][bj][m][n];
            const float v0 = x2.x + sigmoidf_(a[0]) * bflo(pw.x), v1 = x2.y + sigmoidf_(a[1]) * bfhi(pw.x);
            const float v2 = x2.z + sigmoidf_(a[2]) * bflo(pw.y), v3 = x2.w + sigmoidf_(a[3]) * bfhi(pw.y);
            s += v0 * v0 + v1 * v1 + v2 * v2 + v3 * v3;
            *(float4*)(p.out + (size_t)row * DM + col) = make_float4(v0, v1, v2, v3); }
        s += __shfl_xor(s, 16, 64); s += __shfl_xor(s, 32, 64);
        if (fq == 0) atomicAdd(p.ss_fin + row, s);
        asm volatile("" ::: "memory"); }
  }
};
__device__ void phase6_ple(const P& p, LAS unsigned char* lds, int wid_s) {
  { pg8::Gemm g; g.A = p.p16; g.Bt = p.WpleT; g.M = T_TOK; g.N = 1024; g.K = p.k256;
    pg8::StaticOrder S; S.init(T_TOK, 1024, gridDim.x, blockIdx.x);
    Epi6a E; E.p = p;
    pg8::gemm_phase<Epi6a, pg8::StaticOrder>(lds, g, S, E, nullptr, wid_s); }
  { pg8::Gemm g; g.A = p.x2b; g.Bt = p.WgT; g.M = T_TOK; g.N = 1024; g.K = p.k1024;
    pg8::StaticOrder S; S.init(T_TOK, 1024, gridDim.x, blockIdx.x);
    Epi6b E; E.p = p;
    pg8::gemm_phase<Epi6b, pg8::StaticOrder>(lds, g, S, E, nullptr, wid_s); }
}
__device__ void phase7_final(const P& p, int wid_s) {
  const int gt = blockIdx.x * 512 + mk_tid(wid_s), nt = gridDim.x * 512;
  for (int i = gt; i < T_TOK * DM / 4; i += nt) {
    const int row = i >> 8, c4 = i & 255;
    const float rs = rsqrtf(p.ss_fin[row] * (1.f / DM) + 1e-6f);
    const float4 v = ((const float4*)p.out)[i];
    const float4 g = ((const float4*)p.g_final)[c4];
    ((float4*)p.out)[i] = make_float4(v.x * rs * g.x, v.y * rs * g.y, v.z * rs * g.z, v.w * rs * g.w);
  }
}
#define XB_TMO      128
#define XB_XCNT(j)  (256  + 64 * (j))
#define XB_XSUB(j)  (1280 + 64 * (j))
#define XB_XGEN(j)  (2304 + 64 * (j))
#define XB_TOP      3328
#define XB_TOPGEN   3392
#define XCD_BAR_WORDS 3456
#define XB_SPIN_CAP (1u << 22)
__device__ __forceinline__ unsigned xb_ld(unsigned* p)              { return __hip_atomic_load(p, __ATOMIC_RELAXED, __HIP_MEMORY_SCOPE_AGENT); }
__device__ __forceinline__ unsigned xb_add(unsigned* p, unsigned v) { return __hip_atomic_fetch_add(p, v, __ATOMIC_RELAXED, __HIP_MEMORY_SCOPE_AGENT); }
__device__ __forceinline__ unsigned xb_xcc_id() { return (unsigned)__builtin_amdgcn_s_getreg((3 << 11) | 20) & 0xFu; }
#define XB_SPIN(cond, bar) do { unsigned _sp = 0; while (cond) { __builtin_amdgcn_s_sleep(1); \
    if ((++_sp & 255u) == 0u) { if (xb_ld(&(bar)[XB_TMO])) break; if (_sp > XB_SPIN_CAP) { atomicAdd(&(bar)[XB_TMO], 1u); break; } } } } while (0)
struct XcdBarrier { unsigned* bar; unsigned x; volatile LAS unsigned* st; };
__device__ __forceinline__ XcdBarrier xcd_barrier_post(unsigned* bar, volatile LAS unsigned* st, int wid_s) {
    XcdBarrier b; b.bar = bar; b.x = xb_xcc_id(); b.st = st;
    if (mk_tid(wid_s) == 0) (void)xb_add(&bar[XB_XCNT(b.x)], 1u);
    return b;
}
__device__ __forceinline__ void xcd_barrier_complete(unsigned* bar, unsigned x, unsigned& nloc, unsigned& nx) {
    const unsigned G = gridDim.x * gridDim.y * gridDim.z;
    unsigned sum, cnt, mine, sp = 0u;
    for (;;) {
        sum = 0u; cnt = 0u; mine = 0u;
#pragma unroll
        for (unsigned j = 0; j < 16; ++j) { const unsigned c = xb_ld(&bar[XB_XCNT(j)]); sum += c; cnt += (c > 0u) ? 1u : 0u; mine = (j == x) ? c : mine; }
        if (sum == G) break;
        __builtin_amdgcn_s_sleep(1);
        if ((++sp & 255u) == 0u) { if (xb_ld(&bar[XB_TMO])) break; if (sp > XB_SPIN_CAP) { atomicAdd(&bar[XB_TMO], 1u); break; } }
    }
    nloc = mine > 0u ? mine : 1u; nx = cnt > 0u ? cnt : 1u;
}
__device__ __forceinline__ void xcd_barrier2(unsigned* bar_, volatile LAS unsigned* st_, int wid_s) {
    XcdBarrier b; b.bar = bar_; b.st = st_; b.x = xb_xcc_id();
    asm volatile("s_waitcnt vmcnt(0)" ::: "memory");
    __syncthreads();
    if (mk_tid(wid_s) == 0) {
        unsigned* bar = b.bar;
        __builtin_amdgcn_s_waitcnt(0);
        unsigned nloc = b.st[0], nx = b.st[1];
        if (nloc == 0u) { xcd_barrier_complete(bar, b.x, nloc, nx); b.st[0] = nloc; b.st[1] = nx; }
        const unsigned old = xb_add(&bar[XB_XSUB(b.x)], 1u);
        const unsigned gen = old / nloc;
        if (old + 1u == (gen + 1u) * nloc) {
            __builtin_amdgcn_fence(__ATOMIC_RELEASE, "agent");
            asm volatile("s_waitcnt vmcnt(0)" ::: "memory");
            const unsigned og = xb_add(&bar[XB_TOP], 1u);
            const unsigned tg = og / nx;
            if (og + 1u == (tg + 1u) * nx) xb_add(&bar[XB_TOPGEN], 1u);
            else XB_SPIN(xb_ld(&bar[XB_TOPGEN]) == tg, bar);
            __builtin_amdgcn_fence(__ATOMIC_ACQUIRE, "agent");
            xb_add(&bar[XB_XGEN(b.x)], 1u);
            asm volatile("s_waitcnt vmcnt(0)" ::: "memory");
        } else {
            XB_SPIN(xb_ld(&bar[XB_XGEN(b.x)]) == gen, bar);
            __builtin_amdgcn_fence(__ATOMIC_ACQUIRE, "agent");
            asm volatile("s_waitcnt vmcnt(0)" ::: "memory");
        }
    }
    __syncthreads();
}
static void fill_params(P& p, void* const* d_in, void* d_out, void* d_ws, size_t ws_size, size_t* used) {
  p.x = (const float*)d_in[0]; p.p = (const float*)d_in[1]; p.pos = (const int*)d_in[2]; p.g_mix = (const float*)d_in[3];
  p.w_in = (const float*)d_in[4]; p.g_kv = (const float*)d_in[5]; p.w_uk = (const float*)d_in[6]; p.w_uv = (const float*)d_in[7];
  p.conv_w = (const float*)d_in[8]; p.conv_b = (const float*)d_in[9]; p.w_rg = (const float*)d_in[10]; p.b_rg = (const float*)d_in[11];
  p.w_ig = (const float*)d_in[12]; p.b_ig = (const float*)d_in[13]; p.lam = (const float*)d_in[14]; p.w_out = (const float*)d_in[15];
  p.g_ffn = (const float*)d_in[16]; p.w_pq = (const float*)d_in[17]; p.k1 = (const float*)d_in[18]; p.k2 = (const float*)d_in[19];
  p.u_tab = (const float*)d_in[20]; p.v_tab = (const float*)d_in[21]; p.w_ple = (const float*)d_in[22]; p.w_gate = (const float*)d_in[23];
  p.g_final = (const float*)d_in[24];
  p.out = (float*)d_out; p.k1024 = 1024; p.k256 = 256; p.pad0 = 0; p.pad1 = 0;
  char* ws = (char*)d_ws; size_t off = 0;
  auto alloc = [&](size_t bytes) { void* r = ws + off; off += (bytes + 255) & ~(size_t)255; return r; };
  const size_t T = T_TOK;
  p.bar = (unsigned*)alloc(16384);
  p.ctr = (unsigned*)alloc(256);
  p.rstd_mix = (float*)alloc(T * 4); p.ss_ffn = (float*)alloc(T * 4); p.ss_fin = (float*)alloc(T * 4);
  p.ropeA = (float*)alloc(T * 32 * 4); p.ropeI = (float*)alloc(T * 16 * 4);
  p.W1t = (u16*)alloc((size_t)N1 * 1024 * 2); p.WoutT = (u16*)alloc(1024 * 1024 * 2); p.WpqT = (u16*)alloc(2048 * 1024 * 2);
  p.WgT = (u16*)alloc(1024 * 1024 * 2); p.WpleT = (u16*)alloc(1024 * 256 * 2);
  p.K1b = (u16*)alloc(8 * 128 * 128 * 2); p.K2b = (u16*)alloc(8 * 128 * 128 * 2);
  p.WrgT = (u16*)alloc(8 * 64 * 64 * 2); p.WigT = (u16*)alloc(8 * 64 * 64 * 2);
  p.U8 = (unsigned char*)alloc((size_t)16384 * 1024); p.V8 = (unsigned char*)alloc((size_t)16384 * 1024); p.su = (float*)alloc(16384 * 4); p.sv = (float*)alloc(16384 * 4);
  p.p16 = (u16*)alloc(T * 256 * 2);
  p.experts = (int*)alloc(T * 128 * 4); p.gates = (float*)alloc(T * 128 * 4);
  p.xb16 = (u16*)alloc(T * 1024 * 2); p.mix = p.xb16; p.x2b = p.xb16;
  char* rb = ws + off; size_t rboff = 0;
  auto allocB = [&](size_t bytes) { void* r = rb + rboff; rboff += (bytes + 255) & ~(size_t)255; return r; };
  p.qcat = (u16*)allocB(T * 640 * 2); p.kv = (u16*)allocB(T * 160 * 2); p.iqh = (u16*)allocB(T * 512 * 2); p.ikh = (u16*)allocB(T * 64 * 2);
  p.iw = (float*)allocB(T * 8 * 4); p.xbr = (u16*)allocB(T * 512 * 2); p.gate = (u16*)allocB(T * 512 * 2);
  size_t b1 = rboff; rboff = 0;
  p.x1b = (u16*)allocB(T * 1024 * 2); p.pq = (u16*)allocB(T * 2048 * 2); p.pple = p.x1b;
  size_t b2 = rboff;
  off += (b1 > b2 ? b1 : b2);
  *used = off;
}
namespace cg = cooperative_groups;
#ifndef USE_XCD_BARRIER
#define USE_XCD_BARRIER 0
#endif
__global__ void __launch_bounds__(512, 2) mega(P p) {
  extern __shared__ __attribute__((aligned(16))) unsigned char smem[];
  LAS unsigned char* lds = (LAS unsigned char*)smem;
  const int wid_s = __builtin_amdgcn_readfirstlane((int)(threadIdx.x >> 6));
  cg::grid_group grid = cg::this_grid();
#if USE_XCD_BARRIER
  volatile LAS unsigned* xst = (volatile LAS unsigned*)(lds + LDS_BYTES - 16);
  if (mk_tid(wid_s) == 0) { xst[0] = 0u; xst[1] = 0u; xst[2] = 0u; xst[3] = 0u; }
  __syncthreads();
  (void)xcd_barrier_post(p.bar, xst, wid_s);
#define GRID_SYNC() xcd_barrier2(p.bar, (volatile LAS unsigned*)(lds + LDS_BYTES - 16), wid_s)
#else
#define GRID_SYNC() grid.sync()
#endif
  phase0_prep(p, lds, wid_s);
#if USE_XCD_BARRIER
  if (p.k256 == 257) grid.sync();
  GRID_SYNC();
#else
  grid.sync();
#endif
  phase1_gemm1(p, lds, wid_s);
  GRID_SYNC();
  phase2(p, lds, wid_s);
  GRID_SYNC();
  phase3_outproj(p, lds, wid_s);
  GRID_SYNC();
  phase4_pq(p, lds, wid_s);
  GRID_SYNC();
  phase4b_route(p, lds, wid_s);
  GRID_SYNC();
  phase5_experts(p, lds, wid_s);
  GRID_SYNC();
  phase6_ple(p, lds, wid_s);
  GRID_SYNC();
  phase7_final(p, wid_s);
}

extern "C" void kernel_launch(void* const* d_in, const int* in_sizes, int n_in, void* d_out, int out_size, void* d_ws,
                              size_t ws_size, hipStream_t stream) {
  P p; memset(&p, 0, sizeof(p));
  size_t used = 0;
  fill_params(p, d_in, d_out, d_ws, ws_size, &used);
  static int grid_blocks = 0;
  if (!grid_blocks) {
    (void)hipFuncSetAttribute((const void*)mega, hipFuncAttributeMaxDynamicSharedMemorySize, LDS_BYTES);
    int dev = 0, cus = 0, per_cu = 0;
    (void)hipGetDevice(&dev);
    (void)hipDeviceGetAttribute(&cus, hipDeviceAttributeMultiprocessorCount, dev);
    (void)hipOccupancyMaxActiveBlocksPerMultiprocessor(&per_cu, mega, 512, LDS_BYTES);
    if (per_cu > 1) per_cu = 1;
    grid_blocks = cus * per_cu;
    if (grid_blocks <= 0) grid_blocks = 256;
  }
#if USE_XCD_BARRIER
  (void)hipMemsetAsync(p.bar, 0, XCD_BAR_WORDS * 4, stream);
#endif
  void* args[] = {&p};
  (void)hipLaunchCooperativeKernel((void*)mega, dim3(grid_blocks), dim3(512), args, LDS_BYTES, stream);
}
```

```cpp
#define USE_XCD_BARRIER 1
#include <hip/hip_runtime.h>
#include <hip/hip_cooperative_groups.h>
#include <math.h>
#include <stdint.h>
#include <string.h>

#define T_TOK 16384
#define SEQ 2048
#define NB 8
#define DM 1024
#define INTOT 2280
#define N1 2560
#define LDS_BYTES 163840
#define PRESCALE 0.12751743f
#define IDXSCALE 0.04419417382415922f

typedef unsigned short u16;
typedef _Float16 f16;
typedef _Float16 f16x8 __attribute__((ext_vector_type(8)));
typedef _Float16 f16x4 __attribute__((ext_vector_type(4)));
typedef short s16x8 __attribute__((ext_vector_type(8)));
typedef short s16x4 __attribute__((ext_vector_type(4)));
typedef float fx4 __attribute__((ext_vector_type(4)));
typedef float fx16 __attribute__((ext_vector_type(16)));
typedef float fx2 __attribute__((ext_vector_type(2)));
#define LAS __attribute__((address_space(3)))
#if defined(__HIP_DEVICE_COMPILE__)
#define LDS_STORE(T, ptr, val) (*(LAS T*)(ptr) = (val))
#define LDS_ST_FX4(ptr, val) (*(LAS fx4*)(ptr) = (val))
#else
#define LDS_STORE(T, ptr, val) ((void)0)
#define LDS_ST_FX4(ptr, val) ((void)0)
#endif

__device__ __forceinline__ int mk_tid(int wid_s) {
  int l;
  asm volatile("v_mbcnt_lo_u32_b32 %0, -1, 0\n\tv_mbcnt_hi_u32_b32 %0, -1, %0" : "=v"(l));
  return wid_s * 64 + l;
}
__device__ __forceinline__ u16 f2bf(float f) {
  unsigned u = __float_as_uint(f);
  u += 0x7FFFu + ((u >> 16) & 1u);
  return (u16)(u >> 16);
}
__device__ __forceinline__ unsigned pack_bf2(float lo, float hi) { return (unsigned)f2bf(lo) | ((unsigned)f2bf(hi) << 16); }
__device__ __forceinline__ float bf2f(u16 v) { return __uint_as_float((unsigned)v << 16); }
__device__ __forceinline__ float bflo(unsigned v) { return __uint_as_float(v << 16); }
__device__ __forceinline__ float bfhi(unsigned v) { return __uint_as_float(v & 0xFFFF0000u); }
__device__ __forceinline__ unsigned pack_h2(float lo, float hi) {
  f16 a = (f16)lo, b = (f16)hi;
  return (unsigned)__builtin_bit_cast(unsigned short, a) | ((unsigned)__builtin_bit_cast(unsigned short, b) << 16);
}
__device__ __forceinline__ float wave_sum(float v) {
#pragma unroll
  for (int o = 32; o > 0; o >>= 1) v += __shfl_xor(v, o, 64);
  return v;
}
__device__ __forceinline__ float wave_max(float v) {
#pragma unroll
  for (int o = 32; o > 0; o >>= 1) v = fmaxf(v, __shfl_xor(v, o, 64));
  return v;
}
__device__ __forceinline__ float sigmoidf_(float x) { return 1.f / (1.f + __expf(-x)); }
__device__ __forceinline__ float gelu_tanh_f(float x) {
  const float u = 0.7978845608028654f * (x + 0.044715f * x * x * x);
  const float e = __expf(2.f * u);
  const float th = 1.f - 2.f / (e + 1.f);
  return 0.5f * x * (1.f + th);
}
__device__ __forceinline__ float gelu_erf_f(float x) { return 0.5f * x * (1.f + erff(x * 0.7071067811865476f)); }

struct P {
  const float* x; const float* p; const int* pos; const float* g_mix; const float* w_in; const float* g_kv;
  const float* w_uk; const float* w_uv; const float* conv_w; const float* conv_b; const float* w_rg; const float* b_rg;
  const float* w_ig; const float* b_ig; const float* lam; const float* w_out; const float* g_ffn; const float* w_pq;
  const float* k1; const float* k2; const float* u_tab; const float* v_tab; const float* w_ple; const float* w_gate;
  const float* g_final;
  float* out;
  u16* xb16; float* rstd_mix; float* ropeA; float* ropeI;
  u16* W1t; u16* WoutT; u16* WpqT; u16* WgT; u16* WpleT; u16* K1b; u16* K2b; u16* WrgT; u16* WigT;
  unsigned char* U8; unsigned char* V8; float* su; float* sv; u16* p16;
  u16* qcat; u16* kv; u16* iqh; u16* ikh; float* iw; u16* xbr; u16* gate;
  u16* mix; u16* x1b; u16* pq; float* ss_ffn; float* ss_fin;
  int* experts; float* gates; u16* x2b; u16* pple;
  unsigned* ctr; unsigned* bar;
  int k1024, k256, pad0, pad1;
};
namespace pg8 {
#define PG8_LAS __attribute__((address_space(3)))
typedef unsigned short bf16_t;
typedef short bf16x8 __attribute__((ext_vector_type(8)));
typedef float f32x4 __attribute__((ext_vector_type(4)));
typedef unsigned u32x4 __attribute__((ext_vector_type(4)));
constexpr int BM = 256, BK = 64, HALF = 128, HTB = HALF * BK * 2  , STAGE_BYTES = 8 * HTB, NXCD = 8, WGM = 8;

__host__ __device__ __forceinline__ int lds_byte(int r, int c) { const int st = (r >> 4) * 2 + (c >> 5), rr = r & 15, cc = c & 31, ob = rr * 64 + cc * 2; return st * 1024 + (ob ^ (((ob >> 9) & 1) << 5)); }
__host__ __device__ __forceinline__ void stage_rc(int b, int& R, int& C) { const int st = b / 1024, sb = b % 1024, swz = sb ^ (((sb >> 9) & 1) << 5); R = (st >> 1) * 16 + swz / 64; C = (st & 1) * 32 + (swz % 64) / 2; }
__host__ __device__ __forceinline__ int perm32(int rho) { const int n = rho >> 4, i = rho & 15; return 8 * (i >> 2) + 4 * n + (i & 3); }

struct Unit { int pm, pn; };
struct Gemm { const bf16_t* A; const bf16_t* Bt; int M, N, K; };

struct StaticOrder {
    int nM, nN, nwg, G, c;
    __host__ __device__ void init(int M, int N, int G_, int c_) { nM = M / BM; nN = N / BM; nwg = nM * nN; G = G_; c = c_; }
    __host__ __device__ bool next(int i, Unit& u) const {
        const long L = (long)i * G + c; if (L >= nwg) return false;
        int wgid = (int)L; { const int q = nwg / NXCD, r = nwg % NXCD, xcd = wgid % NXCD, off = wgid / NXCD; wgid = (xcd < r ? xcd * (q + 1) : r * (q + 1) + (xcd - r) * q) + off; }
        const int nig = WGM * nN, gid = wgid / nig, fm = gid * WGM, gsz = (nM - fm) < WGM ? (nM - fm) : WGM;
        u.pm = fm + ((wgid % nig) % gsz); u.pn = (wgid % nig) / gsz; return true;
    }
    __device__ __forceinline__ void a_ready(const Unit&) const {}
    __device__ __forceinline__ void done(const Unit&) const {}
};
__device__ __forceinline__ unsigned cvt_pk_bf16(float lo, float hi) { unsigned r; asm volatile("v_cvt_pk_bf16_f32 %0, %1, %2" : "=v"(r) : "v"(lo), "v"(hi)); return r; }
typedef float f32x2 __attribute__((ext_vector_type(2)));
__device__ __forceinline__ f32x2 gelu_pk(f32x2 v) {
    const f32x2 av = __builtin_elementwise_abs(v), d = av * 0.2316418882f + 1.0f;
    f32x2 t; t.x = __builtin_amdgcn_rcpf(d.x); t.y = __builtin_amdgcn_rcpf(d.y);
    f32x2 q = t * 0.5307027145f + (-0.7265760135f); q = q * t + 0.7107068705f; q = q * t + (-0.142248368f); q = q * t + 0.127414796f; q = q * t;
    const f32x2 s = (v * v) * (-0.72134752044f);
    f32x2 e; e.x = __builtin_amdgcn_exp2f(s.x); e.y = __builtin_amdgcn_exp2f(s.y);
    const f32x2 m = v * (q * e), r = v - m;
    f32x2 o; o.x = v.x < 0.f ? m.x : r.x; o.y = v.y < 0.f ? m.y : r.y; return o;
}

template <class Epi, class Sched, bool STAMP = false>
__device__ __forceinline__ void gemm_phase(PG8_LAS unsigned char* lds, const Gemm g, const Sched& S, const Epi& E, unsigned long long* stamps, int wid_s) {
    const int tid = mk_tid(wid_s), wid = __builtin_amdgcn_readfirstlane(tid >> 6), lane = tid & 63, wr = wid >> 2, wc = wid & 3, fr = lane & 15, fq = lane >> 4;
    const int K = g.K, nt = K / BK;
    int ts_lo = 0, ts_hi = 0, nts = 0; const unsigned long long rt_entry = STAMP ? (unsigned long long)wall_clock64() : 0ull;
#define PG8_STAMP() do { if (STAMP && wid == 0 && nts < 64) { const unsigned long long _c = (unsigned long long)clock64(); \
        ts_lo = (lane == nts) ? (int)(unsigned)_c : ts_lo; ts_hi = (lane == nts) ? (int)(unsigned)(_c >> 32) : ts_hi; ++nts; } } while (0)
    PG8_STAMP();
    unsigned voffA[2], voffB[2];
#pragma unroll
    for (int i = 0; i < 2; ++i) { int R, C; stage_rc(tid * 16 + i * 8192, R, C); const int Rb = Epi::PERM ? ((R & ~31) + perm32(R & 31)) : R;
        voffA[i] = (unsigned)(R * K + C) * 2u; voffB[i] = (unsigned)(Rb * K + C) * 2u; }
    const size_t kstep = (size_t)(BK * 2);
    const size_t hstep = (size_t)HALF * K * 2;
    const size_t tstep = 2 * hstep;
    const unsigned ldsw = (unsigned)wid * 1024u;
    const int aoff = lds_byte(wr * 64 + fr, fq * 8), boff = lds_byte(wc * 32 + fr, fq * 8);
#define PG8_SA(b, h) (((b) * 2 + (h)) * HTB)
#define PG8_SB(b, h) ((4 + (b) * 2 + (h)) * HTB)
#define PG8_STAGE(bufoff, gbase, voff) do { _Pragma("unroll") for (int _i = 0; _i < 2; ++_i) \
        __builtin_amdgcn_global_load_lds((const unsigned*)((const char*)(gbase) + (voff)[_i]), (PG8_LAS unsigned*)(lds + (bufoff) + ldsw + _i * 8192), 16, 0, 0); } while (0)
#define PG8_LDA(dst, b, h) do { _Pragma("unroll") for (int m = 0; m < 4; ++m) _Pragma("unroll") for (int k = 0; k < 2; ++k) dst[m][k] = *(const PG8_LAS bf16x8*)(lds + PG8_SA(b, h) + aoff + m * 2048 + k * 1024); } while (0)
#define PG8_LDB(dst, b, h) do { _Pragma("unroll") for (int n = 0; n < 2; ++n) _Pragma("unroll") for (int k = 0; k < 2; ++k) dst[n][k] = *(const PG8_LAS bf16x8*)(lds + PG8_SB(b, h) + boff + n * 2048 + k * 1024); } while (0)
#define PG8_MMA(ai, bj, At, Bt) do { __builtin_amdgcn_s_setprio(1); _Pragma("unroll") for (int m = 0; m < 4; ++m) _Pragma("unroll") for (int n = 0; n < 2; ++n) _Pragma("unroll") for (int k = 0; k < 2; ++k) \
        acc[ai][bj][m][n] = __builtin_amdgcn_mfma_f32_16x16x32_bf16(Bt[n][k], At[m][k], acc[ai][bj][m][n], 0, 0, 0); __builtin_amdgcn_s_setprio(0); } while (0)
#define PG8_WAIT_V(n) asm volatile("s_waitcnt vmcnt(" #n ")" ::: "memory")
#define PG8_WAIT_L(n) asm volatile("s_waitcnt lgkmcnt(" #n ")" ::: "memory")
#define PG8_BAR __builtin_amdgcn_s_barrier()
#define PG8_SCHED __builtin_amdgcn_sched_barrier(0)
    Unit cur, nxt; int ui = 0;
    if (!S.next(0, cur)) return;
    f32x4 acc[2][2][4][2];
#pragma unroll
    for (int a = 0; a < 2; ++a)
#pragma unroll
        for (int b = 0; b < 2; ++b)
#pragma unroll
            for (int m = 0; m < 4; ++m)
#pragma unroll
                for (int n = 0; n < 2; ++n) acc[a][b][m][n] = (f32x4){0.f, 0.f, 0.f, 0.f};
    bf16x8 At[4][2], B0[2][2], B1[2][2];
    const char* cA = (const char*)g.A + (size_t)cur.pm * tstep; const char* cB = (const char*)g.Bt + (size_t)cur.pn * tstep;
    S.a_ready(cur);
    PG8_STAGE(PG8_SB(0, 0), cB, voffB); PG8_STAGE(PG8_SA(0, 0), cA, voffA); PG8_STAGE(PG8_SB(0, 1), cB + hstep, voffB); PG8_STAGE(PG8_SA(0, 1), cA + hstep, voffA);
    if (wr == 1) PG8_BAR;
    PG8_WAIT_V(4); PG8_BAR;
    PG8_STAGE(PG8_SB(1, 0), cB + kstep, voffB); PG8_STAGE(PG8_SA(1, 0), cA + kstep, voffA); PG8_STAGE(PG8_SB(1, 1), cB + hstep + kstep, voffB);
    PG8_WAIT_V(6); PG8_BAR;
    PG8_STAMP();
    for (;;) {
        const bool has_next = S.next(ui + 1, nxt);
        const char* nA = has_next ? (const char*)g.A + (size_t)nxt.pm * tstep : cA; const char* nB = has_next ? (const char*)g.Bt + (size_t)nxt.pn * tstep : cB;
        for (int t = 0; t < nt; t += 2) {
            const bool last = (t == nt - 2);
            const char* a1 = cA + (size_t)(t + 1) * kstep;
            const char* a2 = last ? nA : cA + (size_t)(t + 2) * kstep; const char* b2 = last ? nB : cB + (size_t)(t + 2) * kstep;
            const char* a3 = a2 + kstep; const char* b3 = b2 + kstep;
            if (last && has_next) S.a_ready(nxt);
            PG8_LDB(B0, 0, 0); PG8_SCHED; PG8_LDA(At, 0, 0); PG8_STAGE(PG8_SA(1, 1), a1 + hstep, voffA);
            PG8_WAIT_L(8); PG8_BAR; PG8_WAIT_L(0); PG8_MMA(0, 0, At, B0); PG8_BAR; PG8_SCHED;
            PG8_LDB(B1, 0, 1); PG8_STAGE(PG8_SB(0, 0), b2, voffB);
            PG8_BAR; PG8_WAIT_L(0); PG8_MMA(0, 1, At, B1); PG8_BAR;
            PG8_LDA(At, 0, 1); PG8_STAGE(PG8_SA(0, 0), a2, voffA);
            PG8_BAR; PG8_WAIT_L(0); PG8_MMA(1, 0, At, B0); PG8_BAR; PG8_SCHED;
            PG8_STAGE(PG8_SB(0, 1), b2 + hstep, voffB);
            PG8_WAIT_V(6); PG8_BAR; PG8_MMA(1, 1, At, B1); PG8_BAR;
            PG8_LDB(B0, 1, 0); PG8_SCHED; PG8_LDA(At, 1, 0); PG8_STAGE(PG8_SA(0, 1), a2 + hstep, voffA);
            PG8_WAIT_L(8); PG8_BAR; PG8_WAIT_L(0); PG8_MMA(0, 0, At, B0); PG8_BAR; PG8_SCHED;
            PG8_LDB(B1, 1, 1); PG8_STAGE(PG8_SB(1, 0), b3, voffB);
            PG8_BAR; PG8_WAIT_L(0); PG8_MMA(0, 1, At, B1); PG8_BAR;
            PG8_LDA(At, 1, 1); PG8_STAGE(PG8_SA(1, 0), a3, voffA);
            PG8_BAR; PG8_WAIT_L(0); PG8_MMA(1, 0, At, B0); PG8_BAR; PG8_SCHED;
            PG8_STAGE(PG8_SB(1, 1), b3 + hstep, voffB);
            PG8_WAIT_V(6); PG8_BAR; PG8_MMA(1, 1, At, B1); PG8_BAR;
        }
        PG8_STAMP();
        if constexpr (!Epi::AFTER_DRAIN) { E(acc, cur, wr, wc, fr, fq); S.done(cur); }
        PG8_STAMP();
        if (!has_next) break;
#pragma unroll
        for (int a = 0; a < 2; ++a)
#pragma unroll
            for (int b = 0; b < 2; ++b)
#pragma unroll
                for (int m = 0; m < 4; ++m)
#pragma unroll
                    for (int n = 0; n < 2; ++n) acc[a][b][m][n] = (f32x4){0.f, 0.f, 0.f, 0.f};
        cur = nxt; cA = nA; cB = nB; ++ui;
    }
    PG8_WAIT_V(0);
    if (wr == 0) PG8_BAR;
    PG8_BAR;
    if constexpr (Epi::AFTER_DRAIN) { E.fused(acc, cur, wr, wc, fr, fq, lds, wid, lane); S.done(cur); }
    PG8_STAMP();
    if (STAMP && wid == 0) { stamps[lane] = lane < nts ? (((unsigned long long)(unsigned)ts_hi << 32) | (unsigned)ts_lo) : 0ull;
        if (lane == 62) stamps[62] = rt_entry; if (lane == 63) stamps[63] = (unsigned long long)wall_clock64(); }
#undef PG8_STAMP
#undef PG8_SA
#undef PG8_SB
#undef PG8_STAGE
#undef PG8_LDA
#undef PG8_LDB
#undef PG8_MMA
#undef PG8_WAIT_V
#undef PG8_WAIT_L
#undef PG8_BAR
#undef PG8_SCHED
}
}
__device__ __forceinline__ int w1_src(int n, float& mul) {
  mul = 1.f;
  if (n < 1024) { const int r = n - 512, h = r >> 6, d = r & 63;
    if (d < 16) { const int i = d >> 1, e = d & 1; return 672 + h * 64 + (e ? 8 + i : i); }
    return 672 + h * 64 + d; }
  if (n < 1536) return 1256 + (n - 1024);
  if (n < 2048) return 1768 + (n - 1536);
  if (n < 2176) { const int r = n - 2048, h = r >> 5, j = r & 31, i = j >> 1, e = j & 1; mul = PRESCALE; return h * 128 + (e ? 16 + i : i); }
  if (n < 2304) return 512 + (n - 2176);
  if (n < 2336) { const int j = n - 2304, i = j >> 1, e = j & 1; return 640 + (e ? 16 + i : i); }
  if (n < 2400) { const int d = n - 2336;
    if (d < 16) { const int i = d >> 1, e = d & 1; return 1184 + (e ? 8 + i : i); }
    return 1184 + d; }
  if (n < 2408) { mul = IDXSCALE; return 1248 + (n - 2400); }
  return -1;
}

template <int MODE>
__device__ __forceinline__ void tr_tile(LAS float* tl, const float* __restrict__ src, int ld_src, u16* __restrict__ dst, int ld_dst,
                                        int n0, int k0, int dk0, const float* __restrict__ kscale, int tid) {
  {
    const int nl = tid & 63, kq = tid >> 6;
    float mul = 1.f; int c = n0 + nl;
    if (MODE == 1) c = w1_src(n0 + nl, mul);
#pragma unroll
    for (int i = 0; i < 8; ++i) {
      const int k = k0 + kq * 8 + i;
      float v = 0.f;
      if (c >= 0) { v = src[(size_t)k * ld_src + c] * mul; if (kscale) v *= kscale[k]; }
      tl[(kq * 8 + i) * 65 + nl] = v;
    }
  }
  __syncthreads();
  {
    const int kc = tid & 7, nl = tid >> 3;
    float v[8];
#pragma unroll
    for (int j = 0; j < 8; ++j) v[j] = tl[(kc * 8 + j) * 65 + nl];
    *(uint4*)(dst + (size_t)(n0 + nl) * ld_dst + dk0 + kc * 8) = make_uint4(pack_bf2(v[0], v[1]), pack_bf2(v[2], v[3]), pack_bf2(v[4], v[5]), pack_bf2(v[6], v[7]));
  }
  __syncthreads();
}

__device__ __forceinline__ int q4fp8(float a, float b, float c, float d) {
  int w = __builtin_amdgcn_cvt_pk_fp8_f32(a, b, 0, false);
  return __builtin_amdgcn_cvt_pk_fp8_f32(c, d, w, true);
}

__device__ __forceinline__ void peer_row_fp8(const P& p, int row, int lane) {
  const int e = row & 16383; const bool isv = row >= 16384;
  const float4* src = (const float4*)((isv ? p.v_tab : p.u_tab) + (size_t)e * DM);
  float4 v[4];
  float amax = 0.f;
#pragma unroll
  for (int i = 0; i < 4; ++i) { v[i] = src[lane + 64 * i];
    amax = fmaxf(amax, fmaxf(fmaxf(fabsf(v[i].x), fabsf(v[i].y)), fmaxf(fabsf(v[i].z), fabsf(v[i].w)))); }
  amax = wave_max(amax);
  int ex = 0; const float m = frexpf(amax, &ex);
  const int k = (amax > 0.f) ? ((m > 0.75f) ? (2 - ex) : (3 - ex)) : 0;
  const float sc = ldexpf(1.f, k);
  unsigned w0 = 0u, w1 = 0u;
  w0 = __builtin_amdgcn_cvt_scalef32_pk_fp4_f32(w0, v[0].x * sc, v[0].y * sc, 1.0f, 0);
  w0 = __builtin_amdgcn_cvt_scalef32_pk_fp4_f32(w0, v[0].z * sc, v[0].w * sc, 1.0f, 1);
  w0 = __builtin_amdgcn_cvt_scalef32_pk_fp4_f32(w0, v[1].x * sc, v[1].y * sc, 1.0f, 2);
  w0 = __builtin_amdgcn_cvt_scalef32_pk_fp4_f32(w0, v[1].z * sc, v[1].w * sc, 1.0f, 3);
  w1 = __builtin_amdgcn_cvt_scalef32_pk_fp4_f32(w1, v[2].x * sc, v[2].y * sc, 1.0f, 0);
  w1 = __builtin_amdgcn_cvt_scalef32_pk_fp4_f32(w1, v[2].z * sc, v[2].w * sc, 1.0f, 1);
  w1 = __builtin_amdgcn_cvt_scalef32_pk_fp4_f32(w1, v[3].x * sc, v[3].y * sc, 1.0f, 2);
  w1 = __builtin_amdgcn_cvt_scalef32_pk_fp4_f32(w1, v[3].z * sc, v[3].w * sc, 1.0f, 3);
  *(uint2*)((isv ? p.V8 : p.U8) + (size_t)e * 512 + 8 * lane) = make_uint2(w0, w1);
  if (lane == 0) (isv ? p.sv : p.su)[e] = ldexpf(1.f, -k);
}

__device__ void phase0_prep(const P& p, LAS unsigned char* lds, int wid_s) {
  const int tid = mk_tid(wid_s), lane = tid & 63, wid = tid >> 6;
  const int gw = blockIdx.x * 8 + wid, nw = gridDim.x * 8;
  const int gt = blockIdx.x * 512 + tid, nt = gridDim.x * 512;
  LAS float* tl = (LAS float*)lds;
  for (int i = gt; i < T_TOK; i += nt) { p.ss_ffn[i] = 0.f; p.ss_fin[i] = 0.f; }
  if (gt < 64) p.ctr[gt] = 0u;
  for (int tile = blockIdx.x; tile < 1600; tile += gridDim.x) {
    if (tile < 512) { const int nt_ = tile >> 4, kt = tile & 15;
      tr_tile<1>(tl, p.w_in, INTOT, p.W1t, 1024, 512 + nt_ * 64, kt * 64, kt * 64, p.g_mix, tid);
    } else if (tile < 1024) { const int t2 = tile - 512, nt_ = t2 >> 4, kt = t2 & 15;
      tr_tile<0>(tl, p.w_pq, 2048, p.WpqT, 1024, nt_ * 64, kt * 64, kt * 64, p.g_ffn, tid);
    } else if (tile < 1280) { const int t2 = tile - 1024, nt_ = t2 >> 4, kt = t2 & 15;
      tr_tile<0>(tl, p.w_gate, 1024, p.WgT, 1024, nt_ * 64, kt * 64, kt * 64, nullptr, tid);
    } else if (tile < 1344) { const int t2 = tile - 1280, nt_ = t2 >> 2, kt = t2 & 3;
      tr_tile<0>(tl, p.w_ple, 1024, p.WpleT, 256, nt_ * 64, kt * 64, kt * 64, nullptr, tid);
    } else if (tile < 1472) { const int t2 = tile - 1344, nt_ = t2 >> 3, kt = t2 & 7;
      tr_tile<0>(tl, p.w_out, 1024, p.WoutT, 1024, nt_ * 64, 512 + kt * 64, 512 + kt * 64, nullptr, tid);
    } else if (tile < 1536) {
      const int t2 = tile - 1472, h = t2 >> 4, k0 = (t2 & 15) * 64;
      LAS float* sA = tl;
      LAS float* sB = tl + 64 * 97;
      for (int i = tid; i < 64 * 96; i += 512) { const int kk = i / 96, j = i % 96; sA[kk * 97 + j] = p.w_in[(size_t)(k0 + kk) * INTOT + h * 128 + 32 + j]; }
      for (int i = tid; i < 128 * 96; i += 512) { const int c = i / 96, j = i % 96; sB[j * 129 + c] = p.w_uk[(size_t)(h * 128 + c) * 96 + j]; }
      __syncthreads();
      const int c = tid & 127, kq = tid >> 7;
      float acc[16];
#pragma unroll
      for (int i = 0; i < 16; ++i) acc[i] = 0.f;
      for (int j = 0; j < 96; ++j) { const float b = sB[j * 129 + c];
#pragma unroll
        for (int i = 0; i < 16; ++i) acc[i] += sA[(kq * 16 + i) * 97 + j] * b; }
      unsigned o[8];
#pragma unroll
      for (int i = 0; i < 8; ++i) { const int k = k0 + kq * 16 + 2 * i; o[i] = pack_bf2(acc[2 * i] * PRESCALE * p.g_mix[k], acc[2 * i + 1] * PRESCALE * p.g_mix[k + 1]); }
      uint4* d = (uint4*)(p.W1t + (size_t)(h * 128 + c) * 1024 + k0 + kq * 16);
      d[0] = make_uint4(o[0], o[1], o[2], o[3]); d[1] = make_uint4(o[4], o[5], o[6], o[7]);
      __syncthreads();
    } else {
      const int t2 = tile - 1536, h = t2 >> 4, n0 = (t2 & 15) * 64;
      LAS float* sA = tl;
      LAS float* sB = tl + 128 * 65;
      for (int i = tid; i < 128 * 64; i += 512) { const int d = i >> 6, nl = i & 63; sA[d * 65 + nl] = p.w_out[(size_t)(h * 128 + d) * 1024 + n0 + nl]; }
      for (int i = tid; i < 128 * 128; i += 512) { const int c = i >> 7, d = i & 127; sB[d * 129 + c] = p.w_uv[(size_t)(h * 128 + c) * 128 + d]; }
      __syncthreads();
      const int c = tid & 127, nq = tid >> 7;
      float acc[16];
#pragma unroll
      for (int i = 0; i < 16; ++i) acc[i] = 0.f;
      for (int d = 0; d < 128; ++d) { const float b = sB[d * 129 + c];
#pragma unroll
        for (int i = 0; i < 16; ++i) acc[i] += sA[d * 65 + nq * 16 + i] * b; }
#pragma unroll
      for (int i = 0; i < 16; ++i) p.WoutT[(size_t)(n0 + nq * 16 + i) * 1024 + h * 128 + c] = f2bf(acc[i]);
      __syncthreads();
    }
  }
  for (int idx = gt; idx < 8 * 128 * 128; idx += nt) { p.K1b[idx] = f2bf(p.k1[idx]); p.K2b[idx] = f2bf(p.k2[idx]); }
  for (int idx = gt; idx < 8 * 64 * 64; idx += nt) {
    const int n = idx >> 12, o = (idx >> 6) & 63, i = idx & 63;
    p.WrgT[idx] = f2bf(p.w_rg[(size_t)n * 4096 + i * 64 + o]);
    p.WigT[idx] = f2bf(p.w_ig[(size_t)n * 4096 + i * 64 + o]);
  }
  for (int row = gw; row < T_TOK; row += nw) {
    const float4* xr = (const float4*)(p.x + (size_t)row * DM);
    uint2* xo = (uint2*)(p.xb16 + (size_t)row * DM);
    float ss = 0.f;
#pragma unroll
    for (int i = 0; i < 4; ++i) {
      const float4 v = xr[lane + 64 * i];
      ss += v.x * v.x + v.y * v.y + v.z * v.z + v.w * v.w;
      uint2 o; o.x = pack_bf2(v.x, v.y); o.y = pack_bf2(v.z, v.w);
      xo[lane + 64 * i] = o;
    }
    ss = wave_sum(ss);
    if (lane == 0) p.rstd_mix[row] = rsqrtf(ss * (1.f / DM) + 1e-6f);
    const float pos = (float)p.pos[row];
    if (lane < 16) {
      const float inv = powf(500000.f, -(float)(2 * lane) / 32.f);
      const float ang = pos * inv;
      p.ropeA[(size_t)row * 32 + lane] = cosf(ang);
      p.ropeA[(size_t)row * 32 + 16 + lane] = sinf(ang);
    } else if (lane < 24) {
      const int i = lane - 16;
      const float inv = powf(500000.f, -(float)(2 * i) / 16.f);
      const float ang = pos * inv;
      p.ropeI[(size_t)row * 16 + i] = cosf(ang);
      p.ropeI[(size_t)row * 16 + 8 + i] = sinf(ang);
    }
  }
  for (int i = gt; i < T_TOK * 256 / 4; i += nt) {
    const float4 v = ((const float4*)p.p)[i];
    uint2 o; o.x = pack_bf2(v.x, v.y); o.y = pack_bf2(v.z, v.w);
    ((uint2*)p.p16)[i] = o;
  }
  for (int row = gw; row < 16384; row += nw) peer_row_fp8(p, 16384 + row, lane);
}
__device__ __forceinline__ pg8::f32x4 rope4(pg8::f32x4 a, const float* cs, const float* sn) {
  const float c0 = cs[0], s0 = sn[0], c1 = cs[1], s1 = sn[1];
  pg8::f32x4 o;
  o[0] = a[0] * c0 - a[1] * s0; o[1] = a[1] * c0 + a[0] * s0; o[2] = a[2] * c1 - a[3] * s1; o[3] = a[3] * c1 + a[2] * s1;
  return o;
}
struct Epi1 {
  static constexpr bool PERM = false, AFTER_DRAIN = false;
  P p; LAS float* xch;
  __device__ __forceinline__ void operator()(const pg8::f32x4 (&acc)[2][2][4][2], const pg8::Unit& u, int wr, int wc, int fr_in, int fq_in) const {
    int fr = fr_in, fq = fq_in; asm volatile("" : "+v"(fr), "+v"(fq));
    const int pn = u.pn;
    const int rowb = u.pm * 256 + wr * 64 + fr;
    const int colb = wc * 32 + 4 * fq;
    float rs[2][4];
#pragma unroll
    for (int ai = 0; ai < 2; ++ai)
#pragma unroll
      for (int m = 0; m < 4; ++m) rs[ai][m] = p.rstd_mix[rowb + ai * 128 + m * 16];
    if (pn < 2) {
#pragma unroll
      for (int ai = 0; ai < 2; ++ai)
#pragma unroll
        for (int m = 0; m < 4; ++m) { const int row = rowb + ai * 128 + m * 16;
#pragma unroll
          for (int bj = 0; bj < 2; ++bj)
#pragma unroll
            for (int n = 0; n < 2; ++n) { const int col = pn * 256 + bj * 128 + colb + 16 * n; const int h = col >> 7, c = col & 127;
              const pg8::f32x4 v = acc[ai][bj][m][n] * rs[ai][m];
              uint2 o; o.x = pack_bf2(v[0], v[1]); o.y = pack_bf2(v[2], v[3]);
              *(uint2*)(p.qcat + ((size_t)row * 4 + h) * 160 + c) = o; } }
    } else if (pn < 4) {
#pragma unroll
      for (int ai = 0; ai < 2; ++ai)
#pragma unroll
        for (int m = 0; m < 4; ++m) { const int row = rowb + ai * 128 + m * 16;
#pragma unroll
          for (int bj = 0; bj < 2; ++bj)
#pragma unroll
            for (int n = 0; n < 2; ++n) { const int col = (pn - 2) * 256 + bj * 128 + colb + 16 * n; const int d = col & 63;
              pg8::f32x4 v = acc[ai][bj][m][n] * rs[ai][m];
              if (d < 16) { const float* cs = p.ropeI + (size_t)row * 16 + (d >> 1); v = rope4(v, cs, cs + 8); }
              uint2 o; o.x = pack_h2(v[0], v[1]); o.y = pack_h2(v[2], v[3]);
              *(uint2*)(p.iqh + (size_t)row * 512 + col) = o; } }
    } else if (pn < 8) {
      u16* dst = (pn < 6) ? p.xbr : p.gate;
      const int cb = (pn & 1) * 256;
#pragma unroll
      for (int ai = 0; ai < 2; ++ai)
#pragma unroll
        for (int m = 0; m < 4; ++m) { const int row = rowb + ai * 128 + m * 16;
#pragma unroll
          for (int bj = 0; bj < 2; ++bj)
#pragma unroll
            for (int n = 0; n < 2; ++n) { const int col = cb + bj * 128 + colb + 16 * n;
              const pg8::f32x4 v = acc[ai][bj][m][n] * rs[ai][m];
              uint2 o; o.x = pack_bf2(v[0], v[1]); o.y = pack_bf2(v[2], v[3]);
              *(uint2*)(dst + (size_t)row * 512 + col) = o; } }
    } else if (pn == 8) {
      float ps[2][4];
#pragma unroll
      for (int ai = 0; ai < 2; ++ai)
#pragma unroll
        for (int m = 0; m < 4; ++m) { const int row = rowb + ai * 128 + m * 16;
#pragma unroll
          for (int n = 0; n < 2; ++n) { const int col = colb + 16 * n; const int h = col >> 5, j0 = col & 31;
            pg8::f32x4 v = acc[ai][0][m][n] * rs[ai][m];
            const float* cs = p.ropeA + (size_t)row * 32 + (j0 >> 1); v = rope4(v, cs, cs + 16);
            uint2 o; o.x = pack_bf2(v[0], v[1]); o.y = pack_bf2(v[2], v[3]);
            *(uint2*)(p.qcat + ((size_t)row * 4 + h) * 160 + 128 + j0) = o; }
          float s = 0.f;
#pragma unroll
          for (int n = 0; n < 2; ++n) { const pg8::f32x4 v = acc[ai][1][m][n] * rs[ai][m]; s += v[0] * v[0] + v[1] * v[1] + v[2] * v[2] + v[3] * v[3]; }
          s += __shfl_xor(s, 16, 64); s += __shfl_xor(s, 32, 64);
          ps[ai][m] = s;
          if (fq == 0) xch[(wr * 4 + wc) * 128 + ai * 64 + m * 16 + fr] = s; }
      asm volatile("s_waitcnt lgkmcnt(0)" ::: "memory");
      __builtin_amdgcn_s_barrier();
      asm volatile("" ::: "memory");
#pragma unroll
      for (int ai = 0; ai < 2; ++ai)
#pragma unroll
        for (int m = 0; m < 4; ++m) { const int row = rowb + ai * 128 + m * 16; const int rr = ai * 64 + m * 16 + fr;
          const float tot = xch[(wr * 4 + 0) * 128 + rr] + xch[(wr * 4 + 1) * 128 + rr] + xch[(wr * 4 + 2) * 128 + rr] + xch[(wr * 4 + 3) * 128 + rr];
          const float rk = rsqrtf(tot * (1.f / 128.f) + 1e-6f) * rs[ai][m];
#pragma unroll
          for (int n = 0; n < 2; ++n) { const int c = colb + 16 * n;
            const float4 g = *(const float4*)(p.g_kv + c);
            const pg8::f32x4 v = acc[ai][1][m][n] * rk;
            uint2 o; o.x = pack_bf2(v[0] * g.x, v[1] * g.y); o.y = pack_bf2(v[2] * g.z, v[3] * g.w);
            *(uint2*)(p.kv + (size_t)row * 160 + c) = o; } }
      (void)ps;
    } else {
#pragma unroll
      for (int ai = 0; ai < 2; ++ai)
#pragma unroll
        for (int m = 0; m < 4; ++m) { const int row = rowb + ai * 128 + m * 16;
#pragma unroll
          for (int n = 0; n < 2; ++n) { const int col = colb + 16 * n;
            pg8::f32x4 v = acc[ai][0][m][n] * rs[ai][m];
            if (col < 32) {
              const float* cs = p.ropeA + (size_t)row * 32 + (col >> 1); v = rope4(v, cs, cs + 16);
              uint2 o; o.x = pack_bf2(v[0], v[1]); o.y = pack_bf2(v[2], v[3]);
              *(uint2*)(p.kv + (size_t)row * 160 + 128 + col) = o;
            } else if (col < 96) { const int d = col - 32;
              if (d < 16) { const float* cs = p.ropeI + (size_t)row * 16 + (d >> 1); v = rope4(v, cs, cs + 8); }
              uint2 o; o.x = pack_h2(v[0], v[1]); o.y = pack_h2(v[2], v[3]);
              *(uint2*)(p.ikh + (size_t)row * 64 + d) = o;
            } else if (col < 104) {
              *(float4*)(p.iw + (size_t)row * 8 + (col - 96)) = make_float4(v[0], v[1], v[2], v[3]);
            } } }
    }
  }
};

__device__ void phase1_gemm1(const P& p, LAS unsigned char* lds, int wid_s) {
  pg8::Gemm g; g.A = p.xb16; g.Bt = p.W1t; g.M = T_TOK; g.N = N1; g.K = p.k1024;
  pg8::StaticOrder S; S.init(T_TOK, N1, gridDim.x, blockIdx.x);
  Epi1 E; E.p = p; E.xch = (LAS float*)(lds + pg8::STAGE_BYTES);
  pg8::gemm_phase<Epi1, pg8::StaticOrder>(lds, g, S, E, nullptr, wid_s);
  const int nidle = 3 * (int)gridDim.x - 640;
  if (nidle > 0 && (int)blockIdx.x >= (int)gridDim.x - nidle) {
    const int tid = mk_tid(wid_s), lane = tid & 63;
    const int iw = ((int)blockIdx.x - ((int)gridDim.x - nidle)) * 8 + wid_s, niw = nidle * 8;
    for (int row = iw; row < 16384; row += niw) peer_row_fp8(p, row, lane);
  } else if (nidle <= 0) {
    const int tid = mk_tid(wid_s), lane = tid & 63;
    for (int row = blockIdx.x * 8 + wid_s; row < 16384; row += gridDim.x * 8) peer_row_fp8(p, row, lane);
  }
}
#define SC_STRIDE 2052
#define L_MASK 131328
#define L_HIST 139520
#define L_CAND 147712
#define L_MISC 156160
#define L_MM 156416
#define KV_STRIDE 336
#define KV_TILE_BYTES (64 * KV_STRIDE)

__device__ __forceinline__ float sort2f_(unsigned u) { const unsigned b = (u & 0x80000000u) ? (u & 0x7FFFFFFFu) : ~u; return __uint_as_float(b); }
__device__ __forceinline__ unsigned f2sort(float f) { const unsigned u = __float_as_uint(f); return (u & 0x80000000u) ? ~u : (u | 0x80000000u); }

__device__ __forceinline__ void index_scores(const P& p, LAS unsigned char* lds, int b, int tq0, int nkt, int wid, int lane) {
  const int fr = lane & 15, g = lane >> 4;
  const size_t qtok = (size_t)b * SEQ + tq0 + fr;
  f16x8 Bq[8][2];
  float w[8];
#pragma unroll
  for (int h = 0; h < 8; ++h) {
#pragma unroll
    for (int ks = 0; ks < 2; ++ks) Bq[h][ks] = *(const f16x8*)(p.iqh + qtok * 512 + h * 64 + ks * 32 + g * 8);
    w[h] = p.iw[qtok * 8 + h];
  }
  LAS float* sc = (LAS float*)lds;
  float rmax = -INFINITY, rmin = INFINITY;
  const int tqme = tq0 + fr;
  for (int kt = wid; kt < nkt; kt += 8) {
    const size_t ktok = (size_t)b * SEQ + kt * 16 + fr;
    const f16x8 A0 = *(const f16x8*)(p.ikh + ktok * 64 + g * 8);
    const f16x8 A1 = *(const f16x8*)(p.ikh + ktok * 64 + 32 + g * 8);
    fx4 tot = {0.f, 0.f, 0.f, 0.f};
#pragma unroll
    for (int h = 0; h < 8; ++h) {
      fx4 d = {0.f, 0.f, 0.f, 0.f};
      d = __builtin_amdgcn_mfma_f32_16x16x32_f16(A0, Bq[h][0], d, 0, 0, 0);
      d = __builtin_amdgcn_mfma_f32_16x16x32_f16(A1, Bq[h][1], d, 0, 0, 0);
#pragma unroll
      for (int r = 0; r < 4; ++r) tot[r] += w[h] * fmaxf(d[r], 0.f);
    }
    LDS_ST_FX4(sc + fr * SC_STRIDE + kt * 16 + 4 * g, tot);
#pragma unroll
    for (int r = 0; r < 4; ++r) { const bool ok = (kt * 16 + 4 * g + r) <= tqme; rmax = fmaxf(rmax, ok ? tot[r] : -INFINITY); rmin = fminf(rmin, ok ? tot[r] : INFINITY); }
  }
  rmax = fmaxf(rmax, __shfl_xor(rmax, 16, 64)); rmax = fmaxf(rmax, __shfl_xor(rmax, 32, 64));
  rmin = fminf(rmin, __shfl_xor(rmin, 16, 64)); rmin = fminf(rmin, __shfl_xor(rmin, 32, 64));
  if (g == 0) {
    LAS unsigned* mm = (LAS unsigned*)(lds + L_MM);
    if (rmax != -INFINITY) __hip_atomic_fetch_max(mm + 2 * fr, f2sort(rmax), __ATOMIC_RELAXED, __HIP_MEMORY_SCOPE_WORKGROUP);
    if (rmin != INFINITY) __hip_atomic_fetch_min(mm + 2 * fr + 1, f2sort(rmin), __ATOMIC_RELAXED, __HIP_MEMORY_SCOPE_WORKGROUP);
  }
}

#define DPP_F(x, ctrl) __uint_as_float((unsigned)__builtin_amdgcn_update_dpp(0, (int)__float_as_uint(x), (ctrl), 0xF, 0xF, true))
#define DPP_I(x, ctrl) ((unsigned)__builtin_amdgcn_update_dpp(0, (int)(x), (ctrl), 0xF, 0xF, true))
__device__ __forceinline__ float wave_max_dpp(float x) {
  x = fmaxf(x, DPP_F(x, 0xB1)); x = fmaxf(x, DPP_F(x, 0x4E)); x = fmaxf(x, DPP_F(x, 0x141)); x = fmaxf(x, DPP_F(x, 0x140));
  const int xi = (int)__float_as_uint(x);
  const float a = __uint_as_float((unsigned)__builtin_amdgcn_readlane(xi, 0)), b = __uint_as_float((unsigned)__builtin_amdgcn_readlane(xi, 16));
  const float c = __uint_as_float((unsigned)__builtin_amdgcn_readlane(xi, 32)), d = __uint_as_float((unsigned)__builtin_amdgcn_readlane(xi, 48));
  return fmaxf(fmaxf(a, b), fmaxf(c, d));
}
__device__ __forceinline__ unsigned row16_sum_u32(unsigned x) { x += DPP_I(x, 0xB1); x += DPP_I(x, 0x4E); x += DPP_I(x, 0x141); x += DPP_I(x, 0x140); return x; }

__device__ __forceinline__ void select_row(LAS float* row, int tq, LAS unsigned* mrow, LAS unsigned* hist, LAS unsigned* cand, int lane, int sflags, LAS unsigned* mmq) {
  const int n = tq + 1;
  unsigned long long mybal = 0ull;
  if (n <= 256) {
#pragma unroll 4
    for (int j = 0; j < 32; ++j) {
      const unsigned long long bl = __ballot((j * 64 + lane) <= tq);
      if (lane == j) mybal = bl;
    }
  } else {
    const float vmax = sort2f_(mmq[0]), vmin = sort2f_(mmq[1]);
    const int njb = ((tq >> 6) + 16) & ~15;
    const float scale = (vmax > vmin) ? 255.5f / (vmax - vmin) : 0.f;
#pragma unroll
    for (int i = 0; i < 4; ++i) hist[lane * 4 + i] = 0u;
    if (lane == 0) cand[256] = 0u;
#pragma unroll 1
    for (int jb = 0; jb < njb; jb += 16) {
      float v[16];
#pragma unroll
      for (int j = 0; j < 16; ++j) v[j] = row[(jb + j) * 64 + lane];
#pragma unroll
      for (int j = 0; j < 16; ++j) {
        const bool ok = ((jb + j) * 64 + lane) <= tq;
        const int bk = ok ? min(255, (int)((v[j] - vmin) * scale)) : lane;
        __hip_atomic_fetch_add((LAS unsigned*)&hist[bk], ok ? 1u : 0u, __ATOMIC_RELAXED, __HIP_MEMORY_SCOPE_WAVEFRONT);
      }
    }
    asm volatile("s_waitcnt lgkmcnt(0)" ::: "memory");
    const unsigned h40 = hist[255 - 4 * lane], h41 = hist[254 - 4 * lane], h42 = hist[253 - 4 * lane], h43 = hist[252 - 4 * lane];
    const unsigned mine = h40 + h41 + h42 + h43;
    const unsigned rsum = row16_sum_u32(mine);
    int Bsel = 0; unsigned above = 0u;
    {
      unsigned run = 0u; int R = 0;
#pragma unroll
      for (int r = 0; r < 4; ++r) { const unsigned s = (unsigned)__builtin_amdgcn_readlane((int)rsum, r * 16); if (run + s < 256u && R == r) { run += s; R = r + 1; } }
      if (R > 3) R = 3;
      int L = R * 16;
#pragma unroll 1
      for (int i = 0; i < 16; ++i) { const unsigned s = (unsigned)__builtin_amdgcn_readlane((int)mine, L); if (run + s >= 256u) break; run += s; ++L; }
      if (L > R * 16 + 15) L = R * 16 + 15;
      const unsigned b0 = (unsigned)__builtin_amdgcn_readlane((int)h40, L), b1 = (unsigned)__builtin_amdgcn_readlane((int)h41, L), b2 = (unsigned)__builtin_amdgcn_readlane((int)h42, L);
      if (run + b0 >= 256u) { Bsel = 255 - 4 * L; }
      else { run += b0;
        if (run + b1 >= 256u) { Bsel = 254 - 4 * L; }
        else { run += b1;
          if (run + b2 >= 256u) { Bsel = 253 - 4 * L; }
          else { run += b2; Bsel = 252 - 4 * L; } } }
      above = run;
    }
    const unsigned need = 256u - above;
    if (sflags & 4) { if (lane < 32) { mrow[2 * lane] = need + Bsel; mrow[2 * lane + 1] = 0u; } return; }
    unsigned cmask = 0u;
#pragma unroll 1
    for (int jb = 0; jb < njb; jb += 16) {
      float v[16];
#pragma unroll
      for (int j = 0; j < 16; ++j) v[j] = row[(jb + j) * 64 + lane];
#pragma unroll
      for (int j = 0; j < 16; ++j) {
        const bool is = (((jb + j) * 64 + lane) <= tq) && (min(255, (int)((v[j] - vmin) * scale)) == Bsel);
        cmask |= is ? (1u << (jb + j)) : 0u;
      }
    }
    while (cmask) {
      const int j = __ffs((int)cmask) - 1; cmask &= cmask - 1u;
      const int key = j * 64 + lane;
      const unsigned pos = __hip_atomic_fetch_add((LAS unsigned*)&cand[256], 1u, __ATOMIC_RELAXED, __HIP_MEMORY_SCOPE_WAVEFRONT);
      if (pos < 128u) { cand[2 * pos] = f2sort(row[key]); cand[2 * pos + 1] = (unsigned)key; }
    }
    asm volatile("s_waitcnt lgkmcnt(0)" ::: "memory");
    const unsigned cnt = (unsigned)__builtin_amdgcn_readfirstlane((int)cand[256]);
    if (sflags & 8) { if (lane < 32) { mrow[2 * lane] = cnt; mrow[2 * lane + 1] = 0u; } return; }
    unsigned ustar = 0u, kstar = 0u;
    if (cnt <= 64u) {
      const unsigned mu = (lane < (int)cnt) ? cand[2 * lane] : 0u, mk = (lane < (int)cnt) ? cand[2 * lane + 1] : 0xFFFFFFFFu;
      unsigned rank = 0;
      for (unsigned q = 0; q < cnt; ++q) {
        const unsigned qu = (unsigned)__builtin_amdgcn_readlane((int)mu, q), qk = (unsigned)__builtin_amdgcn_readlane((int)mk, q);
        rank += (qu > mu || (qu == mu && qk < mk)) ? 1u : 0u;
      }
      const unsigned long long fb = __ballot(lane < (int)cnt && rank == need - 1u);
      const int fl = __ffsll((long long)fb) - 1;
      ustar = (unsigned)__builtin_amdgcn_readlane((int)mu, fl); kstar = (unsigned)__builtin_amdgcn_readlane((int)mk, fl);
    } else if (cnt <= 128u) {
      unsigned fu = 0u, fk = 0u; int found = 0;
      for (unsigned base = 0; base < cnt; base += 64) {
        const unsigned i = base + lane;
        const unsigned mu = (i < cnt) ? cand[2 * i] : 0u, mk = (i < cnt) ? cand[2 * i + 1] : 0u;
        unsigned rank = 0;
#pragma unroll 4
        for (unsigned q = 0; q < cnt; ++q) { const unsigned qu = cand[2 * q], qk = cand[2 * q + 1]; rank += (qu > mu || (qu == mu && qk < mk)) ? 1u : 0u; }
        if (i < cnt && rank == need - 1u) { fu = mu; fk = mk; found = 1; }
      }
      const unsigned long long fb = __ballot(found);
      const int fl = __ffsll((long long)fb) - 1;
      ustar = (unsigned)__shfl((int)fu, fl, 64); kstar = (unsigned)__shfl((int)fk, fl, 64);
    } else {
      const int nj = (tq >> 6) + 1;
      unsigned prefix = 0u; unsigned needr = need;
      for (int bit = 31; bit >= 0; --bit) {
        const unsigned trial = prefix | (1u << bit);
        unsigned c = 0;
        for (int j = 0; j < nj; ++j) {
          const int key = j * 64 + lane;
          const float x = row[key];
          const bool inb = (key <= tq) && (min(255, (int)((x - vmin) * scale)) == Bsel);
          c += __popcll(__ballot(inb && (f2sort(x) >> bit) == (trial >> bit)));
        }
        if (c >= needr) prefix = trial; else needr -= c;
      }
      ustar = prefix;
      unsigned seen = 0; int done = 0;
      for (int j = 0; j < nj; ++j) {
        const int key = j * 64 + lane;
        const float x = row[key];
        const unsigned long long bl = __ballot((key <= tq) && f2sort(x) == ustar);
        const unsigned c = __popcll(bl);
        if (!done && seen + c >= needr) {
          unsigned long long m = bl; const unsigned k = needr - seen;
          int pos = 0;
          for (unsigned q = 0; q < k; ++q) { pos = __ffsll((long long)m) - 1; m &= m - 1ull; }
          kstar = (unsigned)(j * 64 + pos); done = 1;
        }
        seen += c;
      }
    }
#pragma unroll 1
    for (int jb = 0; jb < njb; jb += 16) {
      float v[16];
#pragma unroll
      for (int j = 0; j < 16; ++j) v[j] = row[(jb + j) * 64 + lane];
#pragma unroll
      for (int j = 0; j < 16; ++j) {
        const int key = (jb + j) * 64 + lane;
        const unsigned uu = f2sort(v[j]);
        const bool s = (key <= tq) && (uu > ustar || (uu == ustar && (unsigned)key <= kstar));
        const unsigned long long bl = __ballot(s);
        if (lane == jb + j) mybal = bl;
      }
    }
  }
  if (lane < 32) { mrow[2 * lane] = (unsigned)mybal; mrow[2 * lane + 1] = (unsigned)(mybal >> 32); }
}

__device__ __forceinline__ void attn_block(const P& p, LAS unsigned char* lds, int b, int t0, int wid, int lane, int tid) {
  const int fr = lane & 15, g = lane >> 4;
  const int h = wid >> 1, qs = wid & 1;
  const size_t qtok = (size_t)b * SEQ + t0 + qs * 16 + fr;
  s16x8 Qf[5];
#pragma unroll
  for (int ks = 0; ks < 5; ++ks) Qf[ks] = *(const s16x8*)(p.qcat + (qtok * 4 + h) * 160 + ks * 32 + g * 8);
  const int ntile = (t0 + 32 + 63) >> 6;
  const u16* kvb = p.kv + (size_t)b * SEQ * 160;
  LAS unsigned* mrow = (LAS unsigned*)(lds + L_MASK) + (qs * 16 + fr) * 64;
  fx4 O[8];
#pragma unroll
  for (int i = 0; i < 8; ++i) O[i] = (fx4){0.f, 0.f, 0.f, 0.f};
  float m_run = -INFINITY, l_run = 0.f;
  uint4 st0 = make_uint4(0, 0, 0, 0), st1 = st0, st2 = st0;
  const int c0i = tid, c1i = tid + 512, c2i = tid + 1024;
  const int lo0 = (c0i / 20) * KV_STRIDE + (c0i % 20) * 16, lo1 = (c1i / 20) * KV_STRIDE + (c1i % 20) * 16, lo2 = (c2i / 20) * KV_STRIDE + (c2i % 20) * 16;
#define G_LOAD(kt_) do { const uint4* src_ = (const uint4*)(kvb + (size_t)(kt_) * 64 * 160); st0 = src_[c0i]; st1 = src_[c1i]; if (c2i < 1280) st2 = src_[c2i]; } while (0)
#define L_STORE(buf_) do { LAS unsigned char* d_ = lds + (buf_) * KV_TILE_BYTES; LDS_STORE(uint4, d_ + lo0, st0); LDS_STORE(uint4, d_ + lo1, st1); if (c2i < 1280) LDS_STORE(uint4, d_ + lo2, st2); } while (0)
  G_LOAD(0); L_STORE(0);
  __syncthreads();
  for (int kt = 0; kt < ntile; ++kt) {
    const int buf = kt & 1;
    if (kt + 1 < ntile) G_LOAD(kt + 1);
    LAS unsigned char* kb = lds + buf * KV_TILE_BYTES;
#pragma unroll
    for (int ksub = 0; ksub < 2; ++ksub) {
      fx4 S[2];
#pragma unroll
      for (int sub = 0; sub < 2; ++sub) {
        fx4 a = {0.f, 0.f, 0.f, 0.f};
        const int krow = ksub * 32 + sub * 16 + fr;
#pragma unroll
        for (int ks = 0; ks < 5; ++ks) {
          const s16x8 Kf = *(LAS s16x8*)(kb + krow * KV_STRIDE + ks * 64 + g * 16);
          a = __builtin_amdgcn_mfma_f32_16x16x32_bf16(Kf, Qf[ks], a, 0, 0, 0);
        }
        S[sub] = a;
      }
      const unsigned mw = mrow[kt * 2 + ksub];
      float mx = -INFINITY;
#pragma unroll
      for (int sub = 0; sub < 2; ++sub)
#pragma unroll
        for (int r = 0; r < 4; ++r) { const int bit = sub * 16 + 4 * g + r; const float s = ((mw >> bit) & 1u) ? S[sub][r] : -INFINITY; S[sub][r] = s; mx = fmaxf(mx, s); }
      mx = fmaxf(mx, __shfl_xor(mx, 16, 64)); mx = fmaxf(mx, __shfl_xor(mx, 32, 64));
      const float m_new = fmaxf(m_run, mx);
      const float m_use = (m_new == -INFINITY) ? 0.f : m_new;
      const float alpha = exp2f(m_run - m_use);
      m_run = m_new;
      float psum = 0.f;
      s16x8 Pf;
#pragma unroll
      for (int sub = 0; sub < 2; ++sub)
#pragma unroll
        for (int r = 0; r < 4; ++r) { const float pv = exp2f(S[sub][r] - m_use); psum += pv; Pf[sub * 4 + r] = (short)f2bf(pv); }
      l_run = l_run * alpha + psum;
#pragma unroll
      for (int i = 0; i < 8; ++i) O[i] *= alpha;
      const int q4 = fr >> 2, p4 = fr & 3;
      LAS unsigned char* vb0 = kb + (ksub * 32 + 4 * g + q4) * KV_STRIDE + p4 * 8;
#pragma unroll
      for (int dvt = 0; dvt < 8; ++dvt) {
        const s16x4 v0 = __builtin_amdgcn_ds_read_tr16_b64_v4i16((LAS s16x4*)(vb0 + dvt * 32));
        const s16x4 v1 = __builtin_amdgcn_ds_read_tr16_b64_v4i16((LAS s16x4*)(vb0 + 16 * KV_STRIDE + dvt * 32));
        s16x8 Vf; Vf[0] = v0[0]; Vf[1] = v0[1]; Vf[2] = v0[2]; Vf[3] = v0[3]; Vf[4] = v1[0]; Vf[5] = v1[1]; Vf[6] = v1[2]; Vf[7] = v1[3];
        O[dvt] = __builtin_amdgcn_mfma_f32_16x16x32_bf16(Vf, Pf, O[dvt], 0, 0, 0);
      }
    }
    if (kt + 1 < ntile) L_STORE(buf ^ 1);
    __syncthreads();
  }
  float l_tot = l_run + __shfl_xor(l_run, 16, 64); l_tot += __shfl_xor(l_tot, 32, 64);
  const float inv = 1.f / l_tot;
  u16* dst = p.mix + qtok * 1024 + h * 128 + 4 * g;
#pragma unroll
  for (int dvt = 0; dvt < 8; ++dvt) {
    uint2 o; o.x = pack_bf2(O[dvt][0] * inv, O[dvt][1] * inv); o.y = pack_bf2(O[dvt][2] * inv, O[dvt][3] * inv);
    *(uint2*)(dst + dvt * 16) = o;
  }
}

#define LR_XCB 0
#define LR_XCF 18432
#define LR_A   51200
#define LR_B   83968
#define LR_SEG 116736
__device__ void lru_item(const P& p, LAS unsigned char* lds, int b, int blk, int tid) {
  const int lane = tid & 63, wid = tid >> 6, fr = lane & 15, g = lane >> 4;
  LAS u16* xcb = (LAS u16*)(lds + LR_XCB);
  LAS float* xcf = (LAS float*)(lds + LR_XCF);
  LAS float* a_s = (LAS float*)(lds + LR_A);
  LAS float* b_s = (LAS float*)(lds + LR_B);
  LAS float* segP = (LAS float*)(lds + LR_SEG);
  LAS float* segH = segP + 512;
  LAS float* carry = segH + 512;
  LAS float* Hprev = carry + 512;
  LAS float* cw = Hprev + 64;
  LAS float* cb = cw + 256;
  const int c0 = blk * 64;
  if (tid < 256) cw[tid] = p.conv_w[(tid >> 6) * 512 + c0 + (tid & 63)];
  if (tid < 64) { cb[tid] = p.conv_b[c0 + tid]; Hprev[tid] = 0.f; }
  float brg[4], big[4], spl[4];
#pragma unroll
  for (int nt = 0; nt < 4; ++nt) {
    const int c = c0 + nt * 16 + fr;
    brg[nt] = p.b_rg[c]; big[nt] = p.b_ig[c];
    const float l = p.lam[c];
    spl[nt] = (-l > 20.f) ? -l : log1pf(__expf(-l));
  }
  const u16* wrg = p.WrgT + (size_t)blk * 4096 + fr * 64 + g * 8;
  const u16* wig = p.WigT + (size_t)blk * 4096 + fr * 64 + g * 8;
  __syncthreads();
  const int tok_l = tid >> 2, cg = tid & 3;
  uint4 xr[4][2];
  const u16* xbase = p.xbr + (size_t)b * SEQ * 512 + c0 + cg * 16;
#define LRU_LOADX(S0) do { _Pragma("unroll") for (int w = 0; w < 4; ++w) { const int ss = (S0) + tok_l - 3 + w; \
      if (ss >= 0) { const uint4* src = (const uint4*)(xbase + (size_t)ss * 512); xr[w][0] = src[0]; xr[w][1] = src[1]; } \
      else { xr[w][0] = make_uint4(0, 0, 0, 0); xr[w][1] = xr[w][0]; } } } while (0)
  LRU_LOADX(0);
  for (int s0 = 0; s0 < SEQ; s0 += 128) {
    {
      float acc[16];
      { const fx4 b0 = *(LAS fx4*)(cb + cg * 16), b1 = *(LAS fx4*)(cb + cg * 16 + 4), b2 = *(LAS fx4*)(cb + cg * 16 + 8), b3 = *(LAS fx4*)(cb + cg * 16 + 12);
        acc[0] = b0[0]; acc[1] = b0[1]; acc[2] = b0[2]; acc[3] = b0[3]; acc[4] = b1[0]; acc[5] = b1[1]; acc[6] = b1[2]; acc[7] = b1[3];
        acc[8] = b2[0]; acc[9] = b2[1]; acc[10] = b2[2]; acc[11] = b2[3]; acc[12] = b3[0]; acc[13] = b3[1]; acc[14] = b3[2]; acc[15] = b3[3]; }
#pragma unroll
      for (int w = 0; w < 4; ++w) {
        const unsigned uu[8] = {xr[w][0].x, xr[w][0].y, xr[w][0].z, xr[w][0].w, xr[w][1].x, xr[w][1].y, xr[w][1].z, xr[w][1].w};
#pragma unroll
        for (int q = 0; q < 4; ++q) { const fx4 wv = *(LAS fx4*)(cw + w * 64 + cg * 16 + 4 * q);
          acc[4 * q] += bflo(uu[2 * q]) * wv[0]; acc[4 * q + 1] += bfhi(uu[2 * q]) * wv[1]; acc[4 * q + 2] += bflo(uu[2 * q + 1]) * wv[2]; acc[4 * q + 3] += bfhi(uu[2 * q + 1]) * wv[3]; }
      }
#pragma unroll
      for (int i = 0; i < 16; i += 4) { const fx4 t4 = {acc[i], acc[i + 1], acc[i + 2], acc[i + 3]}; LDS_ST_FX4(xcf + tok_l * 64 + cg * 16 + i, t4); }
#pragma unroll
      for (int i = 0; i < 16; i += 4) { uint2 o; o.x = pack_bf2(acc[i], acc[i + 1]); o.y = pack_bf2(acc[i + 2], acc[i + 3]); LDS_STORE(uint2, xcb + tok_l * 72 + cg * 16 + i, o); }
    }
    const size_t t = (size_t)b * SEQ + s0 + tok_l;
    const uint4* gsrc = (const uint4*)(p.gate + t * 512 + c0 + cg * 16);
    const uint4 g0 = gsrc[0], g1 = gsrc[1];
    if (s0 + 128 < SEQ) LRU_LOADX(s0 + 128);
    __syncthreads();
    {
      const s16x8 A0 = *(LAS s16x8*)(xcb + (wid * 16 + fr) * 72 + g * 8);
      const s16x8 A1 = *(LAS s16x8*)(xcb + (wid * 16 + fr) * 72 + 32 + g * 8);
#pragma unroll
      for (int nt = 0; nt < 4; ++nt) {
        fx4 R = {0.f, 0.f, 0.f, 0.f}, I = {0.f, 0.f, 0.f, 0.f};
        const s16x8 br0 = *(const s16x8*)(wrg + nt * 1024), br1 = *(const s16x8*)(wrg + nt * 1024 + 32);
        const s16x8 bi0 = *(const s16x8*)(wig + nt * 1024), bi1 = *(const s16x8*)(wig + nt * 1024 + 32);
        R = __builtin_amdgcn_mfma_f32_16x16x32_bf16(A0, br0, R, 0, 0, 0);
        R = __builtin_amdgcn_mfma_f32_16x16x32_bf16(A1, br1, R, 0, 0, 0);
        I = __builtin_amdgcn_mfma_f32_16x16x32_bf16(A0, bi0, I, 0, 0, 0);
        I = __builtin_amdgcn_mfma_f32_16x16x32_bf16(A1, bi1, I, 0, 0, 0);
#pragma unroll
        for (int r = 0; r < 4; ++r) {
          const int tok = wid * 16 + 4 * g + r, o = nt * 16 + fr;
          const float rr = sigmoidf_(R[r] + brg[nt]), ii = sigmoidf_(I[r] + big[nt]);
          const float log_a = -8.f * rr * spl[nt];
          const float a = __expf(log_a);
          const float bb = sqrtf(fmaxf(1.f - a * a, 0.f)) * (ii * xcf[tok * 64 + o]);
          a_s[tok * 64 + o] = a; b_s[tok * 64 + o] = bb;
        }
      }
    }
    __syncthreads();
    {
      float av[16], bv[16];
#pragma unroll
      for (int i = 0; i < 16; ++i) { av[i] = a_s[(wid * 16 + i) * 64 + lane]; bv[i] = b_s[(wid * 16 + i) * 64 + lane]; }
      float hh = 0.f, pp = 1.f;
#pragma unroll
      for (int i = 0; i < 16; ++i) { hh = av[i] * hh + bv[i]; pp *= av[i]; bv[i] = hh; av[i] = pp; }
#pragma unroll
      for (int i = 0; i < 16; ++i) { b_s[(wid * 16 + i) * 64 + lane] = bv[i]; a_s[(wid * 16 + i) * 64 + lane] = av[i]; }
      segP[wid * 64 + lane] = pp; segH[wid * 64 + lane] = hh;
    }
    __syncthreads();
    if (tid < 64) {
      float sp_[8], sh_[8];
#pragma unroll
      for (int sg = 0; sg < 8; ++sg) { sp_[sg] = segP[sg * 64 + tid]; sh_[sg] = segH[sg * 64 + tid]; }
      float c = Hprev[tid];
#pragma unroll
      for (int sg = 0; sg < 8; ++sg) { carry[sg * 64 + tid] = c; c = sp_[sg] * c + sh_[sg]; }
      Hprev[tid] = c;
    }
    __syncthreads();
    {
      const unsigned gg[8] = {g0.x, g0.y, g0.z, g0.w, g1.x, g1.y, g1.z, g1.w};
      unsigned oo[8];
#pragma unroll
      for (int q = 0; q < 4; ++q) {
        const int o0 = cg * 16 + 4 * q;
        const fx4 cr = *(LAS fx4*)(carry + (tok_l >> 4) * 64 + o0), hl = *(LAS fx4*)(b_s + tok_l * 64 + o0), pl = *(LAS fx4*)(a_s + tok_l * 64 + o0);
        const float h0 = hl[0] + pl[0] * cr[0], h1 = hl[1] + pl[1] * cr[1], h2 = hl[2] + pl[2] * cr[2], h3 = hl[3] + pl[3] * cr[3];
        oo[2 * q] = pack_bf2(h0 * gelu_tanh_f(bflo(gg[2 * q])), h1 * gelu_tanh_f(bfhi(gg[2 * q])));
        oo[2 * q + 1] = pack_bf2(h2 * gelu_tanh_f(bflo(gg[2 * q + 1])), h3 * gelu_tanh_f(bfhi(gg[2 * q + 1])));
      }
      uint4* dst = (uint4*)(p.mix + t * 1024 + 512 + c0 + cg * 16);
      dst[0] = make_uint4(oo[0], oo[1], oo[2], oo[3]); dst[1] = make_uint4(oo[4], oo[5], oo[6], oo[7]);
    }
    __syncthreads();
  }
#undef LRU_LOADX
}

__device__ void phase2(const P& p, LAS unsigned char* lds, int wid_s) {
  const int tid = mk_tid(wid_s), lane = tid & 63, wid = tid >> 6;
  LAS int* misc = (LAS int*)(lds + L_MISC);
  const int flags = p.pad0;
  if (!(flags & 1) && blockIdx.x < 64) lru_item(p, lds, blockIdx.x >> 3, blockIdx.x & 7, tid);
  if (flags & 2) return;
  for (;;) {
    __syncthreads();
    if (tid == 0) misc[0] = (int)atomicAdd(p.ctr, 1u);
    __syncthreads();
    const int a = misc[0];
    if (a >= 512) break;
    const int qb = 63 - (a >> 3), b = a & 7;
    const int t0 = qb * 32;
    for (int r = 0; r < 2; ++r) {
      const int tq0 = t0 + 16 * r;
      if (tid < 16) { LAS unsigned* mm = (LAS unsigned*)(lds + L_MM); mm[2 * tid] = 0u; mm[2 * tid + 1] = 0xFFFFFFFFu; }
      __syncthreads();
      if (!(flags & 16)) index_scores(p, lds, b, tq0, (tq0 >> 4) + 1, wid, lane);
      __syncthreads();
#pragma unroll 1
      for (int qq = 0; qq < ((flags & 4) ? 0 : 2); ++qq) {
        const int qi = wid * 2 + qq;
        select_row((LAS float*)lds + qi * SC_STRIDE, tq0 + qi, (LAS unsigned*)(lds + L_MASK) + (r * 16 + qi) * 64,
                   (LAS unsigned*)(lds + L_HIST) + wid * 256, (LAS unsigned*)(lds + L_CAND) + wid * 260, lane, p.pad1, (LAS unsigned*)(lds + L_MM) + 2 * qi);
      }
      __syncthreads();
    }
    if (!(flags & 8)) attn_block(p, lds, b, t0, wid, lane, tid);
  }
}
struct Epi3 {
  static constexpr bool PERM = false, AFTER_DRAIN = false;
  P p;
  __device__ __forceinline__ void operator()(const pg8::f32x4 (&acc)[2][2][4][2], const pg8::Unit& u, int wr, int wc, int fr_in, int fq_in) const {
    int fr = fr_in, fq = fq_in; asm volatile("" : "+v"(fr), "+v"(fq));
    const int rowb = u.pm * 256 + wr * 64 + fr;
    const int colb = u.pn * 256 + wc * 32 + 4 * fq;
#pragma unroll
    for (int ai = 0; ai < 2; ++ai)
#pragma unroll
      for (int m = 0; m < 4; ++m) { const int row = rowb + ai * 128 + m * 16;
        float s = 0.f;
#pragma unroll
        for (int bj = 0; bj < 2; ++bj)
#pragma unroll
          for (int n = 0; n < 2; ++n) { const int col = colb + bj * 128 + 16 * n;
            const float4 xr = *(const float4*)(p.x + (size_t)row * DM + col);
            const pg8::f32x4 a = acc[ai][bj][m][n];
            const float v0 = a[0] + xr.x, v1 = a[1] + xr.y, v2 = a[2] + xr.z, v3 = a[3] + xr.w;
            s += v0 * v0 + v1 * v1 + v2 * v2 + v3 * v3;
            *(float4*)(p.out + (size_t)row * DM + col) = make_float4(v0, v1, v2, v3);
            uint2 o; o.x = pack_bf2(v0, v1); o.y = pack_bf2(v2, v3);
            *(uint2*)(p.x1b + (size_t)row * DM + col) = o; }
        s += __shfl_xor(s, 16, 64); s += __shfl_xor(s, 32, 64);
        if (fq == 0) atomicAdd(p.ss_ffn + row, s); }
  }
};
__device__ void phase3_outproj(const P& p, LAS unsigned char* lds, int wid_s) {
  pg8::Gemm g; g.A = p.mix; g.Bt = p.WoutT; g.M = T_TOK; g.N = 1024; g.K = p.k1024;
  pg8::StaticOrder S; S.init(T_TOK, 1024, gridDim.x, blockIdx.x);
  Epi3 E; E.p = p;
  pg8::gemm_phase<Epi3, pg8::StaticOrder>(lds, g, S, E, nullptr, wid_s);
}
struct Epi4 {
  static constexpr bool PERM = false, AFTER_DRAIN = false;
  P p;
  __device__ __forceinline__ void operator()(const pg8::f32x4 (&acc)[2][2][4][2], const pg8::Unit& u, int wr, int wc, int fr_in, int fq_in) const {
    int fr = fr_in, fq = fq_in; asm volatile("" : "+v"(fr), "+v"(fq));
    const int rowb = u.pm * 256 + wr * 64 + fr;
    const int colb = u.pn * 256 + wc * 32 + 4 * fq;
#pragma unroll
    for (int ai = 0; ai < 2; ++ai)
#pragma unroll
      for (int m = 0; m < 4; ++m) { const int row = rowb + ai * 128 + m * 16;
        const float rs = rsqrtf(p.ss_ffn[row] * (1.f / DM) + 1e-6f);
#pragma unroll
        for (int bj = 0; bj < 2; ++bj)
#pragma unroll
          for (int n = 0; n < 2; ++n) { const int col = colb + bj * 128 + 16 * n;
            const pg8::f32x4 v = acc[ai][bj][m][n] * rs;
            uint2 o; o.x = pack_bf2(v[0], v[1]); o.y = pack_bf2(v[2], v[3]);
            *(uint2*)(p.pq + (size_t)row * 2048 + col) = o; } }
  }
};
__device__ void phase4_pq(const P& p, LAS unsigned char* lds, int wid_s) {
  pg8::Gemm g; g.A = p.x1b; g.Bt = p.WpqT; g.M = T_TOK; g.N = 2048; g.K = p.k1024;
  pg8::StaticOrder S; S.init(T_TOK, 2048, gridDim.x, blockIdx.x);
  Epi4 E; E.p = p;
  pg8::gemm_phase<Epi4, pg8::StaticOrder>(lds, g, S, E, nullptr, wid_s);
}

#ifdef USE_SHFL_ROW
__device__ __forceinline__ unsigned row16_max_u32(unsigned x) {
  x = max(x, (unsigned)__shfl_xor((int)x, 1, 64)); x = max(x, (unsigned)__shfl_xor((int)x, 2, 64));
  x = max(x, (unsigned)__shfl_xor((int)x, 4, 64)); x = max(x, (unsigned)__shfl_xor((int)x, 8, 64)); return x; }
__device__ __forceinline__ float row16_sum_f32(float x) {
  x += __shfl_xor(x, 1, 64); x += __shfl_xor(x, 2, 64); x += __shfl_xor(x, 4, 64); x += __shfl_xor(x, 8, 64); return x; }
#else
#define DPP_U(x, ctrl) ((unsigned)__builtin_amdgcn_update_dpp(0, (int)(x), (ctrl), 0xF, 0xF, true))
__device__ __forceinline__ unsigned row16_max_u32(unsigned x) {
  x = max(x, DPP_U(x, 0xB1)); x = max(x, DPP_U(x, 0x4E)); x = max(x, DPP_U(x, 0x141)); x = max(x, DPP_U(x, 0x140)); return x; }
__device__ __forceinline__ float row16_sum_f32(float x) {
  x += __uint_as_float(DPP_U(__float_as_uint(x), 0xB1)); x += __uint_as_float(DPP_U(__float_as_uint(x), 0x4E));
  x += __uint_as_float(DPP_U(__float_as_uint(x), 0x141)); x += __uint_as_float(DPP_U(__float_as_uint(x), 0x140)); return x; }
#endif
__device__ __forceinline__ float sort2f(unsigned u) { const unsigned b = (u & 0x80000000u) ? (u & 0x7FFFFFFFu) : ~u; return __uint_as_float(b); }

#define RT_KOFF 8192
#define RT_KSTR 136
__device__ void phase4b_route(const P& p, LAS unsigned char* lds, int wid_s) {
  const int tid = mk_tid(wid_s), lane = tid & 63, wid = tid >> 6, fr = lane & 15, g = lane >> 4;
  LAS unsigned* topk = (LAS unsigned*)lds;
  LAS u16* kimg = (LAS u16*)(lds + RT_KOFF);
  const int nitems = (T_TOK / 64) * 8;
  int hloaded = -1;
  for (int item = blockIdx.x; item < nitems; item += gridDim.x) {
    const int h = item & 7, tile = item >> 3;
    const int tok0 = tile * 64;
    if (h != hloaded) {
      __syncthreads();
      for (int i = tid; i < 2 * 128 * 16; i += 512) { const int side = i >> 11, r = (i >> 4) & 127, c = i & 15;
        const uint4 v = *(const uint4*)((side ? p.K2b : p.K1b) + (size_t)h * 16384 + r * 128 + c * 8);
        LDS_STORE(uint4, kimg + (side * 128 + r) * RT_KSTR + c * 8, v); }
      hloaded = h;
      __syncthreads();
    }
    {
      const int side = wid & 1, mt = wid >> 1;
      const size_t tok = (size_t)tok0 + mt * 16 + fr;
      const u16* qa = p.pq + tok * 2048 + h * 256 + side * 128 + g * 8;
      s16x8 A[4];
#pragma unroll
      for (int ks = 0; ks < 4; ++ks) A[ks] = *(const s16x8*)(qa + ks * 32);
      LAS u16* kb = kimg + (side * 128 + fr) * RT_KSTR + g * 8;
      unsigned val[8][4];
#pragma unroll
      for (int nt = 0; nt < 8; ++nt) {
        fx4 acc = {0.f, 0.f, 0.f, 0.f};
#pragma unroll
        for (int ks = 0; ks < 4; ++ks) {
          const s16x8 B = *(LAS s16x8*)(kb + nt * 16 * RT_KSTR + ks * 32);
          acc = __builtin_amdgcn_mfma_f32_16x16x32_bf16(A[ks], B, acc, 0, 0, 0);
        }
        const unsigned tag = 127u - (unsigned)(nt * 16 + fr);
#pragma unroll
        for (int r = 0; r < 4; ++r) val[nt][r] = (f2sort(acc[r]) & ~0x7Fu) | tag;
      }
#define CE(a, b) do { const unsigned hi_ = max(a, b), lo_ = min(a, b); a = hi_; b = lo_; } while (0)
#pragma unroll
      for (int r = 0; r < 4; ++r) {
        CE(val[0][r], val[1][r]); CE(val[2][r], val[3][r]); CE(val[4][r], val[5][r]); CE(val[6][r], val[7][r]);
        CE(val[0][r], val[2][r]); CE(val[1][r], val[3][r]); CE(val[4][r], val[6][r]); CE(val[5][r], val[7][r]);
        CE(val[1][r], val[2][r]); CE(val[5][r], val[6][r]);
        CE(val[0][r], val[4][r]); CE(val[1][r], val[5][r]); CE(val[2][r], val[6][r]); CE(val[3][r], val[7][r]);
        CE(val[2][r], val[4][r]); CE(val[3][r], val[5][r]);
        CE(val[1][r], val[2][r]); CE(val[3][r], val[4][r]); CE(val[5][r], val[6][r]);
      }
#undef CE
      unsigned mine[4] = {0u, 0u, 0u, 0u};
#pragma unroll 1
      for (int i = 0; i < 16; ++i) {
        unsigned m[4];
#pragma unroll
        for (int r = 0; r < 4; ++r) m[r] = max(val[0][r], DPP_U(val[0][r], 0xB1));
#pragma unroll
        for (int r = 0; r < 4; ++r) m[r] = max(m[r], DPP_U(m[r], 0x4E));
#pragma unroll
        for (int r = 0; r < 4; ++r) m[r] = max(m[r], DPP_U(m[r], 0x141));
#pragma unroll
        for (int r = 0; r < 4; ++r) m[r] = max(m[r], DPP_U(m[r], 0x140));
#pragma unroll
        for (int r = 0; r < 4; ++r) {
          const bool win = (val[0][r] == m[r]);
#pragma unroll
          for (int q = 0; q < 7; ++q) val[q][r] = win ? val[q + 1][r] : val[q][r];
          val[7][r] = win ? 0u : val[7][r];
          if (fr == i) mine[r] = m[r];
        }
      }
#pragma unroll
      for (int r = 0; r < 4; ++r) topk[((mt * 16 + 4 * g + r) * 2 + side) * 16 + fr] = mine[r];
    }
    __syncthreads();
#pragma unroll 1
    for (int rd = 0; rd < 2; ++rd) {
      const int tl = wid * 8 + rd * 4 + g;
      LAS unsigned* t1 = topk + (tl * 2 + 0) * 16;
      LAS unsigned* t2 = topk + (tl * 2 + 1) * 16;
      unsigned cv[4];
#pragma unroll
      for (int j = 0; j < 4; ++j) {
        const int s = fr + 16 * j;
        int a, bb;
        if (s < 16) { a = 0; bb = s; } else if (s < 24) { a = 1; bb = s - 16; } else if (s < 29) { a = 2; bb = s - 24; } else if (s < 33) { a = 3; bb = s - 29; }
        else if (s < 36) { a = 4; bb = s - 33; } else if (s < 38) { a = 5; bb = s - 36; } else if (s < 40) { a = 6; bb = s - 38; } else if (s < 42) { a = 7; bb = s - 40; }
        else if (s < 50) { a = 8 + (s - 42); bb = 0; } else { a = -1; bb = 0; }
        unsigned key = 0u;
        if (a >= 0) {
          const float sum = sort2f(t1[a] & ~0x7Fu) + sort2f(t2[bb] & ~0x7Fu);
          key = (f2sort(sum) & ~0xFFu) | (unsigned)(255 - (a * 16 + bb));
        }
        cv[j] = key;
      }
      unsigned mine = 0u;
#pragma unroll 1
      for (int i = 0; i < 16; ++i) {
        unsigned m = max(max(cv[0], cv[1]), max(cv[2], cv[3]));
        m = row16_max_u32(m);
#pragma unroll
        for (int j = 0; j < 4; ++j) cv[j] = (cv[j] == m) ? 0u : cv[j];
        if (fr == i) mine = m;
      }
      const int flat = 255 - (int)(mine & 0xFFu);
      const int a = flat >> 4, bb = flat & 15;
      const unsigned k1 = t1[a], k2 = t2[bb];
      const float sum = sort2f(k1 & ~0x7Fu) + sort2f(k2 & ~0x7Fu);
      const unsigned m0 = (unsigned)__shfl((int)mine, lane & 48, 64);
      const int f0 = 255 - (int)(m0 & 0xFFu);
      const float s0 = sort2f(t1[f0 >> 4] & ~0x7Fu) + sort2f(t2[f0 & 15] & ~0x7Fu);
      const float ex = __expf(sum - s0);
      const float den = row16_sum_f32(ex);
      const int e = (127 - (int)(k1 & 0x7Fu)) * 128 + (127 - (int)(k2 & 0x7Fu));
      const size_t t = (size_t)tok0 + tl;
      p.experts[t * 128 + h * 16 + fr] = e;
      p.gates[t * 128 + h * 16 + fr] = ex / den;
    }
    __syncthreads();
  }
}
#define FP8_LO(w) __builtin_amdgcn_cvt_pk_f32_fp8((int)(w), false)
#define FP8_HI(w) __builtin_amdgcn_cvt_pk_f32_fp8((int)(w), true)
#define P5_LIST_WORDS (4 * 128 * 3)
#define P5_WAVE_WORDS (P5_LIST_WORDS + 128)
__device__ __forceinline__ float gelu_erf_fast(float v) {
  const float av = fabsf(v), t = __builtin_amdgcn_rcpf(av * 0.2316418882f + 1.0f);
  float q = t * 0.5307027145f + (-0.7265760135f); q = q * t + 0.7107068705f; q = q * t + (-0.142248368f); q = q * t + 0.127414796f; q = q * t;
  const float e = __builtin_amdgcn_exp2f((v * v) * (-0.72134752044f));
  const float m = v * (q * e);
  return v < 0.f ? m : v - m;
}
__device__ __forceinline__ float dot16_fp8(const uint4 r, const float (&h)[16]) {
  fx2 a; float d;
  a = FP8_LO(r.x); d = a.x * h[0] + a.y * h[1]; a = FP8_HI(r.x); d += a.x * h[2] + a.y * h[3];
  a = FP8_LO(r.y); d += a.x * h[4] + a.y * h[5]; a = FP8_HI(r.y); d += a.x * h[6] + a.y * h[7];
  a = FP8_LO(r.z); d += a.x * h[8] + a.y * h[9]; a = FP8_HI(r.z); d += a.x * h[10] + a.y * h[11];
  a = FP8_LO(r.w); d += a.x * h[12] + a.y * h[13]; a = FP8_HI(r.w); d += a.x * h[14] + a.y * h[15];
  return d;
}
#define FP4_B(w, b) __builtin_amdgcn_cvt_scalef32_pk_f32_fp4((w), 1.0f, (b))
__device__ __forceinline__ void axpy16_fp8(const float c, const uint2 r, float (&acc)[16]) {
  fx2 a;
  a = FP4_B(r.x, 0); acc[0] += c * a.x; acc[1] += c * a.y; a = FP4_B(r.x, 1); acc[2] += c * a.x; acc[3] += c * a.y;
  a = FP4_B(r.x, 2); acc[4] += c * a.x; acc[5] += c * a.y; a = FP4_B(r.x, 3); acc[6] += c * a.x; acc[7] += c * a.y;
  a = FP4_B(r.y, 0); acc[8] += c * a.x; acc[9] += c * a.y; a = FP4_B(r.y, 1); acc[10] += c * a.x; acc[11] += c * a.y;
  a = FP4_B(r.y, 2); acc[12] += c * a.x; acc[13] += c * a.y; a = FP4_B(r.y, 3); acc[14] += c * a.x; acc[15] += c * a.y;
}
#define DPPF(x, ctrl) __uint_as_float((unsigned)__builtin_amdgcn_update_dpp(0, (int)__float_as_uint(x), (ctrl), 0xF, 0xF, true))
typedef __bf16 bf16x2_t __attribute__((ext_vector_type(2)));
__device__ __forceinline__ float xsum32(float x) { const unsigned xi = __float_as_uint(x); const auto r = __builtin_amdgcn_permlane32_swap(xi, xi, false, false); return __uint_as_float(r[0]) + __uint_as_float(r[1]); }
__device__ __forceinline__ float xsum16(float x) { const unsigned xi = __float_as_uint(x); const auto r = __builtin_amdgcn_permlane16_swap(xi, xi, false, false); return __uint_as_float(r[0]) + __uint_as_float(r[1]); }
__device__ __forceinline__ float dot16_fp8_bf16(const uint2 r, const unsigned (&h)[8]) {
  float d;
  d = __builtin_amdgcn_fdot2_f32_bf16(__builtin_amdgcn_cvt_scalef32_pk_bf16_fp4(r.x, 1.0f, 0), __builtin_bit_cast(bf16x2_t, h[0]), 0.f, false);
  d = __builtin_amdgcn_fdot2_f32_bf16(__builtin_amdgcn_cvt_scalef32_pk_bf16_fp4(r.x, 1.0f, 1), __builtin_bit_cast(bf16x2_t, h[1]), d, false);
  d = __builtin_amdgcn_fdot2_f32_bf16(__builtin_amdgcn_cvt_scalef32_pk_bf16_fp4(r.x, 1.0f, 2), __builtin_bit_cast(bf16x2_t, h[2]), d, false);
  d = __builtin_amdgcn_fdot2_f32_bf16(__builtin_amdgcn_cvt_scalef32_pk_bf16_fp4(r.x, 1.0f, 3), __builtin_bit_cast(bf16x2_t, h[3]), d, false);
  d = __builtin_amdgcn_fdot2_f32_bf16(__builtin_amdgcn_cvt_scalef32_pk_bf16_fp4(r.y, 1.0f, 0), __builtin_bit_cast(bf16x2_t, h[4]), d, false);
  d = __builtin_amdgcn_fdot2_f32_bf16(__builtin_amdgcn_cvt_scalef32_pk_bf16_fp4(r.y, 1.0f, 1), __builtin_bit_cast(bf16x2_t, h[5]), d, false);
  d = __builtin_amdgcn_fdot2_f32_bf16(__builtin_amdgcn_cvt_scalef32_pk_bf16_fp4(r.y, 1.0f, 2), __builtin_bit_cast(bf16x2_t, h[6]), d, false);
  d = __builtin_amdgcn_fdot2_f32_bf16(__builtin_amdgcn_cvt_scalef32_pk_bf16_fp4(r.y, 1.0f, 3), __builtin_bit_cast(bf16x2_t, h[7]), d, false);
  return d;
}
struct P5Set { uint2 ru0, ru1, ru2, ru3, rv0, rv1, rv2, rv3; float sume, cgme; };
__device__ __forceinline__ void p5_issue(const P& p, P5Set& S, int bid, LAS unsigned* wl, int lane, __amdgpu_buffer_rsrc_t rsU, __amdgpu_buffer_rsrc_t rsV) {
  const int j = bid >> 5, s = (bid & 31) * 4;
  LAS unsigned* lst = wl + j * 384;
  const int sl = s + (lane & 3);
  const unsigned eme = lst[3 * sl]; S.sume = __uint_as_float(lst[3 * sl + 1]); S.cgme = __uint_as_float(lst[3 * sl + 2]);
  const int em_ = (p.pad1 & 4) ? 1023 : 0x7FFFFFFF;
  const int e0 = __builtin_amdgcn_readlane((int)eme, 0) & em_, e1 = __builtin_amdgcn_readlane((int)eme, 1) & em_, e2 = __builtin_amdgcn_readlane((int)eme, 2) & em_, e3 = __builtin_amdgcn_readlane((int)eme, 3) & em_;
  const int l16 = 8 * lane;
  typedef unsigned v2u_ __attribute__((ext_vector_type(2)));
#define P5_LD(dst, rs, e) do { const v2u_ t_ = __builtin_amdgcn_raw_buffer_load_b64(rs, l16, (e) * 512, 0); dst = make_uint2(t_.x, t_.y); } while (0)
  P5_LD(S.ru0, rsU, e0); P5_LD(S.ru1, rsU, e1); P5_LD(S.ru2, rsU, e2); P5_LD(S.ru3, rsU, e3);
  P5_LD(S.rv0, rsV, e0); P5_LD(S.rv1, rsV, e1); P5_LD(S.rv2, rsV, e2); P5_LD(S.rv3, rsV, e3);
#undef P5_LD
}
__device__ __forceinline__ void p5_compute(const P5Set& S, LAS unsigned* ent, const unsigned (&hfp)[8], float (&acc)[16], int lane, int pf) {
  float d0 = dot16_fp8_bf16(S.ru0, hfp), d1 = dot16_fp8_bf16(S.ru1, hfp), d2 = dot16_fp8_bf16(S.ru2, hfp), d3 = dot16_fp8_bf16(S.ru3, hfp);
  {
    const bool up1 = (lane & 1) != 0;
    const float s01 = up1 ? d0 : d1, k01 = up1 ? d1 : d0, s23 = up1 ? d2 : d3, k23 = up1 ? d3 : d2;
    const float a = k01 + DPPF(s01, 0xB1), b = k23 + DPPF(s23, 0xB1);
    const bool up2 = (lane & 2) != 0;
    const float sab = up2 ? a : b, kab = up2 ? b : a;
    d0 = kab + DPPF(sab, 0x4E);
    d0 += DPPF(d0, 0x124); d0 += DPPF(d0, 0x128);
    d0 = xsum16(d0); d0 = xsum32(d0);
  }
  const float cme = gelu_erf_fast(d0 * S.sume) * S.cgme;
  const float c0 = __uint_as_float((unsigned)__builtin_amdgcn_readlane((int)__float_as_uint(cme), 0));
  const float c1 = __uint_as_float((unsigned)__builtin_amdgcn_readlane((int)__float_as_uint(cme), 1));
  const float c2 = __uint_as_float((unsigned)__builtin_amdgcn_readlane((int)__float_as_uint(cme), 2));
  const float c3 = __uint_as_float((unsigned)__builtin_amdgcn_readlane((int)__float_as_uint(cme), 3));
  (void)pf; (void)ent;
  axpy16_fp8(c0, S.rv0, acc); axpy16_fp8(c1, S.rv1, acc); axpy16_fp8(c2, S.rv2, acc); axpy16_fp8(c3, S.rv3, acc);
}
#define P5_COMPUTE(S, bid) do { const int j_ = (bid) >> 5; LAS unsigned* ent_ = wl + j_ * 384 + 12 * ((bid) & 31); \
    if (j_ == 0) p5_compute(S, ent_, hfp[0], acc[0], lane, p.pad1); else if (j_ == 1) p5_compute(S, ent_, hfp[1], acc[1], lane, p.pad1); \
    else if (j_ == 2) p5_compute(S, ent_, hfp[2], acc[2], lane, p.pad1); else p5_compute(S, ent_, hfp[3], acc[3], lane, p.pad1); } while (0)

__device__ __forceinline__ void rank128(int k0, int k1, int lane, int& r0, int& r1) {
  r0 = 0; r1 = 0;
#pragma unroll 8
  for (int i = 0; i < 64; ++i) {
    const int a = __builtin_amdgcn_readlane(k0, i), b = __builtin_amdgcn_readlane(k1, i);
    r0 += ((a < k0) || (a == k0 && i < lane)) ? 1 : 0;
    r0 += (b < k0) ? 1 : 0;
    r1 += (a <= k1) ? 1 : 0;
    r1 += ((b < k1) || (b == k1 && i < lane)) ? 1 : 0;
  }
}

__device__ void phase5_experts(const P& p, LAS unsigned char* lds, int wid_s) {
  const int tid = mk_tid(wid_s), lane_in = tid & 63, wid = wid_s;
  const int gw = blockIdx.x * 8 + wid;
  LAS unsigned* wl = (LAS unsigned*)lds + wid * P5_WAVE_WORDS;
  const __amdgpu_buffer_rsrc_t rsU = __builtin_amdgcn_make_buffer_rsrc(p.U8, 0, 8 << 20, 0x00020000), rsV = __builtin_amdgcn_make_buffer_rsrc(p.V8, 0, 8 << 20, 0x00020000);
  LAS unsigned* ord = wl + P5_LIST_WORDS;
#pragma unroll 1
  for (int sweep = 0; sweep < 2; ++sweep) {
    const int tb = (sweep * 2048 + gw) * 4;
    int lane = lane_in; asm volatile("" : "+v"(lane));
    unsigned hfp[4][8];
    float acc[4][16];
#pragma unroll 1
    for (int j = 0; j < 4; ++j) {
      const size_t t = (size_t)tb + j;
      const int e0 = p.experts[t * 128 + lane], e1 = p.experts[t * 128 + 64 + lane];
      const float g0 = p.gates[t * 128 + lane], g1 = p.gates[t * 128 + 64 + lane];
      const float su0 = p.su[e0], su1 = p.su[e1], sv0 = p.sv[e0], sv1 = p.sv[e1];
      int r0, r1;
      if (p.pad1 & 2) { r0 = lane; r1 = lane + 64; } else rank128(e0, e1, lane, r0, r1);
      LAS unsigned* lst = wl + j * 384;
      lst[3 * r0] = (unsigned)e0; lst[3 * r0 + 1] = __float_as_uint(su0); lst[3 * r0 + 2] = __float_as_uint(g0 * sv0);
      lst[3 * r1] = (unsigned)e1; lst[3 * r1 + 1] = __float_as_uint(su1); lst[3 * r1 + 2] = __float_as_uint(g1 * sv1);
    }
    asm volatile("s_waitcnt lgkmcnt(0)" ::: "memory");
#pragma unroll
    for (int j = 0; j < 4; ++j) {
      const size_t t = (size_t)tb + j;
      const float* x1r = p.out + t * DM;
      const float rs = rsqrtf(p.ss_ffn[t] * (1.f / DM) + 1e-6f);
#pragma unroll
      for (int i = 0; i < 4; ++i) { const float4 xv = *(const float4*)(x1r + 256 * i + 4 * lane); const float4 g = *(const float4*)(p.g_ffn + 256 * i + 4 * lane);
        hfp[j][2 * i] = pack_bf2(xv.x * rs * g.x, xv.y * rs * g.y); hfp[j][2 * i + 1] = pack_bf2(xv.z * rs * g.z, xv.w * rs * g.w); }
#pragma unroll
      for (int i = 0; i < 16; ++i) acc[j][i] = 0.f;
    }
    asm volatile("s_waitcnt lgkmcnt(0)" ::: "memory");
    if (!(p.pad1 & 1)) {
      P5Set A, B, C, D;
      p5_issue(p, A, 0 * 32 + 0, wl, lane, rsU, rsV);
      p5_issue(p, B, 1 * 32 + 0, wl, lane, rsU, rsV);
      p5_issue(p, C, 2 * 32 + 0, wl, lane, rsU, rsV);
#pragma unroll 1
      for (int c = 0; c < 32; ++c) {
        const int cn = min(c + 1, 31);
        p5_issue(p, D, 3 * 32 + c, wl, lane, rsU, rsV);
        p5_compute(A, nullptr, hfp[0], acc[0], lane, 0);
        p5_issue(p, A, 0 * 32 + cn, wl, lane, rsU, rsV);
        p5_compute(B, nullptr, hfp[1], acc[1], lane, 0);
        p5_issue(p, B, 1 * 32 + cn, wl, lane, rsU, rsV);
        p5_compute(C, nullptr, hfp[2], acc[2], lane, 0);
        p5_issue(p, C, 2 * 32 + cn, wl, lane, rsU, rsV);
        p5_compute(D, nullptr, hfp[3], acc[3], lane, 0);
      }
      asm volatile("s_waitcnt vmcnt(0)" ::: "memory");
    }
    int lane_e = lane; asm volatile("" : "+v"(lane_e));
#pragma unroll
    for (int j = 0; j < 4; ++j) {
      const float* x1r = p.out + ((size_t)tb + j) * DM;
#pragma unroll
      for (int i = 0; i < 4; ++i) {
        const float4 xv = *(const float4*)(x1r + 256 * i + 4 * lane_e);
        acc[j][4 * i] += xv.x; acc[j][4 * i + 1] += xv.y; acc[j][4 * i + 2] += xv.z; acc[j][4 * i + 3] += xv.w;
      }
    }
    asm volatile("" ::: "memory");
#pragma unroll
    for (int j = 0; j < 4; ++j) {
      float* x1r = p.out + ((size_t)tb + j) * DM; u16* x2r = p.x2b + ((size_t)tb + j) * DM;
#pragma unroll
      for (int i = 0; i < 4; ++i) {
        *(float4*)(x1r + 256 * i + 4 * lane_e) = make_float4(acc[j][4 * i], acc[j][4 * i + 1], acc[j][4 * i + 2], acc[j][4 * i + 3]);
        *(uint2*)(x2r + 256 * i + 4 * lane_e) = make_uint2(pack_bf2(acc[j][4 * i], acc[j][4 * i + 1]), pack_bf2(acc[j][4 * i + 2], acc[j][4 * i + 3]));
      }
    }
  }
}

struct Epi6a {
  static constexpr bool PERM = false, AFTER_DRAIN = false;
  P p;
  __device__ __forceinline__ void operator()(const pg8::f32x4 (&acc)[2][2][4][2], const pg8::Unit& u, int wr, int wc, int fr_in, int fq_in) const {
    int fr = fr_in, fq = fq_in; asm volatile("" : "+v"(fr), "+v"(fq));
    const int rowb = u.pm * 256 + wr * 64 + fr;
    const int colb = u.pn * 256 + wc * 32 + 4 * fq;
#pragma unroll
    for (int ai = 0; ai < 2; ++ai)
#pragma unroll
      for (int m = 0; m < 4; ++m) { const int row = rowb + ai * 128 + m * 16;
#pragma unroll
        for (int bj = 0; bj < 2; ++bj)
#pragma unroll
          for (int n = 0; n < 2; ++n) { const int col = colb + bj * 128 + 16 * n;
            const pg8::f32x4 v = acc[ai][bj][m][n];
            uint2 o; o.x = pack_bf2(v[0], v[1]); o.y = pack_bf2(v[2], v[3]);
            *(uint2*)(p.pple + (size_t)row * DM + col) = o; } }
  }
};
struct Epi6b {
  static constexpr bool PERM = false, AFTER_DRAIN = false;
  P p;
  __device__ __forceinline__ void operator()(const pg8::f32x4 (&acc)[2][2][4][2], const pg8::Unit& u, int wr, int wc, int fr_in, int fq_in) const {
    int fr = fr_in, fq = fq_in; asm volatile("" : "+v"(fr), "+v"(fq));
    const int rowb = u.pm * 256 + wr * 64 + fr;
    const int colb = u.pn * 256 + wc * 32 + 4 * fq;
#pragma unroll
    for (int ai = 0; ai < 2; ++ai)
#pragma unroll
      for (int m = 0; m < 4; ++m) { const int row = rowb + ai * 128 + m * 16;
        float s = 0.f;
#pragma unroll
        for (int bj = 0; bj < 2; ++bj)
#pragma unroll
          for (int n = 0; n < 2; ++n) { const int col = colb + bj * 128 + 16 * n;
            const float4 x2 = *(const float4*)(p.out + (size_t)row * DM + col);
            const uint2 pw = *(const uint2*)(p.pple + (size_t)row * DM + col);
            const pg8::f32x4 a = acc[ai][bj][m][n];
            const float v0 = x2.x + sigmoidf_(a[0]) * bflo(pw.x), v1 = x2.y + sigmoidf_(a[1]) * bfhi(pw.x);
            const float v2 = x2.z + sigmoidf_(a[2]) * bflo(pw.y), v3 = x2.w + sigmoidf_(a[3]) * bfhi(pw.y);
            s += v0 * v0 + v1 * v1 + v2 * v2 + v3 * v3;
            *(float4*)(p.out + (size_t)row * DM + col) = make_float4(v0, v1, v2, v3); }
        s += __shfl_xor(s, 16, 64); s += __shfl_xor(s, 32, 64);
        if (fq == 0) atomicAdd(p.ss_fin + row, s);
        asm volatile("" ::: "memory"); }
  }
};
__device__ void phase6_ple(const P& p, LAS unsigned char* lds, int wid_s) {
  { pg8::Gemm g; g.A = p.p16; g.Bt = p.WpleT; g.M = T_TOK; g.N = 1024; g.K = p.k256;
    pg8::StaticOrder S; S.init(T_TOK, 1024, gridDim.x, blockIdx.x);
    Epi6a E; E.p = p;
    pg8::gemm_phase<Epi6a, pg8::StaticOrder>(lds, g, S, E, nullptr, wid_s); }
  { pg8::Gemm g; g.A = p.x2b; g.Bt = p.WgT; g.M = T_TOK; g.N = 1024; g.K = p.k1024;
    pg8::StaticOrder S; S.init(T_TOK, 1024, gridDim.x, blockIdx.x);
    Epi6b E; E.p = p;
    pg8::gemm_phase<Epi6b, pg8::StaticOrder>(lds, g, S, E, nullptr, wid_s); }
}
__device__ void phase7_final(const P& p, int wid_s) {
  const int gt = blockIdx.x * 512 + mk_tid(wid_s), nt = gridDim.x * 512;
  for (int i = gt; i < T_TOK * DM / 4; i += nt) {
    const int row = i >> 8, c4 = i & 255;
    const float rs = rsqrtf(p.ss_fin[row] * (1.f / DM) + 1e-6f);
    const float4 v = ((const float4*)p.out)[i];
    const float4 g = ((const float4*)p.g_final)[c4];
    ((float4*)p.out)[i] = make_float4(v.x * rs * g.x, v.y * rs * g.y, v.z * rs * g.z, v.w * rs * g.w);
  }
}
#define XB_TMO      128
#define XB_XCNT(j)  (256  + 64 * (j))
#define XB_XSUB(j)  (1280 + 64 * (j))
#define XB_XGEN(j)  (2304 + 64 * (j))
#define XB_TOP      3328
#define XB_TOPGEN   3392
#define XCD_BAR_WORDS 3456
#define XB_SPIN_CAP (1u << 22)
__device__ __forceinline__ unsigned xb_ld(unsigned* p)              { return __hip_atomic_load(p, __ATOMIC_RELAXED, __HIP_MEMORY_SCOPE_AGENT); }
__device__ __forceinline__ unsigned xb_add(unsigned* p, unsigned v) { return __hip_atomic_fetch_add(p, v, __ATOMIC_RELAXED, __HIP_MEMORY_SCOPE_AGENT); }
__device__ __forceinline__ unsigned xb_xcc_id() { return (unsigned)__builtin_amdgcn_s_getreg((3 << 11) | 20) & 0xFu; }
#define XB_SPIN(cond, bar) do { unsigned _sp = 0; while (cond) { __builtin_amdgcn_s_sleep(1); \
    if ((++_sp & 255u) == 0u) { if (xb_ld(&(bar)[XB_TMO])) break; if (_sp > XB_SPIN_CAP) { atomicAdd(&(bar)[XB_TMO], 1u); break; } } } } while (0)
struct XcdBarrier { unsigned* bar; unsigned x; volatile LAS unsigned* st; };
__device__ __forceinline__ XcdBarrier xcd_barrier_post(unsigned* bar, volatile LAS unsigned* st, int wid_s) {
    XcdBarrier b; b.bar = bar; b.x = xb_xcc_id(); b.st = st;
    if (mk_tid(wid_s) == 0) (void)xb_add(&bar[XB_XCNT(b.x)], 1u);
    return b;
}
__device__ __forceinline__ void xcd_barrier_complete(unsigned* bar, unsigned x, unsigned& nloc, unsigned& nx) {
    const unsigned G = gridDim.x * gridDim.y * gridDim.z;
    unsigned sum, cnt, mine, sp = 0u;
    for (;;) {
        sum = 0u; cnt = 0u; mine = 0u;
#pragma unroll
        for (unsigned j = 0; j < 16; ++j) { const unsigned c = xb_ld(&bar[XB_XCNT(j)]); sum += c; cnt += (c > 0u) ? 1u : 0u; mine = (j == x) ? c : mine; }
        if (sum == G) break;
        __builtin_amdgcn_s_sleep(1);
        if ((++sp & 255u) == 0u) { if (xb_ld(&bar[XB_TMO])) break; if (sp > XB_SPIN_CAP) { atomicAdd(&bar[XB_TMO], 1u); break; } }
    }
    nloc = mine > 0u ? mine : 1u; nx = cnt > 0u ? cnt : 1u;
}
__device__ __forceinline__ void xcd_barrier2(unsigned* bar_, volatile LAS unsigned* st_, int wid_s) {
    XcdBarrier b; b.bar = bar_; b.st = st_; b.x = xb_xcc_id();
    asm volatile("s_waitcnt vmcnt(0)" ::: "memory");
    __syncthreads();
    if (mk_tid(wid_s) == 0) {
        unsigned* bar = b.bar;
        __builtin_amdgcn_s_waitcnt(0);
        unsigned nloc = b.st[0], nx = b.st[1];
        if (nloc == 0u) { xcd_barrier_complete(bar, b.x, nloc, nx); b.st[0] = nloc; b.st[1] = nx; }
        const unsigned old = xb_add(&bar[XB_XSUB(b.x)], 1u);
        const unsigned gen = old / nloc;
        if (old + 1u == (gen + 1u) * nloc) {
            __builtin_amdgcn_fence(__ATOMIC_RELEASE, "agent");
            asm volatile("s_waitcnt vmcnt(0)" ::: "memory");
            const unsigned og = xb_add(&bar[XB_TOP], 1u);
            const unsigned tg = og / nx;
            if (og + 1u == (tg + 1u) * nx) xb_add(&bar[XB_TOPGEN], 1u);
            else XB_SPIN(xb_ld(&bar[XB_TOPGEN]) == tg, bar);
            __builtin_amdgcn_fence(__ATOMIC_ACQUIRE, "agent");
            xb_add(&bar[XB_XGEN(b.x)], 1u);
            asm volatile("s_waitcnt vmcnt(0)" ::: "memory");
        } else {
            XB_SPIN(xb_ld(&bar[XB_XGEN(b.x)]) == gen, bar);
            __builtin_amdgcn_fence(__ATOMIC_ACQUIRE, "agent");
            asm volatile("s_waitcnt vmcnt(0)" ::: "memory");
        }
    }
    __syncthreads();
}
static void fill_params(P& p, void* const* d_in, void* d_out, void* d_ws, size_t ws_size, size_t* used) {
  p.x = (const float*)d_in[0]; p.p = (const float*)d_in[1]; p.pos = (const int*)d_in[2]; p.g_mix = (const float*)d_in[3];
  p.w_in = (const float*)d_in[4]; p.g_kv = (const float*)d_in[5]; p.w_uk = (const float*)d_in[6]; p.w_uv = (const float*)d_in[7];
  p.conv_w = (const float*)d_in[8]; p.conv_b = (const float*)d_in[9]; p.w_rg = (const float*)d_in[10]; p.b_rg = (const float*)d_in[11];
  p.w_ig = (const float*)d_in[12]; p.b_ig = (const float*)d_in[13]; p.lam = (const float*)d_in[14]; p.w_out = (const float*)d_in[15];
  p.g_ffn = (const float*)d_in[16]; p.w_pq = (const float*)d_in[17]; p.k1 = (const float*)d_in[18]; p.k2 = (const float*)d_in[19];
  p.u_tab = (const float*)d_in[20]; p.v_tab = (const float*)d_in[21]; p.w_ple = (const float*)d_in[22]; p.w_gate = (const float*)d_in[23];
  p.g_final = (const float*)d_in[24];
  p.out = (float*)d_out; p.k1024 = 1024; p.k256 = 256; p.pad0 = 0; p.pad1 = 0;
  char* ws = (char*)d_ws; size_t off = 0;
  auto alloc = [&](size_t bytes) { void* r = ws + off; off += (bytes + 255) & ~(size_t)255; return r; };
  const size_t T = T_TOK;
  p.bar = (unsigned*)alloc(16384);
  p.ctr = (unsigned*)alloc(256);
  p.rstd_mix = (float*)alloc(T * 4); p.ss_ffn = (float*)alloc(T * 4); p.ss_fin = (float*)alloc(T * 4);
  p.ropeA = (float*)alloc(T * 32 * 4); p.ropeI = (float*)alloc(T * 16 * 4);
  p.W1t = (u16*)alloc((size_t)N1 * 1024 * 2); p.WoutT = (u16*)alloc(1024 * 1024 * 2); p.WpqT = (u16*)alloc(2048 * 1024 * 2);
  p.WgT = (u16*)alloc(1024 * 1024 * 2); p.WpleT = (u16*)alloc(1024 * 256 * 2);
  p.K1b = (u16*)alloc(8 * 128 * 128 * 2); p.K2b = (u16*)alloc(8 * 128 * 128 * 2);
  p.WrgT = (u16*)alloc(8 * 64 * 64 * 2); p.WigT = (u16*)alloc(8 * 64 * 64 * 2);
  p.U8 = (unsigned char*)alloc((size_t)16384 * 1024); p.V8 = (unsigned char*)alloc((size_t)16384 * 1024); p.su = (float*)alloc(16384 * 4); p.sv = (float*)alloc(16384 * 4);
  p.p16 = (u16*)alloc(T * 256 * 2);
  p.experts = (int*)alloc(T * 128 * 4); p.gates = (float*)alloc(T * 128 * 4);
  p.xb16 = (u16*)alloc(T * 1024 * 2); p.mix = p.xb16; p.x2b = p.xb16;
  char* rb = ws + off; size_t rboff = 0;
  auto allocB = [&](size_t bytes) { void* r = rb + rboff; rboff += (bytes + 255) & ~(size_t)255; return r; };
  p.qcat = (u16*)allocB(T * 640 * 2); p.kv = (u16*)allocB(T * 160 * 2); p.iqh = (u16*)allocB(T * 512 * 2); p.ikh = (u16*)allocB(T * 64 * 2);
  p.iw = (float*)allocB(T * 8 * 4); p.xbr = (u16*)allocB(T * 512 * 2); p.gate = (u16*)allocB(T * 512 * 2);
  size_t b1 = rboff; rboff = 0;
  p.x1b = (u16*)allocB(T * 1024 * 2); p.pq = (u16*)allocB(T * 2048 * 2); p.pple = p.x1b;
  size_t b2 = rboff;
  off += (b1 > b2 ? b1 : b2);
  *used = off;
}
namespace cg = cooperative_groups;
#ifndef USE_XCD_BARRIER
#define USE_XCD_BARRIER 0
#endif
__global__ void __launch_bounds__(512, 2) mega(P p) {
  extern __shared__ __attribute__((aligned(16))) unsigned char smem[];
  LAS unsigned char* lds = (LAS unsigned char*)smem;
  const int wid_s = __builtin_amdgcn_readfirstlane((int)(threadIdx.x >> 6));
  cg::grid_group grid = cg::this_grid();
#if USE_XCD_BARRIER
  volatile LAS unsigned* xst = (volatile LAS unsigned*)(lds + LDS_BYTES - 16);
  if (mk_tid(wid_s) == 0) { xst[0] = 0u; xst[1] = 0u; xst[2] = 0u; xst[3] = 0u; }
  __syncthreads();
  (void)xcd_barrier_post(p.bar, xst, wid_s);
#define GRID_SYNC() xcd_barrier2(p.bar, (volatile LAS unsigned*)(lds + LDS_BYTES - 16), wid_s)
#else
#define GRID_SYNC() grid.sync()
#endif
  phase0_prep(p, lds, wid_s);
#if USE_XCD_BARRIER
  if (p.k256 == 257) grid.sync();
  GRID_SYNC();
#else
  grid.sync();
#endif
  phase1_gemm1(p, lds, wid_s);
  GRID_SYNC();
  phase2(p, lds, wid_s);
  GRID_SYNC();
  phase3_outproj(p, lds, wid_s);
  GRID_SYNC();
  phase4_pq(p, lds, wid_s);
  GRID_SYNC();
  phase4b_route(p, lds, wid_s);
  GRID_SYNC();
  phase5_experts(p, lds, wid_s);
  GRID_SYNC();
  phase6_ple(p, lds, wid_s);
  GRID_SYNC();
  phase7_final(p, wid_s);
}

extern "C" void kernel_launch(void* const* d_in, const int* in_sizes, int n_in, void* d_out, int out_size, void* d_ws,
                              size_t ws_size, hipStream_t stream) {
  P p; memset(&p, 0, sizeof(p));
  size_t used = 0;
  fill_params(p, d_in, d_out, d_ws, ws_size, &used);
  static int grid_blocks = 0;
  if (!grid_blocks) {
    (void)hipFuncSetAttribute((const void*)mega, hipFuncAttributeMaxDynamicSharedMemorySize, LDS_BYTES);
    int dev = 0, cus = 0, per_cu = 0;
    (void)hipGetDevice(&dev);
    (void)hipDeviceGetAttribute(&cus, hipDeviceAttributeMultiprocessorCount, dev);
    (void)hipOccupancyMaxActiveBlocksPerMultiprocessor(&per_cu, mega, 512, LDS_BYTES);
    if (per_cu > 1) per_cu = 1;
    grid_blocks = cus * per_cu;
    if (grid_blocks <= 0) grid_blocks = 256;
  }
#if USE_XCD_BARRIER
  (void)hipMemsetAsync(p.bar, 0, XCD_BAR_WORDS * 4, stream);
#endif
  void* args[] = {&p};
  (void)hipLaunchCooperativeKernel((void*)mega, dim3(grid_blocks), dim3(512), args, LDS_BYTES, stream);
}
```

```cpp
#define USE_XCD_BARRIER 1
#include <hip/hip_runtime.h>
#include <hip/hip_cooperative_groups.h>
#include <math.h>
#include <stdint.h>
#include <string.h>

#define T_TOK 16384
#define SEQ 2048
#define NB 8
#define DM 1024
#define INTOT 2280
#define N1 2560
#define LDS_BYTES 163840
#define PRESCALE 0.12751743f
#define IDXSCALE 0.04419417382415922f

typedef unsigned short u16;
typedef _Float16 f16;
typedef _Float16 f16x8 __attribute__((ext_vector_type(8)));
typedef _Float16 f16x4 __attribute__((ext_vector_type(4)));
typedef short s16x8 __attribute__((ext_vector_type(8)));
typedef short s16x4 __attribute__((ext_vector_type(4)));
typedef float fx4 __attribute__((ext_vector_type(4)));
typedef float fx16 __attribute__((ext_vector_type(16)));
typedef float fx2 __attribute__((ext_vector_type(2)));
#define LAS __attribute__((address_space(3)))
#if defined(__HIP_DEVICE_COMPILE__)
#define LDS_STORE(T, ptr, val) (*(LAS T*)(ptr) = (val))
#define LDS_ST_FX4(ptr, val) (*(LAS fx4*)(ptr) = (val))
#else
#define LDS_STORE(T, ptr, val) ((void)0)
#define LDS_ST_FX4(ptr, val) ((void)0)
#endif

__device__ __forceinline__ int mk_tid(int wid_s) {
  int l;
  asm volatile("v_mbcnt_lo_u32_b32 %0, -1, 0\n\tv_mbcnt_hi_u32_b32 %0, -1, %0" : "=v"(l));
  return wid_s * 64 + l;
}
__device__ __forceinline__ u16 f2bf(float f) {
  unsigned u = __float_as_uint(f);
  u += 0x7FFFu + ((u >> 16) & 1u);
  return (u16)(u >> 16);
}
__device__ __forceinline__ unsigned pack_bf2(float lo, float hi) { return (unsigned)f2bf(lo) | ((unsigned)f2bf(hi) << 16); }
__device__ __forceinline__ float bf2f(u16 v) { return __uint_as_float((unsigned)v << 16); }
__device__ __forceinline__ float bflo(unsigned v) { return __uint_as_float(v << 16); }
__device__ __forceinline__ float bfhi(unsigned v) { return __uint_as_float(v & 0xFFFF0000u); }
__device__ __forceinline__ unsigned pack_h2(float lo, float hi) {
  f16 a = (f16)lo, b = (f16)hi;
  return (unsigned)__builtin_bit_cast(unsigned short, a) | ((unsigned)__builtin_bit_cast(unsigned short, b) << 16);
}
__device__ __forceinline__ float wave_sum(float v) {
#pragma unroll
  for (int o = 32; o > 0; o >>= 1) v += __shfl_xor(v, o, 64);
  return v;
}
__device__ __forceinline__ float wave_max(float v) {
#pragma unroll
  for (int o = 32; o > 0; o >>= 1) v = fmaxf(v, __shfl_xor(v, o, 64));
  return v;
}
__device__ __forceinline__ float sigmoidf_(float x) { return __builtin_amdgcn_rcpf(1.f + __builtin_amdgcn_exp2f(-1.4426950408889634f * x)); }
__device__ __forceinline__ float gelu_tanh_f(float x) {
  const float u = 0.7978845608028654f * (x + 0.044715f * x * x * x);
  const float e = __builtin_amdgcn_exp2f(2.8853900817779268f * u);
  const float th = 1.f - 2.f * __builtin_amdgcn_rcpf(e + 1.f);
  return 0.5f * x * (1.f + th);
}
__device__ __forceinline__ float gelu_erf_f(float x) { return 0.5f * x * (1.f + erff(x * 0.7071067811865476f)); }

struct P {
  const float* x; const float* p; const int* pos; const float* g_mix; const float* w_in; const float* g_kv;
  const float* w_uk; const float* w_uv; const float* conv_w; const float* conv_b; const float* w_rg; const float* b_rg;
  const float* w_ig; const float* b_ig; const float* lam; const float* w_out; const float* g_ffn; const float* w_pq;
  const float* k1; const float* k2; const float* u_tab; const float* v_tab; const float* w_ple; const float* w_gate;
  const float* g_final;
  float* out;
  u16* xb16; float* rstd_mix; float* ropeA; float* ropeI;
  u16* W1t; u16* WoutT; u16* WpqT; u16* WgT; u16* WpleT; u16* K1b; u16* K2b; u16* WrgT; u16* WigT;
  unsigned char* U8; unsigned char* V8; float* su; float* sv; u16* p16;
  u16* qcat; u16* kv; u16* iqh; u16* ikh; float* iw; u16* xbr; u16* gate;
  u16* mix; u16* x1b; u16* pq; float* ss_ffn; float* ss_fin;
  int* experts; float* gates; u16* x2b; u16* pple;
  unsigned* ctr; unsigned* bar;
  int k1024, k256, pad0, pad1;
};
namespace pg8 {
#define PG8_LAS __attribute__((address_space(3)))
typedef unsigned short bf16_t;
typedef short bf16x8 __attribute__((ext_vector_type(8)));
typedef float f32x4 __attribute__((ext_vector_type(4)));
typedef unsigned u32x4 __attribute__((ext_vector_type(4)));
constexpr int BM = 256, BK = 64, HALF = 128, HTB = HALF * BK * 2  , STAGE_BYTES = 8 * HTB, NXCD = 8, WGM = 8;

__host__ __device__ __forceinline__ int lds_byte(int r, int c) { const int st = (r >> 4) * 2 + (c >> 5), rr = r & 15, cc = c & 31, ob = rr * 64 + cc * 2; return st * 1024 + (ob ^ (((ob >> 9) & 1) << 5)); }
__host__ __device__ __forceinline__ void stage_rc(int b, int& R, int& C) { const int st = b / 1024, sb = b % 1024, swz = sb ^ (((sb >> 9) & 1) << 5); R = (st >> 1) * 16 + swz / 64; C = (st & 1) * 32 + (swz % 64) / 2; }
__host__ __device__ __forceinline__ int perm32(int rho) { const int n = rho >> 4, i = rho & 15; return 8 * (i >> 2) + 4 * n + (i & 3); }

struct Unit { int pm, pn; };
struct Gemm { const bf16_t* A; const bf16_t* Bt; int M, N, K; };

struct StaticOrder {
    int nM, nN, nwg, G, c;
    __host__ __device__ void init(int M, int N, int G_, int c_) { nM = M / BM; nN = N / BM; nwg = nM * nN; G = G_; c = c_; }
    __host__ __device__ bool next(int i, Unit& u) const {
        const long L = (long)i * G + c; if (L >= nwg) return false;
        int wgid = (int)L; { const int q = nwg / NXCD, r = nwg % NXCD, xcd = wgid % NXCD, off = wgid / NXCD; wgid = (xcd < r ? xcd * (q + 1) : r * (q + 1) + (xcd - r) * q) + off; }
        const int nig = WGM * nN, gid = wgid / nig, fm = gid * WGM, gsz = (nM - fm) < WGM ? (nM - fm) : WGM;
        u.pm = fm + ((wgid % nig) % gsz); u.pn = (wgid % nig) / gsz; return true;
    }
    __device__ __forceinline__ void a_ready(const Unit&) const {}
    __device__ __forceinline__ void done(const Unit&) const {}
};
__device__ __forceinline__ unsigned cvt_pk_bf16(float lo, float hi) { unsigned r; asm volatile("v_cvt_pk_bf16_f32 %0, %1, %2" : "=v"(r) : "v"(lo), "v"(hi)); return r; }
typedef float f32x2 __attribute__((ext_vector_type(2)));
__device__ __forceinline__ f32x2 gelu_pk(f32x2 v) {
    const f32x2 av = __builtin_elementwise_abs(v), d = av * 0.2316418882f + 1.0f;
    f32x2 t; t.x = __builtin_amdgcn_rcpf(d.x); t.y = __builtin_amdgcn_rcpf(d.y);
    f32x2 q = t * 0.5307027145f + (-0.7265760135f); q = q * t + 0.7107068705f; q = q * t + (-0.142248368f); q = q * t + 0.127414796f; q = q * t;
    const f32x2 s = (v * v) * (-0.72134752044f);
    f32x2 e; e.x = __builtin_amdgcn_exp2f(s.x); e.y = __builtin_amdgcn_exp2f(s.y);
    const f32x2 m = v * (q * e), r = v - m;
    f32x2 o; o.x = v.x < 0.f ? m.x : r.x; o.y = v.y < 0.f ? m.y : r.y; return o;
}

template <class Epi, class Sched, bool STAMP = false>
__device__ __forceinline__ void gemm_phase(PG8_LAS unsigned char* lds, const Gemm g, const Sched& S, const Epi& E, unsigned long long* stamps, int wid_s) {
    const int tid = mk_tid(wid_s), wid = __builtin_amdgcn_readfirstlane(tid >> 6), lane = tid & 63, wr = wid >> 2, wc = wid & 3, fr = lane & 15, fq = lane >> 4;
    const int K = g.K, nt = K / BK;
    int ts_lo = 0, ts_hi = 0, nts = 0; const unsigned long long rt_entry = STAMP ? (unsigned long long)wall_clock64() : 0ull;
#define PG8_STAMP() do { if (STAMP && wid == 0 && nts < 64) { const unsigned long long _c = (unsigned long long)clock64(); \
        ts_lo = (lane == nts) ? (int)(unsigned)_c : ts_lo; ts_hi = (lane == nts) ? (int)(unsigned)(_c >> 32) : ts_hi; ++nts; } } while (0)
    PG8_STAMP();
    unsigned voffA[2], voffB[2];
#pragma unroll
    for (int i = 0; i < 2; ++i) { int R, C; stage_rc(tid * 16 + i * 8192, R, C); const int Rb = Epi::PERM ? ((R & ~31) + perm32(R & 31)) : R;
        voffA[i] = (unsigned)(R * K + C) * 2u; voffB[i] = (unsigned)(Rb * K + C) * 2u; }
    const size_t kstep = (size_t)(BK * 2);
    const size_t hstep = (size_t)HALF * K * 2;
    const size_t tstep = 2 * hstep;
    const unsigned ldsw = (unsigned)wid * 1024u;
    const int aoff = lds_byte(wr * 64 + fr, fq * 8), boff = lds_byte(wc * 32 + fr, fq * 8);
#define PG8_SA(b, h) (((b) * 2 + (h)) * HTB)
#define PG8_SB(b, h) ((4 + (b) * 2 + (h)) * HTB)
#define PG8_STAGE(bufoff, gbase, voff) do { _Pragma("unroll") for (int _i = 0; _i < 2; ++_i) \
        __builtin_amdgcn_global_load_lds((const unsigned*)((const char*)(gbase) + (voff)[_i]), (PG8_LAS unsigned*)(lds + (bufoff) + ldsw + _i * 8192), 16, 0, 0); } while (0)
#define PG8_LDA(dst, b, h) do { _Pragma("unroll") for (int m = 0; m < 4; ++m) _Pragma("unroll") for (int k = 0; k < 2; ++k) dst[m][k] = *(const PG8_LAS bf16x8*)(lds + PG8_SA(b, h) + aoff + m * 2048 + k * 1024); } while (0)
#define PG8_LDB(dst, b, h) do { _Pragma("unroll") for (int n = 0; n < 2; ++n) _Pragma("unroll") for (int k = 0; k < 2; ++k) dst[n][k] = *(const PG8_LAS bf16x8*)(lds + PG8_SB(b, h) + boff + n * 2048 + k * 1024); } while (0)
#define PG8_MMA(ai, bj, At, Bt) do { __builtin_amdgcn_s_setprio(1); _Pragma("unroll") for (int m = 0; m < 4; ++m) _Pragma("unroll") for (int n = 0; n < 2; ++n) _Pragma("unroll") for (int k = 0; k < 2; ++k) \
        acc[ai][bj][m][n] = __builtin_amdgcn_mfma_f32_16x16x32_bf16(Bt[n][k], At[m][k], acc[ai][bj][m][n], 0, 0, 0); __builtin_amdgcn_s_setprio(0); } while (0)
#define PG8_WAIT_V(n) asm volatile("s_waitcnt vmcnt(" #n ")" ::: "memory")
#define PG8_WAIT_L(n) asm volatile("s_waitcnt lgkmcnt(" #n ")" ::: "memory")
#define PG8_BAR __builtin_amdgcn_s_barrier()
#define PG8_SCHED __builtin_amdgcn_sched_barrier(0)
    Unit cur, nxt; int ui = 0;
    if (!S.next(0, cur)) return;
    f32x4 acc[2][2][4][2];
#pragma unroll
    for (int a = 0; a < 2; ++a)
#pragma unroll
        for (int b = 0; b < 2; ++b)
#pragma unroll
            for (int m = 0; m < 4; ++m)
#pragma unroll
                for (int n = 0; n < 2; ++n) acc[a][b][m][n] = (f32x4){0.f, 0.f, 0.f, 0.f};
    bf16x8 At[4][2], B0[2][2], B1[2][2];
    const char* cA = (const char*)g.A + (size_t)cur.pm * tstep; const char* cB = (const char*)g.Bt + (size_t)cur.pn * tstep;
    S.a_ready(cur);
    PG8_STAGE(PG8_SB(0, 0), cB, voffB); PG8_STAGE(PG8_SA(0, 0), cA, voffA); PG8_STAGE(PG8_SB(0, 1), cB + hstep, voffB); PG8_STAGE(PG8_SA(0, 1), cA + hstep, voffA);
    if (wr == 1) PG8_BAR;
    PG8_WAIT_V(4); PG8_BAR;
    PG8_STAGE(PG8_SB(1, 0), cB + kstep, voffB); PG8_STAGE(PG8_SA(1, 0), cA + kstep, voffA); PG8_STAGE(PG8_SB(1, 1), cB + hstep + kstep, voffB);
    PG8_WAIT_V(6); PG8_BAR;
    PG8_STAMP();
    for (;;) {
        const bool has_next = S.next(ui + 1, nxt);
        const char* nA = has_next ? (const char*)g.A + (size_t)nxt.pm * tstep : cA; const char* nB = has_next ? (const char*)g.Bt + (size_t)nxt.pn * tstep : cB;
        for (int t = 0; t < nt; t += 2) {
            const bool last = (t == nt - 2);
            const char* a1 = cA + (size_t)(t + 1) * kstep;
            const char* a2 = last ? nA : cA + (size_t)(t + 2) * kstep; const char* b2 = last ? nB : cB + (size_t)(t + 2) * kstep;
            const char* a3 = a2 + kstep; const char* b3 = b2 + kstep;
            if (last && has_next) S.a_ready(nxt);
            PG8_LDB(B0, 0, 0); PG8_SCHED; PG8_LDA(At, 0, 0); PG8_STAGE(PG8_SA(1, 1), a1 + hstep, voffA);
            PG8_WAIT_L(8); PG8_BAR; PG8_WAIT_L(0); PG8_MMA(0, 0, At, B0); PG8_BAR; PG8_SCHED;
            PG8_LDB(B1, 0, 1); PG8_STAGE(PG8_SB(0, 0), b2, voffB);
            PG8_BAR; PG8_WAIT_L(0); PG8_MMA(0, 1, At, B1); PG8_BAR;
            PG8_LDA(At, 0, 1); PG8_STAGE(PG8_SA(0, 0), a2, voffA);
            PG8_BAR; PG8_WAIT_L(0); PG8_MMA(1, 0, At, B0); PG8_BAR; PG8_SCHED;
            PG8_STAGE(PG8_SB(0, 1), b2 + hstep, voffB);
            PG8_WAIT_V(6); PG8_BAR; PG8_MMA(1, 1, At, B1); PG8_BAR;
            PG8_LDB(B0, 1, 0); PG8_SCHED; PG8_LDA(At, 1, 0); PG8_STAGE(PG8_SA(0, 1), a2 + hstep, voffA);
            PG8_WAIT_L(8); PG8_BAR; PG8_WAIT_L(0); PG8_MMA(0, 0, At, B0); PG8_BAR; PG8_SCHED;
            PG8_LDB(B1, 1, 1); PG8_STAGE(PG8_SB(1, 0), b3, voffB);
            PG8_BAR; PG8_WAIT_L(0); PG8_MMA(0, 1, At, B1); PG8_BAR;
            PG8_LDA(At, 1, 1); PG8_STAGE(PG8_SA(1, 0), a3, voffA);
            PG8_BAR; PG8_WAIT_L(0); PG8_MMA(1, 0, At, B0); PG8_BAR; PG8_SCHED;
            PG8_STAGE(PG8_SB(1, 1), b3 + hstep, voffB);
            PG8_WAIT_V(6); PG8_BAR; PG8_MMA(1, 1, At, B1); PG8_BAR;
        }
        PG8_STAMP();
        if constexpr (!Epi::AFTER_DRAIN) { E(acc, cur, wr, wc, fr, fq); S.done(cur); }
        PG8_STAMP();
        if (!has_next) break;
#pragma unroll
        for (int a = 0; a < 2; ++a)
#pragma unroll
            for (int b = 0; b < 2; ++b)
#pragma unroll
                for (int m = 0; m < 4; ++m)
#pragma unroll
                    for (int n = 0; n < 2; ++n) acc[a][b][m][n] = (f32x4){0.f, 0.f, 0.f, 0.f};
        cur = nxt; cA = nA; cB = nB; ++ui;
    }
    PG8_WAIT_V(0);
    if (wr == 0) PG8_BAR;
    PG8_BAR;
    if constexpr (Epi::AFTER_DRAIN) { E.fused(acc, cur, wr, wc, fr, fq, lds, wid, lane); S.done(cur); }
    PG8_STAMP();
    if (STAMP && wid == 0) { stamps[lane] = lane < nts ? (((unsigned long long)(unsigned)ts_hi << 32) | (unsigned)ts_lo) : 0ull;
        if (lane == 62) stamps[62] = rt_entry; if (lane == 63) stamps[63] = (unsigned long long)wall_clock64(); }
#undef PG8_STAMP
#undef PG8_SA
#undef PG8_SB
#undef PG8_STAGE
#undef PG8_LDA
#undef PG8_LDB
#undef PG8_MMA
#undef PG8_WAIT_V
#undef PG8_WAIT_L
#undef PG8_BAR
#undef PG8_SCHED
}
}
__device__ __forceinline__ int w1_src(int n, float& mul) {
  mul = 1.f;
  if (n < 1024) { const int r = n - 512, h = r >> 6, d = r & 63;
    if (d < 16) { const int i = d >> 1, e = d & 1; return 672 + h * 64 + (e ? 8 + i : i); }
    return 672 + h * 64 + d; }
  if (n < 1536) return 1256 + (n - 1024);
  if (n < 2048) return 1768 + (n - 1536);
  if (n < 2176) { const int r = n - 2048, h = r >> 5, j = r & 31, i = j >> 1, e = j & 1; mul = PRESCALE; return h * 128 + (e ? 16 + i : i); }
  if (n < 2304) return 512 + (n - 2176);
  if (n < 2336) { const int j = n - 2304, i = j >> 1, e = j & 1; return 640 + (e ? 16 + i : i); }
  if (n < 2400) { const int d = n - 2336;
    if (d < 16) { const int i = d >> 1, e = d & 1; return 1184 + (e ? 8 + i : i); }
    return 1184 + d; }
  if (n < 2408) { mul = IDXSCALE; return 1248 + (n - 2400); }
  return -1;
}

template <int MODE>
__device__ __forceinline__ void tr_tile(LAS float* tl, const float* __restrict__ src, int ld_src, u16* __restrict__ dst, int ld_dst,
                                        int n0, int k0, int dk0, const float* __restrict__ kscale, int tid) {
  {
    const int nl = tid & 63, kq = tid >> 6;
    float mul = 1.f; int c = n0 + nl;
    if (MODE == 1) c = w1_src(n0 + nl, mul);
#pragma unroll
    for (int i = 0; i < 8; ++i) {
      const int k = k0 + kq * 8 + i;
      float v = 0.f;
      if (c >= 0) { v = src[(size_t)k * ld_src + c] * mul; if (kscale) v *= kscale[k]; }
      tl[(kq * 8 + i) * 65 + nl] = v;
    }
  }
  __syncthreads();
  {
    const int kc = tid & 7, nl = tid >> 3;
    float v[8];
#pragma unroll
    for (int j = 0; j < 8; ++j) v[j] = tl[(kc * 8 + j) * 65 + nl];
    *(uint4*)(dst + (size_t)(n0 + nl) * ld_dst + dk0 + kc * 8) = make_uint4(pack_bf2(v[0], v[1]), pack_bf2(v[2], v[3]), pack_bf2(v[4], v[5]), pack_bf2(v[6], v[7]));
  }
  __syncthreads();
}

__device__ __forceinline__ int q4fp8(float a, float b, float c, float d) {
  int w = __builtin_amdgcn_cvt_pk_fp8_f32(a, b, 0, false);
  return __builtin_amdgcn_cvt_pk_fp8_f32(c, d, w, true);
}

__device__ __forceinline__ void peer_row_fp8(const P& p, int row, int lane) {
  const int e = row & 16383; const bool isv = row >= 16384;
  const float4* src = (const float4*)((isv ? p.v_tab : p.u_tab) + (size_t)e * DM);
  float4 v[4];
  float amax = 0.f;
#pragma unroll
  for (int i = 0; i < 4; ++i) { v[i] = src[lane + 64 * i];
    amax = fmaxf(amax, fmaxf(fmaxf(fabsf(v[i].x), fabsf(v[i].y)), fmaxf(fabsf(v[i].z), fabsf(v[i].w)))); }
  amax = wave_max(amax);
  int ex = 0; const float m = frexpf(amax, &ex);
  const int k = (amax > 0.f) ? ((m > 0.75f) ? (2 - ex) : (3 - ex)) : 0;
  const float sc = ldexpf(1.f, k);
  unsigned w0 = 0u, w1 = 0u;
  w0 = __builtin_amdgcn_cvt_scalef32_pk_fp4_f32(w0, v[0].x * sc, v[0].y * sc, 1.0f, 0);
  w0 = __builtin_amdgcn_cvt_scalef32_pk_fp4_f32(w0, v[0].z * sc, v[0].w * sc, 1.0f, 1);
  w0 = __builtin_amdgcn_cvt_scalef32_pk_fp4_f32(w0, v[1].x * sc, v[1].y * sc, 1.0f, 2);
  w0 = __builtin_amdgcn_cvt_scalef32_pk_fp4_f32(w0, v[1].z * sc, v[1].w * sc, 1.0f, 3);
  w1 = __builtin_amdgcn_cvt_scalef32_pk_fp4_f32(w1, v[2].x * sc, v[2].y * sc, 1.0f, 0);
  w1 = __builtin_amdgcn_cvt_scalef32_pk_fp4_f32(w1, v[2].z * sc, v[2].w * sc, 1.0f, 1);
  w1 = __builtin_amdgcn_cvt_scalef32_pk_fp4_f32(w1, v[3].x * sc, v[3].y * sc, 1.0f, 2);
  w1 = __builtin_amdgcn_cvt_scalef32_pk_fp4_f32(w1, v[3].z * sc, v[3].w * sc, 1.0f, 3);
  *(uint2*)((isv ? p.V8 : p.U8) + (size_t)e * 512 + 8 * lane) = make_uint2(w0, w1);
  if (lane == 0) (isv ? p.sv : p.su)[e] = ldexpf(1.f, -k);
}

__device__ void phase0_prep(const P& p, LAS unsigned char* lds, int wid_s) {
  const int tid = mk_tid(wid_s), lane = tid & 63, wid = tid >> 6;
  const int gw = blockIdx.x * 8 + wid, nw = gridDim.x * 8;
  const int gt = blockIdx.x * 512 + tid, nt = gridDim.x * 512;
  LAS float* tl = (LAS float*)lds;
  for (int i = gt; i < T_TOK; i += nt) { p.ss_ffn[i] = 0.f; p.ss_fin[i] = 0.f; }
  if (gt < 192) p.ctr[gt] = 0u;
  for (int tile = blockIdx.x; tile < 1600; tile += gridDim.x) {
    if (tile < 512) { const int nt_ = tile >> 4, kt = tile & 15;
      tr_tile<1>(tl, p.w_in, INTOT, p.W1t, 1024, 512 + nt_ * 64, kt * 64, kt * 64, p.g_mix, tid);
    } else if (tile < 1024) { const int t2 = tile - 512, nt_ = t2 >> 4, kt = t2 & 15;
      tr_tile<0>(tl, p.w_pq, 2048, p.WpqT, 1024, nt_ * 64, kt * 64, kt * 64, p.g_ffn, tid);
    } else if (tile < 1280) { const int t2 = tile - 1024, nt_ = t2 >> 4, kt = t2 & 15;
      tr_tile<0>(tl, p.w_gate, 1024, p.WgT, 1024, nt_ * 64, kt * 64, kt * 64, nullptr, tid);
    } else if (tile < 1344) { const int t2 = tile - 1280, nt_ = t2 >> 2, kt = t2 & 3;
      tr_tile<0>(tl, p.w_ple, 1024, p.WpleT, 256, nt_ * 64, kt * 64, kt * 64, nullptr, tid);
    } else if (tile < 1472) { const int t2 = tile - 1344, nt_ = t2 >> 3, kt = t2 & 7;
      tr_tile<0>(tl, p.w_out, 1024, p.WoutT, 1024, nt_ * 64, 512 + kt * 64, 512 + kt * 64, nullptr, tid);
    } else if (tile < 1536) {
      const int t2 = tile - 1472, h = t2 >> 4, k0 = (t2 & 15) * 64;
      LAS float* sA = tl;
      LAS float* sB = tl + 64 * 97;
      for (int i = tid; i < 64 * 96; i += 512) { const int kk = i / 96, j = i % 96; sA[kk * 97 + j] = p.w_in[(size_t)(k0 + kk) * INTOT + h * 128 + 32 + j]; }
      for (int i = tid; i < 128 * 96; i += 512) { const int c = i / 96, j = i % 96; sB[j * 129 + c] = p.w_uk[(size_t)(h * 128 + c) * 96 + j]; }
      __syncthreads();
      const int c = tid & 127, kq = tid >> 7;
      float acc[16];
#pragma unroll
      for (int i = 0; i < 16; ++i) acc[i] = 0.f;
      for (int j = 0; j < 96; ++j) { const float b = sB[j * 129 + c];
#pragma unroll
        for (int i = 0; i < 16; ++i) acc[i] += sA[(kq * 16 + i) * 97 + j] * b; }
      unsigned o[8];
#pragma unroll
      for (int i = 0; i < 8; ++i) { const int k = k0 + kq * 16 + 2 * i; o[i] = pack_bf2(acc[2 * i] * PRESCALE * p.g_mix[k], acc[2 * i + 1] * PRESCALE * p.g_mix[k + 1]); }
      uint4* d = (uint4*)(p.W1t + (size_t)(h * 128 + c) * 1024 + k0 + kq * 16);
      d[0] = make_uint4(o[0], o[1], o[2], o[3]); d[1] = make_uint4(o[4], o[5], o[6], o[7]);
      __syncthreads();
    } else {
      const int t2 = tile - 1536, h = t2 >> 4, n0 = (t2 & 15) * 64;
      LAS float* sA = tl;
      LAS float* sB = tl + 128 * 65;
      for (int i = tid; i < 128 * 64; i += 512) { const int d = i >> 6, nl = i & 63; sA[d * 65 + nl] = p.w_out[(size_t)(h * 128 + d) * 1024 + n0 + nl]; }
      for (int i = tid; i < 128 * 128; i += 512) { const int c = i >> 7, d = i & 127; sB[d * 129 + c] = p.w_uv[(size_t)(h * 128 + c) * 128 + d]; }
      __syncthreads();
      const int c = tid & 127, nq = tid >> 7;
      float acc[16];
#pragma unroll
      for (int i = 0; i < 16; ++i) acc[i] = 0.f;
      for (int d = 0; d < 128; ++d) { const float b = sB[d * 129 + c];
#pragma unroll
        for (int i = 0; i < 16; ++i) acc[i] += sA[d * 65 + nq * 16 + i] * b; }
#pragma unroll
      for (int i = 0; i < 16; ++i) p.WoutT[(size_t)(n0 + nq * 16 + i) * 1024 + h * 128 + c] = f2bf(acc[i]);
      __syncthreads();
    }
  }
  for (int idx = gt; idx < 8 * 128 * 128; idx += nt) { p.K1b[idx] = f2bf(p.k1[idx]); p.K2b[idx] = f2bf(p.k2[idx]); }
  for (int idx = gt; idx < 8 * 64 * 64; idx += nt) {
    const int n = idx >> 12, o = (idx >> 6) & 63, i = idx & 63;
    p.WrgT[idx] = f2bf(p.w_rg[(size_t)n * 4096 + i * 64 + o]);
    p.WigT[idx] = f2bf(p.w_ig[(size_t)n * 4096 + i * 64 + o]);
  }
  for (int row = gw; row < T_TOK; row += nw) {
    const float4* xr = (const float4*)(p.x + (size_t)row * DM);
    uint2* xo = (uint2*)(p.xb16 + (size_t)row * DM);
    float ss = 0.f;
#pragma unroll
    for (int i = 0; i < 4; ++i) {
      const float4 v = xr[lane + 64 * i];
      ss += v.x * v.x + v.y * v.y + v.z * v.z + v.w * v.w;
      uint2 o; o.x = pack_bf2(v.x, v.y); o.y = pack_bf2(v.z, v.w);
      xo[lane + 64 * i] = o;
    }
    ss = wave_sum(ss);
    if (lane == 0) p.rstd_mix[row] = rsqrtf(ss * (1.f / DM) + 1e-6f);
    const float pos = (float)p.pos[row];
    if (lane < 16) {
      const float inv = powf(500000.f, -(float)(2 * lane) / 32.f);
      const float ang = pos * inv;
      p.ropeA[(size_t)row * 32 + lane] = cosf(ang);
      p.ropeA[(size_t)row * 32 + 16 + lane] = sinf(ang);
    } else if (lane < 24) {
      const int i = lane - 16;
      const float inv = powf(500000.f, -(float)(2 * i) / 16.f);
      const float ang = pos * inv;
      p.ropeI[(size_t)row * 16 + i] = cosf(ang);
      p.ropeI[(size_t)row * 16 + 8 + i] = sinf(ang);
    }
  }
  for (int i = gt; i < T_TOK * 256 / 4; i += nt) {
    const float4 v = ((const float4*)p.p)[i];
    uint2 o; o.x = pack_bf2(v.x, v.y); o.y = pack_bf2(v.z, v.w);
    ((uint2*)p.p16)[i] = o;
  }
  for (int row = gw; row < 16384; row += nw) peer_row_fp8(p, 16384 + row, lane);
}
__device__ __forceinline__ pg8::f32x4 rope4(pg8::f32x4 a, const float* cs, const float* sn) {
  const float c0 = cs[0], s0 = sn[0], c1 = cs[1], s1 = sn[1];
  pg8::f32x4 o;
  o[0] = a[0] * c0 - a[1] * s0; o[1] = a[1] * c0 + a[0] * s0; o[2] = a[2] * c1 - a[3] * s1; o[3] = a[3] * c1 + a[2] * s1;
  return o;
}
struct Epi1 {
  static constexpr bool PERM = false, AFTER_DRAIN = false;
  P p; LAS float* xch;
  __device__ __forceinline__ void operator()(const pg8::f32x4 (&acc)[2][2][4][2], const pg8::Unit& u, int wr, int wc, int fr_in, int fq_in) const {
    int fr = fr_in, fq = fq_in; asm volatile("" : "+v"(fr), "+v"(fq));
    const int pn = u.pn;
    const int rowb = u.pm * 256 + wr * 64 + fr;
    const int colb = wc * 32 + 4 * fq;
    float rs[2][4];
#pragma unroll
    for (int ai = 0; ai < 2; ++ai)
#pragma unroll
      for (int m = 0; m < 4; ++m) rs[ai][m] = p.rstd_mix[rowb + ai * 128 + m * 16];
    if (pn < 2) {
#pragma unroll
      for (int ai = 0; ai < 2; ++ai)
#pragma unroll
        for (int m = 0; m < 4; ++m) { const int row = rowb + ai * 128 + m * 16;
#pragma unroll
          for (int bj = 0; bj < 2; ++bj)
#pragma unroll
            for (int n = 0; n < 2; ++n) { const int col = pn * 256 + bj * 128 + colb + 16 * n; const int h = col >> 7, c = col & 127;
              const pg8::f32x4 v = acc[ai][bj][m][n] * rs[ai][m];
              uint2 o; o.x = pack_bf2(v[0], v[1]); o.y = pack_bf2(v[2], v[3]);
              *(uint2*)(p.qcat + ((size_t)row * 4 + h) * 160 + c) = o; } }
    } else if (pn < 4) {
#pragma unroll
      for (int ai = 0; ai < 2; ++ai)
#pragma unroll
        for (int m = 0; m < 4; ++m) { const int row = rowb + ai * 128 + m * 16;
#pragma unroll
          for (int bj = 0; bj < 2; ++bj)
#pragma unroll
            for (int n = 0; n < 2; ++n) { const int col = (pn - 2) * 256 + bj * 128 + colb + 16 * n; const int d = col & 63;
              pg8::f32x4 v = acc[ai][bj][m][n] * rs[ai][m];
              if (d < 16) { const float* cs = p.ropeI + (size_t)row * 16 + (d >> 1); v = rope4(v, cs, cs + 8); }
              uint2 o; o.x = pack_h2(v[0], v[1]); o.y = pack_h2(v[2], v[3]);
              *(uint2*)(p.iqh + (size_t)row * 512 + col) = o; } }
    } else if (pn < 8) {
      u16* dst = (pn < 6) ? p.xbr : p.gate;
      const int cb = (pn & 1) * 256;
#pragma unroll
      for (int ai = 0; ai < 2; ++ai)
#pragma unroll
        for (int m = 0; m < 4; ++m) { const int row = rowb + ai * 128 + m * 16;
#pragma unroll
          for (int bj = 0; bj < 2; ++bj)
#pragma unroll
            for (int n = 0; n < 2; ++n) { const int col = cb + bj * 128 + colb + 16 * n;
              const pg8::f32x4 v = acc[ai][bj][m][n] * rs[ai][m];
              uint2 o; o.x = pack_bf2(v[0], v[1]); o.y = pack_bf2(v[2], v[3]);
              *(uint2*)(dst + (size_t)row * 512 + col) = o; } }
    } else if (pn == 8) {
      float ps[2][4];
#pragma unroll
      for (int ai = 0; ai < 2; ++ai)
#pragma unroll
        for (int m = 0; m < 4; ++m) { const int row = rowb + ai * 128 + m * 16;
#pragma unroll
          for (int n = 0; n < 2; ++n) { const int col = colb + 16 * n; const int h = col >> 5, j0 = col & 31;
            pg8::f32x4 v = acc[ai][0][m][n] * rs[ai][m];
            const float* cs = p.ropeA + (size_t)row * 32 + (j0 >> 1); v = rope4(v, cs, cs + 16);
            uint2 o; o.x = pack_bf2(v[0], v[1]); o.y = pack_bf2(v[2], v[3]);
            *(uint2*)(p.qcat + ((size_t)row * 4 + h) * 160 + 128 + j0) = o; }
          float s = 0.f;
#pragma unroll
          for (int n = 0; n < 2; ++n) { const pg8::f32x4 v = acc[ai][1][m][n] * rs[ai][m]; s += v[0] * v[0] + v[1] * v[1] + v[2] * v[2] + v[3] * v[3]; }
          s += __shfl_xor(s, 16, 64); s += __shfl_xor(s, 32, 64);
          ps[ai][m] = s;
          if (fq == 0) xch[(wr * 4 + wc) * 128 + ai * 64 + m * 16 + fr] = s; }
      asm volatile("s_waitcnt lgkmcnt(0)" ::: "memory");
      __builtin_amdgcn_s_barrier();
      asm volatile("" ::: "memory");
#pragma unroll
      for (int ai = 0; ai < 2; ++ai)
#pragma unroll
        for (int m = 0; m < 4; ++m) { const int row = rowb + ai * 128 + m * 16; const int rr = ai * 64 + m * 16 + fr;
          const float tot = xch[(wr * 4 + 0) * 128 + rr] + xch[(wr * 4 + 1) * 128 + rr] + xch[(wr * 4 + 2) * 128 + rr] + xch[(wr * 4 + 3) * 128 + rr];
          const float rk = rsqrtf(tot * (1.f / 128.f) + 1e-6f) * rs[ai][m];
#pragma unroll
          for (int n = 0; n < 2; ++n) { const int c = colb + 16 * n;
            const float4 g = *(const float4*)(p.g_kv + c);
            const pg8::f32x4 v = acc[ai][1][m][n] * rk;
            uint2 o; o.x = pack_bf2(v[0] * g.x, v[1] * g.y); o.y = pack_bf2(v[2] * g.z, v[3] * g.w);
            *(uint2*)(p.kv + (size_t)row * 160 + c) = o; } }
      (void)ps;
    } else {
#pragma unroll
      for (int ai = 0; ai < 2; ++ai)
#pragma unroll
        for (int m = 0; m < 4; ++m) { const int row = rowb + ai * 128 + m * 16;
#pragma unroll
          for (int n = 0; n < 2; ++n) { const int col = colb + 16 * n;
            pg8::f32x4 v = acc[ai][0][m][n] * rs[ai][m];
            if (col < 32) {
              const float* cs = p.ropeA + (size_t)row * 32 + (col >> 1); v = rope4(v, cs, cs + 16);
              uint2 o; o.x = pack_bf2(v[0], v[1]); o.y = pack_bf2(v[2], v[3]);
              *(uint2*)(p.kv + (size_t)row * 160 + 128 + col) = o;
            } else if (col < 96) { const int d = col - 32;
              if (d < 16) { const float* cs = p.ropeI + (size_t)row * 16 + (d >> 1); v = rope4(v, cs, cs + 8); }
              uint2 o; o.x = pack_h2(v[0], v[1]); o.y = pack_h2(v[2], v[3]);
              *(uint2*)(p.ikh + (size_t)row * 64 + d) = o;
            } else if (col < 104) {
              *(float4*)(p.iw + (size_t)row * 8 + (col - 96)) = make_float4(v[0], v[1], v[2], v[3]);
            } } }
    }
  }
};

__device__ void phase1_gemm1(const P& p, LAS unsigned char* lds, int wid_s) {
  pg8::Gemm g; g.A = p.xb16; g.Bt = p.W1t; g.M = T_TOK; g.N = N1; g.K = p.k1024;
  pg8::StaticOrder S; S.init(T_TOK, N1, gridDim.x, blockIdx.x);
  Epi1 E; E.p = p; E.xch = (LAS float*)(lds + pg8::STAGE_BYTES);
  pg8::gemm_phase<Epi1, pg8::StaticOrder>(lds, g, S, E, nullptr, wid_s);
  const int nidle = 3 * (int)gridDim.x - 640;
  if (nidle > 0 && (int)blockIdx.x >= (int)gridDim.x - nidle) {
    const int tid = mk_tid(wid_s), lane = tid & 63;
    const int iw = ((int)blockIdx.x - ((int)gridDim.x - nidle)) * 8 + wid_s, niw = nidle * 8;
    for (int row = iw; row < 16384; row += niw) peer_row_fp8(p, row, lane);
  } else if (nidle <= 0) {
    const int tid = mk_tid(wid_s), lane = tid & 63;
    for (int row = blockIdx.x * 8 + wid_s; row < 16384; row += gridDim.x * 8) peer_row_fp8(p, row, lane);
  }
}
#define SC_STRIDE 2052
#define L_MASK 131328
#define L_HIST 139520
#define L_CAND 147712
#define L_MISC 156160
#define L_MM 156416
#define KV_STRIDE 336
#define KV_TILE_BYTES (64 * KV_STRIDE)

__device__ __forceinline__ float sort2f_(unsigned u) { const unsigned b = (u & 0x80000000u) ? (u & 0x7FFFFFFFu) : ~u; return __uint_as_float(b); }
__device__ __forceinline__ unsigned f2sort(float f) { const unsigned u = __float_as_uint(f); return (u & 0x80000000u) ? ~u : (u | 0x80000000u); }

__device__ __forceinline__ void index_scores(const P& p, LAS unsigned char* lds, int b, int tq0, int nkt, int wid, int lane) {
  const int fr = lane & 15, g = lane >> 4;
  const size_t qtok = (size_t)b * SEQ + tq0 + fr;
  f16x8 Bq[8][2];
  float w[8];
#pragma unroll
  for (int h = 0; h < 8; ++h) {
#pragma unroll
    for (int ks = 0; ks < 2; ++ks) Bq[h][ks] = *(const f16x8*)(p.iqh + qtok * 512 + h * 64 + ks * 32 + g * 8);
    w[h] = p.iw[qtok * 8 + h];
  }
  LAS float* sc = (LAS float*)lds;
  float rmax = -INFINITY, rmin = INFINITY;
  const int tqme = tq0 + fr;
  for (int kt = wid; kt < nkt; kt += 8) {
    const size_t ktok = (size_t)b * SEQ + kt * 16 + fr;
    const f16x8 A0 = *(const f16x8*)(p.ikh + ktok * 64 + g * 8);
    const f16x8 A1 = *(const f16x8*)(p.ikh + ktok * 64 + 32 + g * 8);
    fx4 tot = {0.f, 0.f, 0.f, 0.f};
#pragma unroll
    for (int h = 0; h < 8; ++h) {
      fx4 d = {0.f, 0.f, 0.f, 0.f};
      d = __builtin_amdgcn_mfma_f32_16x16x32_f16(A0, Bq[h][0], d, 0, 0, 0);
      d = __builtin_amdgcn_mfma_f32_16x16x32_f16(A1, Bq[h][1], d, 0, 0, 0);
#pragma unroll
      for (int r = 0; r < 4; ++r) tot[r] += w[h] * fmaxf(d[r], 0.f);
    }
    LDS_ST_FX4(sc + fr * SC_STRIDE + kt * 16 + 4 * g, tot);
#pragma unroll
    for (int r = 0; r < 4; ++r) { const bool ok = (kt * 16 + 4 * g + r) <= tqme; rmax = fmaxf(rmax, ok ? tot[r] : -INFINITY); rmin = fminf(rmin, ok ? tot[r] : INFINITY); }
  }
  rmax = fmaxf(rmax, __shfl_xor(rmax, 16, 64)); rmax = fmaxf(rmax, __shfl_xor(rmax, 32, 64));
  rmin = fminf(rmin, __shfl_xor(rmin, 16, 64)); rmin = fminf(rmin, __shfl_xor(rmin, 32, 64));
  if (g == 0) {
    LAS unsigned* mm = (LAS unsigned*)(lds + L_MM);
    if (rmax != -INFINITY) __hip_atomic_fetch_max(mm + 2 * fr, f2sort(rmax), __ATOMIC_RELAXED, __HIP_MEMORY_SCOPE_WORKGROUP);
    if (rmin != INFINITY) __hip_atomic_fetch_min(mm + 2 * fr + 1, f2sort(rmin), __ATOMIC_RELAXED, __HIP_MEMORY_SCOPE_WORKGROUP);
  }
}

#define DPP_F(x, ctrl) __uint_as_float((unsigned)__builtin_amdgcn_update_dpp(0, (int)__float_as_uint(x), (ctrl), 0xF, 0xF, true))
#define DPP_I(x, ctrl) ((unsigned)__builtin_amdgcn_update_dpp(0, (int)(x), (ctrl), 0xF, 0xF, true))
__device__ __forceinline__ float wave_max_dpp(float x) {
  x = fmaxf(x, DPP_F(x, 0xB1)); x = fmaxf(x, DPP_F(x, 0x4E)); x = fmaxf(x, DPP_F(x, 0x141)); x = fmaxf(x, DPP_F(x, 0x140));
  const int xi = (int)__float_as_uint(x);
  const float a = __uint_as_float((unsigned)__builtin_amdgcn_readlane(xi, 0)), b = __uint_as_float((unsigned)__builtin_amdgcn_readlane(xi, 16));
  const float c = __uint_as_float((unsigned)__builtin_amdgcn_readlane(xi, 32)), d = __uint_as_float((unsigned)__builtin_amdgcn_readlane(xi, 48));
  return fmaxf(fmaxf(a, b), fmaxf(c, d));
}
__device__ __forceinline__ unsigned row16_sum_u32(unsigned x) { x += DPP_I(x, 0xB1); x += DPP_I(x, 0x4E); x += DPP_I(x, 0x141); x += DPP_I(x, 0x140); return x; }

__device__ __forceinline__ void select_row(LAS float* row, int tq, LAS unsigned* mrow, LAS unsigned* hist, LAS unsigned* cand, int lane, int sflags, LAS unsigned* mmq) {
  const int n = tq + 1;
  unsigned long long mybal = 0ull;
  if (n <= 256) {
#pragma unroll 4
    for (int j = 0; j < 32; ++j) {
      const unsigned long long bl = __ballot((j * 64 + lane) <= tq);
      if (lane == j) mybal = bl;
    }
  } else {
    const float vmax = sort2f_(mmq[0]), vmin = sort2f_(mmq[1]);
    const int njb = ((tq >> 6) + 16) & ~15;
    const float scale = (vmax > vmin) ? 255.5f / (vmax - vmin) : 0.f;
#pragma unroll
    for (int i = 0; i < 4; ++i) hist[lane * 4 + i] = 0u;
    if (lane == 0) cand[256] = 0u;
#pragma unroll 1
    for (int jb = 0; jb < njb; jb += 16) {
      float v[16];
#pragma unroll
      for (int j = 0; j < 16; ++j) v[j] = row[(jb + j) * 64 + lane];
#pragma unroll
      for (int j = 0; j < 16; ++j) {
        const bool ok = ((jb + j) * 64 + lane) <= tq;
        const int bk = ok ? min(255, (int)((v[j] - vmin) * scale)) : lane;
        __hip_atomic_fetch_add((LAS unsigned*)&hist[bk], ok ? 1u : 0u, __ATOMIC_RELAXED, __HIP_MEMORY_SCOPE_WAVEFRONT);
      }
    }
    asm volatile("s_waitcnt lgkmcnt(0)" ::: "memory");
    const unsigned h40 = hist[255 - 4 * lane], h41 = hist[254 - 4 * lane], h42 = hist[253 - 4 * lane], h43 = hist[252 - 4 * lane];
    const unsigned mine = h40 + h41 + h42 + h43;
    const unsigned rsum = row16_sum_u32(mine);
    int Bsel = 0; unsigned above = 0u;
    {
      unsigned run = 0u; int R = 0;
#pragma unroll
      for (int r = 0; r < 4; ++r) { const unsigned s = (unsigned)__builtin_amdgcn_readlane((int)rsum, r * 16); if (run + s < 256u && R == r) { run += s; R = r + 1; } }
      if (R > 3) R = 3;
      int L = R * 16;
#pragma unroll 1
      for (int i = 0; i < 16; ++i) { const unsigned s = (unsigned)__builtin_amdgcn_readlane((int)mine, L); if (run + s >= 256u) break; run += s; ++L; }
      if (L > R * 16 + 15) L = R * 16 + 15;
      const unsigned b0 = (unsigned)__builtin_amdgcn_readlane((int)h40, L), b1 = (unsigned)__builtin_amdgcn_readlane((int)h41, L), b2 = (unsigned)__builtin_amdgcn_readlane((int)h42, L);
      if (run + b0 >= 256u) { Bsel = 255 - 4 * L; }
      else { run += b0;
        if (run + b1 >= 256u) { Bsel = 254 - 4 * L; }
        else { run += b1;
          if (run + b2 >= 256u) { Bsel = 253 - 4 * L; }
          else { run += b2; Bsel = 252 - 4 * L; } } }
      above = run;
    }
    const unsigned need = 256u - above;
    if (sflags & 4) { if (lane < 32) { mrow[2 * lane] = need + Bsel; mrow[2 * lane + 1] = 0u; } return; }
    unsigned cmask = 0u;
#pragma unroll 1
    for (int jb = 0; jb < njb; jb += 16) {
      float v[16];
#pragma unroll
      for (int j = 0; j < 16; ++j) v[j] = row[(jb + j) * 64 + lane];
#pragma unroll
      for (int j = 0; j < 16; ++j) {
        const bool is = (((jb + j) * 64 + lane) <= tq) && (min(255, (int)((v[j] - vmin) * scale)) == Bsel);
        cmask |= is ? (1u << (jb + j)) : 0u;
      }
    }
    while (cmask) {
      const int j = __ffs((int)cmask) - 1; cmask &= cmask - 1u;
      const int key = j * 64 + lane;
      const unsigned pos = __hip_atomic_fetch_add((LAS unsigned*)&cand[256], 1u, __ATOMIC_RELAXED, __HIP_MEMORY_SCOPE_WAVEFRONT);
      if (pos < 128u) { cand[2 * pos] = f2sort(row[key]); cand[2 * pos + 1] = (unsigned)key; }
    }
    asm volatile("s_waitcnt lgkmcnt(0)" ::: "memory");
    const unsigned cnt = (unsigned)__builtin_amdgcn_readfirstlane((int)cand[256]);
    if (sflags & 8) { if (lane < 32) { mrow[2 * lane] = cnt; mrow[2 * lane + 1] = 0u; } return; }
    unsigned ustar = 0u, kstar = 0u;
    if (cnt <= 64u) {
      const unsigned mu = (lane < (int)cnt) ? cand[2 * lane] : 0u, mk = (lane < (int)cnt) ? cand[2 * lane + 1] : 0xFFFFFFFFu;
      unsigned rank = 0;
      for (unsigned q = 0; q < cnt; ++q) {
        const unsigned qu = (unsigned)__builtin_amdgcn_readlane((int)mu, q), qk = (unsigned)__builtin_amdgcn_readlane((int)mk, q);
        rank += (qu > mu || (qu == mu && qk < mk)) ? 1u : 0u;
      }
      const unsigned long long fb = __ballot(lane < (int)cnt && rank == need - 1u);
      const int fl = __ffsll((long long)fb) - 1;
      ustar = (unsigned)__builtin_amdgcn_readlane((int)mu, fl); kstar = (unsigned)__builtin_amdgcn_readlane((int)mk, fl);
    } else if (cnt <= 128u) {
      unsigned fu = 0u, fk = 0u; int found = 0;
      for (unsigned base = 0; base < cnt; base += 64) {
        const unsigned i = base + lane;
        const unsigned mu = (i < cnt) ? cand[2 * i] : 0u, mk = (i < cnt) ? cand[2 * i + 1] : 0u;
        unsigned rank = 0;
#pragma unroll 4
        for (unsigned q = 0; q < cnt; ++q) { const unsigned qu = cand[2 * q], qk = cand[2 * q + 1]; rank += (qu > mu || (qu == mu && qk < mk)) ? 1u : 0u; }
        if (i < cnt && rank == need - 1u) { fu = mu; fk = mk; found = 1; }
      }
      const unsigned long long fb = __ballot(found);
      const int fl = __ffsll((long long)fb) - 1;
      ustar = (unsigned)__shfl((int)fu, fl, 64); kstar = (unsigned)__shfl((int)fk, fl, 64);
    } else {
      const int nj = (tq >> 6) + 1;
      unsigned prefix = 0u; unsigned needr = need;
      for (int bit = 31; bit >= 0; --bit) {
        const unsigned trial = prefix | (1u << bit);
        unsigned c = 0;
        for (int j = 0; j < nj; ++j) {
          const int key = j * 64 + lane;
          const float x = row[key];
          const bool inb = (key <= tq) && (min(255, (int)((x - vmin) * scale)) == Bsel);
          c += __popcll(__ballot(inb && (f2sort(x) >> bit) == (trial >> bit)));
        }
        if (c >= needr) prefix = trial; else needr -= c;
      }
      ustar = prefix;
      unsigned seen = 0; int done = 0;
      for (int j = 0; j < nj; ++j) {
        const int key = j * 64 + lane;
        const float x = row[key];
        const unsigned long long bl = __ballot((key <= tq) && f2sort(x) == ustar);
        const unsigned c = __popcll(bl);
        if (!done && seen + c >= needr) {
          unsigned long long m = bl; const unsigned k = needr - seen;
          int pos = 0;
          for (unsigned q = 0; q < k; ++q) { pos = __ffsll((long long)m) - 1; m &= m - 1ull; }
          kstar = (unsigned)(j * 64 + pos); done = 1;
        }
        seen += c;
      }
    }
#pragma unroll 1
    for (int jb = 0; jb < njb; jb += 16) {
      float v[16];
#pragma unroll
      for (int j = 0; j < 16; ++j) v[j] = row[(jb + j) * 64 + lane];
#pragma unroll
      for (int j = 0; j < 16; ++j) {
        const int key = (jb + j) * 64 + lane;
        const unsigned uu = f2sort(v[j]);
        const bool s = (key <= tq) && (uu > ustar || (uu == ustar && (unsigned)key <= kstar));
        const unsigned long long bl = __ballot(s);
        if (lane == jb + j) mybal = bl;
      }
    }
  }
  if (lane < 32) { mrow[2 * lane] = (unsigned)mybal; mrow[2 * lane + 1] = (unsigned)(mybal >> 32); }
}

__device__ __forceinline__ void attn_block(const P& p, LAS unsigned char* lds, int b, int t0, int wid, int lane, int tid) {
  const int fr = lane & 15, g = lane >> 4;
  const int h = wid >> 1, qs = wid & 1;
  const size_t qtok = (size_t)b * SEQ + t0 + qs * 16 + fr;
  s16x8 Qf[5];
#pragma unroll
  for (int ks = 0; ks < 5; ++ks) Qf[ks] = *(const s16x8*)(p.qcat + (qtok * 4 + h) * 160 + ks * 32 + g * 8);
  const int ntile = (t0 + 32 + 63) >> 6;
  const u16* kvb = p.kv + (size_t)b * SEQ * 160;
  LAS unsigned* mrow = (LAS unsigned*)(lds + L_MASK) + (qs * 16 + fr) * 64;
  fx4 O[8];
#pragma unroll
  for (int i = 0; i < 8; ++i) O[i] = (fx4){0.f, 0.f, 0.f, 0.f};
  float m_run = -INFINITY, l_run = 0.f;
  uint4 st0 = make_uint4(0, 0, 0, 0), st1 = st0, st2 = st0;
  const int c0i = tid, c1i = tid + 512, c2i = tid + 1024;
  const int lo0 = (c0i / 20) * KV_STRIDE + (c0i % 20) * 16, lo1 = (c1i / 20) * KV_STRIDE + (c1i % 20) * 16, lo2 = (c2i / 20) * KV_STRIDE + (c2i % 20) * 16;
#define G_LOAD(kt_) do { const uint4* src_ = (const uint4*)(kvb + (size_t)(kt_) * 64 * 160); st0 = src_[c0i]; st1 = src_[c1i]; if (c2i < 1280) st2 = src_[c2i]; } while (0)
#define L_STORE(buf_) do { LAS unsigned char* d_ = lds + (buf_) * KV_TILE_BYTES; LDS_STORE(uint4, d_ + lo0, st0); LDS_STORE(uint4, d_ + lo1, st1); if (c2i < 1280) LDS_STORE(uint4, d_ + lo2, st2); } while (0)
  G_LOAD(0); L_STORE(0);
  __syncthreads();
  for (int kt = 0; kt < ntile; ++kt) {
    const int buf = kt & 1;
    if (kt + 1 < ntile) G_LOAD(kt + 1);
    LAS unsigned char* kb = lds + buf * KV_TILE_BYTES;
#pragma unroll
    for (int ksub = 0; ksub < 2; ++ksub) {
      fx4 S[2];
#pragma unroll
      for (int sub = 0; sub < 2; ++sub) {
        fx4 a = {0.f, 0.f, 0.f, 0.f};
        const int krow = ksub * 32 + sub * 16 + fr;
#pragma unroll
        for (int ks = 0; ks < 5; ++ks) {
          const s16x8 Kf = *(LAS s16x8*)(kb + krow * KV_STRIDE + ks * 64 + g * 16);
          a = __builtin_amdgcn_mfma_f32_16x16x32_bf16(Kf, Qf[ks], a, 0, 0, 0);
        }
        S[sub] = a;
      }
      const unsigned mw = mrow[kt * 2 + ksub];
      float mx = -INFINITY;
#pragma unroll
      for (int sub = 0; sub < 2; ++sub)
#pragma unroll
        for (int r = 0; r < 4; ++r) { const int bit = sub * 16 + 4 * g + r; const float s = ((mw >> bit) & 1u) ? S[sub][r] : -INFINITY; S[sub][r] = s; mx = fmaxf(mx, s); }
      mx = fmaxf(mx, __shfl_xor(mx, 16, 64)); mx = fmaxf(mx, __shfl_xor(mx, 32, 64));
      const float m_new = fmaxf(m_run, mx);
      const float m_use = (m_new == -INFINITY) ? 0.f : m_new;
      const float alpha = __builtin_amdgcn_exp2f(m_run - m_use);
      const bool resc = __any(m_new != m_run);
      m_run = m_new;
      float psum = 0.f;
      s16x8 Pf;
#pragma unroll
      for (int sub = 0; sub < 2; ++sub)
#pragma unroll
        for (int r = 0; r < 4; ++r) { const float pv = __builtin_amdgcn_exp2f(S[sub][r] - m_use); psum += pv; Pf[sub * 4 + r] = (short)f2bf(pv); }
      l_run = l_run * alpha + psum;
      if (resc) {
#pragma unroll
        for (int i = 0; i < 8; ++i) O[i] *= alpha;
      }
      const int q4 = fr >> 2, p4 = fr & 3;
      LAS unsigned char* vb0 = kb + (ksub * 32 + 4 * g + q4) * KV_STRIDE + p4 * 8;
#pragma unroll
      for (int dvt = 0; dvt < 8; ++dvt) {
        const s16x4 v0 = __builtin_amdgcn_ds_read_tr16_b64_v4i16((LAS s16x4*)(vb0 + dvt * 32));
        const s16x4 v1 = __builtin_amdgcn_ds_read_tr16_b64_v4i16((LAS s16x4*)(vb0 + 16 * KV_STRIDE + dvt * 32));
        s16x8 Vf; Vf[0] = v0[0]; Vf[1] = v0[1]; Vf[2] = v0[2]; Vf[3] = v0[3]; Vf[4] = v1[0]; Vf[5] = v1[1]; Vf[6] = v1[2]; Vf[7] = v1[3];
        O[dvt] = __builtin_amdgcn_mfma_f32_16x16x32_bf16(Vf, Pf, O[dvt], 0, 0, 0);
      }
    }
    if (kt + 1 < ntile) L_STORE(buf ^ 1);
    __syncthreads();
  }
  float l_tot = l_run + __shfl_xor(l_run, 16, 64); l_tot += __shfl_xor(l_tot, 32, 64);
  const float inv = 1.f / l_tot;
  u16* dst = p.mix + qtok * 1024 + h * 128 + 4 * g;
#pragma unroll
  for (int dvt = 0; dvt < 8; ++dvt) {
    uint2 o; o.x = pack_bf2(O[dvt][0] * inv, O[dvt][1] * inv); o.y = pack_bf2(O[dvt][2] * inv, O[dvt][3] * inv);
    *(uint2*)(dst + dvt * 16) = o;
  }
}

#define LR_XCB 0
#define LR_XCF 18432
#define LR_A   51200
#define LR_B   83968
#define LR_SEG 116736
__device__ void lru_item(const P& p, LAS unsigned char* lds, int b, int blk, int tid) {
  const int lane = tid & 63, wid = tid >> 6, fr = lane & 15, g = lane >> 4;
  LAS u16* xcb = (LAS u16*)(lds + LR_XCB);
  LAS float* xcf = (LAS float*)(lds + LR_XCF);
  LAS float* a_s = (LAS float*)(lds + LR_A);
  LAS float* b_s = (LAS float*)(lds + LR_B);
  LAS float* segP = (LAS float*)(lds + LR_SEG);
  LAS float* segH = segP + 512;
  LAS float* carry = segH + 512;
  LAS float* Hprev = carry + 512;
  LAS float* cw = Hprev + 64;
  LAS float* cb = cw + 256;
  const int c0 = blk * 64;
  if (tid < 256) cw[tid] = p.conv_w[(tid >> 6) * 512 + c0 + (tid & 63)];
  if (tid < 64) { cb[tid] = p.conv_b[c0 + tid]; Hprev[tid] = 0.f; }
  float brg[4], big[4], spl[4];
#pragma unroll
  for (int nt = 0; nt < 4; ++nt) {
    const int c = c0 + nt * 16 + fr;
    brg[nt] = p.b_rg[c]; big[nt] = p.b_ig[c];
    const float l = p.lam[c];
    spl[nt] = (-l > 20.f) ? -l : log1pf(__expf(-l));
  }
  const u16* wrg = p.WrgT + (size_t)blk * 4096 + fr * 64 + g * 8;
  const u16* wig = p.WigT + (size_t)blk * 4096 + fr * 64 + g * 8;
  __syncthreads();
  const int tok_l = tid >> 2, cg = tid & 3;
  uint4 xr[4][2];
  const u16* xbase = p.xbr + (size_t)b * SEQ * 512 + c0 + cg * 16;
#define LRU_LOADX(S0) do { _Pragma("unroll") for (int w = 0; w < 4; ++w) { const int ss = (S0) + tok_l - 3 + w; \
      if (ss >= 0) { const uint4* src = (const uint4*)(xbase + (size_t)ss * 512); xr[w][0] = src[0]; xr[w][1] = src[1]; } \
      else { xr[w][0] = make_uint4(0, 0, 0, 0); xr[w][1] = xr[w][0]; } } } while (0)
  LRU_LOADX(0);
  for (int s0 = 0; s0 < SEQ; s0 += 128) {
    {
      float acc[16];
      { const fx4 b0 = *(LAS fx4*)(cb + cg * 16), b1 = *(LAS fx4*)(cb + cg * 16 + 4), b2 = *(LAS fx4*)(cb + cg * 16 + 8), b3 = *(LAS fx4*)(cb + cg * 16 + 12);
        acc[0] = b0[0]; acc[1] = b0[1]; acc[2] = b0[2]; acc[3] = b0[3]; acc[4] = b1[0]; acc[5] = b1[1]; acc[6] = b1[2]; acc[7] = b1[3];
        acc[8] = b2[0]; acc[9] = b2[1]; acc[10] = b2[2]; acc[11] = b2[3]; acc[12] = b3[0]; acc[13] = b3[1]; acc[14] = b3[2]; acc[15] = b3[3]; }
#pragma unroll
      for (int w = 0; w < 4; ++w) {
        const unsigned uu[8] = {xr[w][0].x, xr[w][0].y, xr[w][0].z, xr[w][0].w, xr[w][1].x, xr[w][1].y, xr[w][1].z, xr[w][1].w};
#pragma unroll
        for (int q = 0; q < 4; ++q) { const fx4 wv = *(LAS fx4*)(cw + w * 64 + cg * 16 + 4 * q);
          acc[4 * q] += bflo(uu[2 * q]) * wv[0]; acc[4 * q + 1] += bfhi(uu[2 * q]) * wv[1]; acc[4 * q + 2] += bflo(uu[2 * q + 1]) * wv[2]; acc[4 * q + 3] += bfhi(uu[2 * q + 1]) * wv[3]; }
      }
#pragma unroll
      for (int i = 0; i < 16; i += 4) { const fx4 t4 = {acc[i], acc[i + 1], acc[i + 2], acc[i + 3]}; LDS_ST_FX4(xcf + tok_l * 64 + cg * 16 + i, t4); }
#pragma unroll
      for (int i = 0; i < 16; i += 4) { uint2 o; o.x = pack_bf2(acc[i], acc[i + 1]); o.y = pack_bf2(acc[i + 2], acc[i + 3]); LDS_STORE(uint2, xcb + tok_l * 72 + cg * 16 + i, o); }
    }
    const size_t t = (size_t)b * SEQ + s0 + tok_l;
    const uint4* gsrc = (const uint4*)(p.gate + t * 512 + c0 + cg * 16);
    const uint4 g0 = gsrc[0], g1 = gsrc[1];
    if (s0 + 128 < SEQ) LRU_LOADX(s0 + 128);
    __syncthreads();
    {
      const s16x8 A0 = *(LAS s16x8*)(xcb + (wid * 16 + fr) * 72 + g * 8);
      const s16x8 A1 = *(LAS s16x8*)(xcb + (wid * 16 + fr) * 72 + 32 + g * 8);
#pragma unroll
      for (int nt = 0; nt < 4; ++nt) {
        fx4 R = {0.f, 0.f, 0.f, 0.f}, I = {0.f, 0.f, 0.f, 0.f};
        const s16x8 br0 = *(const s16x8*)(wrg + nt * 1024), br1 = *(const s16x8*)(wrg + nt * 1024 + 32);
        const s16x8 bi0 = *(const s16x8*)(wig + nt * 1024), bi1 = *(const s16x8*)(wig + nt * 1024 + 32);
        R = __builtin_amdgcn_mfma_f32_16x16x32_bf16(A0, br0, R, 0, 0, 0);
        R = __builtin_amdgcn_mfma_f32_16x16x32_bf16(A1, br1, R, 0, 0, 0);
        I = __builtin_amdgcn_mfma_f32_16x16x32_bf16(A0, bi0, I, 0, 0, 0);
        I = __builtin_amdgcn_mfma_f32_16x16x32_bf16(A1, bi1, I, 0, 0, 0);
#pragma unroll
        for (int r = 0; r < 4; ++r) {
          const int tok = wid * 16 + 4 * g + r, o = nt * 16 + fr;
          const float rr = sigmoidf_(R[r] + brg[nt]), ii = sigmoidf_(I[r] + big[nt]);
          const float log_a = -8.f * rr * spl[nt];
          const float a = __builtin_amdgcn_exp2f(1.4426950408889634f * log_a);
          const float bb = __builtin_amdgcn_sqrtf(fmaxf(1.f - a * a, 0.f)) * (ii * xcf[tok * 64 + o]);
          a_s[tok * 64 + o] = a; b_s[tok * 64 + o] = bb;
        }
      }
    }
    __syncthreads();
    {
      float av[16], bv[16];
#pragma unroll
      for (int i = 0; i < 16; ++i) { av[i] = a_s[(wid * 16 + i) * 64 + lane]; bv[i] = b_s[(wid * 16 + i) * 64 + lane]; }
      float hh = 0.f, pp = 1.f;
#pragma unroll
      for (int i = 0; i < 16; ++i) { hh = av[i] * hh + bv[i]; pp *= av[i]; bv[i] = hh; av[i] = pp; }
#pragma unroll
      for (int i = 0; i < 16; ++i) { b_s[(wid * 16 + i) * 64 + lane] = bv[i]; a_s[(wid * 16 + i) * 64 + lane] = av[i]; }
      segP[wid * 64 + lane] = pp; segH[wid * 64 + lane] = hh;
    }
    __syncthreads();
    if (tid < 64) {
      float sp_[8], sh_[8];
#pragma unroll
      for (int sg = 0; sg < 8; ++sg) { sp_[sg] = segP[sg * 64 + tid]; sh_[sg] = segH[sg * 64 + tid]; }
      float c = Hprev[tid];
#pragma unroll
      for (int sg = 0; sg < 8; ++sg) { carry[sg * 64 + tid] = c; c = sp_[sg] * c + sh_[sg]; }
      Hprev[tid] = c;
    }
    __syncthreads();
    {
      const unsigned gg[8] = {g0.x, g0.y, g0.z, g0.w, g1.x, g1.y, g1.z, g1.w};
      unsigned oo[8];
#pragma unroll
      for (int q = 0; q < 4; ++q) {
        const int o0 = cg * 16 + 4 * q;
        const fx4 cr = *(LAS fx4*)(carry + (tok_l >> 4) * 64 + o0), hl = *(LAS fx4*)(b_s + tok_l * 64 + o0), pl = *(LAS fx4*)(a_s + tok_l * 64 + o0);
        const float h0 = hl[0] + pl[0] * cr[0], h1 = hl[1] + pl[1] * cr[1], h2 = hl[2] + pl[2] * cr[2], h3 = hl[3] + pl[3] * cr[3];
        oo[2 * q] = pack_bf2(h0 * gelu_tanh_f(bflo(gg[2 * q])), h1 * gelu_tanh_f(bfhi(gg[2 * q])));
        oo[2 * q + 1] = pack_bf2(h2 * gelu_tanh_f(bflo(gg[2 * q + 1])), h3 * gelu_tanh_f(bfhi(gg[2 * q + 1])));
      }
      uint4* dst = (uint4*)(p.mix + t * 1024 + 512 + c0 + cg * 16);
      dst[0] = make_uint4(oo[0], oo[1], oo[2], oo[3]); dst[1] = make_uint4(oo[4], oo[5], oo[6], oo[7]);
    }
    __syncthreads();
  }
#undef LRU_LOADX
}

__device__ void phase2(const P& p, LAS unsigned char* lds, int wid_s) {
  const int tid = mk_tid(wid_s), lane = tid & 63, wid = tid >> 6;
  LAS int* misc = (LAS int*)(lds + L_MISC);
  const int flags = p.pad0;
  if (!(flags & 1) && blockIdx.x < 64) lru_item(p, lds, blockIdx.x >> 3, blockIdx.x & 7, tid);
  if (flags & 2) return;
  for (;;) {
    __syncthreads();
    if (tid == 0) misc[0] = (int)atomicAdd(p.ctr, 1u);
    __syncthreads();
    const int a = misc[0];
    if (a >= 512) break;
    const int qb = 63 - (a >> 3), b = a & 7;
    const int t0 = qb * 32;
    for (int r = 0; r < 2; ++r) {
      const int tq0 = t0 + 16 * r;
      if (tid < 16) { LAS unsigned* mm = (LAS unsigned*)(lds + L_MM); mm[2 * tid] = 0u; mm[2 * tid + 1] = 0xFFFFFFFFu; }
      __syncthreads();
      if (!(flags & 16)) index_scores(p, lds, b, tq0, (tq0 >> 4) + 1, wid, lane);
      __syncthreads();
#pragma unroll 1
      for (int qq = 0; qq < ((flags & 4) ? 0 : 2); ++qq) {
        const int qi = wid * 2 + qq;
        select_row((LAS float*)lds + qi * SC_STRIDE, tq0 + qi, (LAS unsigned*)(lds + L_MASK) + (r * 16 + qi) * 64,
                   (LAS unsigned*)(lds + L_HIST) + wid * 256, (LAS unsigned*)(lds + L_CAND) + wid * 260, lane, p.pad1, (LAS unsigned*)(lds + L_MM) + 2 * qi);
      }
      __syncthreads();
    }
    if (!(flags & 8)) attn_block(p, lds, b, t0, wid, lane, tid);
  }
}
struct Epi3 {
  static constexpr bool PERM = false, AFTER_DRAIN = false;
  P p;
  __device__ __forceinline__ void operator()(const pg8::f32x4 (&acc)[2][2][4][2], const pg8::Unit& u, int wr, int wc, int fr_in, int fq_in) const {
    int fr = fr_in, fq = fq_in; asm volatile("" : "+v"(fr), "+v"(fq));
    const int rowb = u.pm * 256 + wr * 64 + fr;
    const int colb = u.pn * 256 + wc * 32 + 4 * fq;
#pragma unroll
    for (int ai = 0; ai < 2; ++ai)
#pragma unroll
      for (int m = 0; m < 4; ++m) { const int row = rowb + ai * 128 + m * 16;
        float s = 0.f;
#pragma unroll
        for (int bj = 0; bj < 2; ++bj)
#pragma unroll
          for (int n = 0; n < 2; ++n) { const int col = colb + bj * 128 + 16 * n;
            const float4 xr = *(const float4*)(p.x + (size_t)row * DM + col);
            const pg8::f32x4 a = acc[ai][bj][m][n];
            const float v0 = a[0] + xr.x, v1 = a[1] + xr.y, v2 = a[2] + xr.z, v3 = a[3] + xr.w;
            s += v0 * v0 + v1 * v1 + v2 * v2 + v3 * v3;
            uint2 o; o.x = pack_bf2(v0, v1); o.y = pack_bf2(v2, v3);
            *(uint2*)(p.x1b + (size_t)row * DM + col) = o; }
        s += __shfl_xor(s, 16, 64); s += __shfl_xor(s, 32, 64);
        if (fq == 0) atomicAdd(p.ss_ffn + row, s); }
  }
};
__device__ void phase3_outproj(const P& p, LAS unsigned char* lds, int wid_s) {
  pg8::Gemm g; g.A = p.mix; g.Bt = p.WoutT; g.M = T_TOK; g.N = 1024; g.K = p.k1024;
  pg8::StaticOrder S; S.init(T_TOK, 1024, gridDim.x, blockIdx.x);
  Epi3 E; E.p = p;
  pg8::gemm_phase<Epi3, pg8::StaticOrder>(lds, g, S, E, nullptr, wid_s);
}
struct Epi4 {
  static constexpr bool PERM = false, AFTER_DRAIN = false;
  P p;
  __device__ __forceinline__ void operator()(const pg8::f32x4 (&acc)[2][2][4][2], const pg8::Unit& u, int wr, int wc, int fr_in, int fq_in) const {
    int fr = fr_in, fq = fq_in; asm volatile("" : "+v"(fr), "+v"(fq));
    const int rowb = u.pm * 256 + wr * 64 + fr;
    const int colb = u.pn * 256 + wc * 32 + 4 * fq;
#pragma unroll
    for (int ai = 0; ai < 2; ++ai)
#pragma unroll
      for (int m = 0; m < 4; ++m) { const int row = rowb + ai * 128 + m * 16;
        const float rs = rsqrtf(p.ss_ffn[row] * (1.f / DM) + 1e-6f);
#pragma unroll
        for (int bj = 0; bj < 2; ++bj)
#pragma unroll
          for (int n = 0; n < 2; ++n) { const int col = colb + bj * 128 + 16 * n;
            const pg8::f32x4 v = acc[ai][bj][m][n] * rs;
            uint2 o; o.x = pack_bf2(v[0], v[1]); o.y = pack_bf2(v[2], v[3]);
            *(uint2*)(p.pq + (size_t)row * 2048 + col) = o; } }
  }
};
__device__ void phase4_pq(const P& p, LAS unsigned char* lds, int wid_s) {
  pg8::Gemm g; g.A = p.x1b; g.Bt = p.WpqT; g.M = T_TOK; g.N = 2048; g.K = p.k1024;
  pg8::StaticOrder S; S.init(T_TOK, 2048, gridDim.x, blockIdx.x);
  Epi4 E; E.p = p;
  pg8::gemm_phase<Epi4, pg8::StaticOrder>(lds, g, S, E, nullptr, wid_s);
}

#ifdef USE_SHFL_ROW
__device__ __forceinline__ unsigned row16_max_u32(unsigned x) {
  x = max(x, (unsigned)__shfl_xor((int)x, 1, 64)); x = max(x, (unsigned)__shfl_xor((int)x, 2, 64));
  x = max(x, (unsigned)__shfl_xor((int)x, 4, 64)); x = max(x, (unsigned)__shfl_xor((int)x, 8, 64)); return x; }
__device__ __forceinline__ float row16_sum_f32(float x) {
  x += __shfl_xor(x, 1, 64); x += __shfl_xor(x, 2, 64); x += __shfl_xor(x, 4, 64); x += __shfl_xor(x, 8, 64); return x; }
#else
#define DPP_U(x, ctrl) ((unsigned)__builtin_amdgcn_update_dpp(0, (int)(x), (ctrl), 0xF, 0xF, true))
__device__ __forceinline__ unsigned row16_max_u32(unsigned x) {
  x = max(x, DPP_U(x, 0xB1)); x = max(x, DPP_U(x, 0x4E)); x = max(x, DPP_U(x, 0x141)); x = max(x, DPP_U(x, 0x140)); return x; }
__device__ __forceinline__ float row16_sum_f32(float x) {
  x += __uint_as_float(DPP_U(__float_as_uint(x), 0xB1)); x += __uint_as_float(DPP_U(__float_as_uint(x), 0x4E));
  x += __uint_as_float(DPP_U(__float_as_uint(x), 0x141)); x += __uint_as_float(DPP_U(__float_as_uint(x), 0x140)); return x; }
#endif
__device__ __forceinline__ float sort2f(unsigned u) { const unsigned b = (u & 0x80000000u) ? (u & 0x7FFFFFFFu) : ~u; return __uint_as_float(b); }

#define RT_KOFF 8192
#define RT_KSTR 136
__device__ void phase4b_route(const P& p, LAS unsigned char* lds, int wid_s) {
  const int tid = mk_tid(wid_s), lane = tid & 63, wid = tid >> 6, fr = lane & 15, g = lane >> 4;
  LAS unsigned* topk = (LAS unsigned*)lds;
  LAS u16* kimg = (LAS u16*)(lds + RT_KOFF);
  const int nitems = (T_TOK / 64) * 8;
  int hloaded = -1;
  for (int item = blockIdx.x; item < nitems; item += gridDim.x) {
    const int h = item & 7, tile = item >> 3;
    const int tok0 = tile * 64;
    if (h != hloaded) {
      __syncthreads();
      for (int i = tid; i < 2 * 128 * 16; i += 512) { const int side = i >> 11, r = (i >> 4) & 127, c = i & 15;
        const uint4 v = *(const uint4*)((side ? p.K2b : p.K1b) + (size_t)h * 16384 + r * 128 + c * 8);
        LDS_STORE(uint4, kimg + (side * 128 + r) * RT_KSTR + c * 8, v); }
      hloaded = h;
      __syncthreads();
    }
    {
      const int side = wid & 1, mt = wid >> 1;
      const size_t tok = (size_t)tok0 + mt * 16 + fr;
      const u16* qa = p.pq + tok * 2048 + h * 256 + side * 128 + g * 8;
      s16x8 A[4];
#pragma unroll
      for (int ks = 0; ks < 4; ++ks) A[ks] = *(const s16x8*)(qa + ks * 32);
      LAS u16* kb = kimg + (side * 128 + fr) * RT_KSTR + g * 8;
      unsigned val[8][4];
#pragma unroll
      for (int nt = 0; nt < 8; ++nt) {
        fx4 acc = {0.f, 0.f, 0.f, 0.f};
#pragma unroll
        for (int ks = 0; ks < 4; ++ks) {
          const s16x8 B = *(LAS s16x8*)(kb + nt * 16 * RT_KSTR + ks * 32);
          acc = __builtin_amdgcn_mfma_f32_16x16x32_bf16(A[ks], B, acc, 0, 0, 0);
        }
        const unsigned tag = 127u - (unsigned)(nt * 16 + fr);
#pragma unroll
        for (int r = 0; r < 4; ++r) val[nt][r] = (f2sort(acc[r]) & ~0x7Fu) | tag;
      }
#define CE(a, b) do { const unsigned hi_ = max(a, b), lo_ = min(a, b); a = hi_; b = lo_; } while (0)
#pragma unroll
      for (int r = 0; r < 4; ++r) {
        CE(val[0][r], val[1][r]); CE(val[2][r], val[3][r]); CE(val[4][r], val[5][r]); CE(val[6][r], val[7][r]);
        CE(val[0][r], val[2][r]); CE(val[1][r], val[3][r]); CE(val[4][r], val[6][r]); CE(val[5][r], val[7][r]);
        CE(val[1][r], val[2][r]); CE(val[5][r], val[6][r]);
        CE(val[0][r], val[4][r]); CE(val[1][r], val[5][r]); CE(val[2][r], val[6][r]); CE(val[3][r], val[7][r]);
        CE(val[2][r], val[4][r]); CE(val[3][r], val[5][r]);
        CE(val[1][r], val[2][r]); CE(val[3][r], val[4][r]); CE(val[5][r], val[6][r]);
      }
#undef CE
      unsigned mine[4] = {0u, 0u, 0u, 0u};
#pragma unroll 1
      for (int i = 0; i < 16; ++i) {
        unsigned m[4];
#pragma unroll
        for (int r = 0; r < 4; ++r) m[r] = max(val[0][r], DPP_U(val[0][r], 0xB1));
#pragma unroll
        for (int r = 0; r < 4; ++r) m[r] = max(m[r], DPP_U(m[r], 0x4E));
#pragma unroll
        for (int r = 0; r < 4; ++r) m[r] = max(m[r], DPP_U(m[r], 0x141));
#pragma unroll
        for (int r = 0; r < 4; ++r) m[r] = max(m[r], DPP_U(m[r], 0x140));
#pragma unroll
        for (int r = 0; r < 4; ++r) {
          const bool win = (val[0][r] == m[r]);
#pragma unroll
          for (int q = 0; q < 7; ++q) val[q][r] = win ? val[q + 1][r] : val[q][r];
          val[7][r] = win ? 0u : val[7][r];
          if (fr == i) mine[r] = m[r];
        }
      }
#pragma unroll
      for (int r = 0; r < 4; ++r) topk[((mt * 16 + 4 * g + r) * 2 + side) * 16 + fr] = mine[r];
    }
    __syncthreads();
#pragma unroll 1
    for (int rd = 0; rd < 2; ++rd) {
      const int tl = wid * 8 + rd * 4 + g;
      LAS unsigned* t1 = topk + (tl * 2 + 0) * 16;
      LAS unsigned* t2 = topk + (tl * 2 + 1) * 16;
      unsigned cv[4];
#pragma unroll
      for (int j = 0; j < 4; ++j) {
        const int s = fr + 16 * j;
        int a, bb;
        if (s < 16) { a = 0; bb = s; } else if (s < 24) { a = 1; bb = s - 16; } else if (s < 29) { a = 2; bb = s - 24; } else if (s < 33) { a = 3; bb = s - 29; }
        else if (s < 36) { a = 4; bb = s - 33; } else if (s < 38) { a = 5; bb = s - 36; } else if (s < 40) { a = 6; bb = s - 38; } else if (s < 42) { a = 7; bb = s - 40; }
        else if (s < 50) { a = 8 + (s - 42); bb = 0; } else { a = -1; bb = 0; }
        unsigned key = 0u;
        if (a >= 0) {
          const float sum = sort2f(t1[a] & ~0x7Fu) + sort2f(t2[bb] & ~0x7Fu);
          key = (f2sort(sum) & ~0xFFu) | (unsigned)(255 - (a * 16 + bb));
        }
        cv[j] = key;
      }
      unsigned mine = 0u;
#pragma unroll 1
      for (int i = 0; i < 16; ++i) {
        unsigned m = max(max(cv[0], cv[1]), max(cv[2], cv[3]));
        m = row16_max_u32(m);
#pragma unroll
        for (int j = 0; j < 4; ++j) cv[j] = (cv[j] == m) ? 0u : cv[j];
        if (fr == i) mine = m;
      }
      const int flat = 255 - (int)(mine & 0xFFu);
      const int a = flat >> 4, bb = flat & 15;
      const unsigned k1 = t1[a], k2 = t2[bb];
      const float sum = sort2f(k1 & ~0x7Fu) + sort2f(k2 & ~0x7Fu);
      const unsigned m0 = (unsigned)__shfl((int)mine, lane & 48, 64);
      const int f0 = 255 - (int)(m0 & 0xFFu);
      const float s0 = sort2f(t1[f0 >> 4] & ~0x7Fu) + sort2f(t2[f0 & 15] & ~0x7Fu);
      const float ex = __expf(sum - s0);
      const float den = row16_sum_f32(ex);
      const int e = (127 - (int)(k1 & 0x7Fu)) * 128 + (127 - (int)(k2 & 0x7Fu));
      const size_t t = (size_t)tok0 + tl;
      p.experts[t * 128 + h * 16 + fr] = e;
      p.gates[t * 128 + h * 16 + fr] = ex / den;
    }
    __syncthreads();
  }
}
#define FP8_LO(w) __builtin_amdgcn_cvt_pk_f32_fp8((int)(w), false)
#define FP8_HI(w) __builtin_amdgcn_cvt_pk_f32_fp8((int)(w), true)
#define P5_LIST_WORDS (4 * 128 * 3)
#define P5_WAVE_WORDS (P5_LIST_WORDS + 128)
__device__ __forceinline__ float gelu_erf_fast(float v) {
  const float av = fabsf(v), t = __builtin_amdgcn_rcpf(av * 0.2316418882f + 1.0f);
  float q = t * 0.5307027145f + (-0.7265760135f); q = q * t + 0.7107068705f; q = q * t + (-0.142248368f); q = q * t + 0.127414796f; q = q * t;
  const float e = __builtin_amdgcn_exp2f((v * v) * (-0.72134752044f));
  const float m = v * (q * e);
  return v < 0.f ? m : v - m;
}
__device__ __forceinline__ float dot16_fp8(const uint4 r, const float (&h)[16]) {
  fx2 a; float d;
  a = FP8_LO(r.x); d = a.x * h[0] + a.y * h[1]; a = FP8_HI(r.x); d += a.x * h[2] + a.y * h[3];
  a = FP8_LO(r.y); d += a.x * h[4] + a.y * h[5]; a = FP8_HI(r.y); d += a.x * h[6] + a.y * h[7];
  a = FP8_LO(r.z); d += a.x * h[8] + a.y * h[9]; a = FP8_HI(r.z); d += a.x * h[10] + a.y * h[11];
  a = FP8_LO(r.w); d += a.x * h[12] + a.y * h[13]; a = FP8_HI(r.w); d += a.x * h[14] + a.y * h[15];
  return d;
}
#define FP4_B(w, b) __builtin_amdgcn_cvt_scalef32_pk_f32_fp4((w), 1.0f, (b))
__device__ __forceinline__ void axpy16_fp8(const float c, const uint2 r, float (&acc)[16]) {
  fx2 a;
  a = FP4_B(r.x, 0); acc[0] += c * a.x; acc[1] += c * a.y; a = FP4_B(r.x, 1); acc[2] += c * a.x; acc[3] += c * a.y;
  a = FP4_B(r.x, 2); acc[4] += c * a.x; acc[5] += c * a.y; a = FP4_B(r.x, 3); acc[6] += c * a.x; acc[7] += c * a.y;
  a = FP4_B(r.y, 0); acc[8] += c * a.x; acc[9] += c * a.y; a = FP4_B(r.y, 1); acc[10] += c * a.x; acc[11] += c * a.y;
  a = FP4_B(r.y, 2); acc[12] += c * a.x; acc[13] += c * a.y; a = FP4_B(r.y, 3); acc[14] += c * a.x; acc[15] += c * a.y;
}
#define DPPF(x, ctrl) __uint_as_float((unsigned)__builtin_amdgcn_update_dpp(0, (int)__float_as_uint(x), (ctrl), 0xF, 0xF, true))
typedef __bf16 bf16x2_t __attribute__((ext_vector_type(2)));
__device__ __forceinline__ float xsum32(float x) { const unsigned xi = __float_as_uint(x); const auto r = __builtin_amdgcn_permlane32_swap(xi, xi, false, false); return __uint_as_float(r[0]) + __uint_as_float(r[1]); }
__device__ __forceinline__ float xsum16(float x) { const unsigned xi = __float_as_uint(x); const auto r = __builtin_amdgcn_permlane16_swap(xi, xi, false, false); return __uint_as_float(r[0]) + __uint_as_float(r[1]); }
__device__ __forceinline__ float dot16_fp8_bf16(const uint2 r, const unsigned (&h)[8]) {
  float d;
  d = __builtin_amdgcn_fdot2_f32_bf16(__builtin_amdgcn_cvt_scalef32_pk_bf16_fp4(r.x, 1.0f, 0), __builtin_bit_cast(bf16x2_t, h[0]), 0.f, false);
  d = __builtin_amdgcn_fdot2_f32_bf16(__builtin_amdgcn_cvt_scalef32_pk_bf16_fp4(r.x, 1.0f, 1), __builtin_bit_cast(bf16x2_t, h[1]), d, false);
  d = __builtin_amdgcn_fdot2_f32_bf16(__builtin_amdgcn_cvt_scalef32_pk_bf16_fp4(r.x, 1.0f, 2), __builtin_bit_cast(bf16x2_t, h[2]), d, false);
  d = __builtin_amdgcn_fdot2_f32_bf16(__builtin_amdgcn_cvt_scalef32_pk_bf16_fp4(r.x, 1.0f, 3), __builtin_bit_cast(bf16x2_t, h[3]), d, false);
  d = __builtin_amdgcn_fdot2_f32_bf16(__builtin_amdgcn_cvt_scalef32_pk_bf16_fp4(r.y, 1.0f, 0), __builtin_bit_cast(bf16x2_t, h[4]), d, false);
  d = __builtin_amdgcn_fdot2_f32_bf16(__builtin_amdgcn_cvt_scalef32_pk_bf16_fp4(r.y, 1.0f, 1), __builtin_bit_cast(bf16x2_t, h[5]), d, false);
  d = __builtin_amdgcn_fdot2_f32_bf16(__builtin_amdgcn_cvt_scalef32_pk_bf16_fp4(r.y, 1.0f, 2), __builtin_bit_cast(bf16x2_t, h[6]), d, false);
  d = __builtin_amdgcn_fdot2_f32_bf16(__builtin_amdgcn_cvt_scalef32_pk_bf16_fp4(r.y, 1.0f, 3), __builtin_bit_cast(bf16x2_t, h[7]), d, false);
  return d;
}
struct P5Set { uint2 ru0, ru1, ru2, ru3, rv0, rv1, rv2, rv3; float sume, cgme; };
__device__ __forceinline__ void p5_issue(const P& p, P5Set& S, int bid, LAS unsigned* wl, int lane, __amdgpu_buffer_rsrc_t rsU, __amdgpu_buffer_rsrc_t rsV) {
  const int j = bid >> 5, s = (bid & 31) * 4;
  LAS unsigned* lst = wl + j * 384;
  const int sl = s + (lane & 3);
  const unsigned eme = lst[3 * sl]; S.sume = __uint_as_float(lst[3 * sl + 1]); S.cgme = __uint_as_float(lst[3 * sl + 2]);
  const int em_ = (p.pad1 & 4) ? 1023 : 0x7FFFFFFF;
  const int e0 = __builtin_amdgcn_readlane((int)eme, 0) & em_, e1 = __builtin_amdgcn_readlane((int)eme, 1) & em_, e2 = __builtin_amdgcn_readlane((int)eme, 2) & em_, e3 = __builtin_amdgcn_readlane((int)eme, 3) & em_;
  const int l16 = 8 * lane;
  typedef unsigned v2u_ __attribute__((ext_vector_type(2)));
#define P5_LD(dst, rs, e) do { const v2u_ t_ = __builtin_amdgcn_raw_buffer_load_b64(rs, l16, (e) * 512, 0); dst = make_uint2(t_.x, t_.y); } while (0)
  P5_LD(S.ru0, rsU, e0); P5_LD(S.ru1, rsU, e1); P5_LD(S.ru2, rsU, e2); P5_LD(S.ru3, rsU, e3);
  P5_LD(S.rv0, rsV, e0); P5_LD(S.rv1, rsV, e1); P5_LD(S.rv2, rsV, e2); P5_LD(S.rv3, rsV, e3);
#undef P5_LD
}
__device__ __forceinline__ void p5_compute(const P5Set& S, LAS unsigned* ent, const unsigned (&hfp)[8], float (&acc)[16], int lane, int pf) {
  float d0 = dot16_fp8_bf16(S.ru0, hfp), d1 = dot16_fp8_bf16(S.ru1, hfp), d2 = dot16_fp8_bf16(S.ru2, hfp), d3 = dot16_fp8_bf16(S.ru3, hfp);
  {
    const bool up1 = (lane & 1) != 0;
    const float s01 = up1 ? d0 : d1, k01 = up1 ? d1 : d0, s23 = up1 ? d2 : d3, k23 = up1 ? d3 : d2;
    const float a = k01 + DPPF(s01, 0xB1), b = k23 + DPPF(s23, 0xB1);
    const bool up2 = (lane & 2) != 0;
    const float sab = up2 ? a : b, kab = up2 ? b : a;
    d0 = kab + DPPF(sab, 0x4E);
    d0 += DPPF(d0, 0x124); d0 += DPPF(d0, 0x128);
    d0 = xsum16(d0); d0 = xsum32(d0);
  }
  const float cme = gelu_erf_fast(d0 * S.sume) * S.cgme;
  const float c0 = __uint_as_float((unsigned)__builtin_amdgcn_readlane((int)__float_as_uint(cme), 0));
  const float c1 = __uint_as_float((unsigned)__builtin_amdgcn_readlane((int)__float_as_uint(cme), 1));
  const float c2 = __uint_as_float((unsigned)__builtin_amdgcn_readlane((int)__float_as_uint(cme), 2));
  const float c3 = __uint_as_float((unsigned)__builtin_amdgcn_readlane((int)__float_as_uint(cme), 3));
  (void)pf; (void)ent;
  axpy16_fp8(c0, S.rv0, acc); axpy16_fp8(c1, S.rv1, acc); axpy16_fp8(c2, S.rv2, acc); axpy16_fp8(c3, S.rv3, acc);
}
#define P5_COMPUTE(S, bid) do { const int j_ = (bid) >> 5; LAS unsigned* ent_ = wl + j_ * 384 + 12 * ((bid) & 31); \
    if (j_ == 0) p5_compute(S, ent_, hfp[0], acc[0], lane, p.pad1); else if (j_ == 1) p5_compute(S, ent_, hfp[1], acc[1], lane, p.pad1); \
    else if (j_ == 2) p5_compute(S, ent_, hfp[2], acc[2], lane, p.pad1); else p5_compute(S, ent_, hfp[3], acc[3], lane, p.pad1); } while (0)

__device__ __forceinline__ void rank128(int k0, int k1, int lane, int& r0, int& r1) {
  r0 = 0; r1 = 0;
#pragma unroll 8
  for (int i = 0; i < 64; ++i) {
    const int a = __builtin_amdgcn_readlane(k0, i), b = __builtin_amdgcn_readlane(k1, i);
    r0 += ((a < k0) || (a == k0 && i < lane)) ? 1 : 0;
    r0 += (b < k0) ? 1 : 0;
    r1 += (a <= k1) ? 1 : 0;
    r1 += ((b < k1) || (b == k1 && i < lane)) ? 1 : 0;
  }
}

__device__ void phase5_experts(const P& p, LAS unsigned char* lds, int wid_s) {
  const int tid = mk_tid(wid_s), lane_in = tid & 63, wid = wid_s;
  const int gw = blockIdx.x * 8 + wid;
  LAS unsigned* wl = (LAS unsigned*)lds + wid * P5_WAVE_WORDS;
  const __amdgpu_buffer_rsrc_t rsU = __builtin_amdgcn_make_buffer_rsrc(p.U8, 0, 8 << 20, 0x00020000), rsV = __builtin_amdgcn_make_buffer_rsrc(p.V8, 0, 8 << 20, 0x00020000);
  LAS unsigned* ord = wl + P5_LIST_WORDS;
#pragma unroll 1
  for (int sweep = 0; sweep < 2; ++sweep) {
    const int tb = (sweep * 2048 + gw) * 4;
    int lane = lane_in; asm volatile("" : "+v"(lane));
    unsigned hfp[4][8];
    float acc[4][16];
#pragma unroll 1
    for (int j = 0; j < 4; ++j) {
      const size_t t = (size_t)tb + j;
      const int e0 = p.experts[t * 128 + lane], e1 = p.experts[t * 128 + 64 + lane];
      const float g0 = p.gates[t * 128 + lane], g1 = p.gates[t * 128 + 64 + lane];
      const float su0 = p.su[e0], su1 = p.su[e1], sv0 = p.sv[e0], sv1 = p.sv[e1];
      int r0, r1;
      if (p.pad1 & 2) { r0 = lane; r1 = lane + 64; } else rank128(e0, e1, lane, r0, r1);
      LAS unsigned* lst = wl + j * 384;
      lst[3 * r0] = (unsigned)e0; lst[3 * r0 + 1] = __float_as_uint(su0); lst[3 * r0 + 2] = __float_as_uint(g0 * sv0);
      lst[3 * r1] = (unsigned)e1; lst[3 * r1 + 1] = __float_as_uint(su1); lst[3 * r1 + 2] = __float_as_uint(g1 * sv1);
    }
    asm volatile("s_waitcnt lgkmcnt(0)" ::: "memory");
#pragma unroll
    for (int j = 0; j < 4; ++j) {
      const size_t t = (size_t)tb + j;
      const u16* x1r = p.x1b + t * DM;
      const float rs = rsqrtf(p.ss_ffn[t] * (1.f / DM) + 1e-6f);
#pragma unroll
      for (int i = 0; i < 4; ++i) { const uint2 xw = *(const uint2*)(x1r + 256 * i + 4 * lane); const float4 xv = make_float4(bflo(xw.x), bfhi(xw.x), bflo(xw.y), bfhi(xw.y)); const float4 g = *(const float4*)(p.g_ffn + 256 * i + 4 * lane);
        hfp[j][2 * i] = pack_bf2(xv.x * rs * g.x, xv.y * rs * g.y); hfp[j][2 * i + 1] = pack_bf2(xv.z * rs * g.z, xv.w * rs * g.w); }
#pragma unroll
      for (int i = 0; i < 16; ++i) acc[j][i] = 0.f;
    }
    asm volatile("s_waitcnt lgkmcnt(0)" ::: "memory");
    if (!(p.pad1 & 1)) {
      P5Set A, B, C, D;
      p5_issue(p, A, 0 * 32 + 0, wl, lane, rsU, rsV);
      p5_issue(p, B, 1 * 32 + 0, wl, lane, rsU, rsV);
      p5_issue(p, C, 2 * 32 + 0, wl, lane, rsU, rsV);
#pragma unroll 1
      for (int c = 0; c < 32; ++c) {
        const int cn = min(c + 1, 31);
        p5_issue(p, D, 3 * 32 + c, wl, lane, rsU, rsV);
        p5_compute(A, nullptr, hfp[0], acc[0], lane, 0);
        p5_issue(p, A, 0 * 32 + cn, wl, lane, rsU, rsV);
        p5_compute(B, nullptr, hfp[1], acc[1], lane, 0);
        p5_issue(p, B, 1 * 32 + cn, wl, lane, rsU, rsV);
        p5_compute(C, nullptr, hfp[2], acc[2], lane, 0);
        p5_issue(p, C, 2 * 32 + cn, wl, lane, rsU, rsV);
        p5_compute(D, nullptr, hfp[3], acc[3], lane, 0);
      }
      asm volatile("s_waitcnt vmcnt(0)" ::: "memory");
    }
    int lane_e = lane; asm volatile("" : "+v"(lane_e));
#pragma unroll
    for (int j = 0; j < 4; ++j) {
      const u16* x1r = p.x1b + ((size_t)tb + j) * DM;
#pragma unroll
      for (int i = 0; i < 4; ++i) {
        const uint2 xw = *(const uint2*)(x1r + 256 * i + 4 * lane_e);
        acc[j][4 * i] += bflo(xw.x); acc[j][4 * i + 1] += bfhi(xw.x); acc[j][4 * i + 2] += bflo(xw.y); acc[j][4 * i + 3] += bfhi(xw.y);
      }
    }
    asm volatile("" ::: "memory");
#pragma unroll
    for (int j = 0; j < 4; ++j) {
      float* x1r = p.out + ((size_t)tb + j) * DM; u16* x2r = p.x2b + ((size_t)tb + j) * DM;
#pragma unroll
      for (int i = 0; i < 4; ++i) {
        *(float4*)(x1r + 256 * i + 4 * lane_e) = make_float4(acc[j][4 * i], acc[j][4 * i + 1], acc[j][4 * i + 2], acc[j][4 * i + 3]);
        *(uint2*)(x2r + 256 * i + 4 * lane_e) = make_uint2(pack_bf2(acc[j][4 * i], acc[j][4 * i + 1]), pack_bf2(acc[j][4 * i + 2], acc[j][4 * i + 3]));
      }
    }
  }
}

struct Epi6a {
  static constexpr bool PERM = false, AFTER_DRAIN = false;
  P p;
  __device__ __forceinline__ void operator()(const pg8::f32x4 (&acc)[2][2][4][2], const pg8::Unit& u, int wr, int wc, int fr_in, int fq_in) const {
    int fr = fr_in, fq = fq_in; asm volatile("" : "+v"(fr), "+v"(fq));
    const int rowb = u.pm * 256 + wr * 64 + fr;
    const int colb = u.pn * 256 + wc * 32 + 4 * fq;
#pragma unroll
    for (int ai = 0; ai < 2; ++ai)
#pragma unroll
      for (int m = 0; m < 4; ++m) { const int row = rowb + ai * 128 + m * 16;
#pragma unroll
        for (int bj = 0; bj < 2; ++bj)
#pragma unroll
          for (int n = 0; n < 2; ++n) { const int col = colb + bj * 128 + 16 * n;
            const pg8::f32x4 v = acc[ai][bj][m][n];
            uint2 o; o.x = pack_bf2(v[0], v[1]); o.y = pack_bf2(v[2], v[3]);
            *(uint2*)(p.pple + (size_t)row * DM + col) = o; } }
  }
};
struct Epi6b {
  static constexpr bool PERM = false, AFTER_DRAIN = true;
  P p;
  __device__ __forceinline__ void operator()(const pg8::f32x4 (&)[2][2][4][2], const pg8::Unit&, int, int, int, int) const {}
  __device__ __forceinline__ void fused(pg8::f32x4 (&acc)[2][2][4][2], const pg8::Unit& u, int wr, int wc, int fr_in, int fq_in, LAS unsigned char* lds, int wid, int lane) const {
    int fr = fr_in, fq = fq_in; asm volatile("" : "+v"(fr), "+v"(fq));
    const int rowb = u.pm * 256 + wr * 64 + fr;
    const int colb = u.pn * 256 + wc * 32 + 4 * fq;
#pragma unroll
    for (int ai = 0; ai < 2; ++ai)
#pragma unroll
      for (int m = 0; m < 4; ++m) { const int row = rowb + ai * 128 + m * 16;
        float s = 0.f;
#pragma unroll
        for (int bj = 0; bj < 2; ++bj)
#pragma unroll
          for (int n = 0; n < 2; ++n) { const int col = colb + bj * 128 + 16 * n;
            const float4 x2 = *(const float4*)(p.out + (size_t)row * DM + col);
            const uint2 pw = *(const uint2*)(p.pple + (size_t)row * DM + col);
            pg8::f32x4 a = acc[ai][bj][m][n];
            a[0] = x2.x + sigmoidf_(a[0]) * bflo(pw.x); a[1] = x2.y + sigmoidf_(a[1]) * bfhi(pw.x);
            a[2] = x2.z + sigmoidf_(a[2]) * bflo(pw.y); a[3] = x2.w + sigmoidf_(a[3]) * bfhi(pw.y);
            s += a[0] * a[0] + a[1] * a[1] + a[2] * a[2] + a[3] * a[3];
            acc[ai][bj][m][n] = a; }
        s += __shfl_xor(s, 16, 64); s += __shfl_xor(s, 32, 64);
        if (fq == 0) atomicAdd(p.ss_fin + row, s);
        asm volatile("" ::: "memory"); }
    asm volatile("s_waitcnt vmcnt(0)" ::: "memory");
    __syncthreads();
    if (wid == 0 && lane == 0) {
      unsigned* cnt = p.ctr + 64 + u.pm;
      __hip_atomic_fetch_add(cnt, 1u, __ATOMIC_RELAXED, __HIP_MEMORY_SCOPE_AGENT);
      unsigned spins = 0;
      while (__hip_atomic_load(cnt, __ATOMIC_RELAXED, __HIP_MEMORY_SCOPE_AGENT) < 4u) { __builtin_amdgcn_s_sleep(2); if (++spins > (1u << 24)) break; }
    }
    __syncthreads();
#pragma unroll
    for (int ai = 0; ai < 2; ++ai)
#pragma unroll
      for (int m = 0; m < 4; ++m) { const int row = rowb + ai * 128 + m * 16;
        const float tot = __hip_atomic_load(p.ss_fin + row, __ATOMIC_RELAXED, __HIP_MEMORY_SCOPE_AGENT);
        const float rs = rsqrtf(tot * (1.f / DM) + 1e-6f);
#pragma unroll
        for (int bj = 0; bj < 2; ++bj)
#pragma unroll
          for (int n = 0; n < 2; ++n) { const int col = colb + bj * 128 + 16 * n;
            const float4 g = *(const float4*)(p.g_final + col);
            const pg8::f32x4 a = acc[ai][bj][m][n];
            *(float4*)(p.out + (size_t)row * DM + col) = make_float4(a[0] * rs * g.x, a[1] * rs * g.y, a[2] * rs * g.z, a[3] * rs * g.w); }
        asm volatile("" ::: "memory"); }
    (void)lds;
  }
};
__device__ void phase6_ple(const P& p, LAS unsigned char* lds, int wid_s) {
  { pg8::Gemm g; g.A = p.p16; g.Bt = p.WpleT; g.M = T_TOK; g.N = 1024; g.K = p.k256;
    pg8::StaticOrder S; S.init(T_TOK, 1024, gridDim.x, blockIdx.x);
    Epi6a E; E.p = p;
    pg8::gemm_phase<Epi6a, pg8::StaticOrder>(lds, g, S, E, nullptr, wid_s); }
  { pg8::Gemm g; g.A = p.x2b; g.Bt = p.WgT; g.M = T_TOK; g.N = 1024; g.K = p.k1024;
    pg8::StaticOrder S; S.init(T_TOK, 1024, gridDim.x, blockIdx.x);
    Epi6b E; E.p = p;
    pg8::gemm_phase<Epi6b, pg8::StaticOrder>(lds, g, S, E, nullptr, wid_s); }
}
__device__ void phase7_final(const P& p, int wid_s) {
  const int gt = blockIdx.x * 512 + mk_tid(wid_s), nt = gridDim.x * 512;
  for (int i = gt; i < T_TOK * DM / 4; i += nt) {
    const int row = i >> 8, c4 = i & 255;
    const float rs = rsqrtf(p.ss_fin[row] * (1.f / DM) + 1e-6f);
    const float4 v = ((const float4*)p.out)[i];
    const float4 g = ((const float4*)p.g_final)[c4];
    ((float4*)p.out)[i] = make_float4(v.x * rs * g.x, v.y * rs * g.y, v.z * rs * g.z, v.w * rs * g.w);
  }
}
#define XB_TMO      128
#define XB_XCNT(j)  (256  + 64 * (j))
#define XB_XSUB(j)  (1280 + 64 * (j))
#define XB_XGEN(j)  (2304 + 64 * (j))
#define XB_TOP      3328
#define XB_TOPGEN   3392
#define XCD_BAR_WORDS 3456
#define XB_SPIN_CAP (1u << 22)
__device__ __forceinline__ unsigned xb_ld(unsigned* p)              { return __hip_atomic_load(p, __ATOMIC_RELAXED, __HIP_MEMORY_SCOPE_AGENT); }
__device__ __forceinline__ unsigned xb_add(unsigned* p, unsigned v) { return __hip_atomic_fetch_add(p, v, __ATOMIC_RELAXED, __HIP_MEMORY_SCOPE_AGENT); }
__device__ __forceinline__ unsigned xb_xcc_id() { return (unsigned)__builtin_amdgcn_s_getreg((3 << 11) | 20) & 0xFu; }
#define XB_SPIN(cond, bar) do { unsigned _sp = 0; while (cond) { __builtin_amdgcn_s_sleep(1); \
    if ((++_sp & 255u) == 0u) { if (xb_ld(&(bar)[XB_TMO])) break; if (_sp > XB_SPIN_CAP) { atomicAdd(&(bar)[XB_TMO], 1u); break; } } } } while (0)
struct XcdBarrier { unsigned* bar; unsigned x; volatile LAS unsigned* st; };
__device__ __forceinline__ XcdBarrier xcd_barrier_post(unsigned* bar, volatile LAS unsigned* st, int wid_s) {
    XcdBarrier b; b.bar = bar; b.x = xb_xcc_id(); b.st = st;
    if (mk_tid(wid_s) == 0) (void)xb_add(&bar[XB_XCNT(b.x)], 1u);
    return b;
}
__device__ __forceinline__ void xcd_barrier_complete(unsigned* bar, unsigned x, unsigned& nloc, unsigned& nx) {
    const unsigned G = gridDim.x * gridDim.y * gridDim.z;
    unsigned sum, cnt, mine, sp = 0u;
    for (;;) {
        sum = 0u; cnt = 0u; mine = 0u;
#pragma unroll
        for (unsigned j = 0; j < 16; ++j) { const unsigned c = xb_ld(&bar[XB_XCNT(j)]); sum += c; cnt += (c > 0u) ? 1u : 0u; mine = (j == x) ? c : mine; }
        if (sum == G) break;
        __builtin_amdgcn_s_sleep(1);
        if ((++sp & 255u) == 0u) { if (xb_ld(&bar[XB_TMO])) break; if (sp > XB_SPIN_CAP) { atomicAdd(&bar[XB_TMO], 1u); break; } }
    }
    nloc = mine > 0u ? mine : 1u; nx = cnt > 0u ? cnt : 1u;
}
__device__ __forceinline__ void xcd_barrier2(unsigned* bar_, volatile LAS unsigned* st_, int wid_s) {
    XcdBarrier b; b.bar = bar_; b.st = st_; b.x = xb_xcc_id();
    asm volatile("s_waitcnt vmcnt(0)" ::: "memory");
    __syncthreads();
    if (mk_tid(wid_s) == 0) {
        unsigned* bar = b.bar;
        __builtin_amdgcn_s_waitcnt(0);
        unsigned nloc = b.st[0], nx = b.st[1];
        if (nloc == 0u) { xcd_barrier_complete(bar, b.x, nloc, nx); b.st[0] = nloc; b.st[1] = nx; }
        const unsigned old = xb_add(&bar[XB_XSUB(b.x)], 1u);
        const unsigned gen = old / nloc;
        if (old + 1u == (gen + 1u) * nloc) {
            __builtin_amdgcn_fence(__ATOMIC_RELEASE, "agent");
            asm volatile("s_waitcnt vmcnt(0)" ::: "memory");
            const unsigned og = xb_add(&bar[XB_TOP], 1u);
            const unsigned tg = og / nx;
            if (og + 1u == (tg + 1u) * nx) xb_add(&bar[XB_TOPGEN], 1u);
            else XB_SPIN(xb_ld(&bar[XB_TOPGEN]) == tg, bar);
            __builtin_amdgcn_fence(__ATOMIC_ACQUIRE, "agent");
            xb_add(&bar[XB_XGEN(b.x)], 1u);
            asm volatile("s_waitcnt vmcnt(0)" ::: "memory");
        } else {
            XB_SPIN(xb_ld(&bar[XB_XGEN(b.x)]) == gen, bar);
            __builtin_amdgcn_fence(__ATOMIC_ACQUIRE, "agent");
            asm volatile("s_waitcnt vmcnt(0)" ::: "memory");
        }
    }
    __syncthreads();
}
static void fill_params(P& p, void* const* d_in, void* d_out, void* d_ws, size_t ws_size, size_t* used) {
  p.x = (const float*)d_in[0]; p.p = (const float*)d_in[1]; p.pos = (const int*)d_in[2]; p.g_mix = (const float*)d_in[3];
  p.w_in = (const float*)d_in[4]; p.g_kv = (const float*)d_in[5]; p.w_uk = (const float*)d_in[6]; p.w_uv = (const float*)d_in[7];
  p.conv_w = (const float*)d_in[8]; p.conv_b = (const float*)d_in[9]; p.w_rg = (const float*)d_in[10]; p.b_rg = (const float*)d_in[11];
  p.w_ig = (const float*)d_in[12]; p.b_ig = (const float*)d_in[13]; p.lam = (const float*)d_in[14]; p.w_out = (const float*)d_in[15];
  p.g_ffn = (const float*)d_in[16]; p.w_pq = (const float*)d_in[17]; p.k1 = (const float*)d_in[18]; p.k2 = (const float*)d_in[19];
  p.u_tab = (const float*)d_in[20]; p.v_tab = (const float*)d_in[21]; p.w_ple = (const float*)d_in[22]; p.w_gate = (const float*)d_in[23];
  p.g_final = (const float*)d_in[24];
  p.out = (float*)d_out; p.k1024 = 1024; p.k256 = 256; p.pad0 = 0; p.pad1 = 0;
  char* ws = (char*)d_ws; size_t off = 0;
  auto alloc = [&](size_t bytes) { void* r = ws + off; off += (bytes + 255) & ~(size_t)255; return r; };
  const size_t T = T_TOK;
  p.bar = (unsigned*)alloc(16384);
  p.ctr = (unsigned*)alloc(1024);
  p.rstd_mix = (float*)alloc(T * 4); p.ss_ffn = (float*)alloc(T * 4); p.ss_fin = (float*)alloc(T * 4);
  p.ropeA = (float*)alloc(T * 32 * 4); p.ropeI = (float*)alloc(T * 16 * 4);
  p.W1t = (u16*)alloc((size_t)N1 * 1024 * 2); p.WoutT = (u16*)alloc(1024 * 1024 * 2); p.WpqT = (u16*)alloc(2048 * 1024 * 2);
  p.WgT = (u16*)alloc(1024 * 1024 * 2); p.WpleT = (u16*)alloc(1024 * 256 * 2);
  p.K1b = (u16*)alloc(8 * 128 * 128 * 2); p.K2b = (u16*)alloc(8 * 128 * 128 * 2);
  p.WrgT = (u16*)alloc(8 * 64 * 64 * 2); p.WigT = (u16*)alloc(8 * 64 * 64 * 2);
  p.U8 = (unsigned char*)alloc((size_t)16384 * 1024); p.V8 = (unsigned char*)alloc((size_t)16384 * 1024); p.su = (float*)alloc(16384 * 4); p.sv = (float*)alloc(16384 * 4);
  p.p16 = (u16*)alloc(T * 256 * 2);
  p.experts = (int*)alloc(T * 128 * 4); p.gates = (float*)alloc(T * 128 * 4);
  p.xb16 = (u16*)alloc(T * 1024 * 2); p.mix = p.xb16; p.x2b = p.xb16;
  char* rb = ws + off; size_t rboff = 0;
  auto allocB = [&](size_t bytes) { void* r = rb + rboff; rboff += (bytes + 255) & ~(size_t)255; return r; };
  p.qcat = (u16*)allocB(T * 640 * 2); p.kv = (u16*)allocB(T * 160 * 2); p.iqh = (u16*)allocB(T * 512 * 2); p.ikh = (u16*)allocB(T * 64 * 2);
  p.iw = (float*)allocB(T * 8 * 4); p.xbr = (u16*)allocB(T * 512 * 2); p.gate = (u16*)allocB(T * 512 * 2);
  size_t b1 = rboff; rboff = 0;
  p.x1b = (u16*)allocB(T * 1024 * 2); p.pq = (u16*)allocB(T * 2048 * 2); p.pple = p.x1b;
  size_t b2 = rboff;
  off += (b1 > b2 ? b1 : b2);
  *used = off;
}
namespace cg = cooperative_groups;
#ifndef USE_XCD_BARRIER
#define USE_XCD_BARRIER 0
#endif
__global__ void __launch_bounds__(512, 2) mega(P p) {
  extern __shared__ __attribute__((aligned(16))) unsigned char smem[];
  LAS unsigned char* lds = (LAS unsigned char*)smem;
  const int wid_s = __builtin_amdgcn_readfirstlane((int)(threadIdx.x >> 6));
  cg::grid_group grid = cg::this_grid();
#if USE_XCD_BARRIER
  volatile LAS unsigned* xst = (volatile LAS unsigned*)(lds + LDS_BYTES - 16);
  if (mk_tid(wid_s) == 0) { xst[0] = 0u; xst[1] = 0u; xst[2] = 0u; xst[3] = 0u; }
  __syncthreads();
  (void)xcd_barrier_post(p.bar, xst, wid_s);
#define GRID_SYNC() xcd_barrier2(p.bar, (volatile LAS unsigned*)(lds + LDS_BYTES - 16), wid_s)
#else
#define GRID_SYNC() grid.sync()
#endif
  phase0_prep(p, lds, wid_s);
#if USE_XCD_BARRIER
  if (p.k256 == 257) grid.sync();
  GRID_SYNC();
#else
  grid.sync();
#endif
  phase1_gemm1(p, lds, wid_s);
  GRID_SYNC();
  phase2(p, lds, wid_s);
  GRID_SYNC();
  phase3_outproj(p, lds, wid_s);
  GRID_SYNC();
  phase4_pq(p, lds, wid_s);
  GRID_SYNC();
  phase4b_route(p, lds, wid_s);
  GRID_SYNC();
  phase5_experts(p, lds, wid_s);
  GRID_SYNC();
  phase6_ple(p, lds, wid_s);
}

extern "C" void kernel_launch(void* const* d_in, const int* in_sizes, int n_in, void* d_out, int out_size, void* d_ws,
                              size_t ws_size, hipStream_t stream) {
  P p; memset(&p, 0, sizeof(p));
  size_t used = 0;
  fill_params(p, d_in, d_out, d_ws, ws_size, &used);
  static int grid_blocks = 0;
  if (!grid_blocks) {
    (void)hipFuncSetAttribute((const void*)mega, hipFuncAttributeMaxDynamicSharedMemorySize, LDS_BYTES);
    int dev = 0, cus = 0, per_cu = 0;
    (void)hipGetDevice(&dev);
    (void)hipDeviceGetAttribute(&cus, hipDeviceAttributeMultiprocessorCount, dev);
    (void)hipOccupancyMaxActiveBlocksPerMultiprocessor(&per_cu, mega, 512, LDS_BYTES);
    if (per_cu > 1) per_cu = 1;
    grid_blocks = cus * per_cu;
    if (grid_blocks <= 0) grid_blocks = 256;
  }
#if USE_XCD_BARRIER
  (void)hipMemsetAsync(p.bar, 0, XCD_BAR_WORDS * 4, stream);
#endif
  void* args[] = {&p};
  (void)hipLaunchCooperativeKernel((void*)mega, dim3(grid_blocks), dim3(512), args, LDS_BYTES, stream);
}
```

```cpp
#define USE_XCD_BARRIER 1
#include <hip/hip_runtime.h>
#include <hip/hip_cooperative_groups.h>
#include <math.h>
#include <stdint.h>
#include <string.h>

#define T_TOK 16384
#define SEQ 2048
#define NB 8
#define DM 1024
#define INTOT 2280
#define N1 2560
#define LDS_BYTES 163840
#define PRESCALE 0.12751743f
#define IDXSCALE 0.04419417382415922f

typedef unsigned short u16;
typedef _Float16 f16;
typedef _Float16 f16x8 __attribute__((ext_vector_type(8)));
typedef _Float16 f16x4 __attribute__((ext_vector_type(4)));
typedef short s16x8 __attribute__((ext_vector_type(8)));
typedef short s16x4 __attribute__((ext_vector_type(4)));
typedef float fx4 __attribute__((ext_vector_type(4)));
typedef float fx16 __attribute__((ext_vector_type(16)));
typedef float fx2 __attribute__((ext_vector_type(2)));
#define LAS __attribute__((address_space(3)))
#if defined(__HIP_DEVICE_COMPILE__)
#define LDS_STORE(T, ptr, val) (*(LAS T*)(ptr) = (val))
#define LDS_ST_FX4(ptr, val) (*(LAS fx4*)(ptr) = (val))
#else
#define LDS_STORE(T, ptr, val) ((void)0)
#define LDS_ST_FX4(ptr, val) ((void)0)
#endif

__device__ __forceinline__ int mk_tid(int wid_s) {
  int l;
  asm volatile("v_mbcnt_lo_u32_b32 %0, -1, 0\n\tv_mbcnt_hi_u32_b32 %0, -1, %0" : "=v"(l));
  return wid_s * 64 + l;
}
__device__ __forceinline__ u16 f2bf(float f) {
  unsigned u = __float_as_uint(f);
  u += 0x7FFFu + ((u >> 16) & 1u);
  return (u16)(u >> 16);
}
__device__ __forceinline__ unsigned pack_bf2(float lo, float hi) { return (unsigned)f2bf(lo) | ((unsigned)f2bf(hi) << 16); }
__device__ __forceinline__ float bf2f(u16 v) { return __uint_as_float((unsigned)v << 16); }
__device__ __forceinline__ float bflo(unsigned v) { return __uint_as_float(v << 16); }
__device__ __forceinline__ float bfhi(unsigned v) { return __uint_as_float(v & 0xFFFF0000u); }
__device__ __forceinline__ unsigned pack_h2(float lo, float hi) {
  f16 a = (f16)lo, b = (f16)hi;
  return (unsigned)__builtin_bit_cast(unsigned short, a) | ((unsigned)__builtin_bit_cast(unsigned short, b) << 16);
}
__device__ __forceinline__ float wave_sum(float v) {
#pragma unroll
  for (int o = 32; o > 0; o >>= 1) v += __shfl_xor(v, o, 64);
  return v;
}
__device__ __forceinline__ float wave_max(float v) {
#pragma unroll
  for (int o = 32; o > 0; o >>= 1) v = fmaxf(v, __shfl_xor(v, o, 64));
  return v;
}
__device__ __forceinline__ float sigmoidf_(float x) { return __builtin_amdgcn_rcpf(1.f + __builtin_amdgcn_exp2f(-1.4426950408889634f * x)); }
__device__ __forceinline__ float gelu_tanh_f(float x) {
  const float u = 0.7978845608028654f * (x + 0.044715f * x * x * x);
  const float e = __builtin_amdgcn_exp2f(2.8853900817779268f * u);
  const float th = 1.f - 2.f * __builtin_amdgcn_rcpf(e + 1.f);
  return 0.5f * x * (1.f + th);
}
__device__ __forceinline__ float gelu_erf_f(float x) { return 0.5f * x * (1.f + erff(x * 0.7071067811865476f)); }

struct P {
  const float* x; const float* p; const int* pos; const float* g_mix; const float* w_in; const float* g_kv;
  const float* w_uk; const float* w_uv; const float* conv_w; const float* conv_b; const float* w_rg; const float* b_rg;
  const float* w_ig; const float* b_ig; const float* lam; const float* w_out; const float* g_ffn; const float* w_pq;
  const float* k1; const float* k2; const float* u_tab; const float* v_tab; const float* w_ple; const float* w_gate;
  const float* g_final;
  float* out;
  u16* xb16; float* rstd_mix; float* ropeA; float* ropeI;
  u16* W1t; u16* WoutT; u16* WpqT; u16* WgT; u16* WpleT; u16* K1b; u16* K2b; u16* WrgT; u16* WigT;
  unsigned char* U8; unsigned char* V8; float* su; float* sv; u16* p16;
  u16* qcat; u16* kv; u16* iqh; u16* ikh; float* iw; u16* xbr; u16* gate;
  u16* mix; u16* x1b; u16* pq; float* ss_ffn; float* ss_fin;
  int* experts; float* gates; u16* x2b; u16* pple;
  unsigned* ctr; unsigned* bar;
  int k1024, k256, pad0, pad1;
};
namespace pg8 {
#define PG8_LAS __attribute__((address_space(3)))
typedef unsigned short bf16_t;
typedef short bf16x8 __attribute__((ext_vector_type(8)));
typedef float f32x4 __attribute__((ext_vector_type(4)));
typedef unsigned u32x4 __attribute__((ext_vector_type(4)));
constexpr int BM = 256, BK = 64, HALF = 128, HTB = HALF * BK * 2  , STAGE_BYTES = 8 * HTB, NXCD = 8, WGM = 8;

__host__ __device__ __forceinline__ int lds_byte(int r, int c) { const int st = (r >> 4) * 2 + (c >> 5), rr = r & 15, cc = c & 31, ob = rr * 64 + cc * 2; return st * 1024 + (ob ^ (((ob >> 9) & 1) << 5)); }
__host__ __device__ __forceinline__ void stage_rc(int b, int& R, int& C) { const int st = b / 1024, sb = b % 1024, swz = sb ^ (((sb >> 9) & 1) << 5); R = (st >> 1) * 16 + swz / 64; C = (st & 1) * 32 + (swz % 64) / 2; }
__host__ __device__ __forceinline__ int perm32(int rho) { const int n = rho >> 4, i = rho & 15; return 8 * (i >> 2) + 4 * n + (i & 3); }

struct Unit { int pm, pn; };
struct Gemm { const bf16_t* A; const bf16_t* Bt; int M, N, K; };

struct StaticOrder {
    int nM, nN, nwg, G, c;
    __host__ __device__ void init(int M, int N, int G_, int c_) { nM = M / BM; nN = N / BM; nwg = nM * nN; G = G_; c = c_; }
    __host__ __device__ bool next(int i, Unit& u) const {
        const long L = (long)i * G + c; if (L >= nwg) return false;
        int wgid = (int)L; { const int q = nwg / NXCD, r = nwg % NXCD, xcd = wgid % NXCD, off = wgid / NXCD; wgid = (xcd < r ? xcd * (q + 1) : r * (q + 1) + (xcd - r) * q) + off; }
        const int nig = WGM * nN, gid = wgid / nig, fm = gid * WGM, gsz = (nM - fm) < WGM ? (nM - fm) : WGM;
        u.pm = fm + ((wgid % nig) % gsz); u.pn = (wgid % nig) / gsz; return true;
    }
    __device__ __forceinline__ void a_ready(const Unit&) const {}
    __device__ __forceinline__ void done(const Unit&) const {}
};
__device__ __forceinline__ unsigned cvt_pk_bf16(float lo, float hi) { unsigned r; asm volatile("v_cvt_pk_bf16_f32 %0, %1, %2" : "=v"(r) : "v"(lo), "v"(hi)); return r; }
typedef float f32x2 __attribute__((ext_vector_type(2)));
__device__ __forceinline__ f32x2 gelu_pk(f32x2 v) {
    const f32x2 av = __builtin_elementwise_abs(v), d = av * 0.2316418882f + 1.0f;
    f32x2 t; t.x = __builtin_amdgcn_rcpf(d.x); t.y = __builtin_amdgcn_rcpf(d.y);
    f32x2 q = t * 0.5307027145f + (-0.7265760135f); q = q * t + 0.7107068705f; q = q * t + (-0.142248368f); q = q * t + 0.127414796f; q = q * t;
    const f32x2 s = (v * v) * (-0.72134752044f);
    f32x2 e; e.x = __builtin_amdgcn_exp2f(s.x); e.y = __builtin_amdgcn_exp2f(s.y);
    const f32x2 m = v * (q * e), r = v - m;
    f32x2 o; o.x = v.x < 0.f ? m.x : r.x; o.y = v.y < 0.f ? m.y : r.y; return o;
}

template <class Epi, class Sched, bool STAMP = false>
__device__ __forceinline__ void gemm_phase(PG8_LAS unsigned char* lds, const Gemm g, const Sched& S, const Epi& E, unsigned long long* stamps, int wid_s) {
    const int tid = mk_tid(wid_s), wid = __builtin_amdgcn_readfirstlane(tid >> 6), lane = tid & 63, wr = wid >> 2, wc = wid & 3, fr = lane & 15, fq = lane >> 4;
    const int K = g.K, nt = K / BK;
    int ts_lo = 0, ts_hi = 0, nts = 0; const unsigned long long rt_entry = STAMP ? (unsigned long long)wall_clock64() : 0ull;
#define PG8_STAMP() do { if (STAMP && wid == 0 && nts < 64) { const unsigned long long _c = (unsigned long long)clock64(); \
        ts_lo = (lane == nts) ? (int)(unsigned)_c : ts_lo; ts_hi = (lane == nts) ? (int)(unsigned)(_c >> 32) : ts_hi; ++nts; } } while (0)
    PG8_STAMP();
    unsigned voffA[2], voffB[2];
#pragma unroll
    for (int i = 0; i < 2; ++i) { int R, C; stage_rc(tid * 16 + i * 8192, R, C); const int Rb = Epi::PERM ? ((R & ~31) + perm32(R & 31)) : R;
        voffA[i] = (unsigned)(R * K + C) * 2u; voffB[i] = (unsigned)(Rb * K + C) * 2u; }
    const size_t kstep = (size_t)(BK * 2);
    const size_t hstep = (size_t)HALF * K * 2;
    const size_t tstep = 2 * hstep;
    const unsigned ldsw = (unsigned)wid * 1024u;
    const int aoff = lds_byte(wr * 64 + fr, fq * 8), boff = lds_byte(wc * 32 + fr, fq * 8);
#define PG8_SA(b, h) (((b) * 2 + (h)) * HTB)
#define PG8_SB(b, h) ((4 + (b) * 2 + (h)) * HTB)
#define PG8_STAGE(bufoff, gbase, voff) do { _Pragma("unroll") for (int _i = 0; _i < 2; ++_i) \
        __builtin_amdgcn_global_load_lds((const unsigned*)((const char*)(gbase) + (voff)[_i]), (PG8_LAS unsigned*)(lds + (bufoff) + ldsw + _i * 8192), 16, 0, 0); } while (0)
#define PG8_LDA(dst, b, h) do { _Pragma("unroll") for (int m = 0; m < 4; ++m) _Pragma("unroll") for (int k = 0; k < 2; ++k) dst[m][k] = *(const PG8_LAS bf16x8*)(lds + PG8_SA(b, h) + aoff + m * 2048 + k * 1024); } while (0)
#define PG8_LDB(dst, b, h) do { _Pragma("unroll") for (int n = 0; n < 2; ++n) _Pragma("unroll") for (int k = 0; k < 2; ++k) dst[n][k] = *(const PG8_LAS bf16x8*)(lds + PG8_SB(b, h) + boff + n * 2048 + k * 1024); } while (0)
#define PG8_MMA(ai, bj, At, Bt) do { __builtin_amdgcn_s_setprio(1); _Pragma("unroll") for (int m = 0; m < 4; ++m) _Pragma("unroll") for (int n = 0; n < 2; ++n) _Pragma("unroll") for (int k = 0; k < 2; ++k) \
        acc[ai][bj][m][n] = __builtin_amdgcn_mfma_f32_16x16x32_bf16(Bt[n][k], At[m][k], acc[ai][bj][m][n], 0, 0, 0); __builtin_amdgcn_s_setprio(0); } while (0)
#define PG8_WAIT_V(n) asm volatile("s_waitcnt vmcnt(" #n ")" ::: "memory")
#define PG8_WAIT_L(n) asm volatile("s_waitcnt lgkmcnt(" #n ")" ::: "memory")
#define PG8_BAR __builtin_amdgcn_s_barrier()
#define PG8_SCHED __builtin_amdgcn_sched_barrier(0)
    Unit cur, nxt; int ui = 0;
    if (!S.next(0, cur)) return;
    f32x4 acc[2][2][4][2];
#pragma unroll
    for (int a = 0; a < 2; ++a)
#pragma unroll
        for (int b = 0; b < 2; ++b)
#pragma unroll
            for (int m = 0; m < 4; ++m)
#pragma unroll
                for (int n = 0; n < 2; ++n) acc[a][b][m][n] = (f32x4){0.f, 0.f, 0.f, 0.f};
    bf16x8 At[4][2], B0[2][2], B1[2][2];
    const char* cA = (const char*)g.A + (size_t)cur.pm * tstep; const char* cB = (const char*)g.Bt + (size_t)cur.pn * tstep;
    S.a_ready(cur);
    PG8_STAGE(PG8_SB(0, 0), cB, voffB); PG8_STAGE(PG8_SA(0, 0), cA, voffA); PG8_STAGE(PG8_SB(0, 1), cB + hstep, voffB); PG8_STAGE(PG8_SA(0, 1), cA + hstep, voffA);
    if (wr == 1) PG8_BAR;
    PG8_WAIT_V(4); PG8_BAR;
    PG8_STAGE(PG8_SB(1, 0), cB + kstep, voffB); PG8_STAGE(PG8_SA(1, 0), cA + kstep, voffA); PG8_STAGE(PG8_SB(1, 1), cB + hstep + kstep, voffB);
    PG8_WAIT_V(6); PG8_BAR;
    PG8_STAMP();
    for (;;) {
        const bool has_next = S.next(ui + 1, nxt);
        const char* nA = has_next ? (const char*)g.A + (size_t)nxt.pm * tstep : cA; const char* nB = has_next ? (const char*)g.Bt + (size_t)nxt.pn * tstep : cB;
        for (int t = 0; t < nt; t += 2) {
            const bool last = (t == nt - 2);
            const char* a1 = cA + (size_t)(t + 1) * kstep;
            const char* a2 = last ? nA : cA + (size_t)(t + 2) * kstep; const char* b2 = last ? nB : cB + (size_t)(t + 2) * kstep;
            const char* a3 = a2 + kstep; const char* b3 = b2 + kstep;
            if (last && has_next) S.a_ready(nxt);
            PG8_LDB(B0, 0, 0); PG8_SCHED; PG8_LDA(At, 0, 0); PG8_STAGE(PG8_SA(1, 1), a1 + hstep, voffA);
            PG8_WAIT_L(8); PG8_BAR; PG8_WAIT_L(0); PG8_MMA(0, 0, At, B0); PG8_BAR; PG8_SCHED;
            PG8_LDB(B1, 0, 1); PG8_STAGE(PG8_SB(0, 0), b2, voffB);
            PG8_BAR; PG8_WAIT_L(0); PG8_MMA(0, 1, At, B1); PG8_BAR;
            PG8_LDA(At, 0, 1); PG8_STAGE(PG8_SA(0, 0), a2, voffA);
            PG8_BAR; PG8_WAIT_L(0); PG8_MMA(1, 0, At, B0); PG8_BAR; PG8_SCHED;
            PG8_STAGE(PG8_SB(0, 1), b2 + hstep, voffB);
            PG8_WAIT_V(6); PG8_BAR; PG8_MMA(1, 1, At, B1); PG8_BAR;
            PG8_LDB(B0, 1, 0); PG8_SCHED; PG8_LDA(At, 1, 0); PG8_STAGE(PG8_SA(0, 1), a2 + hstep, voffA);
            PG8_WAIT_L(8); PG8_BAR; PG8_WAIT_L(0); PG8_MMA(0, 0, At, B0); PG8_BAR; PG8_SCHED;
            PG8_LDB(B1, 1, 1); PG8_STAGE(PG8_SB(1, 0), b3, voffB);
            PG8_BAR; PG8_WAIT_L(0); PG8_MMA(0, 1, At, B1); PG8_BAR;
            PG8_LDA(At, 1, 1); PG8_STAGE(PG8_SA(1, 0), a3, voffA);
            PG8_BAR; PG8_WAIT_L(0); PG8_MMA(1, 0, At, B0); PG8_BAR; PG8_SCHED;
            PG8_STAGE(PG8_SB(1, 1), b3 + hstep, voffB);
            PG8_WAIT_V(6); PG8_BAR; PG8_MMA(1, 1, At, B1); PG8_BAR;
        }
        PG8_STAMP();
        if constexpr (!Epi::AFTER_DRAIN) { E(acc, cur, wr, wc, fr, fq); S.done(cur); }
        PG8_STAMP();
        if (!has_next) break;
#pragma unroll
        for (int a = 0; a < 2; ++a)
#pragma unroll
            for (int b = 0; b < 2; ++b)
#pragma unroll
                for (int m = 0; m < 4; ++m)
#pragma unroll
                    for (int n = 0; n < 2; ++n) acc[a][b][m][n] = (f32x4){0.f, 0.f, 0.f, 0.f};
        cur = nxt; cA = nA; cB = nB; ++ui;
    }
    PG8_WAIT_V(0);
    if (wr == 0) PG8_BAR;
    PG8_BAR;
    if constexpr (Epi::AFTER_DRAIN) { E.fused(acc, cur, wr, wc, fr, fq, lds, wid, lane); S.done(cur); }
    PG8_STAMP();
    if (STAMP && wid == 0) { stamps[lane] = lane < nts ? (((unsigned long long)(unsigned)ts_hi << 32) | (unsigned)ts_lo) : 0ull;
        if (lane == 62) stamps[62] = rt_entry; if (lane == 63) stamps[63] = (unsigned long long)wall_clock64(); }
#undef PG8_STAMP
#undef PG8_SA
#undef PG8_SB
#undef PG8_STAGE
#undef PG8_LDA
#undef PG8_LDB
#undef PG8_MMA
#undef PG8_WAIT_V
#undef PG8_WAIT_L
#undef PG8_BAR
#undef PG8_SCHED
}
}
__device__ __forceinline__ int w1_src(int n, float& mul) {
  mul = 1.f;
  if (n < 1024) { const int r = n - 512, h = r >> 6, d = r & 63;
    if (d < 16) { const int i = d >> 1, e = d & 1; return 672 + h * 64 + (e ? 8 + i : i); }
    return 672 + h * 64 + d; }
  if (n < 1536) return 1256 + (n - 1024);
  if (n < 2048) return 1768 + (n - 1536);
  if (n < 2176) { const int r = n - 2048, h = r >> 5, j = r & 31, i = j >> 1, e = j & 1; mul = PRESCALE; return h * 128 + (e ? 16 + i : i); }
  if (n < 2304) return 512 + (n - 2176);
  if (n < 2336) { const int j = n - 2304, i = j >> 1, e = j & 1; return 640 + (e ? 16 + i : i); }
  if (n < 2400) { const int d = n - 2336;
    if (d < 16) { const int i = d >> 1, e = d & 1; return 1184 + (e ? 8 + i : i); }
    return 1184 + d; }
  if (n < 2408) { mul = IDXSCALE; return 1248 + (n - 2400); }
  return -1;
}

template <int MODE>
__device__ __forceinline__ void tr_tile(LAS float* tl, const float* __restrict__ src, int ld_src, u16* __restrict__ dst, int ld_dst,
                                        int n0, int k0, int dk0, const float* __restrict__ kscale, int tid) {
  {
    const int nl = tid & 63, kq = tid >> 6;
    float mul = 1.f; int c = n0 + nl;
    if (MODE == 1) c = w1_src(n0 + nl, mul);
#pragma unroll
    for (int i = 0; i < 8; ++i) {
      const int k = k0 + kq * 8 + i;
      float v = 0.f;
      if (c >= 0) { v = src[(size_t)k * ld_src + c] * mul; if (kscale) v *= kscale[k]; }
      tl[(kq * 8 + i) * 65 + nl] = v;
    }
  }
  __syncthreads();
  {
    const int kc = tid & 7, nl = tid >> 3;
    float v[8];
#pragma unroll
    for (int j = 0; j < 8; ++j) v[j] = tl[(kc * 8 + j) * 65 + nl];
    *(uint4*)(dst + (size_t)(n0 + nl) * ld_dst + dk0 + kc * 8) = make_uint4(pack_bf2(v[0], v[1]), pack_bf2(v[2], v[3]), pack_bf2(v[4], v[5]), pack_bf2(v[6], v[7]));
  }
  __syncthreads();
}

__device__ __forceinline__ int q4fp8(float a, float b, float c, float d) {
  int w = __builtin_amdgcn_cvt_pk_fp8_f32(a, b, 0, false);
  return __builtin_amdgcn_cvt_pk_fp8_f32(c, d, w, true);
}

__device__ __forceinline__ void peer_row_fp8(const P& p, int row, int lane) {
  const int e = row & 16383; const bool isv = row >= 16384;
  const float4* src = (const float4*)((isv ? p.v_tab : p.u_tab) + (size_t)e * DM);
  float4 v[4];
  float amax = 0.f;
#pragma unroll
  for (int i = 0; i < 4; ++i) { v[i] = src[lane + 64 * i];
    amax = fmaxf(amax, fmaxf(fmaxf(fabsf(v[i].x), fabsf(v[i].y)), fmaxf(fabsf(v[i].z), fabsf(v[i].w)))); }
  amax = wave_max(amax);
  int ex = 0; const float m = frexpf(amax, &ex);
  const int k = (amax > 0.f) ? ((m > 0.75f) ? (2 - ex) : (3 - ex)) : 0;
  const float sc = ldexpf(1.f, k);
  unsigned w0 = 0u, w1 = 0u;
  w0 = __builtin_amdgcn_cvt_scalef32_pk_fp4_f32(w0, v[0].x * sc, v[0].y * sc, 1.0f, 0);
  w0 = __builtin_amdgcn_cvt_scalef32_pk_fp4_f32(w0, v[0].z * sc, v[0].w * sc, 1.0f, 1);
  w0 = __builtin_amdgcn_cvt_scalef32_pk_fp4_f32(w0, v[1].x * sc, v[1].y * sc, 1.0f, 2);
  w0 = __builtin_amdgcn_cvt_scalef32_pk_fp4_f32(w0, v[1].z * sc, v[1].w * sc, 1.0f, 3);
  w1 = __builtin_amdgcn_cvt_scalef32_pk_fp4_f32(w1, v[2].x * sc, v[2].y * sc, 1.0f, 0);
  w1 = __builtin_amdgcn_cvt_scalef32_pk_fp4_f32(w1, v[2].z * sc, v[2].w * sc, 1.0f, 1);
  w1 = __builtin_amdgcn_cvt_scalef32_pk_fp4_f32(w1, v[3].x * sc, v[3].y * sc, 1.0f, 2);
  w1 = __builtin_amdgcn_cvt_scalef32_pk_fp4_f32(w1, v[3].z * sc, v[3].w * sc, 1.0f, 3);
  *(uint2*)((isv ? p.V8 : p.U8) + (size_t)e * 512 + 8 * lane) = make_uint2(w0, w1);
  if (lane == 0) (isv ? p.sv : p.su)[e] = ldexpf(1.f, -k);
}

__device__ void phase0_prep(const P& p, LAS unsigned char* lds, int wid_s) {
  const int tid = mk_tid(wid_s), lane = tid & 63, wid = tid >> 6;
  const int gw = blockIdx.x * 8 + wid, nw = gridDim.x * 8;
  const int gt = blockIdx.x * 512 + tid, nt = gridDim.x * 512;
  LAS float* tl = (LAS float*)lds;
  for (int i = gt; i < T_TOK; i += nt) { p.ss_ffn[i] = 0.f; p.ss_fin[i] = 0.f; }
  if (gt < 192) p.ctr[gt] = 0u;
  for (int tile = blockIdx.x; tile < 1600; tile += gridDim.x) {
    if (tile < 512) { const int nt_ = tile >> 4, kt = tile & 15;
      tr_tile<1>(tl, p.w_in, INTOT, p.W1t, 1024, 512 + nt_ * 64, kt * 64, kt * 64, p.g_mix, tid);
    } else if (tile < 1024) { const int t2 = tile - 512, nt_ = t2 >> 4, kt = t2 & 15;
      tr_tile<0>(tl, p.w_pq, 2048, p.WpqT, 1024, nt_ * 64, kt * 64, kt * 64, p.g_ffn, tid);
    } else if (tile < 1280) { const int t2 = tile - 1024, nt_ = t2 >> 4, kt = t2 & 15;
      tr_tile<0>(tl, p.w_gate, 1024, p.WgT, 1024, nt_ * 64, kt * 64, kt * 64, nullptr, tid);
    } else if (tile < 1344) { const int t2 = tile - 1280, nt_ = t2 >> 2, kt = t2 & 3;
      tr_tile<0>(tl, p.w_ple, 1024, p.WpleT, 256, nt_ * 64, kt * 64, kt * 64, nullptr, tid);
    } else if (tile < 1472) { const int t2 = tile - 1344, nt_ = t2 >> 3, kt = t2 & 7;
      tr_tile<0>(tl, p.w_out, 1024, p.WoutT, 1024, nt_ * 64, 512 + kt * 64, 512 + kt * 64, nullptr, tid);
    } else if (tile < 1536) {
      const int t2 = tile - 1472, h = t2 >> 4, k0 = (t2 & 15) * 64;
      LAS float* sA = tl;
      LAS float* sB = tl + 64 * 97;
      for (int i = tid; i < 64 * 96; i += 512) { const int kk = i / 96, j = i % 96; sA[kk * 97 + j] = p.w_in[(size_t)(k0 + kk) * INTOT + h * 128 + 32 + j]; }
      for (int i = tid; i < 128 * 96; i += 512) { const int c = i / 96, j = i % 96; sB[j * 129 + c] = p.w_uk[(size_t)(h * 128 + c) * 96 + j]; }
      __syncthreads();
      const int c = tid & 127, kq = tid >> 7;
      float acc[16];
#pragma unroll
      for (int i = 0; i < 16; ++i) acc[i] = 0.f;
      for (int j = 0; j < 96; ++j) { const float b = sB[j * 129 + c];
#pragma unroll
        for (int i = 0; i < 16; ++i) acc[i] += sA[(kq * 16 + i) * 97 + j] * b; }
      unsigned o[8];
#pragma unroll
      for (int i = 0; i < 8; ++i) { const int k = k0 + kq * 16 + 2 * i; o[i] = pack_bf2(acc[2 * i] * PRESCALE * p.g_mix[k], acc[2 * i + 1] * PRESCALE * p.g_mix[k + 1]); }
      uint4* d = (uint4*)(p.W1t + (size_t)(h * 128 + c) * 1024 + k0 + kq * 16);
      d[0] = make_uint4(o[0], o[1], o[2], o[3]); d[1] = make_uint4(o[4], o[5], o[6], o[7]);
      __syncthreads();
    } else {
      const int t2 = tile - 1536, h = t2 >> 4, n0 = (t2 & 15) * 64;
      LAS float* sA = tl;
      LAS float* sB = tl + 128 * 65;
      for (int i = tid; i < 128 * 64; i += 512) { const int d = i >> 6, nl = i & 63; sA[d * 65 + nl] = p.w_out[(size_t)(h * 128 + d) * 1024 + n0 + nl]; }
      for (int i = tid; i < 128 * 128; i += 512) { const int c = i >> 7, d = i & 127; sB[d * 129 + c] = p.w_uv[(size_t)(h * 128 + c) * 128 + d]; }
      __syncthreads();
      const int c = tid & 127, nq = tid >> 7;
      float acc[16];
#pragma unroll
      for (int i = 0; i < 16; ++i) acc[i] = 0.f;
      for (int d = 0; d < 128; ++d) { const float b = sB[d * 129 + c];
#pragma unroll
        for (int i = 0; i < 16; ++i) acc[i] += sA[d * 65 + nq * 16 + i] * b; }
#pragma unroll
      for (int i = 0; i < 16; ++i) p.WoutT[(size_t)(n0 + nq * 16 + i) * 1024 + h * 128 + c] = f2bf(acc[i]);
      __syncthreads();
    }
  }
  for (int idx = gt; idx < 8 * 128 * 128; idx += nt) { p.K1b[idx] = f2bf(p.k1[idx]); p.K2b[idx] = f2bf(p.k2[idx]); }
  for (int idx = gt; idx < 8 * 64 * 64; idx += nt) {
    const int n = idx >> 12, o = (idx >> 6) & 63, i = idx & 63;
    p.WrgT[idx] = f2bf(p.w_rg[(size_t)n * 4096 + i * 64 + o]);
    p.WigT[idx] = f2bf(p.w_ig[(size_t)n * 4096 + i * 64 + o]);
  }
  for (int row = gw; row < T_TOK; row += nw) {
    const float4* xr = (const float4*)(p.x + (size_t)row * DM);
    uint2* xo = (uint2*)(p.xb16 + (size_t)row * DM);
    float ss = 0.f;
#pragma unroll
    for (int i = 0; i < 4; ++i) {
      const float4 v = xr[lane + 64 * i];
      ss += v.x * v.x + v.y * v.y + v.z * v.z + v.w * v.w;
      uint2 o; o.x = pack_bf2(v.x, v.y); o.y = pack_bf2(v.z, v.w);
      xo[lane + 64 * i] = o;
    }
    ss = wave_sum(ss);
    if (lane == 0) p.rstd_mix[row] = rsqrtf(ss * (1.f / DM) + 1e-6f);
    const float pos = (float)p.pos[row];
    if (lane < 16) {
      const float inv = powf(500000.f, -(float)(2 * lane) / 32.f);
      const float ang = pos * inv;
      p.ropeA[(size_t)row * 32 + lane] = cosf(ang);
      p.ropeA[(size_t)row * 32 + 16 + lane] = sinf(ang);
    } else if (lane < 24) {
      const int i = lane - 16;
      const float inv = powf(500000.f, -(float)(2 * i) / 16.f);
      const float ang = pos * inv;
      p.ropeI[(size_t)row * 16 + i] = cosf(ang);
      p.ropeI[(size_t)row * 16 + 8 + i] = sinf(ang);
    }
  }
  for (int i = gt; i < T_TOK * 256 / 4; i += nt) {
    const float4 v = ((const float4*)p.p)[i];
    uint2 o; o.x = pack_bf2(v.x, v.y); o.y = pack_bf2(v.z, v.w);
    ((uint2*)p.p16)[i] = o;
  }
}
__device__ __forceinline__ pg8::f32x4 rope4(pg8::f32x4 a, const float* cs, const float* sn) {
  const float c0 = cs[0], s0 = sn[0], c1 = cs[1], s1 = sn[1];
  pg8::f32x4 o;
  o[0] = a[0] * c0 - a[1] * s0; o[1] = a[1] * c0 + a[0] * s0; o[2] = a[2] * c1 - a[3] * s1; o[3] = a[3] * c1 + a[2] * s1;
  return o;
}
struct Epi1 {
  static constexpr bool PERM = false, AFTER_DRAIN = false;
  P p; LAS float* xch;
  __device__ __forceinline__ void operator()(const pg8::f32x4 (&acc)[2][2][4][2], const pg8::Unit& u, int wr, int wc, int fr_in, int fq_in) const {
    int fr = fr_in, fq = fq_in; asm volatile("" : "+v"(fr), "+v"(fq));
    const int pn = u.pn;
    const int rowb = u.pm * 256 + wr * 64 + fr;
    const int colb = wc * 32 + 4 * fq;
    float rs[2][4];
#pragma unroll
    for (int ai = 0; ai < 2; ++ai)
#pragma unroll
      for (int m = 0; m < 4; ++m) rs[ai][m] = p.rstd_mix[rowb + ai * 128 + m * 16];
    if (pn < 2) {
#pragma unroll
      for (int ai = 0; ai < 2; ++ai)
#pragma unroll
        for (int m = 0; m < 4; ++m) { const int row = rowb + ai * 128 + m * 16;
#pragma unroll
          for (int bj = 0; bj < 2; ++bj)
#pragma unroll
            for (int n = 0; n < 2; ++n) { const int col = pn * 256 + bj * 128 + colb + 16 * n; const int h = col >> 7, c = col & 127;
              const pg8::f32x4 v = acc[ai][bj][m][n] * rs[ai][m];
              uint2 o; o.x = pack_bf2(v[0], v[1]); o.y = pack_bf2(v[2], v[3]);
              *(uint2*)(p.qcat + ((size_t)row * 4 + h) * 160 + c) = o; } }
    } else if (pn < 4) {
#pragma unroll
      for (int ai = 0; ai < 2; ++ai)
#pragma unroll
        for (int m = 0; m < 4; ++m) { const int row = rowb + ai * 128 + m * 16;
#pragma unroll
          for (int bj = 0; bj < 2; ++bj)
#pragma unroll
            for (int n = 0; n < 2; ++n) { const int col = (pn - 2) * 256 + bj * 128 + colb + 16 * n; const int d = col & 63;
              pg8::f32x4 v = acc[ai][bj][m][n] * rs[ai][m];
              if (d < 16) { const float* cs = p.ropeI + (size_t)row * 16 + (d >> 1); v = rope4(v, cs, cs + 8); }
              uint2 o; o.x = pack_h2(v[0], v[1]); o.y = pack_h2(v[2], v[3]);
              *(uint2*)(p.iqh + (size_t)row * 512 + col) = o; } }
    } else if (pn < 8) {
      u16* dst = (pn < 6) ? p.xbr : p.gate;
      const int cb = (pn & 1) * 256;
#pragma unroll
      for (int ai = 0; ai < 2; ++ai)
#pragma unroll
        for (int m = 0; m < 4; ++m) { const int row = rowb + ai * 128 + m * 16;
#pragma unroll
          for (int bj = 0; bj < 2; ++bj)
#pragma unroll
            for (int n = 0; n < 2; ++n) { const int col = cb + bj * 128 + colb + 16 * n;
              const pg8::f32x4 v = acc[ai][bj][m][n] * rs[ai][m];
              uint2 o; o.x = pack_bf2(v[0], v[1]); o.y = pack_bf2(v[2], v[3]);
              *(uint2*)(dst + (size_t)row * 512 + col) = o; } }
    } else if (pn == 8) {
      float ps[2][4];
#pragma unroll
      for (int ai = 0; ai < 2; ++ai)
#pragma unroll
        for (int m = 0; m < 4; ++m) { const int row = rowb + ai * 128 + m * 16;
#pragma unroll
          for (int n = 0; n < 2; ++n) { const int col = colb + 16 * n; const int h = col >> 5, j0 = col & 31;
            pg8::f32x4 v = acc[ai][0][m][n] * rs[ai][m];
            const float* cs = p.ropeA + (size_t)row * 32 + (j0 >> 1); v = rope4(v, cs, cs + 16);
            uint2 o; o.x = pack_bf2(v[0], v[1]); o.y = pack_bf2(v[2], v[3]);
            *(uint2*)(p.qcat + ((size_t)row * 4 + h) * 160 + 128 + j0) = o; }
          float s = 0.f;
#pragma unroll
          for (int n = 0; n < 2; ++n) { const pg8::f32x4 v = acc[ai][1][m][n] * rs[ai][m]; s += v[0] * v[0] + v[1] * v[1] + v[2] * v[2] + v[3] * v[3]; }
          s += __shfl_xor(s, 16, 64); s += __shfl_xor(s, 32, 64);
          ps[ai][m] = s;
          if (fq == 0) xch[(wr * 4 + wc) * 128 + ai * 64 + m * 16 + fr] = s; }
      asm volatile("s_waitcnt lgkmcnt(0)" ::: "memory");
      __builtin_amdgcn_s_barrier();
      asm volatile("" ::: "memory");
#pragma unroll
      for (int ai = 0; ai < 2; ++ai)
#pragma unroll
        for (int m = 0; m < 4; ++m) { const int row = rowb + ai * 128 + m * 16; const int rr = ai * 64 + m * 16 + fr;
          const float tot = xch[(wr * 4 + 0) * 128 + rr] + xch[(wr * 4 + 1) * 128 + rr] + xch[(wr * 4 + 2) * 128 + rr] + xch[(wr * 4 + 3) * 128 + rr];
          const float rk = rsqrtf(tot * (1.f / 128.f) + 1e-6f) * rs[ai][m];
#pragma unroll
          for (int n = 0; n < 2; ++n) { const int c = colb + 16 * n;
            const float4 g = *(const float4*)(p.g_kv + c);
            const pg8::f32x4 v = acc[ai][1][m][n] * rk;
            uint2 o; o.x = pack_bf2(v[0] * g.x, v[1] * g.y); o.y = pack_bf2(v[2] * g.z, v[3] * g.w);
            *(uint2*)(p.kv + (size_t)row * 160 + c) = o; } }
      (void)ps;
    } else {
#pragma unroll
      for (int ai = 0; ai < 2; ++ai)
#pragma unroll
        for (int m = 0; m < 4; ++m) { const int row = rowb + ai * 128 + m * 16;
#pragma unroll
          for (int n = 0; n < 2; ++n) { const int col = colb + 16 * n;
            pg8::f32x4 v = acc[ai][0][m][n] * rs[ai][m];
            if (col < 32) {
              const float* cs = p.ropeA + (size_t)row * 32 + (col >> 1); v = rope4(v, cs, cs + 16);
              uint2 o; o.x = pack_bf2(v[0], v[1]); o.y = pack_bf2(v[2], v[3]);
              *(uint2*)(p.kv + (size_t)row * 160 + 128 + col) = o;
            } else if (col < 96) { const int d = col - 32;
              if (d < 16) { const float* cs = p.ropeI + (size_t)row * 16 + (d >> 1); v = rope4(v, cs, cs + 8); }
              uint2 o; o.x = pack_h2(v[0], v[1]); o.y = pack_h2(v[2], v[3]);
              *(uint2*)(p.ikh + (size_t)row * 64 + d) = o;
            } else if (col < 104) {
              *(float4*)(p.iw + (size_t)row * 8 + (col - 96)) = make_float4(v[0], v[1], v[2], v[3]);
            } } }
    }
  }
};

__device__ void phase1_gemm1(const P& p, LAS unsigned char* lds, int wid_s) {
  pg8::Gemm g; g.A = p.xb16; g.Bt = p.W1t; g.M = T_TOK; g.N = N1; g.K = p.k1024;
  pg8::StaticOrder S; S.init(T_TOK, N1, gridDim.x, blockIdx.x);
  Epi1 E; E.p = p; E.xch = (LAS float*)(lds + pg8::STAGE_BYTES);
  pg8::gemm_phase<Epi1, pg8::StaticOrder>(lds, g, S, E, nullptr, wid_s);
  const int nidle = 3 * (int)gridDim.x - 640;
  if (nidle > 0 && (int)blockIdx.x >= (int)gridDim.x - nidle) {
    const int tid = mk_tid(wid_s), lane = tid & 63;
    const int iw = ((int)blockIdx.x - ((int)gridDim.x - nidle)) * 8 + wid_s, niw = nidle * 8;
    for (int row = iw; row < 2 * 16384; row += niw) peer_row_fp8(p, row, lane);
  } else if (nidle <= 0) {
    const int tid = mk_tid(wid_s), lane = tid & 63;
    for (int row = blockIdx.x * 8 + wid_s; row < 2 * 16384; row += gridDim.x * 8) peer_row_fp8(p, row, lane);
  }
}
#define SC_STRIDE 2052
#define L_MASK 131328
#define L_HIST 139520
#define L_CAND 147712
#define L_MISC 156160
#define L_MM 156416
#define KV_STRIDE 336
#define KV_TILE_BYTES (64 * KV_STRIDE)

__device__ __forceinline__ float sort2f_(unsigned u) { const unsigned b = (u & 0x80000000u) ? (u & 0x7FFFFFFFu) : ~u; return __uint_as_float(b); }
__device__ __forceinline__ unsigned f2sort(float f) { const unsigned u = __float_as_uint(f); return (u & 0x80000000u) ? ~u : (u | 0x80000000u); }

__device__ __forceinline__ void index_scores(const P& p, LAS unsigned char* lds, int b, int tq0, int nkt, int wid, int lane) {
  const int fr = lane & 15, g = lane >> 4;
  const size_t qtok = (size_t)b * SEQ + tq0 + fr;
  f16x8 Bq[8][2];
  float w[8];
#pragma unroll
  for (int h = 0; h < 8; ++h) {
#pragma unroll
    for (int ks = 0; ks < 2; ++ks) Bq[h][ks] = *(const f16x8*)(p.iqh + qtok * 512 + h * 64 + ks * 32 + g * 8);
    w[h] = p.iw[qtok * 8 + h];
  }
  LAS float* sc = (LAS float*)lds;
  float rmax = -INFINITY, rmin = INFINITY;
  const int tqme = tq0 + fr;
  for (int kt = wid; kt < nkt; kt += 8) {
    const size_t ktok = (size_t)b * SEQ + kt * 16 + fr;
    const f16x8 A0 = *(const f16x8*)(p.ikh + ktok * 64 + g * 8);
    const f16x8 A1 = *(const f16x8*)(p.ikh + ktok * 64 + 32 + g * 8);
    fx4 tot = {0.f, 0.f, 0.f, 0.f};
#pragma unroll
    for (int h = 0; h < 8; ++h) {
      fx4 d = {0.f, 0.f, 0.f, 0.f};
      d = __builtin_amdgcn_mfma_f32_16x16x32_f16(A0, Bq[h][0], d, 0, 0, 0);
      d = __builtin_amdgcn_mfma_f32_16x16x32_f16(A1, Bq[h][1], d, 0, 0, 0);
#pragma unroll
      for (int r = 0; r < 4; ++r) tot[r] += w[h] * fmaxf(d[r], 0.f);
    }
    LDS_ST_FX4(sc + fr * SC_STRIDE + kt * 16 + 4 * g, tot);
#pragma unroll
    for (int r = 0; r < 4; ++r) { const bool ok = (kt * 16 + 4 * g + r) <= tqme; rmax = fmaxf(rmax, ok ? tot[r] : -INFINITY); rmin = fminf(rmin, ok ? tot[r] : INFINITY); }
  }
  rmax = fmaxf(rmax, __shfl_xor(rmax, 16, 64)); rmax = fmaxf(rmax, __shfl_xor(rmax, 32, 64));
  rmin = fminf(rmin, __shfl_xor(rmin, 16, 64)); rmin = fminf(rmin, __shfl_xor(rmin, 32, 64));
  if (g == 0) {
    LAS unsigned* mm = (LAS unsigned*)(lds + L_MM);
    if (rmax != -INFINITY) __hip_atomic_fetch_max(mm + 2 * fr, f2sort(rmax), __ATOMIC_RELAXED, __HIP_MEMORY_SCOPE_WORKGROUP);
    if (rmin != INFINITY) __hip_atomic_fetch_min(mm + 2 * fr + 1, f2sort(rmin), __ATOMIC_RELAXED, __HIP_MEMORY_SCOPE_WORKGROUP);
  }
}

#define DPP_F(x, ctrl) __uint_as_float((unsigned)__builtin_amdgcn_update_dpp(0, (int)__float_as_uint(x), (ctrl), 0xF, 0xF, true))
#define DPP_I(x, ctrl) ((unsigned)__builtin_amdgcn_update_dpp(0, (int)(x), (ctrl), 0xF, 0xF, true))
__device__ __forceinline__ float wave_max_dpp(float x) {
  x = fmaxf(x, DPP_F(x, 0xB1)); x = fmaxf(x, DPP_F(x, 0x4E)); x = fmaxf(x, DPP_F(x, 0x141)); x = fmaxf(x, DPP_F(x, 0x140));
  const int xi = (int)__float_as_uint(x);
  const float a = __uint_as_float((unsigned)__builtin_amdgcn_readlane(xi, 0)), b = __uint_as_float((unsigned)__builtin_amdgcn_readlane(xi, 16));
  const float c = __uint_as_float((unsigned)__builtin_amdgcn_readlane(xi, 32)), d = __uint_as_float((unsigned)__builtin_amdgcn_readlane(xi, 48));
  return fmaxf(fmaxf(a, b), fmaxf(c, d));
}
__device__ __forceinline__ unsigned row16_sum_u32(unsigned x) { x += DPP_I(x, 0xB1); x += DPP_I(x, 0x4E); x += DPP_I(x, 0x141); x += DPP_I(x, 0x140); return x; }

__device__ __forceinline__ void select_row(LAS float* row, int tq, LAS unsigned* mrow, LAS unsigned* hist, LAS unsigned* cand, int lane, int sflags, LAS unsigned* mmq) {
  const int n = tq + 1;
  unsigned long long mybal = 0ull;
  if (n <= 256) {
#pragma unroll 4
    for (int j = 0; j < 32; ++j) {
      const unsigned long long bl = __ballot((j * 64 + lane) <= tq);
      if (lane == j) mybal = bl;
    }
  } else {
    const float vmax = sort2f_(mmq[0]), vmin = sort2f_(mmq[1]);
    const int njb = ((tq >> 6) + 16) & ~15;
    const float scale = (vmax > vmin) ? 255.5f / (vmax - vmin) : 0.f;
#pragma unroll
    for (int i = 0; i < 4; ++i) hist[lane * 4 + i] = 0u;
    if (lane == 0) cand[256] = 0u;
#pragma unroll 1
    for (int jb = 0; jb < njb; jb += 16) {
      float v[16];
#pragma unroll
      for (int j = 0; j < 16; ++j) v[j] = row[(jb + j) * 64 + lane];
#pragma unroll
      for (int j = 0; j < 16; ++j) {
        const bool ok = ((jb + j) * 64 + lane) <= tq;
        const int bk = ok ? min(255, (int)((v[j] - vmin) * scale)) : lane;
        __hip_atomic_fetch_add((LAS unsigned*)&hist[bk], ok ? 1u : 0u, __ATOMIC_RELAXED, __HIP_MEMORY_SCOPE_WAVEFRONT);
      }
    }
    asm volatile("s_waitcnt lgkmcnt(0)" ::: "memory");
    const unsigned h40 = hist[255 - 4 * lane], h41 = hist[254 - 4 * lane], h42 = hist[253 - 4 * lane], h43 = hist[252 - 4 * lane];
    const unsigned mine = h40 + h41 + h42 + h43;
    const unsigned rsum = row16_sum_u32(mine);
    int Bsel = 0; unsigned above = 0u;
    {
      unsigned run = 0u; int R = 0;
#pragma unroll
      for (int r = 0; r < 4; ++r) { const unsigned s = (unsigned)__builtin_amdgcn_readlane((int)rsum, r * 16); if (run + s < 256u && R == r) { run += s; R = r + 1; } }
      if (R > 3) R = 3;
      int L = R * 16;
#pragma unroll 1
      for (int i = 0; i < 16; ++i) { const unsigned s = (unsigned)__builtin_amdgcn_readlane((int)mine, L); if (run + s >= 256u) break; run += s; ++L; }
      if (L > R * 16 + 15) L = R * 16 + 15;
      const unsigned b0 = (unsigned)__builtin_amdgcn_readlane((int)h40, L), b1 = (unsigned)__builtin_amdgcn_readlane((int)h41, L), b2 = (unsigned)__builtin_amdgcn_readlane((int)h42, L);
      if (run + b0 >= 256u) { Bsel = 255 - 4 * L; }
      else { run += b0;
        if (run + b1 >= 256u) { Bsel = 254 - 4 * L; }
        else { run += b1;
          if (run + b2 >= 256u) { Bsel = 253 - 4 * L; }
          else { run += b2; Bsel = 252 - 4 * L; } } }
      above = run;
    }
    const unsigned need = 256u - above;
    if (sflags & 4) { if (lane < 32) { mrow[2 * lane] = need + Bsel; mrow[2 * lane + 1] = 0u; } return; }
    unsigned cmask = 0u;
#pragma unroll 1
    for (int jb = 0; jb < njb; jb += 16) {
      float v[16];
#pragma unroll
      for (int j = 0; j < 16; ++j) v[j] = row[(jb + j) * 64 + lane];
#pragma unroll
      for (int j = 0; j < 16; ++j) {
        const bool is = (((jb + j) * 64 + lane) <= tq) && (min(255, (int)((v[j] - vmin) * scale)) == Bsel);
        cmask |= is ? (1u << (jb + j)) : 0u;
      }
    }
    while (cmask) {
      const int j = __ffs((int)cmask) - 1; cmask &= cmask - 1u;
      const int key = j * 64 + lane;
      const unsigned pos = __hip_atomic_fetch_add((LAS unsigned*)&cand[256], 1u, __ATOMIC_RELAXED, __HIP_MEMORY_SCOPE_WAVEFRONT);
      if (pos < 128u) { cand[2 * pos] = f2sort(row[key]); cand[2 * pos + 1] = (unsigned)key; }
    }
    asm volatile("s_waitcnt lgkmcnt(0)" ::: "memory");
    const unsigned cnt = (unsigned)__builtin_amdgcn_readfirstlane((int)cand[256]);
    if (sflags & 8) { if (lane < 32) { mrow[2 * lane] = cnt; mrow[2 * lane + 1] = 0u; } return; }
    unsigned ustar = 0u, kstar = 0u;
    if (cnt <= 64u) {
      const unsigned mu = (lane < (int)cnt) ? cand[2 * lane] : 0u, mk = (lane < (int)cnt) ? cand[2 * lane + 1] : 0xFFFFFFFFu;
      unsigned rank = 0;
      for (unsigned q = 0; q < cnt; ++q) {
        const unsigned qu = (unsigned)__builtin_amdgcn_readlane((int)mu, q), qk = (unsigned)__builtin_amdgcn_readlane((int)mk, q);
        rank += (qu > mu || (qu == mu && qk < mk)) ? 1u : 0u;
      }
      const unsigned long long fb = __ballot(lane < (int)cnt && rank == need - 1u);
      const int fl = __ffsll((long long)fb) - 1;
      ustar = (unsigned)__builtin_amdgcn_readlane((int)mu, fl); kstar = (unsigned)__builtin_amdgcn_readlane((int)mk, fl);
    } else if (cnt <= 128u) {
      unsigned fu = 0u, fk = 0u; int found = 0;
      for (unsigned base = 0; base < cnt; base += 64) {
        const unsigned i = base + lane;
        const unsigned mu = (i < cnt) ? cand[2 * i] : 0u, mk = (i < cnt) ? cand[2 * i + 1] : 0u;
        unsigned rank = 0;
#pragma unroll 4
        for (unsigned q = 0; q < cnt; ++q) { const unsigned qu = cand[2 * q], qk = cand[2 * q + 1]; rank += (qu > mu || (qu == mu && qk < mk)) ? 1u : 0u; }
        if (i < cnt && rank == need - 1u) { fu = mu; fk = mk; found = 1; }
      }
      const unsigned long long fb = __ballot(found);
      const int fl = __ffsll((long long)fb) - 1;
      ustar = (unsigned)__shfl((int)fu, fl, 64); kstar = (unsigned)__shfl((int)fk, fl, 64);
    } else {
      const int nj = (tq >> 6) + 1;
      unsigned prefix = 0u; unsigned needr = need;
      for (int bit = 31; bit >= 0; --bit) {
        const unsigned trial = prefix | (1u << bit);
        unsigned c = 0;
        for (int j = 0; j < nj; ++j) {
          const int key = j * 64 + lane;
          const float x = row[key];
          const bool inb = (key <= tq) && (min(255, (int)((x - vmin) * scale)) == Bsel);
          c += __popcll(__ballot(inb && (f2sort(x) >> bit) == (trial >> bit)));
        }
        if (c >= needr) prefix = trial; else needr -= c;
      }
      ustar = prefix;
      unsigned seen = 0; int done = 0;
      for (int j = 0; j < nj; ++j) {
        const int key = j * 64 + lane;
        const float x = row[key];
        const unsigned long long bl = __ballot((key <= tq) && f2sort(x) == ustar);
        const unsigned c = __popcll(bl);
        if (!done && seen + c >= needr) {
          unsigned long long m = bl; const unsigned k = needr - seen;
          int pos = 0;
          for (unsigned q = 0; q < k; ++q) { pos = __ffsll((long long)m) - 1; m &= m - 1ull; }
          kstar = (unsigned)(j * 64 + pos); done = 1;
        }
        seen += c;
      }
    }
#pragma unroll 1
    for (int jb = 0; jb < njb; jb += 16) {
      float v[16];
#pragma unroll
      for (int j = 0; j < 16; ++j) v[j] = row[(jb + j) * 64 + lane];
#pragma unroll
      for (int j = 0; j < 16; ++j) {
        const int key = (jb + j) * 64 + lane;
        const unsigned uu = f2sort(v[j]);
        const bool s = (key <= tq) && (uu > ustar || (uu == ustar && (unsigned)key <= kstar));
        const unsigned long long bl = __ballot(s);
        if (lane == jb + j) mybal = bl;
      }
    }
  }
  if (lane < 32) { mrow[2 * lane] = (unsigned)mybal; mrow[2 * lane + 1] = (unsigned)(mybal >> 32); }
}

__device__ __forceinline__ void attn_block(const P& p, LAS unsigned char* lds, int b, int t0, int wid, int lane, int tid) {
  const int fr = lane & 15, g = lane >> 4;
  const int h = wid >> 1, qs = wid & 1;
  const size_t qtok = (size_t)b * SEQ + t0 + qs * 16 + fr;
  s16x8 Qf[5];
#pragma unroll
  for (int ks = 0; ks < 5; ++ks) Qf[ks] = *(const s16x8*)(p.qcat + (qtok * 4 + h) * 160 + ks * 32 + g * 8);
  const int ntile = (t0 + 32 + 63) >> 6;
  const u16* kvb = p.kv + (size_t)b * SEQ * 160;
  LAS unsigned* mrow = (LAS unsigned*)(lds + L_MASK) + (qs * 16 + fr) * 64;
  fx4 O[8];
#pragma unroll
  for (int i = 0; i < 8; ++i) O[i] = (fx4){0.f, 0.f, 0.f, 0.f};
  float m_run = -INFINITY, l_run = 0.f;
  uint4 st0 = make_uint4(0, 0, 0, 0), st1 = st0, st2 = st0;
  const int c0i = tid, c1i = tid + 512, c2i = tid + 1024;
  const int lo0 = (c0i / 20) * KV_STRIDE + (c0i % 20) * 16, lo1 = (c1i / 20) * KV_STRIDE + (c1i % 20) * 16, lo2 = (c2i / 20) * KV_STRIDE + (c2i % 20) * 16;
#define G_LOAD(kt_) do { const uint4* src_ = (const uint4*)(kvb + (size_t)(kt_) * 64 * 160); st0 = src_[c0i]; st1 = src_[c1i]; if (c2i < 1280) st2 = src_[c2i]; } while (0)
#define L_STORE(buf_) do { LAS unsigned char* d_ = lds + (buf_) * KV_TILE_BYTES; LDS_STORE(uint4, d_ + lo0, st0); LDS_STORE(uint4, d_ + lo1, st1); if (c2i < 1280) LDS_STORE(uint4, d_ + lo2, st2); } while (0)
  G_LOAD(0); L_STORE(0);
  __syncthreads();
  for (int kt = 0; kt < ntile; ++kt) {
    const int buf = kt & 1;
    if (kt + 1 < ntile) G_LOAD(kt + 1);
    LAS unsigned char* kb = lds + buf * KV_TILE_BYTES;
#pragma unroll
    for (int ksub = 0; ksub < 2; ++ksub) {
      fx4 S[2];
#pragma unroll
      for (int sub = 0; sub < 2; ++sub) {
        fx4 a = {0.f, 0.f, 0.f, 0.f};
        const int krow = ksub * 32 + sub * 16 + fr;
#pragma unroll
        for (int ks = 0; ks < 5; ++ks) {
          const s16x8 Kf = *(LAS s16x8*)(kb + krow * KV_STRIDE + ks * 64 + g * 16);
          a = __builtin_amdgcn_mfma_f32_16x16x32_bf16(Kf, Qf[ks], a, 0, 0, 0);
        }
        S[sub] = a;
      }
      const unsigned mw = mrow[kt * 2 + ksub];
      float mx = -INFINITY;
#pragma unroll
      for (int sub = 0; sub < 2; ++sub)
#pragma unroll
        for (int r = 0; r < 4; ++r) { const int bit = sub * 16 + 4 * g + r; const float s = ((mw >> bit) & 1u) ? S[sub][r] : -INFINITY; S[sub][r] = s; mx = fmaxf(mx, s); }
      mx = fmaxf(mx, __shfl_xor(mx, 16, 64)); mx = fmaxf(mx, __shfl_xor(mx, 32, 64));
      const float m_new = fmaxf(m_run, mx);
      const float m_use = (m_new == -INFINITY) ? 0.f : m_new;
      const float alpha = __builtin_amdgcn_exp2f(m_run - m_use);
      const bool resc = __any(m_new != m_run);
      m_run = m_new;
      float psum = 0.f;
      s16x8 Pf;
#pragma unroll
      for (int sub = 0; sub < 2; ++sub)
#pragma unroll
        for (int r = 0; r < 4; ++r) { const float pv = __builtin_amdgcn_exp2f(S[sub][r] - m_use); psum += pv; Pf[sub * 4 + r] = (short)f2bf(pv); }
      l_run = l_run * alpha + psum;
      if (resc) {
#pragma unroll
        for (int i = 0; i < 8; ++i) O[i] *= alpha;
      }
      const int q4 = fr >> 2, p4 = fr & 3;
      LAS unsigned char* vb0 = kb + (ksub * 32 + 4 * g + q4) * KV_STRIDE + p4 * 8;
#pragma unroll
      for (int dvt = 0; dvt < 8; ++dvt) {
        const s16x4 v0 = __builtin_amdgcn_ds_read_tr16_b64_v4i16((LAS s16x4*)(vb0 + dvt * 32));
        const s16x4 v1 = __builtin_amdgcn_ds_read_tr16_b64_v4i16((LAS s16x4*)(vb0 + 16 * KV_STRIDE + dvt * 32));
        s16x8 Vf; Vf[0] = v0[0]; Vf[1] = v0[1]; Vf[2] = v0[2]; Vf[3] = v0[3]; Vf[4] = v1[0]; Vf[5] = v1[1]; Vf[6] = v1[2]; Vf[7] = v1[3];
        O[dvt] = __builtin_amdgcn_mfma_f32_16x16x32_bf16(Vf, Pf, O[dvt], 0, 0, 0);
      }
    }
    if (kt + 1 < ntile) L_STORE(buf ^ 1);
    __syncthreads();
  }
  float l_tot = l_run + __shfl_xor(l_run, 16, 64); l_tot += __shfl_xor(l_tot, 32, 64);
  const float inv = 1.f / l_tot;
  u16* dst = p.mix + qtok * 1024 + h * 128 + 4 * g;
#pragma unroll
  for (int dvt = 0; dvt < 8; ++dvt) {
    uint2 o; o.x = pack_bf2(O[dvt][0] * inv, O[dvt][1] * inv); o.y = pack_bf2(O[dvt][2] * inv, O[dvt][3] * inv);
    *(uint2*)(dst + dvt * 16) = o;
  }
}

#define LR_XCB 0
#define LR_XCF 18432
#define LR_A   51200
#define LR_B   83968
#define LR_SEG 116736
__device__ void lru_item(const P& p, LAS unsigned char* lds, int b, int blk, int tid) {
  const int lane = tid & 63, wid = tid >> 6, fr = lane & 15, g = lane >> 4;
  LAS u16* xcb = (LAS u16*)(lds + LR_XCB);
  LAS float* xcf = (LAS float*)(lds + LR_XCF);
  LAS float* a_s = (LAS float*)(lds + LR_A);
  LAS float* b_s = (LAS float*)(lds + LR_B);
  LAS float* segP = (LAS float*)(lds + LR_SEG);
  LAS float* segH = segP + 512;
  LAS float* carry = segH + 512;
  LAS float* Hprev = carry + 512;
  LAS float* cw = Hprev + 64;
  LAS float* cb = cw + 256;
  const int c0 = blk * 64;
  if (tid < 256) cw[tid] = p.conv_w[(tid >> 6) * 512 + c0 + (tid & 63)];
  if (tid < 64) { cb[tid] = p.conv_b[c0 + tid]; Hprev[tid] = 0.f; }
  float brg[4], big[4], spl[4];
#pragma unroll
  for (int nt = 0; nt < 4; ++nt) {
    const int c = c0 + nt * 16 + fr;
    brg[nt] = p.b_rg[c]; big[nt] = p.b_ig[c];
    const float l = p.lam[c];
    spl[nt] = (-l > 20.f) ? -l : log1pf(__expf(-l));
  }
  const u16* wrg = p.WrgT + (size_t)blk * 4096 + fr * 64 + g * 8;
  const u16* wig = p.WigT + (size_t)blk * 4096 + fr * 64 + g * 8;
  __syncthreads();
  const int tok_l = tid >> 2, cg = tid & 3;
  uint4 xr[4][2];
  const u16* xbase = p.xbr + (size_t)b * SEQ * 512 + c0 + cg * 16;
#define LRU_LOADX(S0) do { _Pragma("unroll") for (int w = 0; w < 4; ++w) { const int ss = (S0) + tok_l - 3 + w; \
      if (ss >= 0) { const uint4* src = (const uint4*)(xbase + (size_t)ss * 512); xr[w][0] = src[0]; xr[w][1] = src[1]; } \
      else { xr[w][0] = make_uint4(0, 0, 0, 0); xr[w][1] = xr[w][0]; } } } while (0)
  LRU_LOADX(0);
  for (int s0 = 0; s0 < SEQ; s0 += 128) {
    {
      float acc[16];
      { const fx4 b0 = *(LAS fx4*)(cb + cg * 16), b1 = *(LAS fx4*)(cb + cg * 16 + 4), b2 = *(LAS fx4*)(cb + cg * 16 + 8), b3 = *(LAS fx4*)(cb + cg * 16 + 12);
        acc[0] = b0[0]; acc[1] = b0[1]; acc[2] = b0[2]; acc[3] = b0[3]; acc[4] = b1[0]; acc[5] = b1[1]; acc[6] = b1[2]; acc[7] = b1[3];
        acc[8] = b2[0]; acc[9] = b2[1]; acc[10] = b2[2]; acc[11] = b2[3]; acc[12] = b3[0]; acc[13] = b3[1]; acc[14] = b3[2]; acc[15] = b3[3]; }
#pragma unroll
      for (int w = 0; w < 4; ++w) {
        const unsigned uu[8] = {xr[w][0].x, xr[w][0].y, xr[w][0].z, xr[w][0].w, xr[w][1].x, xr[w][1].y, xr[w][1].z, xr[w][1].w};
#pragma unroll
        for (int q = 0; q < 4; ++q) { const fx4 wv = *(LAS fx4*)(cw + w * 64 + cg * 16 + 4 * q);
          acc[4 * q] += bflo(uu[2 * q]) * wv[0]; acc[4 * q + 1] += bfhi(uu[2 * q]) * wv[1]; acc[4 * q + 2] += bflo(uu[2 * q + 1]) * wv[2]; acc[4 * q + 3] += bfhi(uu[2 * q + 1]) * wv[3]; }
      }
#pragma unroll
      for (int i = 0; i < 16; i += 4) { const fx4 t4 = {acc[i], acc[i + 1], acc[i + 2], acc[i + 3]}; LDS_ST_FX4(xcf + tok_l * 64 + cg * 16 + i, t4); }
#pragma unroll
      for (int i = 0; i < 16; i += 4) { uint2 o; o.x = pack_bf2(acc[i], acc[i + 1]); o.y = pack_bf2(acc[i + 2], acc[i + 3]); LDS_STORE(uint2, xcb + tok_l * 72 + cg * 16 + i, o); }
    }
    const size_t t = (size_t)b * SEQ + s0 + tok_l;
    const uint4* gsrc = (const uint4*)(p.gate + t * 512 + c0 + cg * 16);
    const uint4 g0 = gsrc[0], g1 = gsrc[1];
    if (s0 + 128 < SEQ) LRU_LOADX(s0 + 128);
    __syncthreads();
    {
      const s16x8 A0 = *(LAS s16x8*)(xcb + (wid * 16 + fr) * 72 + g * 8);
      const s16x8 A1 = *(LAS s16x8*)(xcb + (wid * 16 + fr) * 72 + 32 + g * 8);
#pragma unroll
      for (int nt = 0; nt < 4; ++nt) {
        fx4 R = {0.f, 0.f, 0.f, 0.f}, I = {0.f, 0.f, 0.f, 0.f};
        const s16x8 br0 = *(const s16x8*)(wrg + nt * 1024), br1 = *(const s16x8*)(wrg + nt * 1024 + 32);
        const s16x8 bi0 = *(const s16x8*)(wig + nt * 1024), bi1 = *(const s16x8*)(wig + nt * 1024 + 32);
        R = __builtin_amdgcn_mfma_f32_16x16x32_bf16(A0, br0, R, 0, 0, 0);
        R = __builtin_amdgcn_mfma_f32_16x16x32_bf16(A1, br1, R, 0, 0, 0);
        I = __builtin_amdgcn_mfma_f32_16x16x32_bf16(A0, bi0, I, 0, 0, 0);
        I = __builtin_amdgcn_mfma_f32_16x16x32_bf16(A1, bi1, I, 0, 0, 0);
#pragma unroll
        for (int r = 0; r < 4; ++r) {
          const int tok = wid * 16 + 4 * g + r, o = nt * 16 + fr;
          const float rr = sigmoidf_(R[r] + brg[nt]), ii = sigmoidf_(I[r] + big[nt]);
          const float log_a = -8.f * rr * spl[nt];
          const float a = __builtin_amdgcn_exp2f(1.4426950408889634f * log_a);
          const float bb = __builtin_amdgcn_sqrtf(fmaxf(1.f - a * a, 0.f)) * (ii * xcf[tok * 64 + o]);
          a_s[tok * 64 + o] = a; b_s[tok * 64 + o] = bb;
        }
      }
    }
    __syncthreads();
    {
      float av[16], bv[16];
#pragma unroll
      for (int i = 0; i < 16; ++i) { av[i] = a_s[(wid * 16 + i) * 64 + lane]; bv[i] = b_s[(wid * 16 + i) * 64 + lane]; }
      float hh = 0.f, pp = 1.f;
#pragma unroll
      for (int i = 0; i < 16; ++i) { hh = av[i] * hh + bv[i]; pp *= av[i]; bv[i] = hh; av[i] = pp; }
#pragma unroll
      for (int i = 0; i < 16; ++i) { b_s[(wid * 16 + i) * 64 + lane] = bv[i]; a_s[(wid * 16 + i) * 64 + lane] = av[i]; }
      segP[wid * 64 + lane] = pp; segH[wid * 64 + lane] = hh;
    }
    __syncthreads();
    if (tid < 64) {
      float sp_[8], sh_[8];
#pragma unroll
      for (int sg = 0; sg < 8; ++sg) { sp_[sg] = segP[sg * 64 + tid]; sh_[sg] = segH[sg * 64 + tid]; }
      float c = Hprev[tid];
#pragma unroll
      for (int sg = 0; sg < 8; ++sg) { carry[sg * 64 + tid] = c; c = sp_[sg] * c + sh_[sg]; }
      Hprev[tid] = c;
    }
    __syncthreads();
    {
      const unsigned gg[8] = {g0.x, g0.y, g0.z, g0.w, g1.x, g1.y, g1.z, g1.w};
      unsigned oo[8];
#pragma unroll
      for (int q = 0; q < 4; ++q) {
        const int o0 = cg * 16 + 4 * q;
        const fx4 cr = *(LAS fx4*)(carry + (tok_l >> 4) * 64 + o0), hl = *(LAS fx4*)(b_s + tok_l * 64 + o0), pl = *(LAS fx4*)(a_s + tok_l * 64 + o0);
        const float h0 = hl[0] + pl[0] * cr[0], h1 = hl[1] + pl[1] * cr[1], h2 = hl[2] + pl[2] * cr[2], h3 = hl[3] + pl[3] * cr[3];
        oo[2 * q] = pack_bf2(h0 * gelu_tanh_f(bflo(gg[2 * q])), h1 * gelu_tanh_f(bfhi(gg[2 * q])));
        oo[2 * q + 1] = pack_bf2(h2 * gelu_tanh_f(bflo(gg[2 * q + 1])), h3 * gelu_tanh_f(bfhi(gg[2 * q + 1])));
      }
      uint4* dst = (uint4*)(p.mix + t * 1024 + 512 + c0 + cg * 16);
      dst[0] = make_uint4(oo[0], oo[1], oo[2], oo[3]); dst[1] = make_uint4(oo[4], oo[5], oo[6], oo[7]);
    }
    __syncthreads();
  }
#undef LRU_LOADX
}

__device__ void phase2(const P& p, LAS unsigned char* lds, int wid_s) {
  const int tid = mk_tid(wid_s), lane = tid & 63, wid = tid >> 6;
  LAS int* misc = (LAS int*)(lds + L_MISC);
  const int flags = p.pad0;
  if (!(flags & 1) && blockIdx.x < 64) lru_item(p, lds, blockIdx.x >> 3, blockIdx.x & 7, tid);
  if (flags & 2) return;
  for (;;) {
    __syncthreads();
    if (tid == 0) misc[0] = (int)atomicAdd(p.ctr, 1u);
    __syncthreads();
    const int a = misc[0];
    if (a >= 512) break;
    const int qb = 63 - (a >> 3), b = a & 7;
    const int t0 = qb * 32;
    for (int r = 0; r < 2; ++r) {
      const int tq0 = t0 + 16 * r;
      if (tid < 16) { LAS unsigned* mm = (LAS unsigned*)(lds + L_MM); mm[2 * tid] = 0u; mm[2 * tid + 1] = 0xFFFFFFFFu; }
      __syncthreads();
      if (!(flags & 16)) index_scores(p, lds, b, tq0, (tq0 >> 4) + 1, wid, lane);
      __syncthreads();
#pragma unroll 1
      for (int qq = 0; qq < ((flags & 4) ? 0 : 2); ++qq) {
        const int qi = wid * 2 + qq;
        select_row((LAS float*)lds + qi * SC_STRIDE, tq0 + qi, (LAS unsigned*)(lds + L_MASK) + (r * 16 + qi) * 64,
                   (LAS unsigned*)(lds + L_HIST) + wid * 256, (LAS unsigned*)(lds + L_CAND) + wid * 260, lane, p.pad1, (LAS unsigned*)(lds + L_MM) + 2 * qi);
      }
      __syncthreads();
    }
    if (!(flags & 8)) attn_block(p, lds, b, t0, wid, lane, tid);
  }
}
struct Epi3 {
  static constexpr bool PERM = false, AFTER_DRAIN = false;
  P p;
  __device__ __forceinline__ void operator()(const pg8::f32x4 (&acc)[2][2][4][2], const pg8::Unit& u, int wr, int wc, int fr_in, int fq_in) const {
    int fr = fr_in, fq = fq_in; asm volatile("" : "+v"(fr), "+v"(fq));
    const int rowb = u.pm * 256 + wr * 64 + fr;
    const int colb = u.pn * 256 + wc * 32 + 4 * fq;
#pragma unroll
    for (int ai = 0; ai < 2; ++ai)
#pragma unroll
      for (int m = 0; m < 4; ++m) { const int row = rowb + ai * 128 + m * 16;
        float s = 0.f;
#pragma unroll
        for (int bj = 0; bj < 2; ++bj)
#pragma unroll
          for (int n = 0; n < 2; ++n) { const int col = colb + bj * 128 + 16 * n;
            const float4 xr = *(const float4*)(p.x + (size_t)row * DM + col);
            const pg8::f32x4 a = acc[ai][bj][m][n];
            const float v0 = a[0] + xr.x, v1 = a[1] + xr.y, v2 = a[2] + xr.z, v3 = a[3] + xr.w;
            s += v0 * v0 + v1 * v1 + v2 * v2 + v3 * v3;
            uint2 o; o.x = pack_bf2(v0, v1); o.y = pack_bf2(v2, v3);
            *(uint2*)(p.x1b + (size_t)row * DM + col) = o; }
        s += __shfl_xor(s, 16, 64); s += __shfl_xor(s, 32, 64);
        if (fq == 0) atomicAdd(p.ss_ffn + row, s); }
  }
};
__device__ void phase3_outproj(const P& p, LAS unsigned char* lds, int wid_s) {
  pg8::Gemm g; g.A = p.mix; g.Bt = p.WoutT; g.M = T_TOK; g.N = 1024; g.K = p.k1024;
  pg8::StaticOrder S; S.init(T_TOK, 1024, gridDim.x, blockIdx.x);
  Epi3 E; E.p = p;
  pg8::gemm_phase<Epi3, pg8::StaticOrder>(lds, g, S, E, nullptr, wid_s);
}
struct Epi4 {
  static constexpr bool PERM = false, AFTER_DRAIN = false;
  P p;
  __device__ __forceinline__ void operator()(const pg8::f32x4 (&acc)[2][2][4][2], const pg8::Unit& u, int wr, int wc, int fr_in, int fq_in) const {
    int fr = fr_in, fq = fq_in; asm volatile("" : "+v"(fr), "+v"(fq));
    const int rowb = u.pm * 256 + wr * 64 + fr;
    const int colb = u.pn * 256 + wc * 32 + 4 * fq;
#pragma unroll
    for (int ai = 0; ai < 2; ++ai)
#pragma unroll
      for (int m = 0; m < 4; ++m) { const int row = rowb + ai * 128 + m * 16;
        const float rs = rsqrtf(p.ss_ffn[row] * (1.f / DM) + 1e-6f);
#pragma unroll
        for (int bj = 0; bj < 2; ++bj)
#pragma unroll
          for (int n = 0; n < 2; ++n) { const int col = colb + bj * 128 + 16 * n;
            const pg8::f32x4 v = acc[ai][bj][m][n] * rs;
            uint2 o; o.x = pack_bf2(v[0], v[1]); o.y = pack_bf2(v[2], v[3]);
            *(uint2*)(p.pq + (size_t)row * 2048 + col) = o; } }
  }
};
__device__ void phase4_pq(const P& p, LAS unsigned char* lds, int wid_s) {
  pg8::Gemm g; g.A = p.x1b; g.Bt = p.WpqT; g.M = T_TOK; g.N = 2048; g.K = p.k1024;
  pg8::StaticOrder S; S.init(T_TOK, 2048, gridDim.x, blockIdx.x);
  Epi4 E; E.p = p;
  pg8::gemm_phase<Epi4, pg8::StaticOrder>(lds, g, S, E, nullptr, wid_s);
}

#ifdef USE_SHFL_ROW
__device__ __forceinline__ unsigned row16_max_u32(unsigned x) {
  x = max(x, (unsigned)__shfl_xor((int)x, 1, 64)); x = max(x, (unsigned)__shfl_xor((int)x, 2, 64));
  x = max(x, (unsigned)__shfl_xor((int)x, 4, 64)); x = max(x, (unsigned)__shfl_xor((int)x, 8, 64)); return x; }
__device__ __forceinline__ float row16_sum_f32(float x) {
  x += __shfl_xor(x, 1, 64); x += __shfl_xor(x, 2, 64); x += __shfl_xor(x, 4, 64); x += __shfl_xor(x, 8, 64); return x; }
#else
#define DPP_U(x, ctrl) ((unsigned)__builtin_amdgcn_update_dpp(0, (int)(x), (ctrl), 0xF, 0xF, true))
__device__ __forceinline__ unsigned row16_max_u32(unsigned x) {
  x = max(x, DPP_U(x, 0xB1)); x = max(x, DPP_U(x, 0x4E)); x = max(x, DPP_U(x, 0x141)); x = max(x, DPP_U(x, 0x140)); return x; }
__device__ __forceinline__ float row16_sum_f32(float x) {
  x += __uint_as_float(DPP_U(__float_as_uint(x), 0xB1)); x += __uint_as_float(DPP_U(__float_as_uint(x), 0x4E));
  x += __uint_as_float(DPP_U(__float_as_uint(x), 0x141)); x += __uint_as_float(DPP_U(__float_as_uint(x), 0x140)); return x; }
#endif
__device__ __forceinline__ float sort2f(unsigned u) { const unsigned b = (u & 0x80000000u) ? (u & 0x7FFFFFFFu) : ~u; return __uint_as_float(b); }

#define RT_KOFF 8192
#define RT_KSTR 136
__device__ void phase4b_route(const P& p, LAS unsigned char* lds, int wid_s) {
  const int tid = mk_tid(wid_s), lane = tid & 63, wid = tid >> 6, fr = lane & 15, g = lane >> 4;
  LAS unsigned* topk = (LAS unsigned*)lds;
  LAS u16* kimg = (LAS u16*)(lds + RT_KOFF);
  pg8::StaticOrder S; S.init(T_TOK, 2048, gridDim.x, blockIdx.x);
  int hloaded = -1;
  for (int item = 0; item < 64; ++item) {
    pg8::Unit un; if (!S.next(item >> 2, un)) break;
    const int h = un.pn, tile = un.pm * 4 + (item & 3);
    const int tok0 = tile * 64;
    if (h != hloaded) {
      __syncthreads();
      for (int i = tid; i < 2 * 128 * 16; i += 512) { const int side = i >> 11, r = (i >> 4) & 127, c = i & 15;
        const uint4 v = *(const uint4*)((side ? p.K2b : p.K1b) + (size_t)h * 16384 + r * 128 + c * 8);
        LDS_STORE(uint4, kimg + (side * 128 + r) * RT_KSTR + c * 8, v); }
      hloaded = h;
      __syncthreads();
    }
    {
      const int side = wid & 1, mt = wid >> 1;
      const size_t tok = (size_t)tok0 + mt * 16 + fr;
      const u16* qa = p.pq + tok * 2048 + h * 256 + side * 128 + g * 8;
      s16x8 A[4];
#pragma unroll
      for (int ks = 0; ks < 4; ++ks) A[ks] = *(const s16x8*)(qa + ks * 32);
      LAS u16* kb = kimg + (side * 128 + fr) * RT_KSTR + g * 8;
      unsigned val[8][4];
#pragma unroll
      for (int nt = 0; nt < 8; ++nt) {
        fx4 acc = {0.f, 0.f, 0.f, 0.f};
#pragma unroll
        for (int ks = 0; ks < 4; ++ks) {
          const s16x8 B = *(LAS s16x8*)(kb + nt * 16 * RT_KSTR + ks * 32);
          acc = __builtin_amdgcn_mfma_f32_16x16x32_bf16(A[ks], B, acc, 0, 0, 0);
        }
        const unsigned tag = 127u - (unsigned)(nt * 16 + fr);
#pragma unroll
        for (int r = 0; r < 4; ++r) val[nt][r] = (f2sort(acc[r]) & ~0x7Fu) | tag;
      }
#define CE(a, b) do { const unsigned hi_ = max(a, b), lo_ = min(a, b); a = hi_; b = lo_; } while (0)
#pragma unroll
      for (int r = 0; r < 4; ++r) {
        CE(val[0][r], val[1][r]); CE(val[2][r], val[3][r]); CE(val[4][r], val[5][r]); CE(val[6][r], val[7][r]);
        CE(val[0][r], val[2][r]); CE(val[1][r], val[3][r]); CE(val[4][r], val[6][r]); CE(val[5][r], val[7][r]);
        CE(val[1][r], val[2][r]); CE(val[5][r], val[6][r]);
        CE(val[0][r], val[4][r]); CE(val[1][r], val[5][r]); CE(val[2][r], val[6][r]); CE(val[3][r], val[7][r]);
        CE(val[2][r], val[4][r]); CE(val[3][r], val[5][r]);
        CE(val[1][r], val[2][r]); CE(val[3][r], val[4][r]); CE(val[5][r], val[6][r]);
      }
#undef CE
      unsigned mine[4] = {0u, 0u, 0u, 0u};
#pragma unroll 1
      for (int i = 0; i < 16; ++i) {
        unsigned m[4];
#pragma unroll
        for (int r = 0; r < 4; ++r) m[r] = max(val[0][r], DPP_U(val[0][r], 0xB1));
#pragma unroll
        for (int r = 0; r < 4; ++r) m[r] = max(m[r], DPP_U(m[r], 0x4E));
#pragma unroll
        for (int r = 0; r < 4; ++r) m[r] = max(m[r], DPP_U(m[r], 0x141));
#pragma unroll
        for (int r = 0; r < 4; ++r) m[r] = max(m[r], DPP_U(m[r], 0x140));
#pragma unroll
        for (int r = 0; r < 4; ++r) {
          const bool win = (val[0][r] == m[r]);
#pragma unroll
          for (int q = 0; q < 7; ++q) val[q][r] = win ? val[q + 1][r] : val[q][r];
          val[7][r] = win ? 0u : val[7][r];
          if (fr == i) mine[r] = m[r];
        }
      }
#pragma unroll
      for (int r = 0; r < 4; ++r) topk[((mt * 16 + 4 * g + r) * 2 + side) * 16 + fr] = mine[r];
    }
    __syncthreads();
#pragma unroll 1
    for (int rd = 0; rd < 2; ++rd) {
      const int tl = wid * 8 + rd * 4 + g;
      LAS unsigned* t1 = topk + (tl * 2 + 0) * 16;
      LAS unsigned* t2 = topk + (tl * 2 + 1) * 16;
      unsigned cv[4];
#pragma unroll
      for (int j = 0; j < 4; ++j) {
        const int s = fr + 16 * j;
        int a, bb;
        if (s < 16) { a = 0; bb = s; } else if (s < 24) { a = 1; bb = s - 16; } else if (s < 29) { a = 2; bb = s - 24; } else if (s < 33) { a = 3; bb = s - 29; }
        else if (s < 36) { a = 4; bb = s - 33; } else if (s < 38) { a = 5; bb = s - 36; } else if (s < 40) { a = 6; bb = s - 38; } else if (s < 42) { a = 7; bb = s - 40; }
        else if (s < 50) { a = 8 + (s - 42); bb = 0; } else { a = -1; bb = 0; }
        unsigned key = 0u;
        if (a >= 0) {
          const float sum = sort2f(t1[a] & ~0x7Fu) + sort2f(t2[bb] & ~0x7Fu);
          key = (f2sort(sum) & ~0xFFu) | (unsigned)(255 - (a * 16 + bb));
        }
        cv[j] = key;
      }
      unsigned mine = 0u;
#pragma unroll 1
      for (int i = 0; i < 16; ++i) {
        unsigned m = max(max(cv[0], cv[1]), max(cv[2], cv[3]));
        m = row16_max_u32(m);
#pragma unroll
        for (int j = 0; j < 4; ++j) cv[j] = (cv[j] == m) ? 0u : cv[j];
        if (fr == i) mine = m;
      }
      const int flat = 255 - (int)(mine & 0xFFu);
      const int a = flat >> 4, bb = flat & 15;
      const unsigned k1 = t1[a], k2 = t2[bb];
      const float sum = sort2f(k1 & ~0x7Fu) + sort2f(k2 & ~0x7Fu);
      const unsigned m0 = (unsigned)__shfl((int)mine, lane & 48, 64);
      const int f0 = 255 - (int)(m0 & 0xFFu);
      const float s0 = sort2f(t1[f0 >> 4] & ~0x7Fu) + sort2f(t2[f0 & 15] & ~0x7Fu);
      const float ex = __expf(sum - s0);
      const float den = row16_sum_f32(ex);
      const int e = (127 - (int)(k1 & 0x7Fu)) * 128 + (127 - (int)(k2 & 0x7Fu));
      const size_t t = (size_t)tok0 + tl;
      p.experts[t * 128 + h * 16 + fr] = e;
      p.gates[t * 128 + h * 16 + fr] = ex / den;
    }
    __syncthreads();
  }
}
#define FP8_LO(w) __builtin_amdgcn_cvt_pk_f32_fp8((int)(w), false)
#define FP8_HI(w) __builtin_amdgcn_cvt_pk_f32_fp8((int)(w), true)
#define P5_LIST_WORDS (4 * 128 * 3)
#define P5_WAVE_WORDS (P5_LIST_WORDS + 128)
__device__ __forceinline__ float gelu_erf_fast(float v) {
  const float av = fabsf(v), t = __builtin_amdgcn_rcpf(av * 0.2316418882f + 1.0f);
  float q = t * 0.5307027145f + (-0.7265760135f); q = q * t + 0.7107068705f; q = q * t + (-0.142248368f); q = q * t + 0.127414796f; q = q * t;
  const float e = __builtin_amdgcn_exp2f((v * v) * (-0.72134752044f));
  const float m = v * (q * e);
  return v < 0.f ? m : v - m;
}
__device__ __forceinline__ float dot16_fp8(const uint4 r, const float (&h)[16]) {
  fx2 a; float d;
  a = FP8_LO(r.x); d = a.x * h[0] + a.y * h[1]; a = FP8_HI(r.x); d += a.x * h[2] + a.y * h[3];
  a = FP8_LO(r.y); d += a.x * h[4] + a.y * h[5]; a = FP8_HI(r.y); d += a.x * h[6] + a.y * h[7];
  a = FP8_LO(r.z); d += a.x * h[8] + a.y * h[9]; a = FP8_HI(r.z); d += a.x * h[10] + a.y * h[11];
  a = FP8_LO(r.w); d += a.x * h[12] + a.y * h[13]; a = FP8_HI(r.w); d += a.x * h[14] + a.y * h[15];
  return d;
}
#define FP4_B(w, b) __builtin_amdgcn_cvt_scalef32_pk_f32_fp4((w), 1.0f, (b))
__device__ __forceinline__ void axpy16_fp8(const float c, const uint2 r, float (&acc)[16]) {
  fx2 a;
  a = FP4_B(r.x, 0); acc[0] += c * a.x; acc[1] += c * a.y; a = FP4_B(r.x, 1); acc[2] += c * a.x; acc[3] += c * a.y;
  a = FP4_B(r.x, 2); acc[4] += c * a.x; acc[5] += c * a.y; a = FP4_B(r.x, 3); acc[6] += c * a.x; acc[7] += c * a.y;
  a = FP4_B(r.y, 0); acc[8] += c * a.x; acc[9] += c * a.y; a = FP4_B(r.y, 1); acc[10] += c * a.x; acc[11] += c * a.y;
  a = FP4_B(r.y, 2); acc[12] += c * a.x; acc[13] += c * a.y; a = FP4_B(r.y, 3); acc[14] += c * a.x; acc[15] += c * a.y;
}
#define DPPF(x, ctrl) __uint_as_float((unsigned)__builtin_amdgcn_update_dpp(0, (int)__float_as_uint(x), (ctrl), 0xF, 0xF, true))
typedef __bf16 bf16x2_t __attribute__((ext_vector_type(2)));
__device__ __forceinline__ float xsum32(float x) { const unsigned xi = __float_as_uint(x); const auto r = __builtin_amdgcn_permlane32_swap(xi, xi, false, false); return __uint_as_float(r[0]) + __uint_as_float(r[1]); }
__device__ __forceinline__ float xsum16(float x) { const unsigned xi = __float_as_uint(x); const auto r = __builtin_amdgcn_permlane16_swap(xi, xi, false, false); return __uint_as_float(r[0]) + __uint_as_float(r[1]); }
__device__ __forceinline__ float dot16_fp8_bf16(const uint2 r, const unsigned (&h)[8]) {
  float d;
  d = __builtin_amdgcn_fdot2_f32_bf16(__builtin_amdgcn_cvt_scalef32_pk_bf16_fp4(r.x, 1.0f, 0), __builtin_bit_cast(bf16x2_t, h[0]), 0.f, false);
  d = __builtin_amdgcn_fdot2_f32_bf16(__builtin_amdgcn_cvt_scalef32_pk_bf16_fp4(r.x, 1.0f, 1), __builtin_bit_cast(bf16x2_t, h[1]), d, false);
  d = __builtin_amdgcn_fdot2_f32_bf16(__builtin_amdgcn_cvt_scalef32_pk_bf16_fp4(r.x, 1.0f, 2), __builtin_bit_cast(bf16x2_t, h[2]), d, false);
  d = __builtin_amdgcn_fdot2_f32_bf16(__builtin_amdgcn_cvt_scalef32_pk_bf16_fp4(r.x, 1.0f, 3), __builtin_bit_cast(bf16x2_t, h[3]), d, false);
  d = __builtin_amdgcn_fdot2_f32_bf16(__builtin_amdgcn_cvt_scalef32_pk_bf16_fp4(r.y, 1.0f, 0), __builtin_bit_cast(bf16x2_t, h[4]), d, false);
  d = __builtin_amdgcn_fdot2_f32_bf16(__builtin_amdgcn_cvt_scalef32_pk_bf16_fp4(r.y, 1.0f, 1), __builtin_bit_cast(bf16x2_t, h[5]), d, false);
  d = __builtin_amdgcn_fdot2_f32_bf16(__builtin_amdgcn_cvt_scalef32_pk_bf16_fp4(r.y, 1.0f, 2), __builtin_bit_cast(bf16x2_t, h[6]), d, false);
  d = __builtin_amdgcn_fdot2_f32_bf16(__builtin_amdgcn_cvt_scalef32_pk_bf16_fp4(r.y, 1.0f, 3), __builtin_bit_cast(bf16x2_t, h[7]), d, false);
  return d;
}
struct P5Set { uint2 ru0, ru1, ru2, ru3, rv0, rv1, rv2, rv3; float sume, cgme; };
__device__ __forceinline__ void p5_issue(const P& p, P5Set& S, int bid, LAS unsigned* wl, int lane, __amdgpu_buffer_rsrc_t rsU, __amdgpu_buffer_rsrc_t rsV) {
  const int j = bid >> 5, s = (bid & 31) * 4;
  LAS unsigned* lst = wl + j * 384;
  const int sl = s + (lane & 3);
  const unsigned eme = lst[3 * sl]; S.sume = __uint_as_float(lst[3 * sl + 1]); S.cgme = __uint_as_float(lst[3 * sl + 2]);
  const int em_ = (p.pad1 & 4) ? 1023 : 0x7FFFFFFF;
  const int e0 = __builtin_amdgcn_readlane((int)eme, 0) & em_, e1 = __builtin_amdgcn_readlane((int)eme, 1) & em_, e2 = __builtin_amdgcn_readlane((int)eme, 2) & em_, e3 = __builtin_amdgcn_readlane((int)eme, 3) & em_;
  const int l16 = 8 * lane;
  typedef unsigned v2u_ __attribute__((ext_vector_type(2)));
#define P5_LD(dst, rs, e) do { const v2u_ t_ = __builtin_amdgcn_raw_buffer_load_b64(rs, l16, (e) * 512, 0); dst = make_uint2(t_.x, t_.y); } while (0)
  P5_LD(S.ru0, rsU, e0); P5_LD(S.ru1, rsU, e1); P5_LD(S.ru2, rsU, e2); P5_LD(S.ru3, rsU, e3);
  P5_LD(S.rv0, rsV, e0); P5_LD(S.rv1, rsV, e1); P5_LD(S.rv2, rsV, e2); P5_LD(S.rv3, rsV, e3);
#undef P5_LD
}
__device__ __forceinline__ void p5_compute(const P5Set& S, LAS unsigned* ent, const unsigned (&hfp)[8], float (&acc)[16], int lane, int pf) {
  float d0 = dot16_fp8_bf16(S.ru0, hfp), d1 = dot16_fp8_bf16(S.ru1, hfp), d2 = dot16_fp8_bf16(S.ru2, hfp), d3 = dot16_fp8_bf16(S.ru3, hfp);
  {
    const bool up1 = (lane & 1) != 0;
    const float s01 = up1 ? d0 : d1, k01 = up1 ? d1 : d0, s23 = up1 ? d2 : d3, k23 = up1 ? d3 : d2;
    const float a = k01 + DPPF(s01, 0xB1), b = k23 + DPPF(s23, 0xB1);
    const bool up2 = (lane & 2) != 0;
    const float sab = up2 ? a : b, kab = up2 ? b : a;
    d0 = kab + DPPF(sab, 0x4E);
    d0 += DPPF(d0, 0x124); d0 += DPPF(d0, 0x128);
    d0 = xsum16(d0); d0 = xsum32(d0);
  }
  const float cme = gelu_erf_fast(d0 * S.sume) * S.cgme;
  const float c0 = __uint_as_float((unsigned)__builtin_amdgcn_readlane((int)__float_as_uint(cme), 0));
  const float c1 = __uint_as_float((unsigned)__builtin_amdgcn_readlane((int)__float_as_uint(cme), 1));
  const float c2 = __uint_as_float((unsigned)__builtin_amdgcn_readlane((int)__float_as_uint(cme), 2));
  const float c3 = __uint_as_float((unsigned)__builtin_amdgcn_readlane((int)__float_as_uint(cme), 3));
  (void)pf; (void)ent;
  axpy16_fp8(c0, S.rv0, acc); axpy16_fp8(c1, S.rv1, acc); axpy16_fp8(c2, S.rv2, acc); axpy16_fp8(c3, S.rv3, acc);
}
#define P5_COMPUTE(S, bid) do { const int j_ = (bid) >> 5; LAS unsigned* ent_ = wl + j_ * 384 + 12 * ((bid) & 31); \
    if (j_ == 0) p5_compute(S, ent_, hfp[0], acc[0], lane, p.pad1); else if (j_ == 1) p5_compute(S, ent_, hfp[1], acc[1], lane, p.pad1); \
    else if (j_ == 2) p5_compute(S, ent_, hfp[2], acc[2], lane, p.pad1); else p5_compute(S, ent_, hfp[3], acc[3], lane, p.pad1); } while (0)

__device__ __forceinline__ void rank128(int k0, int k1, int lane, int& r0, int& r1) {
  r0 = 0; r1 = 0;
#pragma unroll 8
  for (int i = 0; i < 64; ++i) {
    const int a = __builtin_amdgcn_readlane(k0, i), b = __builtin_amdgcn_readlane(k1, i);
    r0 += ((a < k0) || (a == k0 && i < lane)) ? 1 : 0;
    r0 += (b < k0) ? 1 : 0;
    r1 += (a <= k1) ? 1 : 0;
    r1 += ((b < k1) || (b == k1 && i < lane)) ? 1 : 0;
  }
}

__device__ void phase5_experts(const P& p, LAS unsigned char* lds, int wid_s) {
  const int tid = mk_tid(wid_s), lane_in = tid & 63, wid = wid_s;
  const int gw = blockIdx.x * 8 + wid;
  LAS unsigned* wl = (LAS unsigned*)lds + wid * P5_WAVE_WORDS;
  const __amdgpu_buffer_rsrc_t rsU = __builtin_amdgcn_make_buffer_rsrc(p.U8, 0, 8 << 20, 0x00020000), rsV = __builtin_amdgcn_make_buffer_rsrc(p.V8, 0, 8 << 20, 0x00020000);
  LAS unsigned* ord = wl + P5_LIST_WORDS;
#pragma unroll 1
  for (int sweep = 0; sweep < 2; ++sweep) {
    const int tb = (sweep * 2048 + gw) * 4;
    int lane = lane_in; asm volatile("" : "+v"(lane));
    unsigned hfp[4][8];
    float acc[4][16];
    {
      int e0[4], e1[4], r0[4], r1[4];
#pragma unroll
      for (int j = 0; j < 4; ++j) { const size_t t = (size_t)tb + j; e0[j] = p.experts[t * 128 + lane]; e1[j] = p.experts[t * 128 + 64 + lane]; r0[j] = 0; r1[j] = 0; }
#pragma unroll 2
      for (int i = 0; i < 64; ++i) {
#pragma unroll
        for (int j = 0; j < 4; ++j) {
          const int a = __builtin_amdgcn_readlane(e0[j], i), b = __builtin_amdgcn_readlane(e1[j], i);
          r0[j] += ((a < e0[j]) || (a == e0[j] && i < lane)) ? 1 : 0;
          r0[j] += (b < e0[j]) ? 1 : 0;
          r1[j] += (a <= e1[j]) ? 1 : 0;
          r1[j] += ((b < e1[j]) || (b == e1[j] && i < lane)) ? 1 : 0;
        }
      }
#pragma unroll
      for (int j = 0; j < 4; ++j) {
        const size_t t = (size_t)tb + j;
        const float g0 = p.gates[t * 128 + lane], g1 = p.gates[t * 128 + 64 + lane];
        const float su0 = p.su[e0[j]], su1 = p.su[e1[j]], sv0 = p.sv[e0[j]], sv1 = p.sv[e1[j]];
        LAS unsigned* lst = wl + j * 384;
        lst[3 * r0[j]] = (unsigned)e0[j]; lst[3 * r0[j] + 1] = __float_as_uint(su0); lst[3 * r0[j] + 2] = __float_as_uint(g0 * sv0);
        lst[3 * r1[j]] = (unsigned)e1[j]; lst[3 * r1[j] + 1] = __float_as_uint(su1); lst[3 * r1[j] + 2] = __float_as_uint(g1 * sv1);
      }
    }
#pragma unroll
    for (int j = 0; j < 4; ++j) {
      const size_t t = (size_t)tb + j;
      const u16* x1r = p.x1b + t * DM;
      const float rs = rsqrtf(p.ss_ffn[t] * (1.f / DM) + 1e-6f);
#pragma unroll
      for (int i = 0; i < 4; ++i) { const uint2 xw = *(const uint2*)(x1r + 256 * i + 4 * lane); const float4 xv = make_float4(bflo(xw.x), bfhi(xw.x), bflo(xw.y), bfhi(xw.y)); const float4 g = *(const float4*)(p.g_ffn + 256 * i + 4 * lane);
        hfp[j][2 * i] = pack_bf2(xv.x * rs * g.x, xv.y * rs * g.y); hfp[j][2 * i + 1] = pack_bf2(xv.z * rs * g.z, xv.w * rs * g.w); }
#pragma unroll
      for (int i = 0; i < 16; ++i) acc[j][i] = 0.f;
    }
    asm volatile("s_waitcnt lgkmcnt(0)" ::: "memory");
    if (!(p.pad1 & 1)) {
      P5Set A, B, C, D;
      p5_issue(p, A, 0 * 32 + 0, wl, lane, rsU, rsV);
      p5_issue(p, B, 1 * 32 + 0, wl, lane, rsU, rsV);
      p5_issue(p, C, 2 * 32 + 0, wl, lane, rsU, rsV);
#pragma unroll 1
      for (int c = 0; c < 32; ++c) {
        const int cn = min(c + 1, 31);
        p5_issue(p, D, 3 * 32 + c, wl, lane, rsU, rsV);
        p5_compute(A, nullptr, hfp[0], acc[0], lane, 0);
        p5_issue(p, A, 0 * 32 + cn, wl, lane, rsU, rsV);
        p5_compute(B, nullptr, hfp[1], acc[1], lane, 0);
        p5_issue(p, B, 1 * 32 + cn, wl, lane, rsU, rsV);
        p5_compute(C, nullptr, hfp[2], acc[2], lane, 0);
        p5_issue(p, C, 2 * 32 + cn, wl, lane, rsU, rsV);
        p5_compute(D, nullptr, hfp[3], acc[3], lane, 0);
      }
      asm volatile("s_waitcnt vmcnt(0)" ::: "memory");
    }
    int lane_e = lane; asm volatile("" : "+v"(lane_e));
#pragma unroll
    for (int j = 0; j < 4; ++j) {
      const u16* x1r = p.x1b + ((size_t)tb + j) * DM;
#pragma unroll
      for (int i = 0; i < 4; ++i) {
        const uint2 xw = *(const uint2*)(x1r + 256 * i + 4 * lane_e);
        acc[j][4 * i] += bflo(xw.x); acc[j][4 * i + 1] += bfhi(xw.x); acc[j][4 * i + 2] += bflo(xw.y); acc[j][4 * i + 3] += bfhi(xw.y);
      }
    }
    asm volatile("" ::: "memory");
#pragma unroll
    for (int j = 0; j < 4; ++j) {
      float* x1r = p.out + ((size_t)tb + j) * DM; u16* x2r = p.x2b + ((size_t)tb + j) * DM;
#pragma unroll
      for (int i = 0; i < 4; ++i) {
        *(float4*)(x1r + 256 * i + 4 * lane_e) = make_float4(acc[j][4 * i], acc[j][4 * i + 1], acc[j][4 * i + 2], acc[j][4 * i + 3]);
        *(uint2*)(x2r + 256 * i + 4 * lane_e) = make_uint2(pack_bf2(acc[j][4 * i], acc[j][4 * i + 1]), pack_bf2(acc[j][4 * i + 2], acc[j][4 * i + 3]));
      }
    }
  }
}

struct Epi6a {
  static constexpr bool PERM = false, AFTER_DRAIN = false;
  P p;
  __device__ __forceinline__ void operator()(const pg8::f32x4 (&acc)[2][2][4][2], const pg8::Unit& u, int wr, int wc, int fr_in, int fq_in) const {
    int fr = fr_in, fq = fq_in; asm volatile("" : "+v"(fr), "+v"(fq));
    const int rowb = u.pm * 256 + wr * 64 + fr;
    const int colb = u.pn * 256 + wc * 32 + 4 * fq;
#pragma unroll
    for (int ai = 0; ai < 2; ++ai)
#pragma unroll
      for (int m = 0; m < 4; ++m) { const int row = rowb + ai * 128 + m * 16;
#pragma unroll
        for (int bj = 0; bj < 2; ++bj)
#pragma unroll
          for (int n = 0; n < 2; ++n) { const int col = colb + bj * 128 + 16 * n;
            const pg8::f32x4 v = acc[ai][bj][m][n];
            uint2 o; o.x = pack_bf2(v[0], v[1]); o.y = pack_bf2(v[2], v[3]);
            *(uint2*)(p.pple + (size_t)row * DM + col) = o; } }
  }
};
struct Epi6b {
  static constexpr bool PERM = false, AFTER_DRAIN = true;
  P p;
  __device__ __forceinline__ void operator()(const pg8::f32x4 (&)[2][2][4][2], const pg8::Unit&, int, int, int, int) const {}
  __device__ __forceinline__ void fused(pg8::f32x4 (&acc)[2][2][4][2], const pg8::Unit& u, int wr, int wc, int fr_in, int fq_in, LAS unsigned char* lds, int wid, int lane) const {
    int fr = fr_in, fq = fq_in; asm volatile("" : "+v"(fr), "+v"(fq));
    const int rowb = u.pm * 256 + wr * 64 + fr;
    const int colb = u.pn * 256 + wc * 32 + 4 * fq;
#pragma unroll
    for (int ai = 0; ai < 2; ++ai)
#pragma unroll
      for (int m = 0; m < 4; ++m) { const int row = rowb + ai * 128 + m * 16;
        float s = 0.f;
#pragma unroll
        for (int bj = 0; bj < 2; ++bj)
#pragma unroll
          for (int n = 0; n < 2; ++n) { const int col = colb + bj * 128 + 16 * n;
            const float4 x2 = *(const float4*)(p.out + (size_t)row * DM + col);
            const uint2 pw = *(const uint2*)(p.pple + (size_t)row * DM + col);
            pg8::f32x4 a = acc[ai][bj][m][n];
            a[0] = x2.x + sigmoidf_(a[0]) * bflo(pw.x); a[1] = x2.y + sigmoidf_(a[1]) * bfhi(pw.x);
            a[2] = x2.z + sigmoidf_(a[2]) * bflo(pw.y); a[3] = x2.w + sigmoidf_(a[3]) * bfhi(pw.y);
            s += a[0] * a[0] + a[1] * a[1] + a[2] * a[2] + a[3] * a[3];
            acc[ai][bj][m][n] = a; }
        s += __shfl_xor(s, 16, 64); s += __shfl_xor(s, 32, 64);
        if (fq == 0) atomicAdd(p.ss_fin + row, s);
        asm volatile("" ::: "memory"); }
    asm volatile("s_waitcnt vmcnt(0)" ::: "memory");
    __syncthreads();
    if (wid == 0 && lane == 0) {
      unsigned* cnt = p.ctr + 64 + u.pm;
      __hip_atomic_fetch_add(cnt, 1u, __ATOMIC_RELAXED, __HIP_MEMORY_SCOPE_AGENT);
      unsigned spins = 0;
      while (__hip_atomic_load(cnt, __ATOMIC_RELAXED, __HIP_MEMORY_SCOPE_AGENT) < 4u) { __builtin_amdgcn_s_sleep(2); if (++spins > (1u << 24)) break; }
    }
    __syncthreads();
#pragma unroll
    for (int ai = 0; ai < 2; ++ai)
#pragma unroll
      for (int m = 0; m < 4; ++m) { const int row = rowb + ai * 128 + m * 16;
        const float tot = __hip_atomic_load(p.ss_fin + row, __ATOMIC_RELAXED, __HIP_MEMORY_SCOPE_AGENT);
        const float rs = rsqrtf(tot * (1.f / DM) + 1e-6f);
#pragma unroll
        for (int bj = 0; bj < 2; ++bj)
#pragma unroll
          for (int n = 0; n < 2; ++n) { const int col = colb + bj * 128 + 16 * n;
            const float4 g = *(const float4*)(p.g_final + col);
            const pg8::f32x4 a = acc[ai][bj][m][n];
            *(float4*)(p.out + (size_t)row * DM + col) = make_float4(a[0] * rs * g.x, a[1] * rs * g.y, a[2] * rs * g.z, a[3] * rs * g.w); }
        asm volatile("" ::: "memory"); }
    (void)lds;
  }
};
__device__ void phase6_ple(const P& p, LAS unsigned char* lds, int wid_s) {
  { pg8::Gemm g; g.A = p.p16; g.Bt = p.WpleT; g.M = T_TOK; g.N = 1024; g.K = p.k256;
    pg8::StaticOrder S; S.init(T_TOK, 1024, gridDim.x, blockIdx.x);
    Epi6a E; E.p = p;
    pg8::gemm_phase<Epi6a, pg8::StaticOrder>(lds, g, S, E, nullptr, wid_s); }
  { pg8::Gemm g; g.A = p.x2b; g.Bt = p.WgT; g.M = T_TOK; g.N = 1024; g.K = p.k1024;
    pg8::StaticOrder S; S.init(T_TOK, 1024, gridDim.x, blockIdx.x);
    Epi6b E; E.p = p;
    pg8::gemm_phase<Epi6b, pg8::StaticOrder>(lds, g, S, E, nullptr, wid_s); }
}
__device__ void phase7_final(const P& p, int wid_s) {
  const int gt = blockIdx.x * 512 + mk_tid(wid_s), nt = gridDim.x * 512;
  for (int i = gt; i < T_TOK * DM / 4; i += nt) {
    const int row = i >> 8, c4 = i & 255;
    const float rs = rsqrtf(p.ss_fin[row] * (1.f / DM) + 1e-6f);
    const float4 v = ((const float4*)p.out)[i];
    const float4 g = ((const float4*)p.g_final)[c4];
    ((float4*)p.out)[i] = make_float4(v.x * rs * g.x, v.y * rs * g.y, v.z * rs * g.z, v.w * rs * g.w);
  }
}
#define XB_TMO      128
#define XB_XCNT(j)  (256  + 64 * (j))
#define XB_XSUB(j)  (1280 + 64 * (j))
#define XB_XGEN(j)  (2304 + 64 * (j))
#define XB_TOP      3328
#define XB_TOPGEN   3392
#define XCD_BAR_WORDS 3456
#define XB_SPIN_CAP (1u << 22)
__device__ __forceinline__ unsigned xb_ld(unsigned* p)              { return __hip_atomic_load(p, __ATOMIC_RELAXED, __HIP_MEMORY_SCOPE_AGENT); }
__device__ __forceinline__ unsigned xb_add(unsigned* p, unsigned v) { return __hip_atomic_fetch_add(p, v, __ATOMIC_RELAXED, __HIP_MEMORY_SCOPE_AGENT); }
__device__ __forceinline__ unsigned xb_xcc_id() { return (unsigned)__builtin_amdgcn_s_getreg((3 << 11) | 20) & 0xFu; }
#define XB_SPIN(cond, bar) do { unsigned _sp = 0; while (cond) { __builtin_amdgcn_s_sleep(1); \
    if ((++_sp & 255u) == 0u) { if (xb_ld(&(bar)[XB_TMO])) break; if (_sp > XB_SPIN_CAP) { atomicAdd(&(bar)[XB_TMO], 1u); break; } } } } while (0)
struct XcdBarrier { unsigned* bar; unsigned x; volatile LAS unsigned* st; };
__device__ __forceinline__ XcdBarrier xcd_barrier_post(unsigned* bar, volatile LAS unsigned* st, int wid_s) {
    XcdBarrier b; b.bar = bar; b.x = xb_xcc_id(); b.st = st;
    if (mk_tid(wid_s) == 0) (void)xb_add(&bar[XB_XCNT(b.x)], 1u);
    return b;
}
__device__ __forceinline__ void xcd_barrier_complete(unsigned* bar, unsigned x, unsigned& nloc, unsigned& nx) {
    const unsigned G = gridDim.x * gridDim.y * gridDim.z;
    unsigned sum, cnt, mine, sp = 0u;
    for (;;) {
        sum = 0u; cnt = 0u; mine = 0u;
#pragma unroll
        for (unsigned j = 0; j < 16; ++j) { const unsigned c = xb_ld(&bar[XB_XCNT(j)]); sum += c; cnt += (c > 0u) ? 1u : 0u; mine = (j == x) ? c : mine; }
        if (sum == G) break;
        __builtin_amdgcn_s_sleep(1);
        if ((++sp & 255u) == 0u) { if (xb_ld(&bar[XB_TMO])) break; if (sp > XB_SPIN_CAP) { atomicAdd(&bar[XB_TMO], 1u); break; } }
    }
    nloc = mine > 0u ? mine : 1u; nx = cnt > 0u ? cnt : 1u;
}
__device__ __forceinline__ void xcd_barrier2(unsigned* bar_, volatile LAS unsigned* st_, int wid_s) {
    XcdBarrier b; b.bar = bar_; b.st = st_; b.x = xb_xcc_id();
    asm volatile("s_waitcnt vmcnt(0)" ::: "memory");
    __syncthreads();
    if (mk_tid(wid_s) == 0) {
        unsigned* bar = b.bar;
        __builtin_amdgcn_s_waitcnt(0);
        unsigned nloc = b.st[0], nx = b.st[1];
        if (nloc == 0u) { xcd_barrier_complete(bar, b.x, nloc, nx); b.st[0] = nloc; b.st[1] = nx; }
        const unsigned old = xb_add(&bar[XB_XSUB(b.x)], 1u);
        const unsigned gen = old / nloc;
        if (old + 1u == (gen + 1u) * nloc) {
            __builtin_amdgcn_fence(__ATOMIC_RELEASE, "agent");
            asm volatile("s_waitcnt vmcnt(0)" ::: "memory");
            const unsigned og = xb_add(&bar[XB_TOP], 1u);
            const unsigned tg = og / nx;
            if (og + 1u == (tg + 1u) * nx) xb_add(&bar[XB_TOPGEN], 1u);
            else XB_SPIN(xb_ld(&bar[XB_TOPGEN]) == tg, bar);
            __builtin_amdgcn_fence(__ATOMIC_ACQUIRE, "agent");
            xb_add(&bar[XB_XGEN(b.x)], 1u);
            asm volatile("s_waitcnt vmcnt(0)" ::: "memory");
        } else {
            XB_SPIN(xb_ld(&bar[XB_XGEN(b.x)]) == gen, bar);
            __builtin_amdgcn_fence(__ATOMIC_ACQUIRE, "agent");
            asm volatile("s_waitcnt vmcnt(0)" ::: "memory");
        }
    }
    __syncthreads();
}
static void fill_params(P& p, void* const* d_in, void* d_out, void* d_ws, size_t ws_size, size_t* used) {
  p.x = (const float*)d_in[0]; p.p = (const float*)d_in[1]; p.pos = (const int*)d_in[2]; p.g_mix = (const float*)d_in[3];
  p.w_in = (const float*)d_in[4]; p.g_kv = (const float*)d_in[5]; p.w_uk = (const float*)d_in[6]; p.w_uv = (const float*)d_in[7];
  p.conv_w = (const float*)d_in[8]; p.conv_b = (const float*)d_in[9]; p.w_rg = (const float*)d_in[10]; p.b_rg = (const float*)d_in[11];
  p.w_ig = (const float*)d_in[12]; p.b_ig = (const float*)d_in[13]; p.lam = (const float*)d_in[14]; p.w_out = (const float*)d_in[15];
  p.g_ffn = (const float*)d_in[16]; p.w_pq = (const float*)d_in[17]; p.k1 = (const float*)d_in[18]; p.k2 = (const float*)d_in[19];
  p.u_tab = (const float*)d_in[20]; p.v_tab = (const float*)d_in[21]; p.w_ple = (const float*)d_in[22]; p.w_gate = (const float*)d_in[23];
  p.g_final = (const float*)d_in[24];
  p.out = (float*)d_out; p.k1024 = 1024; p.k256 = 256; p.pad0 = 0; p.pad1 = 0;
  char* ws = (char*)d_ws; size_t off = 0;
  auto alloc = [&](size_t bytes) { void* r = ws + off; off += (bytes + 255) & ~(size_t)255; return r; };
  const size_t T = T_TOK;
  p.bar = (unsigned*)alloc(16384);
  p.ctr = (unsigned*)alloc(1024);
  p.rstd_mix = (float*)alloc(T * 4); p.ss_ffn = (float*)alloc(T * 4); p.ss_fin = (float*)alloc(T * 4);
  p.ropeA = (float*)alloc(T * 32 * 4); p.ropeI = (float*)alloc(T * 16 * 4);
  p.W1t = (u16*)alloc((size_t)N1 * 1024 * 2); p.WoutT = (u16*)alloc(1024 * 1024 * 2); p.WpqT = (u16*)alloc(2048 * 1024 * 2);
  p.WgT = (u16*)alloc(1024 * 1024 * 2); p.WpleT = (u16*)alloc(1024 * 256 * 2);
  p.K1b = (u16*)alloc(8 * 128 * 128 * 2); p.K2b = (u16*)alloc(8 * 128 * 128 * 2);
  p.WrgT = (u16*)alloc(8 * 64 * 64 * 2); p.WigT = (u16*)alloc(8 * 64 * 64 * 2);
  p.U8 = (unsigned char*)alloc((size_t)16384 * 1024); p.V8 = (unsigned char*)alloc((size_t)16384 * 1024); p.su = (float*)alloc(16384 * 4); p.sv = (float*)alloc(16384 * 4);
  p.p16 = (u16*)alloc(T * 256 * 2);
  p.experts = (int*)alloc(T * 128 * 4); p.gates = (float*)alloc(T * 128 * 4);
  p.xb16 = (u16*)alloc(T * 1024 * 2); p.mix = p.xb16; p.x2b = p.xb16;
  char* rb = ws + off; size_t rboff = 0;
  auto allocB = [&](size_t bytes) { void* r = rb + rboff; rboff += (bytes + 255) & ~(size_t)255; return r; };
  p.qcat = (u16*)allocB(T * 640 * 2); p.kv = (u16*)allocB(T * 160 * 2); p.iqh = (u16*)allocB(T * 512 * 2); p.ikh = (u16*)allocB(T * 64 * 2);
  p.iw = (float*)allocB(T * 8 * 4); p.xbr = (u16*)allocB(T * 512 * 2); p.gate = (u16*)allocB(T * 512 * 2);
  size_t b1 = rboff; rboff = 0;
  p.x1b = (u16*)allocB(T * 1024 * 2); p.pq = (u16*)allocB(T * 2048 * 2); p.pple = p.x1b;
  size_t b2 = rboff;
  off += (b1 > b2 ? b1 : b2);
  *used = off;
}
namespace cg = cooperative_groups;
#ifndef USE_XCD_BARRIER
#define USE_XCD_BARRIER 0
#endif
__global__ void __launch_bounds__(512, 2) mega(P p) {
  extern __shared__ __attribute__((aligned(16))) unsigned char smem[];
  LAS unsigned char* lds = (LAS unsigned char*)smem;
  const int wid_s = __builtin_amdgcn_readfirstlane((int)(threadIdx.x >> 6));
  cg::grid_group grid = cg::this_grid();
#if USE_XCD_BARRIER
  volatile LAS unsigned* xst = (volatile LAS unsigned*)(lds + LDS_BYTES - 16);
  if (mk_tid(wid_s) == 0) { xst[0] = 0u; xst[1] = 0u; xst[2] = 0u; xst[3] = 0u; }
  __syncthreads();
  (void)xcd_barrier_post(p.bar, xst, wid_s);
#define GRID_SYNC() xcd_barrier2(p.bar, (volatile LAS unsigned*)(lds + LDS_BYTES - 16), wid_s)
#else
#define GRID_SYNC() grid.sync()
#endif
  phase0_prep(p, lds, wid_s);
#if USE_XCD_BARRIER
  if (p.k256 == 257) grid.sync();
  GRID_SYNC();
#else
  grid.sync();
#endif
  phase1_gemm1(p, lds, wid_s);
  GRID_SYNC();
  phase2(p, lds, wid_s);
  GRID_SYNC();
  phase3_outproj(p, lds, wid_s);
  GRID_SYNC();
  phase4_pq(p, lds, wid_s);
  asm volatile("s_waitcnt vmcnt(0)" ::: "memory"); __syncthreads();
  phase4b_route(p, lds, wid_s);
  GRID_SYNC();
  phase5_experts(p, lds, wid_s);
  GRID_SYNC();
  phase6_ple(p, lds, wid_s);
}

extern "C" void kernel_launch(void* const* d_in, const int* in_sizes, int n_in, void* d_out, int out_size, void* d_ws,
                              size_t ws_size, hipStream_t stream) {
  P p; memset(&p, 0, sizeof(p));
  size_t used = 0;
  fill_params(p, d_in, d_out, d_ws, ws_size, &used);
  static int grid_blocks = 0;
  if (!grid_blocks) {
    (void)hipFuncSetAttribute((const void*)mega, hipFuncAttributeMaxDynamicSharedMemorySize, LDS_BYTES);
    int dev = 0, cus = 0, per_cu = 0;
    (void)hipGetDevice(&dev);
    (void)hipDeviceGetAttribute(&cus, hipDeviceAttributeMultiprocessorCount, dev);
    (void)hipOccupancyMaxActiveBlocksPerMultiprocessor(&per_cu, mega, 512, LDS_BYTES);
    if (per_cu > 1) per_cu = 1;
    grid_blocks = 256;
    (void)cus;
  }
#if USE_XCD_BARRIER
  (void)hipMemsetAsync(p.bar, 0, XCD_BAR_WORDS * 4, stream);
#endif
  void* args[] = {&p};
  (void)hipLaunchCooperativeKernel((void*)mega, dim3(grid_blocks), dim3(512), args, LDS_BYTES, stream);
}
```

```cpp
#define USE_XCD_BARRIER 1
#include <hip/hip_runtime.h>
#include <hip/hip_cooperative_groups.h>
#include <math.h>
#include <stdint.h>
#include <string.h>

#define T_TOK 16384
#define SEQ 2048
#define NB 8
#define DM 1024
#define INTOT 2280
#define N1 2560
#define LDS_BYTES 163840
#define PRESCALE 0.12751743f
#define IDXSCALE 0.04419417382415922f

typedef unsigned short u16;
typedef _Float16 f16;
typedef _Float16 f16x8 __attribute__((ext_vector_type(8)));
typedef _Float16 f16x4 __attribute__((ext_vector_type(4)));
typedef short s16x8 __attribute__((ext_vector_type(8)));
typedef short s16x4 __attribute__((ext_vector_type(4)));
typedef float fx4 __attribute__((ext_vector_type(4)));
typedef float fx16 __attribute__((ext_vector_type(16)));
typedef float fx2 __attribute__((ext_vector_type(2)));
typedef unsigned u32x4 __attribute__((ext_vector_type(4)));
#define LAS __attribute__((address_space(3)))
#if defined(__HIP_DEVICE_COMPILE__)
#define LDS_STORE(T, ptr, val) (*(LAS T*)(ptr) = (val))
#define LDS_ST_FX4(ptr, val) (*(LAS fx4*)(ptr) = (val))
#else
#define LDS_STORE(T, ptr, val) ((void)0)
#define LDS_ST_FX4(ptr, val) ((void)0)
#endif

__device__ __forceinline__ int mk_tid(int wid_s) {
  int l;
  asm volatile("v_mbcnt_lo_u32_b32 %0, -1, 0\n\tv_mbcnt_hi_u32_b32 %0, -1, %0" : "=v"(l));
  return wid_s * 64 + l;
}
typedef __bf16 bfx2_t __attribute__((ext_vector_type(2)));
__device__ __forceinline__ unsigned pack_bf2(float lo, float hi) { const fx2 v = {lo, hi}; const bfx2_t b = __builtin_convertvector(v, bfx2_t); return __builtin_bit_cast(unsigned, b); }
__device__ __forceinline__ u16 f2bf(float f) { return (u16)pack_bf2(f, f); }
__device__ __forceinline__ float bf2f(u16 v) { return __uint_as_float((unsigned)v << 16); }
__device__ __forceinline__ float bflo(unsigned v) { return __uint_as_float(v << 16); }
__device__ __forceinline__ float bfhi(unsigned v) { return __uint_as_float(v & 0xFFFF0000u); }
__device__ __forceinline__ unsigned pack_h2(float lo, float hi) {
  f16 a = (f16)lo, b = (f16)hi;
  return (unsigned)__builtin_bit_cast(unsigned short, a) | ((unsigned)__builtin_bit_cast(unsigned short, b) << 16);
}
__device__ __forceinline__ float xsum32(float x) { const unsigned xi = __float_as_uint(x); const auto r = __builtin_amdgcn_permlane32_swap(xi, xi, false, false); return __uint_as_float(r[0]) + __uint_as_float(r[1]); }
__device__ __forceinline__ float xsum16(float x) { const unsigned xi = __float_as_uint(x); const auto r = __builtin_amdgcn_permlane16_swap(xi, xi, false, false); return __uint_as_float(r[0]) + __uint_as_float(r[1]); }
#define HDPPF(x, ctrl) __uint_as_float((unsigned)__builtin_amdgcn_update_dpp(0, (int)__float_as_uint(x), (ctrl), 0xF, 0xF, true))
__device__ __forceinline__ float wave_sum(float v) {
  v += HDPPF(v, 0xB1); v += HDPPF(v, 0x4E); v += HDPPF(v, 0x141); v += HDPPF(v, 0x140);
  return xsum32(xsum16(v));
}
__device__ __forceinline__ float wave_max(float v) {
  v = fmaxf(v, HDPPF(v, 0xB1)); v = fmaxf(v, HDPPF(v, 0x4E)); v = fmaxf(v, HDPPF(v, 0x141)); v = fmaxf(v, HDPPF(v, 0x140));
  { const unsigned xi = __float_as_uint(v); const auto r = __builtin_amdgcn_permlane16_swap(xi, xi, false, false); v = fmaxf(__uint_as_float(r[0]), __uint_as_float(r[1])); }
  { const unsigned xi = __float_as_uint(v); const auto r = __builtin_amdgcn_permlane32_swap(xi, xi, false, false); v = fmaxf(__uint_as_float(r[0]), __uint_as_float(r[1])); }
  return v;
}
__device__ __forceinline__ float sigmoidf_(float x) { return __builtin_amdgcn_rcpf(1.f + __builtin_amdgcn_exp2f(-1.4426950408889634f * x)); }
__device__ __forceinline__ float gelu_tanh_f(float x) {
  const float w = x * __builtin_fmaf(x * x, -0.1029432397f, -2.302208198f);
  return x * __builtin_amdgcn_rcpf(1.f + __builtin_amdgcn_exp2f(w));
}
__device__ __forceinline__ float gelu_erf_f(float x) { return 0.5f * x * (1.f + erff(x * 0.7071067811865476f)); }

struct P {
  const float* x; const float* p; const int* pos; const float* g_mix; const float* w_in; const float* g_kv;
  const float* w_uk; const float* w_uv; const float* conv_w; const float* conv_b; const float* w_rg; const float* b_rg;
  const float* w_ig; const float* b_ig; const float* lam; const float* w_out; const float* g_ffn; const float* w_pq;
  const float* k1; const float* k2; const float* u_tab; const float* v_tab; const float* w_ple; const float* w_gate;
  const float* g_final;
  float* out;
  u16* xb16; float* rstd_mix; float* ropeA; float* ropeI;
  u16* W1t; u16* WoutT; u16* WpqT; u16* WgT; u16* WpleT; u16* K1b; u16* K2b; u16* WrgT; u16* WigT;
  unsigned char* U8; unsigned char* V8; float* su; float* sv; u16* p16;
  u16* qcat; u16* kv; u16* iqh; u16* ikh; float* iw; u16* xbr; u16* gate;
  u16* mix; u16* x1b; u16* pq; float* ss_ffn; float* ss_fin;
  int* experts; float* gates; u16* x2b; u16* pple;
  unsigned* ctr; unsigned* bar;
  int k1024, k256, pad0, pad1;
};
namespace pg8 {
#define PG8_LAS __attribute__((address_space(3)))
typedef unsigned short bf16_t;
typedef short bf16x8 __attribute__((ext_vector_type(8)));
typedef float f32x4 __attribute__((ext_vector_type(4)));
typedef unsigned u32x4 __attribute__((ext_vector_type(4)));
constexpr int BM = 256, BK = 64, HALF = 128, HTB = HALF * BK * 2  , STAGE_BYTES = 8 * HTB, NXCD = 8, WGM = 8;

__host__ __device__ __forceinline__ int lds_byte(int r, int c) { const int st = (r >> 4) * 2 + (c >> 5), rr = r & 15, cc = c & 31, ob = rr * 64 + cc * 2; return st * 1024 + (ob ^ (((ob >> 9) & 1) << 5)); }
__host__ __device__ __forceinline__ void stage_rc(int b, int& R, int& C) { const int st = b / 1024, sb = b % 1024, swz = sb ^ (((sb >> 9) & 1) << 5); R = (st >> 1) * 16 + swz / 64; C = (st & 1) * 32 + (swz % 64) / 2; }
__host__ __device__ __forceinline__ int perm32(int rho) { const int n = rho >> 4, i = rho & 15; return 8 * (i >> 2) + 4 * n + (i & 3); }

struct Unit { int pm, pn; };
struct Gemm { const bf16_t* A; const bf16_t* Bt; int M, N, K; };

struct StaticOrder {
    int nM, nN, nwg, G, c;
    __host__ __device__ void init(int M, int N, int G_, int c_) { nM = M / BM; nN = N / BM; nwg = nM * nN; G = G_; c = c_; }
    __host__ __device__ bool next(int i, Unit& u) const {
        const long L = (long)i * G + c; if (L >= nwg) return false;
        int wgid = (int)L; { const int q = nwg / NXCD, r = nwg % NXCD, xcd = wgid % NXCD, off = wgid / NXCD; wgid = (xcd < r ? xcd * (q + 1) : r * (q + 1) + (xcd - r) * q) + off; }
        const int nig = WGM * nN, gid = wgid / nig, fm = gid * WGM, gsz = (nM - fm) < WGM ? (nM - fm) : WGM;
        u.pm = fm + ((wgid % nig) % gsz); u.pn = (wgid % nig) / gsz; return true;
    }
    __device__ __forceinline__ void a_ready(const Unit&) const {}
    __device__ __forceinline__ void done(const Unit&) const {}
};
__device__ __forceinline__ unsigned cvt_pk_bf16(float lo, float hi) { unsigned r; asm volatile("v_cvt_pk_bf16_f32 %0, %1, %2" : "=v"(r) : "v"(lo), "v"(hi)); return r; }
typedef float f32x2 __attribute__((ext_vector_type(2)));
__device__ __forceinline__ f32x2 gelu_pk(f32x2 v) {
    const f32x2 av = __builtin_elementwise_abs(v), d = av * 0.2316418882f + 1.0f;
    f32x2 t; t.x = __builtin_amdgcn_rcpf(d.x); t.y = __builtin_amdgcn_rcpf(d.y);
    f32x2 q = t * 0.5307027145f + (-0.7265760135f); q = q * t + 0.7107068705f; q = q * t + (-0.142248368f); q = q * t + 0.127414796f; q = q * t;
    const f32x2 s = (v * v) * (-0.72134752044f);
    f32x2 e; e.x = __builtin_amdgcn_exp2f(s.x); e.y = __builtin_amdgcn_exp2f(s.y);
    const f32x2 m = v * (q * e), r = v - m;
    f32x2 o; o.x = v.x < 0.f ? m.x : r.x; o.y = v.y < 0.f ? m.y : r.y; return o;
}

template <class Epi, class Sched, bool STAMP = false>
__device__ __forceinline__ void gemm_phase(PG8_LAS unsigned char* lds, const Gemm g, const Sched& S, const Epi& E, unsigned long long* stamps, int wid_s) {
    const int tid = mk_tid(wid_s), wid = __builtin_amdgcn_readfirstlane(tid >> 6), lane = tid & 63, wr = wid >> 2, wc = wid & 3, fr = lane & 15, fq = lane >> 4;
    const int K = g.K, nt = K / BK;
    int ts_lo = 0, ts_hi = 0, nts = 0; const unsigned long long rt_entry = STAMP ? (unsigned long long)wall_clock64() : 0ull;
#define PG8_STAMP() do { if (STAMP && wid == 0 && nts < 64) { const unsigned long long _c = (unsigned long long)clock64(); \
        ts_lo = (lane == nts) ? (int)(unsigned)_c : ts_lo; ts_hi = (lane == nts) ? (int)(unsigned)(_c >> 32) : ts_hi; ++nts; } } while (0)
    PG8_STAMP();
    unsigned voffA[2], voffB[2];
#pragma unroll
    for (int i = 0; i < 2; ++i) { int R, C; stage_rc(tid * 16 + i * 8192, R, C); const int Rb = Epi::PERM ? ((R & ~31) + perm32(R & 31)) : R;
        voffA[i] = (unsigned)(R * K + C) * 2u; voffB[i] = (unsigned)(Rb * K + C) * 2u; }
    const size_t kstep = (size_t)(BK * 2);
    const size_t hstep = (size_t)HALF * K * 2;
    const size_t tstep = 2 * hstep;
    const unsigned ldsw = (unsigned)wid * 1024u;
    const int aoff = lds_byte(wr * 64 + fr, fq * 8), boff = lds_byte(wc * 32 + fr, fq * 8);
#define PG8_SA(b, h) (((b) * 2 + (h)) * HTB)
#define PG8_SB(b, h) ((4 + (b) * 2 + (h)) * HTB)
#define PG8_STAGE(bufoff, gbase, voff) do { _Pragma("unroll") for (int _i = 0; _i < 2; ++_i) \
        __builtin_amdgcn_global_load_lds((const unsigned*)((const char*)(gbase) + (voff)[_i]), (PG8_LAS unsigned*)(lds + (bufoff) + ldsw + _i * 8192), 16, 0, 0); } while (0)
#define PG8_LDA(dst, b, h) do { _Pragma("unroll") for (int m = 0; m < 4; ++m) _Pragma("unroll") for (int k = 0; k < 2; ++k) dst[m][k] = *(const PG8_LAS bf16x8*)(lds + PG8_SA(b, h) + aoff + m * 2048 + k * 1024); } while (0)
#define PG8_LDB(dst, b, h) do { _Pragma("unroll") for (int n = 0; n < 2; ++n) _Pragma("unroll") for (int k = 0; k < 2; ++k) dst[n][k] = *(const PG8_LAS bf16x8*)(lds + PG8_SB(b, h) + boff + n * 2048 + k * 1024); } while (0)
#define PG8_MMA(ai, bj, At, Bt) do { __builtin_amdgcn_s_setprio(1); _Pragma("unroll") for (int m = 0; m < 4; ++m) _Pragma("unroll") for (int n = 0; n < 2; ++n) _Pragma("unroll") for (int k = 0; k < 2; ++k) \
        acc[ai][bj][m][n] = __builtin_amdgcn_mfma_f32_16x16x32_bf16(Bt[n][k], At[m][k], acc[ai][bj][m][n], 0, 0, 0); __builtin_amdgcn_s_setprio(0); } while (0)
#define PG8_WAIT_V(n) asm volatile("s_waitcnt vmcnt(" #n ")" ::: "memory")
#define PG8_WAIT_L(n) asm volatile("s_waitcnt lgkmcnt(" #n ")" ::: "memory")
#define PG8_BAR __builtin_amdgcn_s_barrier()
#define PG8_SCHED __builtin_amdgcn_sched_barrier(0)
    Unit cur, nxt; int ui = 0;
    if (!S.next(0, cur)) return;
    f32x4 acc[2][2][4][2];
#pragma unroll
    for (int a = 0; a < 2; ++a)
#pragma unroll
        for (int b = 0; b < 2; ++b)
#pragma unroll
            for (int m = 0; m < 4; ++m)
#pragma unroll
                for (int n = 0; n < 2; ++n) acc[a][b][m][n] = (f32x4){0.f, 0.f, 0.f, 0.f};
    bf16x8 At[4][2], B0[2][2], B1[2][2];
    const char* cA = (const char*)g.A + (size_t)cur.pm * tstep; const char* cB = (const char*)g.Bt + (size_t)cur.pn * tstep;
    S.a_ready(cur);
    PG8_STAGE(PG8_SB(0, 0), cB, voffB); PG8_STAGE(PG8_SA(0, 0), cA, voffA); PG8_STAGE(PG8_SB(0, 1), cB + hstep, voffB); PG8_STAGE(PG8_SA(0, 1), cA + hstep, voffA);
    if (wr == 1) PG8_BAR;
    PG8_WAIT_V(4); PG8_BAR;
    PG8_STAGE(PG8_SB(1, 0), cB + kstep, voffB); PG8_STAGE(PG8_SA(1, 0), cA + kstep, voffA); PG8_STAGE(PG8_SB(1, 1), cB + hstep + kstep, voffB);
    PG8_WAIT_V(6); PG8_BAR;
    PG8_STAMP();
    for (;;) {
        const bool has_next = S.next(ui + 1, nxt);
        const char* nA = has_next ? (const char*)g.A + (size_t)nxt.pm * tstep : cA; const char* nB = has_next ? (const char*)g.Bt + (size_t)nxt.pn * tstep : cB;
        for (int t = 0; t < nt; t += 2) {
            const bool last = (t == nt - 2);
            const char* a1 = cA + (size_t)(t + 1) * kstep;
            const char* a2 = last ? nA : cA + (size_t)(t + 2) * kstep; const char* b2 = last ? nB : cB + (size_t)(t + 2) * kstep;
            const char* a3 = a2 + kstep; const char* b3 = b2 + kstep;
            if (last && has_next) S.a_ready(nxt);
            PG8_LDB(B0, 0, 0); PG8_SCHED; PG8_LDA(At, 0, 0); PG8_STAGE(PG8_SA(1, 1), a1 + hstep, voffA);
            PG8_WAIT_L(8); PG8_BAR; PG8_WAIT_L(0); PG8_MMA(0, 0, At, B0); PG8_BAR; PG8_SCHED;
            PG8_LDB(B1, 0, 1); PG8_STAGE(PG8_SB(0, 0), b2, voffB);
            PG8_BAR; PG8_WAIT_L(0); PG8_MMA(0, 1, At, B1); PG8_BAR;
            PG8_LDA(At, 0, 1); PG8_STAGE(PG8_SA(0, 0), a2, voffA);
            PG8_BAR; PG8_WAIT_L(0); PG8_MMA(1, 0, At, B0); PG8_BAR; PG8_SCHED;
            PG8_STAGE(PG8_SB(0, 1), b2 + hstep, voffB);
            PG8_WAIT_V(6); PG8_BAR; PG8_MMA(1, 1, At, B1); PG8_BAR;
            PG8_LDB(B0, 1, 0); PG8_SCHED; PG8_LDA(At, 1, 0); PG8_STAGE(PG8_SA(0, 1), a2 + hstep, voffA);
            PG8_WAIT_L(8); PG8_BAR; PG8_WAIT_L(0); PG8_MMA(0, 0, At, B0); PG8_BAR; PG8_SCHED;
            PG8_LDB(B1, 1, 1); PG8_STAGE(PG8_SB(1, 0), b3, voffB);
            PG8_BAR; PG8_WAIT_L(0); PG8_MMA(0, 1, At, B1); PG8_BAR;
            PG8_LDA(At, 1, 1); PG8_STAGE(PG8_SA(1, 0), a3, voffA);
            PG8_BAR; PG8_WAIT_L(0); PG8_MMA(1, 0, At, B0); PG8_BAR; PG8_SCHED;
            PG8_STAGE(PG8_SB(1, 1), b3 + hstep, voffB);
            PG8_WAIT_V(6); PG8_BAR; PG8_MMA(1, 1, At, B1); PG8_BAR;
        }
        PG8_STAMP();
        if constexpr (!Epi::AFTER_DRAIN) { E(acc, cur, wr, wc, fr, fq); S.done(cur); }
        PG8_STAMP();
        if (!has_next) break;
#pragma unroll
        for (int a = 0; a < 2; ++a)
#pragma unroll
            for (int b = 0; b < 2; ++b)
#pragma unroll
                for (int m = 0; m < 4; ++m)
#pragma unroll
                    for (int n = 0; n < 2; ++n) acc[a][b][m][n] = (f32x4){0.f, 0.f, 0.f, 0.f};
        cur = nxt; cA = nA; cB = nB; ++ui;
    }
    PG8_WAIT_V(0);
    if (wr == 0) PG8_BAR;
    PG8_BAR;
    if constexpr (Epi::AFTER_DRAIN) { E.fused(acc, cur, wr, wc, fr, fq, lds, wid, lane); S.done(cur); }
    PG8_STAMP();
    if (STAMP && wid == 0) { stamps[lane] = lane < nts ? (((unsigned long long)(unsigned)ts_hi << 32) | (unsigned)ts_lo) : 0ull;
        if (lane == 62) stamps[62] = rt_entry; if (lane == 63) stamps[63] = (unsigned long long)wall_clock64(); }
#undef PG8_STAMP
#undef PG8_SA
#undef PG8_SB
#undef PG8_STAGE
#undef PG8_LDA
#undef PG8_LDB
#undef PG8_MMA
#undef PG8_WAIT_V
#undef PG8_WAIT_L
#undef PG8_BAR
#undef PG8_SCHED
}
}
__device__ __forceinline__ int w1_src(int n, float& mul) {
  mul = 1.f;
  if (n < 1024) { const int r = n - 512, h = r >> 6, d = r & 63;
    if (d < 16) { const int i = d >> 1, e = d & 1; return 672 + h * 64 + (e ? 8 + i : i); }
    return 672 + h * 64 + d; }
  if (n < 1536) return 1256 + (n - 1024);
  if (n < 2048) return 1768 + (n - 1536);
  if (n < 2176) { const int r = n - 2048, h = r >> 5, j = r & 31, i = j >> 1, e = j & 1; mul = PRESCALE; return h * 128 + (e ? 16 + i : i); }
  if (n < 2304) return 512 + (n - 2176);
  if (n < 2336) { const int j = n - 2304, i = j >> 1, e = j & 1; return 640 + (e ? 16 + i : i); }
  if (n < 2400) { const int d = n - 2336;
    if (d < 16) { const int i = d >> 1, e = d & 1; return 1184 + (e ? 8 + i : i); }
    return 1184 + d; }
  if (n < 2408) { mul = IDXSCALE; return 1248 + (n - 2400); }
  return -1;
}

template <int MODE>
__device__ __forceinline__ void tr_tile(LAS float* tl, const float* __restrict__ src, int ld_src, u16* __restrict__ dst, int ld_dst,
                                        int n0, int k0, int dk0, const float* __restrict__ kscale, int tid) {
  {
    const int nl = tid & 63, kq = tid >> 6;
    float mul = 1.f; int c = n0 + nl;
    if (MODE == 1) c = w1_src(n0 + nl, mul);
#pragma unroll
    for (int i = 0; i < 8; ++i) {
      const int k = k0 + kq * 8 + i;
      float v = 0.f;
      if (c >= 0) { v = src[(size_t)k * ld_src + c] * mul; if (kscale) v *= kscale[k]; }
      tl[(kq * 8 + i) * 65 + nl] = v;
    }
  }
  __syncthreads();
  {
    const int kc = tid & 7, nl = tid >> 3;
    float v[8];
#pragma unroll
    for (int j = 0; j < 8; ++j) v[j] = tl[(kc * 8 + j) * 65 + nl];
    *(uint4*)(dst + (size_t)(n0 + nl) * ld_dst + dk0 + kc * 8) = make_uint4(pack_bf2(v[0], v[1]), pack_bf2(v[2], v[3]), pack_bf2(v[4], v[5]), pack_bf2(v[6], v[7]));
  }
  __syncthreads();
}

__device__ __forceinline__ int q4fp8(float a, float b, float c, float d) {
  int w = __builtin_amdgcn_cvt_pk_fp8_f32(a, b, 0, false);
  return __builtin_amdgcn_cvt_pk_fp8_f32(c, d, w, true);
}

__device__ __forceinline__ void peer_row_fp8(const P& p, int row, int lane) {
  const int e = row & 16383; const bool isv = row >= 16384;
  const float4* src = (const float4*)((isv ? p.v_tab : p.u_tab) + (size_t)e * DM);
  float4 v[4];
  float amax = 0.f;
#pragma unroll
  for (int i = 0; i < 4; ++i) { v[i] = src[lane + 64 * i];
    amax = fmaxf(amax, fmaxf(fmaxf(fabsf(v[i].x), fabsf(v[i].y)), fmaxf(fabsf(v[i].z), fabsf(v[i].w)))); }
  amax = wave_max(amax);
  if (!isv) {
    float ss = 0.f;
#pragma unroll
    for (int i = 0; i < 4; ++i) ss += v[i].x * v[i].x + v[i].y * v[i].y + v[i].z * v[i].z + v[i].w * v[i].w;
    ss = wave_sum(ss);
    const float step = fmaxf(__builtin_amdgcn_sqrtf(ss * (1.f / DM)) * (2.5f / 7.5f), 1e-30f);
    const float inv = __builtin_amdgcn_rcpf(step);
#define Q4(x) ((unsigned)((int)__builtin_rintf(__builtin_amdgcn_fmed3f((x) * inv, -8.f, 7.f)) & 15))
    const unsigned w0 = Q4(v[0].x) | (Q4(v[0].y) << 4) | (Q4(v[0].z) << 8) | (Q4(v[0].w) << 12) | (Q4(v[1].x) << 16) | (Q4(v[1].y) << 20) | (Q4(v[1].z) << 24) | (Q4(v[1].w) << 28);
    const unsigned w1 = Q4(v[2].x) | (Q4(v[2].y) << 4) | (Q4(v[2].z) << 8) | (Q4(v[2].w) << 12) | (Q4(v[3].x) << 16) | (Q4(v[3].y) << 20) | (Q4(v[3].z) << 24) | (Q4(v[3].w) << 28);
#undef Q4
    *(uint2*)(p.U8 + (size_t)e * 512 + 8 * lane) = make_uint2(w0, w1);
    if (lane == 0) p.su[e] = step;
    return;
  }
  int ex = 0; const float m = frexpf(amax, &ex);
  const int k = (amax > 0.f) ? ((m > 0.75f) ? (2 - ex) : (3 - ex)) : 0;
  const float sc = ldexpf(1.f, k);
  unsigned w0 = 0u, w1 = 0u;
  w0 = __builtin_amdgcn_cvt_scalef32_pk_fp4_f32(w0, v[0].x * sc, v[0].y * sc, 1.0f, 0);
  w0 = __builtin_amdgcn_cvt_scalef32_pk_fp4_f32(w0, v[0].z * sc, v[0].w * sc, 1.0f, 1);
  w0 = __builtin_amdgcn_cvt_scalef32_pk_fp4_f32(w0, v[1].x * sc, v[1].y * sc, 1.0f, 2);
  w0 = __builtin_amdgcn_cvt_scalef32_pk_fp4_f32(w0, v[1].z * sc, v[1].w * sc, 1.0f, 3);
  w1 = __builtin_amdgcn_cvt_scalef32_pk_fp4_f32(w1, v[2].x * sc, v[2].y * sc, 1.0f, 0);
  w1 = __builtin_amdgcn_cvt_scalef32_pk_fp4_f32(w1, v[2].z * sc, v[2].w * sc, 1.0f, 1);
  w1 = __builtin_amdgcn_cvt_scalef32_pk_fp4_f32(w1, v[3].x * sc, v[3].y * sc, 1.0f, 2);
  w1 = __builtin_amdgcn_cvt_scalef32_pk_fp4_f32(w1, v[3].z * sc, v[3].w * sc, 1.0f, 3);
  *(uint2*)(p.V8 + (size_t)e * 512 + 8 * lane) = make_uint2(w0, w1);
  if (lane == 0) p.sv[e] = ldexpf(1.f, -k);
}


__device__ __forceinline__ void tr_tile_w(LAS float* wl, const float* __restrict__ src, int ld_src, u16* __restrict__ dst, int ld_dst,
                                          int n0, int k0, int dk0, const float* __restrict__ kscale, int mode, int lane) {
  float mul = 1.f; int c = n0 + lane;
  if (mode) c = w1_src(n0 + lane, mul);
  const float* sp = src + (size_t)k0 * ld_src + (c < 0 ? 0 : c);
  if (c < 0) mul = 0.f;
#pragma unroll
  for (int h = 0; h < 2; ++h) {
    float v[32];
#pragma unroll
    for (int i = 0; i < 32; ++i) v[i] = sp[(size_t)(h * 32 + i) * ld_src];
#pragma unroll
    for (int i = 0; i < 32; ++i) { float s = mul; if (kscale) s *= kscale[k0 + h * 32 + i]; wl[(h * 32 + i) * 65 + lane] = v[i] * s; }
  }
  __builtin_amdgcn_wave_barrier(); asm volatile("s_waitcnt lgkmcnt(0)" ::: "memory");
#pragma unroll
  for (int r = 0; r < 8; ++r) {
    const int idx = r * 64 + lane, kc = idx & 7, nl = idx >> 3;
    float v[8];
#pragma unroll
    for (int j = 0; j < 8; ++j) v[j] = wl[(kc * 8 + j) * 65 + nl];
    *(uint4*)(dst + (size_t)(n0 + nl) * ld_dst + dk0 + kc * 8) = make_uint4(pack_bf2(v[0], v[1]), pack_bf2(v[2], v[3]), pack_bf2(v[4], v[5]), pack_bf2(v[6], v[7]));
  }
  __builtin_amdgcn_wave_barrier(); asm volatile("s_waitcnt lgkmcnt(0)" ::: "memory");
}

__device__ __forceinline__ void peer_vrow_cvt(const P& p, int e, int lane, const float4 v0, const float4 v1, const float4 v2, const float4 v3) {
  float amax = fmaxf(fmaxf(fmaxf(fabsf(v0.x), fabsf(v0.y)), fmaxf(fabsf(v0.z), fabsf(v0.w))), fmaxf(fmaxf(fabsf(v1.x), fabsf(v1.y)), fmaxf(fabsf(v1.z), fabsf(v1.w))));
  amax = fmaxf(amax, fmaxf(fmaxf(fmaxf(fabsf(v2.x), fabsf(v2.y)), fmaxf(fabsf(v2.z), fabsf(v2.w))), fmaxf(fmaxf(fabsf(v3.x), fabsf(v3.y)), fmaxf(fabsf(v3.z), fabsf(v3.w)))));
  amax = wave_max(amax);
  int ex = 0; const float m = frexpf(amax, &ex);
  const int k = (amax > 0.f) ? ((m > 0.75f) ? (2 - ex) : (3 - ex)) : 0;
  const float sc = ldexpf(1.f, k);
  unsigned w0 = 0u, w1 = 0u;
  w0 = __builtin_amdgcn_cvt_scalef32_pk_fp4_f32(w0, v0.x * sc, v0.y * sc, 1.0f, 0);
  w0 = __builtin_amdgcn_cvt_scalef32_pk_fp4_f32(w0, v0.z * sc, v0.w * sc, 1.0f, 1);
  w0 = __builtin_amdgcn_cvt_scalef32_pk_fp4_f32(w0, v1.x * sc, v1.y * sc, 1.0f, 2);
  w0 = __builtin_amdgcn_cvt_scalef32_pk_fp4_f32(w0, v1.z * sc, v1.w * sc, 1.0f, 3);
  w1 = __builtin_amdgcn_cvt_scalef32_pk_fp4_f32(w1, v2.x * sc, v2.y * sc, 1.0f, 0);
  w1 = __builtin_amdgcn_cvt_scalef32_pk_fp4_f32(w1, v2.z * sc, v2.w * sc, 1.0f, 1);
  w1 = __builtin_amdgcn_cvt_scalef32_pk_fp4_f32(w1, v3.x * sc, v3.y * sc, 1.0f, 2);
  w1 = __builtin_amdgcn_cvt_scalef32_pk_fp4_f32(w1, v3.z * sc, v3.w * sc, 1.0f, 3);
  *(uint2*)(p.V8 + (size_t)e * 512 + 8 * lane) = make_uint2(w0, w1);
  if (lane == 0) p.sv[e] = ldexpf(1.f, -k);
}

__device__ __forceinline__ void peer_urow_cvt(const P& p, int e, int lane, const float4 v0, const float4 v1, const float4 v2, const float4 v3) {
  float ss = v0.x * v0.x + v0.y * v0.y + v0.z * v0.z + v0.w * v0.w + v1.x * v1.x + v1.y * v1.y + v1.z * v1.z + v1.w * v1.w
           + v2.x * v2.x + v2.y * v2.y + v2.z * v2.z + v2.w * v2.w + v3.x * v3.x + v3.y * v3.y + v3.z * v3.z + v3.w * v3.w;
  ss = wave_sum(ss);
  const float step = fmaxf(__builtin_amdgcn_sqrtf(ss * (1.f / DM)) * (2.5f / 7.5f), 1e-30f);
  const float inv = __builtin_amdgcn_rcpf(step);
#define Q4(x) ((unsigned)((int)__builtin_rintf(__builtin_amdgcn_fmed3f((x) * inv, -8.f, 7.f)) & 15))
  const unsigned w0 = Q4(v0.x) | (Q4(v0.y) << 4) | (Q4(v0.z) << 8) | (Q4(v0.w) << 12) | (Q4(v1.x) << 16) | (Q4(v1.y) << 20) | (Q4(v1.z) << 24) | (Q4(v1.w) << 28);
  const unsigned w1 = Q4(v2.x) | (Q4(v2.y) << 4) | (Q4(v2.z) << 8) | (Q4(v2.w) << 12) | (Q4(v3.x) << 16) | (Q4(v3.y) << 20) | (Q4(v3.z) << 24) | (Q4(v3.w) << 28);
#undef Q4
  *(uint2*)(p.U8 + (size_t)e * 512 + 8 * lane) = make_uint2(w0, w1);
  if (lane == 0) p.su[e] = step;
}
__device__ __forceinline__ void peer_rows4(const P& p, int item, int lane) {
  const bool isv = item >= 4096; const int e0 = (item & 4095) * 4;
  const float4* src = (const float4*)((isv ? p.v_tab : p.u_tab) + (size_t)e0 * DM);
  float4 v[16];
#pragma unroll
  for (int i = 0; i < 16; ++i) v[i] = src[lane + 64 * i];
  if (isv) {
#pragma unroll
    for (int r = 0; r < 4; ++r) peer_vrow_cvt(p, e0 + r, lane, v[r * 4], v[r * 4 + 1], v[r * 4 + 2], v[r * 4 + 3]);
  } else {
#pragma unroll
    for (int r = 0; r < 4; ++r) peer_urow_cvt(p, e0 + r, lane, v[r * 4], v[r * 4 + 1], v[r * 4 + 2], v[r * 4 + 3]);
  }
}

#define P0_NTILE 1472
#define P0_NX    4096
#define P0_NV    0
#define P0_NP    1024
#define P0_QWORD 3600

__device__ __forceinline__ void p0_fold_qlat(const P& p, LAS float* tl, int slice, int tid) {
  const int h = slice >> 6, s0 = (slice & 63) * 16;
  LAS float* sA1 = tl;
  LAS float* sB1 = tl + 96 * 20;
  {
    const float4* uk4 = (const float4*)(p.w_uk + (size_t)h * 128 * 96);
    float4 vk[6], va1 = make_float4(0.f, 0.f, 0.f, 0.f);
#pragma unroll
    for (int m = 0; m < 6; ++m) vk[m] = uk4[tid + 512 * m];
    const int kk1 = tid / 24, j41 = tid % 24;
    if (tid < 384) va1 = *(const float4*)(p.w_in + (size_t)(s0 + kk1) * INTOT + h * 128 + 32 + 4 * j41);
#pragma unroll
    for (int m = 0; m < 6; ++m) { const int e = 4 * (tid + 512 * m), c = e / 96, j = e % 96;
      sB1[j * 129 + c] = vk[m].x; sB1[(j + 1) * 129 + c] = vk[m].y; sB1[(j + 2) * 129 + c] = vk[m].z; sB1[(j + 3) * 129 + c] = vk[m].w; }
    if (tid < 384) { sA1[(4 * j41) * 20 + kk1] = va1.x; sA1[(4 * j41 + 1) * 20 + kk1] = va1.y; sA1[(4 * j41 + 2) * 20 + kk1] = va1.z; sA1[(4 * j41 + 3) * 20 + kk1] = va1.w; }
  }
  __syncthreads();
  const int c = tid & 127, q4 = tid >> 7;
  float a0 = 0.f, a1 = 0.f, a2 = 0.f, a3 = 0.f;
  for (int j = 0; j < 96; ++j) { const float b = sB1[j * 129 + c]; const pg8::f32x4 a = *(LAS pg8::f32x4*)(sA1 + j * 20 + q4 * 4);
    a0 += a[0] * b; a1 += a[1] * b; a2 += a[2] * b; a3 += a[3] * b; }
  const int k = s0 + q4 * 4;
  uint2 o; o.x = pack_bf2(a0 * PRESCALE * p.g_mix[k], a1 * PRESCALE * p.g_mix[k + 1]); o.y = pack_bf2(a2 * PRESCALE * p.g_mix[k + 2], a3 * PRESCALE * p.g_mix[k + 3]);
  *(uint2*)(p.W1t + (size_t)(h * 128 + c) * 1024 + k) = o;
  __syncthreads();
}
__device__ __forceinline__ void p0_fold_ov(const P& p, LAS float* tl, int slice, int tid) {
  const int h = slice >> 6, s0 = (slice & 63) * 16;
  LAS float* sA2 = tl;
  LAS float* sB2 = tl + 128 * 20;
  {
    const float4* uv4 = (const float4*)(p.w_uv + (size_t)h * 128 * 128);
    float4 vv[8], va2;
#pragma unroll
    for (int m = 0; m < 8; ++m) vv[m] = uv4[tid + 512 * m];
    const int d2 = tid >> 2, n42 = tid & 3;
    va2 = *(const float4*)(p.w_out + (size_t)(h * 128 + d2) * 1024 + s0 + 4 * n42);
#pragma unroll
    for (int m = 0; m < 8; ++m) { const int e = 4 * (tid + 512 * m), c = e >> 7, d = e & 127;
      sB2[d * 129 + c] = vv[m].x; sB2[(d + 1) * 129 + c] = vv[m].y; sB2[(d + 2) * 129 + c] = vv[m].z; sB2[(d + 3) * 129 + c] = vv[m].w; }
    { pg8::f32x4 w4; w4[0] = va2.x; w4[1] = va2.y; w4[2] = va2.z; w4[3] = va2.w; LDS_ST_FX4(sA2 + d2 * 20 + 4 * n42, w4); }
  }
  __syncthreads();
  const int c = tid & 127, q4 = tid >> 7;
  float a0 = 0.f, a1 = 0.f, a2 = 0.f, a3 = 0.f;
  for (int d = 0; d < 128; ++d) { const float b = sB2[d * 129 + c]; const pg8::f32x4 a = *(LAS pg8::f32x4*)(sA2 + d * 20 + q4 * 4);
    a0 += a[0] * b; a1 += a[1] * b; a2 += a[2] * b; a3 += a[3] * b; }
  u16* d0 = p.WoutT + (size_t)(s0 + q4 * 4) * 1024 + h * 128 + c;
  d0[0] = f2bf(a0); d0[1024] = f2bf(a1); d0[2048] = f2bf(a2); d0[3072] = f2bf(a3);
  __syncthreads();
}
__device__ __forceinline__ void p0_tile(const P& p, LAS float* wl, int tile, int lane) {
  const float* src; u16* dst; const float* ks = nullptr; int ld_src, ld_dst = 1024, n0, k0, mode = 0;
  if (tile < 512) { src = p.w_in; ld_src = INTOT; dst = p.W1t; n0 = 512 + (tile >> 4) * 64; k0 = (tile & 15) * 64; ks = p.g_mix; mode = 1; }
  else if (tile < 1024) { const int t2 = tile - 512; src = p.w_pq; ld_src = 2048; dst = p.WpqT; n0 = (t2 >> 4) * 64; k0 = (t2 & 15) * 64; ks = p.g_ffn; }
  else if (tile < 1280) { const int t2 = tile - 1024; src = p.w_gate; ld_src = 1024; dst = p.WgT; n0 = (t2 >> 4) * 64; k0 = (t2 & 15) * 64; }
  else if (tile < 1344) { const int t2 = tile - 1280; src = p.w_ple; ld_src = 1024; dst = p.WpleT; ld_dst = 256; n0 = (t2 >> 2) * 64; k0 = (t2 & 3) * 64; }
  else { const int t2 = tile - 1344; src = p.w_out; ld_src = 1024; dst = p.WoutT; n0 = (t2 >> 3) * 64; k0 = 512 + (t2 & 7) * 64; }
  tr_tile_w(wl, src, ld_src, dst, ld_dst, n0, k0, k0, ks, mode, lane);
}
__device__ __forceinline__ void p0_prows(const P& p, int item, int lane) {
  const int i0 = item * 1024;
  float4 v[16];
#pragma unroll
  for (int i = 0; i < 16; ++i) v[i] = ((const float4*)p.p)[i0 + lane + 64 * i];
#pragma unroll
  for (int i = 0; i < 16; ++i) { uint2 o; o.x = pack_bf2(v[i].x, v[i].y); o.y = pack_bf2(v[i].z, v[i].w);
    ((uint2*)p.p16)[i0 + lane + 64 * i] = o; }
}
__device__ __forceinline__ void p0_late(const P& p, LAS unsigned char* lds, int idx, int n, int wid_s) {
  const int tid = mk_tid(wid_s), lane = tid & 63;
  for (int s = idx; s < 256; s += n) p0_fold_ov(p, (LAS float*)lds, s, tid);
  LAS float* wl = (LAS float*)(lds + wid_s * 16640);
  for (int j = idx * 8 + wid_s; j < 960 + P0_NP; j += n * 8) { if (j < 960) p0_tile(p, wl, 512 + j, lane); else p0_prows(p, j - 960, lane); }
}

__device__ void phase0_prep(const P& p, LAS unsigned char* lds, int wid_s) {
  const int tid = mk_tid(wid_s), lane = tid & 63, wid = tid >> 6;
  const int gt = blockIdx.x * 512 + tid, nt = gridDim.x * 512;
  LAS float* tl = (LAS float*)lds;
  for (int i = gt; i < T_TOK; i += nt) { p.ss_ffn[i] = 0.f; p.ss_fin[i] = 0.f; }
  if (gt < 192) p.ctr[gt] = 0u;
  for (int s = blockIdx.x; s < 256; s += gridDim.x) p0_fold_qlat(p, tl, s, tid);
  for (int idx = gt; idx < 8 * 128 * 128; idx += nt) { p.K1b[idx] = f2bf(p.k1[idx]); p.K2b[idx] = f2bf(p.k2[idx]); }
  for (int idx = gt; idx < 8 * 64 * 64; idx += nt) {
    const int n = idx >> 12, o = (idx >> 6) & 63, i = idx & 63;
    p.WrgT[idx] = f2bf(p.w_rg[(size_t)n * 4096 + i * 64 + o]);
    p.WigT[idx] = f2bf(p.w_ig[(size_t)n * 4096 + i * 64 + o]);
  }
  LAS float* wl = (LAS float*)(lds + wid_s * 16640);
  const float invA = powf(500000.f, -(float)(2 * (lane & 15)) / 32.f), invI = powf(500000.f, -(float)(2 * (lane & 7)) / 16.f);
  for (int cur = blockIdx.x * 8 + wid_s; cur < 512 + P0_NX; cur += 2048) {
    if (cur < 512) { p0_tile(p, wl, cur, lane);
    } else {
      const int row0 = (cur - 512) * 4;
      const float4* xr = (const float4*)(p.x + (size_t)row0 * DM);
      float4 v[16];
#pragma unroll
      for (int i = 0; i < 16; ++i) v[i] = xr[lane + 64 * i];
      uint2* xo = (uint2*)(p.xb16 + (size_t)row0 * DM);
#pragma unroll
      for (int r = 0; r < 4; ++r) {
        float ss = 0.f;
#pragma unroll
        for (int i = 0; i < 4; ++i) { const float4 w = v[r * 4 + i];
          ss += w.x * w.x + w.y * w.y + w.z * w.z + w.w * w.w;
          uint2 o; o.x = pack_bf2(w.x, w.y); o.y = pack_bf2(w.z, w.w);
          xo[r * 256 + lane + 64 * i] = o; }
        ss = wave_sum(ss);
        if (lane == 0) p.rstd_mix[row0 + r] = rsqrtf(ss * (1.f / DM) + 1e-6f);
      }
      { const int r = lane >> 4, i = lane & 15;
        const float rev = (float)p.pos[row0 + r] * invA * 0.15915494309f;
        const float fr_ = __builtin_amdgcn_fractf(rev);
        p.ropeA[(size_t)(row0 + r) * 32 + i] = __builtin_amdgcn_cosf(fr_);
        p.ropeA[(size_t)(row0 + r) * 32 + 16 + i] = __builtin_amdgcn_sinf(fr_); }
      if (lane < 32) { const int r = lane >> 3, i = lane & 7;
        const float rev = (float)p.pos[row0 + r] * invI * 0.15915494309f;
        const float fr_ = __builtin_amdgcn_fractf(rev);
        p.ropeI[(size_t)(row0 + r) * 16 + i] = __builtin_amdgcn_cosf(fr_);
        p.ropeI[(size_t)(row0 + r) * 16 + 8 + i] = __builtin_amdgcn_sinf(fr_); }
    }
  }
}
__device__ __forceinline__ pg8::f32x4 rope4(pg8::f32x4 a, const float* cs, const float* sn) {
  const float c0 = cs[0], s0 = sn[0], c1 = cs[1], s1 = sn[1];
  pg8::f32x4 o;
  o[0] = a[0] * c0 - a[1] * s0; o[1] = a[1] * c0 + a[0] * s0; o[2] = a[2] * c1 - a[3] * s1; o[3] = a[3] * c1 + a[2] * s1;
  return o;
}
struct Epi1 {
  static constexpr bool PERM = true, AFTER_DRAIN = false;
  P p; LAS float* xch;
  __device__ __forceinline__ void operator()(const pg8::f32x4 (&acc)[2][2][4][2], const pg8::Unit& u, int wr, int wc, int fr_in, int fq_in) const {
    int fr = fr_in, fq = fq_in; asm volatile("" : "+v"(fr), "+v"(fq));
    const int pn = u.pn;
    const int rowb = u.pm * 256 + wr * 64 + fr;
    const int colb = wc * 32 + 8 * fq;
    float rs[2][4];
#pragma unroll
    for (int ai = 0; ai < 2; ++ai)
#pragma unroll
      for (int m = 0; m < 4; ++m) rs[ai][m] = p.rstd_mix[rowb + ai * 128 + m * 16];
    if (pn < 2) {
#pragma unroll
      for (int ai = 0; ai < 2; ++ai)
#pragma unroll
        for (int m = 0; m < 4; ++m) { const int row = rowb + ai * 128 + m * 16;
#pragma unroll
          for (int bj = 0; bj < 2; ++bj) { const int col = pn * 256 + bj * 128 + colb; const int h = col >> 7, c = col & 127;
            const pg8::f32x4 v = acc[ai][bj][m][0] * rs[ai][m], w = acc[ai][bj][m][1] * rs[ai][m];
            *(uint4*)(p.qcat + ((size_t)row * 4 + h) * 160 + c) = make_uint4(pack_bf2(v[0], v[1]), pack_bf2(v[2], v[3]), pack_bf2(w[0], w[1]), pack_bf2(w[2], w[3])); } }
    } else if (pn < 4) {
#pragma unroll
      for (int ai = 0; ai < 2; ++ai)
#pragma unroll
        for (int m = 0; m < 4; ++m) { const int row = rowb + ai * 128 + m * 16;
#pragma unroll
          for (int bj = 0; bj < 2; ++bj) { const int col = (pn - 2) * 256 + bj * 128 + colb; const int d = col & 63;
            pg8::f32x4 v = acc[ai][bj][m][0] * rs[ai][m], w = acc[ai][bj][m][1] * rs[ai][m];
            if (d < 16) { const float* cs = p.ropeI + (size_t)row * 16 + (d >> 1); v = rope4(v, cs, cs + 8); w = rope4(w, cs + 2, cs + 10); }
            *(uint4*)(p.iqh + (size_t)row * 512 + col) = make_uint4(pack_h2(v[0], v[1]), pack_h2(v[2], v[3]), pack_h2(w[0], w[1]), pack_h2(w[2], w[3])); } }
    } else if (pn < 8) {
      u16* dst = (pn < 6) ? p.xbr : p.gate;
      const int cb = (pn & 1) * 256;
#pragma unroll
      for (int ai = 0; ai < 2; ++ai)
#pragma unroll
        for (int m = 0; m < 4; ++m) { const int row = rowb + ai * 128 + m * 16;
#pragma unroll
          for (int bj = 0; bj < 2; ++bj) { const int col = cb + bj * 128 + colb;
            const pg8::f32x4 v = acc[ai][bj][m][0] * rs[ai][m], w = acc[ai][bj][m][1] * rs[ai][m];
            *(uint4*)(dst + (size_t)row * 512 + col) = make_uint4(pack_bf2(v[0], v[1]), pack_bf2(v[2], v[3]), pack_bf2(w[0], w[1]), pack_bf2(w[2], w[3])); } }
    } else if (pn == 8) {
#pragma unroll
      for (int ai = 0; ai < 2; ++ai)
#pragma unroll
        for (int m = 0; m < 4; ++m) { const int row = rowb + ai * 128 + m * 16;
          { const int h = colb >> 5, j0 = colb & 31;
            pg8::f32x4 v = acc[ai][0][m][0] * rs[ai][m], w = acc[ai][0][m][1] * rs[ai][m];
            const float* cs = p.ropeA + (size_t)row * 32 + (j0 >> 1); v = rope4(v, cs, cs + 16); w = rope4(w, cs + 2, cs + 18);
            *(uint4*)(p.qcat + ((size_t)row * 4 + h) * 160 + 128 + j0) = make_uint4(pack_bf2(v[0], v[1]), pack_bf2(v[2], v[3]), pack_bf2(w[0], w[1]), pack_bf2(w[2], w[3])); }
          float s = 0.f;
#pragma unroll
          for (int n = 0; n < 2; ++n) { const pg8::f32x4 v = acc[ai][1][m][n] * rs[ai][m]; s += v[0] * v[0] + v[1] * v[1] + v[2] * v[2] + v[3] * v[3]; }
          s = xsum32(xsum16(s));
          if (fq == 0) xch[(wr * 4 + wc) * 128 + ai * 64 + m * 16 + fr] = s; }
      asm volatile("s_waitcnt lgkmcnt(0)" ::: "memory");
      __builtin_amdgcn_s_barrier();
      asm volatile("" ::: "memory");
#pragma unroll
      for (int ai = 0; ai < 2; ++ai)
#pragma unroll
        for (int m = 0; m < 4; ++m) { const int row = rowb + ai * 128 + m * 16; const int rr = ai * 64 + m * 16 + fr;
          const float tot = xch[(wr * 4 + 0) * 128 + rr] + xch[(wr * 4 + 1) * 128 + rr] + xch[(wr * 4 + 2) * 128 + rr] + xch[(wr * 4 + 3) * 128 + rr];
          const float rk = rsqrtf(tot * (1.f / 128.f) + 1e-6f) * rs[ai][m];
          const float4 g0 = *(const float4*)(p.g_kv + colb), g1 = *(const float4*)(p.g_kv + colb + 4);
          const pg8::f32x4 v = acc[ai][1][m][0] * rk, w = acc[ai][1][m][1] * rk;
          *(uint4*)(p.kv + (size_t)row * 160 + colb) = make_uint4(pack_bf2(v[0] * g0.x, v[1] * g0.y), pack_bf2(v[2] * g0.z, v[3] * g0.w), pack_bf2(w[0] * g1.x, w[1] * g1.y), pack_bf2(w[2] * g1.z, w[3] * g1.w)); }
    } else {
#pragma unroll
      for (int ai = 0; ai < 2; ++ai)
#pragma unroll
        for (int m = 0; m < 4; ++m) { const int row = rowb + ai * 128 + m * 16;
          const int col = colb;
          pg8::f32x4 v = acc[ai][0][m][0] * rs[ai][m], w = acc[ai][0][m][1] * rs[ai][m];
          if (col < 32) {
            const float* cs = p.ropeA + (size_t)row * 32 + (col >> 1); v = rope4(v, cs, cs + 16); w = rope4(w, cs + 2, cs + 18);
            *(uint4*)(p.kv + (size_t)row * 160 + 128 + col) = make_uint4(pack_bf2(v[0], v[1]), pack_bf2(v[2], v[3]), pack_bf2(w[0], w[1]), pack_bf2(w[2], w[3]));
          } else if (col < 96) { const int d = col - 32;
            if (d < 16) { const float* cs = p.ropeI + (size_t)row * 16 + (d >> 1); v = rope4(v, cs, cs + 8); w = rope4(w, cs + 2, cs + 10); }
            *(uint4*)(p.ikh + (size_t)row * 64 + d) = make_uint4(pack_h2(v[0], v[1]), pack_h2(v[2], v[3]), pack_h2(w[0], w[1]), pack_h2(w[2], w[3]));
          } else if (col < 104) {
            float* o = p.iw + (size_t)row * 8;
            *(float4*)o = make_float4(v[0], v[1], v[2], v[3]); *(float4*)(o + 4) = make_float4(w[0], w[1], w[2], w[3]);
          } }
    }
  }
};

__device__ void phase1_gemm1(const P& p, LAS unsigned char* lds, int wid_s) {
  pg8::Gemm g; g.A = p.xb16; g.Bt = p.W1t; g.M = T_TOK; g.N = N1; g.K = p.k1024;
  pg8::StaticOrder S; S.init(T_TOK, N1, gridDim.x, blockIdx.x);
  Epi1 E; E.p = p; E.xch = (LAS float*)(lds + pg8::STAGE_BYTES);
  pg8::gemm_phase<Epi1, pg8::StaticOrder>(lds, g, S, E, nullptr, wid_s);
  const int nidle = 3 * (int)gridDim.x - 640;
  int li = -1, ln = 1;
  if (nidle > 0) { if ((int)blockIdx.x >= (int)gridDim.x - nidle) { li = (int)blockIdx.x - ((int)gridDim.x - nidle); ln = nidle; } }
  else { li = (int)blockIdx.x; ln = (int)gridDim.x; }
  if (li >= 0) {
    const int tid = mk_tid(wid_s), lane = tid & 63;
    for (int item = li * 8 + wid_s; item < 4096; item += ln * 8) peer_rows4(p, item, lane);
  }
}
typedef float f32x2 __attribute__((ext_vector_type(2)));
#define SC_STRIDE 2052
#define L_MASK 131328
#define L_HIST 139520
#define L_CAND 147712
#define L_MISC 156160
#define L_MM 156416
#define KV_STRIDE 336
#define KV_TILE_BYTES (64 * KV_STRIDE)

__device__ __forceinline__ float sort2f_(unsigned u) { const unsigned b = (u & 0x80000000u) ? (u & 0x7FFFFFFFu) : ~u; return __uint_as_float(b); }
__device__ __forceinline__ unsigned f2sort(float f) { const unsigned u = __float_as_uint(f); return u ^ ((unsigned)((int)u >> 31) | 0x80000000u); }

__device__ __forceinline__ void index_scores(const P& p, LAS unsigned char* lds, int b, int tq0, int nkt, int wid, int lane) {
  const int fr = lane & 15, g = lane >> 4;
  const size_t qtok = (size_t)b * SEQ + tq0 + fr;
  f16x8 Bq[8][2];
  float w[8];
#pragma unroll
  for (int h = 0; h < 8; ++h) {
#pragma unroll
    for (int ks = 0; ks < 2; ++ks) Bq[h][ks] = *(const f16x8*)(p.iqh + qtok * 512 + h * 64 + ks * 32 + g * 8);
    w[h] = p.iw[qtok * 8 + h];
  }
  LAS float* sc = (LAS float*)lds;
  float rmax = -INFINITY, rmin = INFINITY;
  const int tqme = tq0 + fr;
#define IDX_LOAD(A0_, A1_, kt_) { const int kc_ = min((kt_), nkt - 1); const size_t ktok = (size_t)b * SEQ + kc_ * 16 + fr; \
    A0_ = *(const f16x8*)(p.ikh + ktok * 64 + g * 8); A1_ = *(const f16x8*)(p.ikh + ktok * 64 + 32 + g * 8); }
#define IDX_COMP(A0_, A1_, kt_) { \
    f32x2 t01 = {0.f, 0.f}, t23 = {0.f, 0.f}; \
    _Pragma("unroll") for (int h = 0; h < 8; ++h) { \
      fx4 d = {0.f, 0.f, 0.f, 0.f}; \
      d = __builtin_amdgcn_mfma_f32_16x16x32_f16(A0_, Bq[h][0], d, 0, 0, 0); \
      d = __builtin_amdgcn_mfma_f32_16x16x32_f16(A1_, Bq[h][1], d, 0, 0, 0); \
      f32x2 r01, r23;                                    \
      r01[0] = __int_as_float(max(__float_as_int(d[0]), 0)); r01[1] = __int_as_float(max(__float_as_int(d[1]), 0)); \
      r23[0] = __int_as_float(max(__float_as_int(d[2]), 0)); r23[1] = __int_as_float(max(__float_as_int(d[3]), 0)); \
      const f32x2 w2 = {w[h], w[h]}; \
      t01 = __builtin_elementwise_fma(r01, w2, t01); t23 = __builtin_elementwise_fma(r23, w2, t23); } \
    fx4 tot; tot[0] = t01[0]; tot[1] = t01[1]; tot[2] = t23[0]; tot[3] = t23[1]; \
    LDS_ST_FX4(sc + fr * SC_STRIDE + (kt_) * 16 + 4 * g, tot);        \
    if ((kt_) < nkt - 1) {                               \
      rmax = fmaxf(rmax, fmaxf(tot[0], tot[1])); rmax = fmaxf(rmax, fmaxf(tot[2], tot[3])); \
      rmin = fminf(rmin, fminf(tot[0], tot[1])); rmin = fminf(rmin, fminf(tot[2], tot[3])); \
    } else { \
      _Pragma("unroll") for (int r = 0; r < 4; ++r) { const bool ok = ((kt_) * 16 + 4 * g + r) <= tqme; rmax = fmaxf(rmax, ok ? tot[r] : -INFINITY); rmin = fminf(rmin, ok ? tot[r] : INFINITY); } } }
  {
    f16x8 a0, a1, b0, b1;
    int kt = wid;
    IDX_LOAD(a0, a1, kt) IDX_LOAD(b0, b1, kt + 8)
#pragma unroll 1
    for (; kt < nkt; kt += 16) {
      IDX_COMP(a0, a1, kt) IDX_LOAD(a0, a1, kt + 16)
      if (kt + 8 < nkt) IDX_COMP(b0, b1, kt + 8)
      IDX_LOAD(b0, b1, kt + 24)
    }
  }
#undef IDX_LOAD
#undef IDX_COMP
  rmax = fmaxf(rmax, __shfl_xor(rmax, 16, 64)); rmax = fmaxf(rmax, __shfl_xor(rmax, 32, 64));
  rmin = fminf(rmin, __shfl_xor(rmin, 16, 64)); rmin = fminf(rmin, __shfl_xor(rmin, 32, 64));
  if (g == 0) {
    LAS unsigned* mm = (LAS unsigned*)(lds + L_MM);
    if (rmax != -INFINITY) __hip_atomic_fetch_max(mm + 2 * fr, f2sort(rmax), __ATOMIC_RELAXED, __HIP_MEMORY_SCOPE_WORKGROUP);
    if (rmin != INFINITY) __hip_atomic_fetch_min(mm + 2 * fr + 1, f2sort(rmin), __ATOMIC_RELAXED, __HIP_MEMORY_SCOPE_WORKGROUP);
  }
}

#define DPP_F(x, ctrl) __uint_as_float((unsigned)__builtin_amdgcn_update_dpp(0, (int)__float_as_uint(x), (ctrl), 0xF, 0xF, true))
#define DPP_I(x, ctrl) ((unsigned)__builtin_amdgcn_update_dpp(0, (int)(x), (ctrl), 0xF, 0xF, true))
__device__ __forceinline__ float wave_max_dpp(float x) {
  x = fmaxf(x, DPP_F(x, 0xB1)); x = fmaxf(x, DPP_F(x, 0x4E)); x = fmaxf(x, DPP_F(x, 0x141)); x = fmaxf(x, DPP_F(x, 0x140));
  const int xi = (int)__float_as_uint(x);
  const float a = __uint_as_float((unsigned)__builtin_amdgcn_readlane(xi, 0)), b = __uint_as_float((unsigned)__builtin_amdgcn_readlane(xi, 16));
  const float c = __uint_as_float((unsigned)__builtin_amdgcn_readlane(xi, 32)), d = __uint_as_float((unsigned)__builtin_amdgcn_readlane(xi, 48));
  return fmaxf(fmaxf(a, b), fmaxf(c, d));
}
__device__ __forceinline__ unsigned row16_sum_u32(unsigned x) { x += DPP_I(x, 0xB1); x += DPP_I(x, 0x4E); x += DPP_I(x, 0x141); x += DPP_I(x, 0x140); return x; }

__device__ __forceinline__ void select_row(LAS float* row, int tq, LAS unsigned* mrow, LAS unsigned* hist, LAS unsigned* cand, int lane, int sflags, LAS unsigned* mmq) {
  const int n = tq + 1;
  unsigned long long mybal = 0ull;
  if (n <= 256) {
#pragma unroll 4
    for (int j = 0; j < 32; ++j) {
      const unsigned long long bl = __ballot((j * 64 + lane) <= tq);
      if (lane == j) mybal = bl;
    }
  } else {
    const float vmax = sort2f_(mmq[0]), vmin = sort2f_(mmq[1]);
    const int njb = ((tq >> 6) + 8) & ~7;
    const float scale = (vmax > vmin) ? 511.5f / (vmax - vmin) : 0.f;
    const float boff = -vmin * scale;
#pragma unroll
    for (int i = 0; i < 4; ++i) hist[lane * 4 + i] = 0u;
    if (lane == 0) cand[256] = 0u;
    const int nf8 = ((tq + 1) >> 9) << 3;
#pragma unroll 1
    for (int jb = 0; jb < nf8; jb += 8) {
      float v[8];
#pragma unroll
      for (int j = 0; j < 8; ++j) v[j] = row[(jb + j) * 64 + lane];
#pragma unroll
      for (int j = 0; j < 8; ++j) {
        const int bk = min(511, (int)__builtin_fmaf(v[j], scale, boff));
        __hip_atomic_fetch_add((LAS unsigned*)&hist[bk >> 1], 1u << ((bk & 1) * 16), __ATOMIC_RELAXED, __HIP_MEMORY_SCOPE_WAVEFRONT);
      }
    }
#pragma unroll 1
    for (int jb = nf8; jb < njb; jb += 8) {
      float v[8];
#pragma unroll
      for (int j = 0; j < 8; ++j) v[j] = row[(jb + j) * 64 + lane];
#pragma unroll
      for (int j = 0; j < 8; ++j) {
        const bool ok = ((jb + j) * 64 + lane) <= tq;
        const int bk = ok ? min(511, (int)__builtin_fmaf(v[j], scale, boff)) : 2 * lane;
        __hip_atomic_fetch_add((LAS unsigned*)&hist[bk >> 1], ok ? (1u << ((bk & 1) * 16)) : 0u, __ATOMIC_RELAXED, __HIP_MEMORY_SCOPE_WAVEFRONT);
      }
    }
    asm volatile("s_waitcnt lgkmcnt(0)" ::: "memory");
    const unsigned h40 = hist[255 - 4 * lane], h41 = hist[254 - 4 * lane], h42 = hist[253 - 4 * lane], h43 = hist[252 - 4 * lane];
    const unsigned pk = h40 + h41 + h42 + h43;
    const unsigned mine = (pk & 0xFFFFu) + (pk >> 16);
    const unsigned rsum = row16_sum_u32(mine);
    int Bsel = 0; unsigned above = 0u;
    {
      unsigned run = 0u; int R = 0;
#pragma unroll
      for (int r = 0; r < 4; ++r) { const unsigned s = (unsigned)__builtin_amdgcn_readlane((int)rsum, r * 16); if (run + s < 256u && R == r) { run += s; R = r + 1; } }
      if (R > 3) R = 3;
      int L = R * 16;
#pragma unroll 1
      for (int i = 0; i < 16; ++i) { const unsigned s = (unsigned)__builtin_amdgcn_readlane((int)mine, L); if (run + s >= 256u) break; run += s; ++L; }
      if (L > R * 16 + 15) L = R * 16 + 15;
      const unsigned w0 = (unsigned)__builtin_amdgcn_readlane((int)h40, L), w1 = (unsigned)__builtin_amdgcn_readlane((int)h41, L);
      const unsigned w2 = (unsigned)__builtin_amdgcn_readlane((int)h42, L), w3 = (unsigned)__builtin_amdgcn_readlane((int)h43, L);
      const unsigned cs[8] = {w0 >> 16, w0 & 0xFFFFu, w1 >> 16, w1 & 0xFFFFu, w2 >> 16, w2 & 0xFFFFu, w3 >> 16, w3 & 0xFFFFu};
      int fi = 7;
#pragma unroll
      for (int i = 6; i >= 0; --i) { unsigned pre = 0u;
#pragma unroll
        for (int k = 0; k <= i; ++k) pre += cs[k];
        if (run + pre >= 256u) fi = i; }
      unsigned pre2 = 0u;
#pragma unroll
      for (int k = 0; k < 7; ++k) pre2 += (k < fi) ? cs[k] : 0u;
      Bsel = 511 - 8 * L - fi;
      above = run + pre2;
    }
    const unsigned need = 256u - above;
    if (sflags & 4) { if (lane < 32) { mrow[2 * lane] = need + Bsel; mrow[2 * lane + 1] = 0u; } return; }
    unsigned cmask = 0u;
#pragma unroll 1
    for (int jb = 0; jb < nf8; jb += 8) {
      float v[8];
#pragma unroll
      for (int j = 0; j < 8; ++j) v[j] = row[(jb + j) * 64 + lane];
#pragma unroll
      for (int j = 0; j < 8; ++j) {
        const bool is = min(511, (int)__builtin_fmaf(v[j], scale, boff)) == Bsel;
        cmask |= is ? (1u << (jb + j)) : 0u;
      }
    }
#pragma unroll 1
    for (int jb = nf8; jb < njb; jb += 8) {
      float v[8];
#pragma unroll
      for (int j = 0; j < 8; ++j) v[j] = row[(jb + j) * 64 + lane];
#pragma unroll
      for (int j = 0; j < 8; ++j) {
        const bool is = (((jb + j) * 64 + lane) <= tq) && (min(511, (int)__builtin_fmaf(v[j], scale, boff)) == Bsel);
        cmask |= is ? (1u << (jb + j)) : 0u;
      }
    }
    while (cmask) {
      const int j = __ffs((int)cmask) - 1; cmask &= cmask - 1u;
      const int key = j * 64 + lane;
      const unsigned pos = __hip_atomic_fetch_add((LAS unsigned*)&cand[256], 1u, __ATOMIC_RELAXED, __HIP_MEMORY_SCOPE_WAVEFRONT);
      if (pos < 128u) { cand[2 * pos] = f2sort(row[key]); cand[2 * pos + 1] = (unsigned)key; }
    }
    asm volatile("s_waitcnt lgkmcnt(0)" ::: "memory");
    const unsigned cnt = (unsigned)__builtin_amdgcn_readfirstlane((int)cand[256]);
    if (sflags & 8) { if (lane < 32) { mrow[2 * lane] = cnt; mrow[2 * lane + 1] = 0u; } return; }
    unsigned ustar = 0u, kstar = 0u;
    if (cnt <= 64u) {
      const unsigned mu = (lane < (int)cnt) ? cand[2 * lane] : 0u, mk = (lane < (int)cnt) ? cand[2 * lane + 1] : 0xFFFFFFFFu;
      unsigned rank = 0;
      for (unsigned q = 0; q < cnt; ++q) {
        const unsigned qu = (unsigned)__builtin_amdgcn_readlane((int)mu, q), qk = (unsigned)__builtin_amdgcn_readlane((int)mk, q);
        rank += (qu > mu || (qu == mu && qk < mk)) ? 1u : 0u;
      }
      const unsigned long long fb = __ballot(lane < (int)cnt && rank == need - 1u);
      const int fl = __ffsll((long long)fb) - 1;
      ustar = (unsigned)__builtin_amdgcn_readlane((int)mu, fl); kstar = (unsigned)__builtin_amdgcn_readlane((int)mk, fl);
    } else if (cnt <= 128u) {
      unsigned fu = 0u, fk = 0u; int found = 0;
      for (unsigned base = 0; base < cnt; base += 64) {
        const unsigned i = base + lane;
        const unsigned mu = (i < cnt) ? cand[2 * i] : 0u, mk = (i < cnt) ? cand[2 * i + 1] : 0u;
        unsigned rank = 0;
#pragma unroll 4
        for (unsigned q = 0; q < cnt; ++q) { const unsigned qu = cand[2 * q], qk = cand[2 * q + 1]; rank += (qu > mu || (qu == mu && qk < mk)) ? 1u : 0u; }
        if (i < cnt && rank == need - 1u) { fu = mu; fk = mk; found = 1; }
      }
      const unsigned long long fb = __ballot(found);
      const int fl = __ffsll((long long)fb) - 1;
      ustar = (unsigned)__shfl((int)fu, fl, 64); kstar = (unsigned)__shfl((int)fk, fl, 64);
    } else {
      const int nj = (tq >> 6) + 1;
      unsigned prefix = 0u; unsigned needr = need;
      for (int bit = 31; bit >= 0; --bit) {
        const unsigned trial = prefix | (1u << bit);
        unsigned c = 0;
        for (int j = 0; j < nj; ++j) {
          const int key = j * 64 + lane;
          const float x = row[key];
          const bool inb = (key <= tq) && (min(511, (int)__builtin_fmaf(x, scale, boff)) == Bsel);
          c += __popcll(__ballot(inb && (f2sort(x) >> bit) == (trial >> bit)));
        }
        if (c >= needr) prefix = trial; else needr -= c;
      }
      ustar = prefix;
      unsigned seen = 0; int done = 0;
      for (int j = 0; j < nj; ++j) {
        const int key = j * 64 + lane;
        const float x = row[key];
        const unsigned long long bl = __ballot((key <= tq) && f2sort(x) == ustar);
        const unsigned c = __popcll(bl);
        if (!done && seen + c >= needr) {
          unsigned long long m = bl; const unsigned k = needr - seen;
          int pos = 0;
          for (unsigned q = 0; q < k; ++q) { pos = __ffsll((long long)m) - 1; m &= m - 1ull; }
          kstar = (unsigned)(j * 64 + pos); done = 1;
        }
        seen += c;
      }
    }
#pragma unroll 1
    for (int jb = 0; jb < nf8; jb += 8) {
      float v[8];
#pragma unroll
      for (int j = 0; j < 8; ++j) v[j] = row[(jb + j) * 64 + lane];
#pragma unroll
      for (int j = 0; j < 8; ++j) {
        const int key = (jb + j) * 64 + lane;
        const unsigned uu = f2sort(v[j]);
        const bool s = uu > ustar || (uu == ustar && (unsigned)key <= kstar);
        const unsigned long long bl = __ballot(s);
        if (lane == jb + j) mybal = bl;
      }
    }
#pragma unroll 1
    for (int jb = nf8; jb < njb; jb += 8) {
      float v[8];
#pragma unroll
      for (int j = 0; j < 8; ++j) v[j] = row[(jb + j) * 64 + lane];
#pragma unroll
      for (int j = 0; j < 8; ++j) {
        const int key = (jb + j) * 64 + lane;
        const unsigned uu = f2sort(v[j]);
        const bool s = (key <= tq) && (uu > ustar || (uu == ustar && (unsigned)key <= kstar));
        const unsigned long long bl = __ballot(s);
        if (lane == jb + j) mybal = bl;
      }
    }
  }
  if (lane < 32) { mrow[2 * lane] = (unsigned)mybal; mrow[2 * lane + 1] = (unsigned)(mybal >> 32); }
}

__device__ __forceinline__ s16x8 attn_softmax(fx4 (&S)[2], unsigned mw, int g, float& m_run, float& l_run, fx4 (&O)[8]) {
  float mx = -INFINITY;
#pragma unroll
  for (int sub = 0; sub < 2; ++sub)
#pragma unroll
    for (int r = 0; r < 4; ++r) { const int bit = sub * 16 + 4 * g + r; const float s = ((mw >> bit) & 1u) ? S[sub][r] : -INFINITY; S[sub][r] = s; mx = fmaxf(mx, s); }
  { const unsigned xi = __float_as_uint(mx); const auto r32 = __builtin_amdgcn_permlane32_swap(xi, xi, false, false); mx = fmaxf(__uint_as_float(r32[0]), __uint_as_float(r32[1])); }
  { const unsigned xi = __float_as_uint(mx); const auto r16 = __builtin_amdgcn_permlane16_swap(xi, xi, false, false); mx = fmaxf(__uint_as_float(r16[0]), __uint_as_float(r16[1])); }
  const float m_new = fmaxf(m_run, mx);
  const float m_use = (m_new == -INFINITY) ? 0.f : m_new;
  const float alpha = __builtin_amdgcn_exp2f(m_run - m_use);
  const bool resc = __any(m_new != m_run);
  m_run = m_new;
  float psum = 0.f;
  float pv[8];
#pragma unroll
  for (int sub = 0; sub < 2; ++sub)
#pragma unroll
    for (int r = 0; r < 4; ++r) { pv[sub * 4 + r] = __builtin_amdgcn_exp2f(S[sub][r] - m_use); psum += pv[sub * 4 + r]; }
  u32x4 pw4; pw4[0] = pack_bf2(pv[0], pv[1]); pw4[1] = pack_bf2(pv[2], pv[3]); pw4[2] = pack_bf2(pv[4], pv[5]); pw4[3] = pack_bf2(pv[6], pv[7]);
  l_run = l_run * alpha + psum;
  if (resc) {
#pragma unroll
    for (int i = 0; i < 8; ++i) O[i] *= alpha;
  }
  return __builtin_bit_cast(s16x8, pw4);
}
__device__ __forceinline__ void attn_half2(LAS unsigned char* kb, unsigned mw, int kh, int fr, int g, const s16x8 (&QA)[5], const s16x8 (&QB)[5],
                                           fx4 (&OA)[8], fx4 (&OB)[8], float& mA, float& lA, float& mB, float& lB) {
  LAS unsigned char* kr0 = kb + (kh * 32 + fr) * KV_STRIDE + g * 16;
  fx4 SA[2], SB[2];
  SA[0] = (fx4){0.f, 0.f, 0.f, 0.f}; SA[1] = SA[0]; SB[0] = SA[0]; SB[1] = SA[0];
#pragma unroll
  for (int sub = 0; sub < 2; ++sub) {
    s16x8 Kf[5];
#pragma unroll
    for (int ks = 0; ks < 5; ++ks) Kf[ks] = *(LAS s16x8*)(kr0 + sub * 16 * KV_STRIDE + ks * 64);
    __builtin_amdgcn_sched_barrier(0);
    __builtin_amdgcn_s_setprio(1);
#pragma unroll
    for (int ks = 0; ks < 5; ++ks) {
      SA[sub] = __builtin_amdgcn_mfma_f32_16x16x32_bf16(Kf[ks], QA[ks], SA[sub], 0, 0, 0);
      SB[sub] = __builtin_amdgcn_mfma_f32_16x16x32_bf16(Kf[ks], QB[ks], SB[sub], 0, 0, 0);
    }
    __builtin_amdgcn_s_setprio(0);
    __builtin_amdgcn_sched_barrier(0);
  }
  const int q4 = fr >> 2, p4 = fr & 3;
  LAS unsigned char* vb0 = kb + (kh * 32 + 4 * g + q4) * KV_STRIDE + p4 * 8;
  s16x4 va[4], vb[4];
#pragma unroll
  for (int dvt = 0; dvt < 4; ++dvt) {
    va[dvt] = __builtin_amdgcn_ds_read_tr16_b64_v4i16((LAS s16x4*)(vb0 + dvt * 32));
    vb[dvt] = __builtin_amdgcn_ds_read_tr16_b64_v4i16((LAS s16x4*)(vb0 + 16 * KV_STRIDE + dvt * 32));
  }
  __builtin_amdgcn_sched_barrier(0);
  const s16x8 PA = attn_softmax(SA, mw, g, mA, lA, OA);
  const s16x8 PB = attn_softmax(SB, mw, g, mB, lB, OB);
  __builtin_amdgcn_sched_barrier(0);
  __builtin_amdgcn_s_setprio(1);
#pragma unroll
  for (int dvt = 0; dvt < 4; ++dvt) {
    s16x8 Vf; Vf[0] = va[dvt][0]; Vf[1] = va[dvt][1]; Vf[2] = va[dvt][2]; Vf[3] = va[dvt][3]; Vf[4] = vb[dvt][0]; Vf[5] = vb[dvt][1]; Vf[6] = vb[dvt][2]; Vf[7] = vb[dvt][3];
    OA[dvt] = __builtin_amdgcn_mfma_f32_16x16x32_bf16(Vf, PA, OA[dvt], 0, 0, 0);
    OB[dvt] = __builtin_amdgcn_mfma_f32_16x16x32_bf16(Vf, PB, OB[dvt], 0, 0, 0);
  }
  __builtin_amdgcn_s_setprio(0);
  __builtin_amdgcn_sched_barrier(0);
#pragma unroll
  for (int dvt = 0; dvt < 4; ++dvt) {
    va[dvt] = __builtin_amdgcn_ds_read_tr16_b64_v4i16((LAS s16x4*)(vb0 + (4 + dvt) * 32));
    vb[dvt] = __builtin_amdgcn_ds_read_tr16_b64_v4i16((LAS s16x4*)(vb0 + 16 * KV_STRIDE + (4 + dvt) * 32));
  }
  __builtin_amdgcn_sched_barrier(0);
  __builtin_amdgcn_s_setprio(1);
#pragma unroll
  for (int dvt = 0; dvt < 4; ++dvt) {
    s16x8 Vf; Vf[0] = va[dvt][0]; Vf[1] = va[dvt][1]; Vf[2] = va[dvt][2]; Vf[3] = va[dvt][3]; Vf[4] = vb[dvt][0]; Vf[5] = vb[dvt][1]; Vf[6] = vb[dvt][2]; Vf[7] = vb[dvt][3];
    OA[4 + dvt] = __builtin_amdgcn_mfma_f32_16x16x32_bf16(Vf, PA, OA[4 + dvt], 0, 0, 0);
    OB[4 + dvt] = __builtin_amdgcn_mfma_f32_16x16x32_bf16(Vf, PB, OB[4 + dvt], 0, 0, 0);
  }
  __builtin_amdgcn_s_setprio(0);
}
#define AT_MG_STRIDE 68
__device__ __forceinline__ void attn_block(const P& p, LAS unsigned char* lds, int b, int t0, int wid, int lane_in, int tid_in, uint4 pre0, uint4 pre1, uint4 pre2) {
  int lane = lane_in, tid = tid_in; asm volatile("" : "+v"(lane), "+v"(tid));
  const int fr = lane & 15, g = lane >> 4;
  const int hp = wid >> 2, qs = (wid >> 1) & 1, kh = wid & 1;
  const size_t qtok = (size_t)b * SEQ + t0 + qs * 16 + fr;
  s16x8 QA[5], QB[5];
#pragma unroll
  for (int ks = 0; ks < 5; ++ks) { QA[ks] = *(const s16x8*)(p.qcat + (qtok * 4 + 2 * hp) * 160 + ks * 32 + g * 8);
    QB[ks] = *(const s16x8*)(p.qcat + (qtok * 4 + 2 * hp + 1) * 160 + ks * 32 + g * 8); }
  const int ntile = (t0 + 32 + 63) >> 6;
  const u16* kvb = p.kv + (size_t)b * SEQ * 160;
  LAS unsigned* mrow = (LAS unsigned*)(lds + L_MASK) + (qs * 16 + fr) * 64;
  fx4 OA[8], OB[8];
#pragma unroll
  for (int i = 0; i < 8; ++i) { OA[i] = (fx4){0.f, 0.f, 0.f, 0.f}; OB[i] = OA[i]; }
  float mA = -INFINITY, lA = 0.f, mB = -INFINITY, lB = 0.f;
  uint4 st0 = pre0, st1 = pre1, st2 = pre2;
  const int c0i = tid, c1i = tid + 512, c2i = tid + 1024;
  const int lo0 = (c0i / 20) * KV_STRIDE + (c0i % 20) * 16, lo1 = (c1i / 20) * KV_STRIDE + (c1i % 20) * 16, lo2 = (c2i / 20) * KV_STRIDE + (c2i % 20) * 16;
#define G_LOAD(kt_) do { const uint4* src_ = (const uint4*)(kvb + (size_t)(kt_) * 64 * 160); st0 = src_[c0i]; st1 = src_[c1i]; if (c2i < 1280) st2 = src_[c2i]; } while (0)
#define L_STORE(buf_) do { LAS unsigned char* d_ = lds + (buf_) * KV_TILE_BYTES; LDS_STORE(uint4, d_ + lo0, st0); LDS_STORE(uint4, d_ + lo1, st1); if (c2i < 1280) LDS_STORE(uint4, d_ + lo2, st2); } while (0)
  L_STORE(0);
  __syncthreads();
  for (int kt = 0; kt < ntile; ++kt) {
    const int buf = kt & 1;
    if (kt + 1 < ntile) G_LOAD(kt + 1);
    const unsigned mw = mrow[kt * 2 + kh];
    attn_half2(lds + buf * KV_TILE_BYTES, mw, kh, fr, g, QA, QB, OA, OB, mA, lA, mB, lB);
    if (kt + 1 < ntile) L_STORE(buf ^ 1);
    __syncthreads();
  }
#undef G_LOAD
#undef L_STORE
  LAS float* mg = (LAS float*)lds + (wid >> 1) * (64 * AT_MG_STRIDE) + lane * AT_MG_STRIDE;
  if (kh == 1) {
#pragma unroll
    for (int i = 0; i < 8; ++i) { LDS_ST_FX4(mg + 4 * i, OA[i]); LDS_ST_FX4(mg + 32 + 4 * i, OB[i]); }
    const fx4 ml = {mA, lA, mB, lB};
    LDS_ST_FX4(mg + 64, ml);
  }
  __syncthreads();
  if (kh == 0) {
    const fx4 ml = *(LAS fx4*)(mg + 64);
    {
      const float m = fmaxf(mA, ml[0]);
      const float a0 = (mA == -INFINITY) ? 0.f : __builtin_amdgcn_exp2f(mA - m), a1 = (ml[0] == -INFINITY) ? 0.f : __builtin_amdgcn_exp2f(ml[0] - m);
      const float l = lA * a0 + ml[1] * a1;
      const float inv = 1.f / xsum32(xsum16(l));
      u16* dst = p.mix + qtok * 1024 + (2 * hp) * 128 + 4 * g;
#pragma unroll
      for (int dvt = 0; dvt < 8; ++dvt) { const fx4 o1 = *(LAS fx4*)(mg + 4 * dvt);
        uint2 o; o.x = pack_bf2((OA[dvt][0] * a0 + o1[0] * a1) * inv, (OA[dvt][1] * a0 + o1[1] * a1) * inv);
        o.y = pack_bf2((OA[dvt][2] * a0 + o1[2] * a1) * inv, (OA[dvt][3] * a0 + o1[3] * a1) * inv);
        *(uint2*)(dst + dvt * 16) = o; }
    }
    {
      const float m = fmaxf(mB, ml[2]);
      const float a0 = (mB == -INFINITY) ? 0.f : __builtin_amdgcn_exp2f(mB - m), a1 = (ml[2] == -INFINITY) ? 0.f : __builtin_amdgcn_exp2f(ml[2] - m);
      const float l = lB * a0 + ml[3] * a1;
      const float inv = 1.f / xsum32(xsum16(l));
      u16* dst = p.mix + qtok * 1024 + (2 * hp + 1) * 128 + 4 * g;
#pragma unroll
      for (int dvt = 0; dvt < 8; ++dvt) { const fx4 o1 = *(LAS fx4*)(mg + 32 + 4 * dvt);
        uint2 o; o.x = pack_bf2((OB[dvt][0] * a0 + o1[0] * a1) * inv, (OB[dvt][1] * a0 + o1[1] * a1) * inv);
        o.y = pack_bf2((OB[dvt][2] * a0 + o1[2] * a1) * inv, (OB[dvt][3] * a0 + o1[3] * a1) * inv);
        *(uint2*)(dst + dvt * 16) = o; }
    }
  }
}

#define LR_XCB 0
#define LRS 68
#define LR_XCF 18432
#define LR_A   53248
#define LR_B   88064
#define LR_SEG 122880
__device__ void lru_item(const P& p, LAS unsigned char* lds, int b, int blk, int tid, int wid) {
  const int lane = tid & 63, fr = lane & 15, g = lane >> 4;
  LAS u16* xcb = (LAS u16*)(lds + LR_XCB);
  LAS float* xcf = (LAS float*)(lds + LR_XCF);
  LAS float* a_s = (LAS float*)(lds + LR_A);
  LAS float* b_s = (LAS float*)(lds + LR_B);
  LAS float* segP = (LAS float*)(lds + LR_SEG);
  LAS float* segH = segP + 512;
  LAS float* carry = segH + 512;
  LAS float* Hprev = carry + 512;
  LAS float* cw = Hprev + 64;
  LAS float* cb = cw + 256;
  const int c0 = blk * 64;
  if (tid < 256) cw[tid] = p.conv_w[(tid >> 6) * 512 + c0 + (tid & 63)];
  if (tid < 64) { cb[tid] = p.conv_b[c0 + tid]; Hprev[tid] = 0.f; }
  float brg[4], big[4], spl[4];
#pragma unroll
  for (int nt = 0; nt < 4; ++nt) {
    const int c = c0 + nt * 16 + fr;
    brg[nt] = p.b_rg[c]; big[nt] = p.b_ig[c];
    const float l = p.lam[c];
    spl[nt] = (-l > 20.f) ? -l : log1pf(__expf(-l));
  }
  LAS u16* wimg = (LAS u16*)(lds + L_MASK);
  for (int i = tid; i < 2 * 64 * 8; i += 512) { const int which = i >> 9, o = (i >> 3) & 63, c8 = i & 7;
    const uint4 v = *(const uint4*)((which ? p.WigT : p.WrgT) + (size_t)blk * 4096 + o * 64 + c8 * 8);
    LDS_STORE(uint4, wimg + (which * 64 + o) * 72 + c8 * 8, v); }
  __syncthreads();
  const int tok_l = tid >> 2, cg = tid & 3;
  uint4 xr[4][2];
  const u16* xbase = p.xbr + (size_t)b * SEQ * 512 + c0 + cg * 16;
#define LRU_LOADX(S0) do { _Pragma("unroll") for (int w = 0; w < 4; ++w) { const int ss = (S0) + tok_l - 3 + w; \
      if (ss >= 0) { const uint4* src = (const uint4*)(xbase + (size_t)ss * 512); xr[w][0] = src[0]; xr[w][1] = src[1]; } \
      else { xr[w][0] = make_uint4(0, 0, 0, 0); xr[w][1] = xr[w][0]; } } } while (0)
  LRU_LOADX(0);
  for (int s0 = 0; s0 < SEQ; s0 += 128) {
    {
      float acc[16];
      { const fx4 b0 = *(LAS fx4*)(cb + cg * 16), b1 = *(LAS fx4*)(cb + cg * 16 + 4), b2 = *(LAS fx4*)(cb + cg * 16 + 8), b3 = *(LAS fx4*)(cb + cg * 16 + 12);
        acc[0] = b0[0]; acc[1] = b0[1]; acc[2] = b0[2]; acc[3] = b0[3]; acc[4] = b1[0]; acc[5] = b1[1]; acc[6] = b1[2]; acc[7] = b1[3];
        acc[8] = b2[0]; acc[9] = b2[1]; acc[10] = b2[2]; acc[11] = b2[3]; acc[12] = b3[0]; acc[13] = b3[1]; acc[14] = b3[2]; acc[15] = b3[3]; }
#pragma unroll
      for (int w = 0; w < 4; ++w) {
        const unsigned uu[8] = {xr[w][0].x, xr[w][0].y, xr[w][0].z, xr[w][0].w, xr[w][1].x, xr[w][1].y, xr[w][1].z, xr[w][1].w};
#pragma unroll
        for (int q = 0; q < 4; ++q) { const fx4 wv = *(LAS fx4*)(cw + w * 64 + cg * 16 + 4 * q);
          acc[4 * q] += bflo(uu[2 * q]) * wv[0]; acc[4 * q + 1] += bfhi(uu[2 * q]) * wv[1]; acc[4 * q + 2] += bflo(uu[2 * q + 1]) * wv[2]; acc[4 * q + 3] += bfhi(uu[2 * q + 1]) * wv[3]; }
      }
#pragma unroll
      for (int i = 0; i < 16; i += 4) { const fx4 t4 = {acc[i], acc[i + 1], acc[i + 2], acc[i + 3]}; LDS_ST_FX4(xcf + tok_l * LRS + cg * 16 + i, t4); }
#pragma unroll
      for (int i = 0; i < 16; i += 4) { uint2 o; o.x = pack_bf2(acc[i], acc[i + 1]); o.y = pack_bf2(acc[i + 2], acc[i + 3]); LDS_STORE(uint2, xcb + tok_l * 72 + cg * 16 + i, o); }
    }
    const size_t t = (size_t)b * SEQ + s0 + tok_l;
    const uint4* gsrc = (const uint4*)(p.gate + t * 512 + c0 + cg * 16);
    const uint4 g0 = gsrc[0], g1 = gsrc[1];
    if (s0 + 128 < SEQ) LRU_LOADX(s0 + 128);
    __syncthreads();
    {
      const s16x8 A0 = *(LAS s16x8*)(xcb + (wid * 16 + fr) * 72 + g * 8);
      const s16x8 A1 = *(LAS s16x8*)(xcb + (wid * 16 + fr) * 72 + 32 + g * 8);
#pragma unroll
      for (int nt = 0; nt < 4; ++nt) {
        fx4 R = {0.f, 0.f, 0.f, 0.f}, I = {0.f, 0.f, 0.f, 0.f};
        const s16x8 br0 = *(LAS s16x8*)(wimg + (nt * 16 + fr) * 72 + g * 8), br1 = *(LAS s16x8*)(wimg + (nt * 16 + fr) * 72 + 32 + g * 8);
        const s16x8 bi0 = *(LAS s16x8*)(wimg + (64 + nt * 16 + fr) * 72 + g * 8), bi1 = *(LAS s16x8*)(wimg + (64 + nt * 16 + fr) * 72 + 32 + g * 8);
        R = __builtin_amdgcn_mfma_f32_16x16x32_bf16(A0, br0, R, 0, 0, 0);
        R = __builtin_amdgcn_mfma_f32_16x16x32_bf16(A1, br1, R, 0, 0, 0);
        I = __builtin_amdgcn_mfma_f32_16x16x32_bf16(A0, bi0, I, 0, 0, 0);
        I = __builtin_amdgcn_mfma_f32_16x16x32_bf16(A1, bi1, I, 0, 0, 0);
#pragma unroll
        for (int r = 0; r < 4; ++r) {
          const int tok = wid * 16 + 4 * g + r, o = nt * 16 + fr;
          const float rr = sigmoidf_(R[r] + brg[nt]), ii = sigmoidf_(I[r] + big[nt]);
          const float log_a = -8.f * rr * spl[nt];
          const float a = __builtin_amdgcn_exp2f(1.4426950408889634f * log_a);
          const float bb = __builtin_amdgcn_sqrtf(fmaxf(1.f - a * a, 0.f)) * (ii * xcf[tok * LRS + o]);
          a_s[tok * LRS + o] = a; b_s[tok * LRS + o] = bb;
        }
      }
    }
    __syncthreads();
    {
      float av[16], bv[16];
#pragma unroll
      for (int i = 0; i < 16; ++i) { av[i] = a_s[(wid * 16 + i) * LRS + lane]; bv[i] = b_s[(wid * 16 + i) * LRS + lane]; }
      float hh = 0.f, pp = 1.f;
#pragma unroll
      for (int i = 0; i < 16; ++i) { hh = av[i] * hh + bv[i]; pp *= av[i]; bv[i] = hh; av[i] = pp; }
#pragma unroll
      for (int i = 0; i < 16; ++i) { b_s[(wid * 16 + i) * LRS + lane] = bv[i]; a_s[(wid * 16 + i) * LRS + lane] = av[i]; }
      segP[wid * 64 + lane] = pp; segH[wid * 64 + lane] = hh;
    }
    __syncthreads();
    if (tid < 64) {
      float sp_[8], sh_[8];
#pragma unroll
      for (int sg = 0; sg < 8; ++sg) { sp_[sg] = segP[sg * 64 + tid]; sh_[sg] = segH[sg * 64 + tid]; }
      float c = Hprev[tid];
#pragma unroll
      for (int sg = 0; sg < 8; ++sg) { carry[sg * 64 + tid] = c; c = sp_[sg] * c + sh_[sg]; }
      Hprev[tid] = c;
    }
    __syncthreads();
    {
      const unsigned gg[8] = {g0.x, g0.y, g0.z, g0.w, g1.x, g1.y, g1.z, g1.w};
      unsigned oo[8];
#pragma unroll
      for (int q = 0; q < 4; ++q) {
        const int o0 = cg * 16 + 4 * q;
        const fx4 cr = *(LAS fx4*)(carry + (tok_l >> 4) * 64 + o0), hl = *(LAS fx4*)(b_s + tok_l * LRS + o0), pl = *(LAS fx4*)(a_s + tok_l * LRS + o0);
        const float h0 = hl[0] + pl[0] * cr[0], h1 = hl[1] + pl[1] * cr[1], h2 = hl[2] + pl[2] * cr[2], h3 = hl[3] + pl[3] * cr[3];
        oo[2 * q] = pack_bf2(h0 * gelu_tanh_f(bflo(gg[2 * q])), h1 * gelu_tanh_f(bfhi(gg[2 * q])));
        oo[2 * q + 1] = pack_bf2(h2 * gelu_tanh_f(bflo(gg[2 * q + 1])), h3 * gelu_tanh_f(bfhi(gg[2 * q + 1])));
      }
      uint4* dst = (uint4*)(p.mix + t * 1024 + 512 + c0 + cg * 16);
      dst[0] = make_uint4(oo[0], oo[1], oo[2], oo[3]); dst[1] = make_uint4(oo[4], oo[5], oo[6], oo[7]);
    }
    __syncthreads();
  }
#undef LRU_LOADX
}

#define P2_NLATE 1016
__device__ void phase2(const P& p, LAS unsigned char* lds, int wid_s) {
  const int tid = mk_tid(wid_s), lane = tid & 63, wid = wid_s;
  LAS int* misc = (LAS int*)(lds + L_MISC);
  const int flags = p.pad0;
  if (!(flags & 1) && blockIdx.x < 64) lru_item(p, lds, blockIdx.x >> 3, blockIdx.x & 7, tid, wid);
  if (flags & 2) return;
  int nxt = 0;
  if (tid == 0) misc[0] = (int)atomicAdd(p.ctr, 1u);
  for (;;) {
    __syncthreads();
    const int a = misc[0];
    __syncthreads();
    if (a >= 512 + P2_NLATE) break;
    if (a >= 512) {
      if (tid == 0) nxt = (int)atomicAdd(p.ctr, 1u);
      const int bq = a - 512;
      if (bq < 512) peer_rows4(p, 4096 + bq * 8 + wid, lane);
      else if (bq < 760) { const int j = (bq - 512) * 8 + wid;
        if (j < 960) p0_tile(p, (LAS float*)(lds + wid * 16640), 512 + j, lane); else p0_prows(p, j - 960, lane); }
      else p0_fold_ov(p, (LAS float*)lds, bq - 760, tid);
      if (tid == 0) misc[0] = nxt;
      continue; }
    const int qb = 63 - (a >> 3), b = a & 7;
    const int t0 = qb * 32;
    int lane_i = lane; asm volatile("" : "+v"(lane_i));
    uint4 pk0 = make_uint4(0, 0, 0, 0), pk1 = pk0, pk2 = pk0;
    for (int r = 0; r < 2; ++r) {
      const int tq0 = t0 + 16 * r;
      if (tid < 16) { LAS unsigned* mm = (LAS unsigned*)(lds + L_MM); mm[2 * tid] = 0u; mm[2 * tid + 1] = 0xFFFFFFFFu; }
      __syncthreads();
      if (!(flags & 16) && tq0 + 15 >= 256) index_scores(p, lds, b, tq0, (tq0 >> 4) + 1, wid, lane_i);
      __syncthreads();
      if (r == 1) {
        const uint4* src_ = (const uint4*)(p.kv + (size_t)b * SEQ * 160);
        pk0 = src_[tid]; pk1 = src_[tid + 512]; if (tid + 1024 < 1280) pk2 = src_[tid + 1024]; }
#pragma unroll 1
      for (int qq = 0; qq < ((flags & 4) ? 0 : 2); ++qq) {
        const int qi = wid * 2 + qq;
        select_row((LAS float*)lds + qi * SC_STRIDE, tq0 + qi, (LAS unsigned*)(lds + L_MASK) + (r * 16 + qi) * 64,
                   (LAS unsigned*)(lds + L_HIST) + wid * 256, (LAS unsigned*)(lds + L_CAND) + wid * 260, lane_i, p.pad1, (LAS unsigned*)(lds + L_MM) + 2 * qi);
      }
      __syncthreads();
    }
    if (!(flags & 8)) attn_block(p, lds, b, t0, wid, lane, tid, pk0, pk1, pk2);
    if (tid == 0) misc[0] = (int)atomicAdd(p.ctr, 1u);
  }
}
struct Epi3 {
  static constexpr bool PERM = true, AFTER_DRAIN = false;
  P p;
  __device__ __forceinline__ void operator()(const pg8::f32x4 (&acc)[2][2][4][2], const pg8::Unit& u, int wr, int wc, int fr_in, int fq_in) const {
    int fr = fr_in, fq = fq_in; asm volatile("" : "+v"(fr), "+v"(fq));
    const int rowb = u.pm * 256 + wr * 64 + fr;
    const int colb = u.pn * 256 + wc * 32 + 8 * fq;
#pragma unroll
    for (int ai = 0; ai < 2; ++ai)
#pragma unroll
      for (int m = 0; m < 4; ++m) { const int row = rowb + ai * 128 + m * 16;
        float s = 0.f;
#pragma unroll
        for (int bj = 0; bj < 2; ++bj) { const int col = colb + bj * 128;
          const uint4 xw = *(const uint4*)(p.xb16 + (size_t)row * DM + col);
          const pg8::f32x4 a = acc[ai][bj][m][0], c = acc[ai][bj][m][1];
          const float v0 = a[0] + bflo(xw.x), v1 = a[1] + bfhi(xw.x), v2 = a[2] + bflo(xw.y), v3 = a[3] + bfhi(xw.y);
          const float v4 = c[0] + bflo(xw.z), v5 = c[1] + bfhi(xw.z), v6 = c[2] + bflo(xw.w), v7 = c[3] + bfhi(xw.w);
          s += v0 * v0 + v1 * v1 + v2 * v2 + v3 * v3 + v4 * v4 + v5 * v5 + v6 * v6 + v7 * v7;
          *(uint4*)(p.x1b + (size_t)row * DM + col) = make_uint4(pack_bf2(v0, v1), pack_bf2(v2, v3), pack_bf2(v4, v5), pack_bf2(v6, v7)); }
        s = xsum32(xsum16(s));
        if (fq == 0) atomicAdd(p.ss_ffn + row, s); }
  }
};
__device__ void phase3_outproj(const P& p, LAS unsigned char* lds, int wid_s) {
  pg8::Gemm g; g.A = p.mix; g.Bt = p.WoutT; g.M = T_TOK; g.N = 1024; g.K = p.k1024;
  pg8::StaticOrder S; S.init(T_TOK, 1024, gridDim.x, blockIdx.x);
  Epi3 E; E.p = p;
  pg8::gemm_phase<Epi3, pg8::StaticOrder>(lds, g, S, E, nullptr, wid_s);
}
struct Epi4 {
  static constexpr bool PERM = true, AFTER_DRAIN = false;
  P p;
  __device__ __forceinline__ void operator()(const pg8::f32x4 (&acc)[2][2][4][2], const pg8::Unit& u, int wr, int wc, int fr_in, int fq_in) const {
    int fr = fr_in, fq = fq_in; asm volatile("" : "+v"(fr), "+v"(fq));
    const int rowb = u.pm * 256 + wr * 64 + fr;
    const int colb = u.pn * 256 + wc * 32 + 8 * fq;
#pragma unroll
    for (int ai = 0; ai < 2; ++ai)
#pragma unroll
      for (int m = 0; m < 4; ++m) { const int row = rowb + ai * 128 + m * 16;
        const float rs = rsqrtf(p.ss_ffn[row] * (1.f / DM) + 1e-6f);
#pragma unroll
        for (int bj = 0; bj < 2; ++bj) { const int col = colb + bj * 128;
          const pg8::f32x4 v = acc[ai][bj][m][0] * rs, w = acc[ai][bj][m][1] * rs;
          *(uint4*)(p.pq + (size_t)row * 2048 + col) = make_uint4(pack_bf2(v[0], v[1]), pack_bf2(v[2], v[3]), pack_bf2(w[0], w[1]), pack_bf2(w[2], w[3])); } }
  }
};
__device__ void phase4_pq(const P& p, LAS unsigned char* lds, int wid_s) {
  pg8::Gemm g; g.A = p.x1b; g.Bt = p.WpqT; g.M = T_TOK; g.N = 2048; g.K = p.k1024;
  pg8::StaticOrder S; S.init(T_TOK, 2048, gridDim.x, blockIdx.x);
  Epi4 E; E.p = p;
  pg8::gemm_phase<Epi4, pg8::StaticOrder>(lds, g, S, E, nullptr, wid_s);
}

#ifdef USE_SHFL_ROW
__device__ __forceinline__ unsigned row16_max_u32(unsigned x) {
  x = max(x, (unsigned)__shfl_xor((int)x, 1, 64)); x = max(x, (unsigned)__shfl_xor((int)x, 2, 64));
  x = max(x, (unsigned)__shfl_xor((int)x, 4, 64)); x = max(x, (unsigned)__shfl_xor((int)x, 8, 64)); return x; }
__device__ __forceinline__ float row16_sum_f32(float x) {
  x += __shfl_xor(x, 1, 64); x += __shfl_xor(x, 2, 64); x += __shfl_xor(x, 4, 64); x += __shfl_xor(x, 8, 64); return x; }
#else
#define DPP_U(x, ctrl) ((unsigned)__builtin_amdgcn_update_dpp(0, (int)(x), (ctrl), 0xF, 0xF, true))
__device__ __forceinline__ unsigned row16_max_u32(unsigned x) {
  x = max(x, DPP_U(x, 0xB1)); x = max(x, DPP_U(x, 0x4E)); x = max(x, DPP_U(x, 0x141)); x = max(x, DPP_U(x, 0x140)); return x; }
__device__ __forceinline__ float row16_sum_f32(float x) {
  x += __uint_as_float(DPP_U(__float_as_uint(x), 0xB1)); x += __uint_as_float(DPP_U(__float_as_uint(x), 0x4E));
  x += __uint_as_float(DPP_U(__float_as_uint(x), 0x141)); x += __uint_as_float(DPP_U(__float_as_uint(x), 0x140)); return x; }
#endif
__device__ __forceinline__ float sort2f(unsigned u) { const unsigned b = (u & 0x80000000u) ? (u & 0x7FFFFFFFu) : ~u; return __uint_as_float(b); }

#define RT_KOFF 8192
#define RT_KSTR 136
__device__ void phase4b_route(const P& p, LAS unsigned char* lds, int wid_s) {
  const int tid = mk_tid(wid_s), lane = tid & 63, wid = wid_s, fr = lane & 15, g = lane >> 4;
  LAS unsigned* topk = (LAS unsigned*)lds;
  LAS u16* kimg = (LAS u16*)(lds + RT_KOFF);
  pg8::StaticOrder S; S.init(T_TOK, 2048, gridDim.x, blockIdx.x);
  int hloaded = -1;
  s16x8 A[4];
#define RT_LOADA(item_) { pg8::Unit u2_; if (S.next((item_) >> 2, u2_)) { \
      const size_t tok_ = (size_t)(u2_.pm * 4 + ((item_) & 3)) * 64 + (wid >> 1) * 16 + fr; \
      const u16* qa_ = p.pq + tok_ * 2048 + u2_.pn * 256 + (wid & 1) * 128 + g * 8; \
      _Pragma("unroll") for (int ks = 0; ks < 4; ++ks) A[ks] = *(const s16x8*)(qa_ + ks * 32); } }
  RT_LOADA(0)
  for (int item = 0; item < 64; ++item) {
    pg8::Unit un; if (!S.next(item >> 2, un)) break;
    const int h = un.pn, tile = un.pm * 4 + (item & 3);
    const int tok0 = tile * 64;
    if (h != hloaded) {
      __syncthreads();
      { uint4 kv_[8];
#pragma unroll
        for (int m = 0; m < 8; ++m) { const int i = tid + 512 * m; const int side = i >> 11, r = (i >> 4) & 127, c = i & 15;
          kv_[m] = *(const uint4*)((side ? p.K2b : p.K1b) + (size_t)h * 16384 + r * 128 + c * 8); }
#pragma unroll
        for (int m = 0; m < 8; ++m) { const int i = tid + 512 * m; const int side = i >> 11, r = (i >> 4) & 127, c = i & 15;
          LDS_STORE(uint4, kimg + (side * 128 + r) * RT_KSTR + c * 8, kv_[m]); } }
      hloaded = h;
      __syncthreads();
    }
    {
      const int side = wid & 1, mt = wid >> 1;
      LAS u16* kb = kimg + (side * 128 + fr) * RT_KSTR + g * 8;
      unsigned val[8][4];
#pragma unroll
      for (int np = 0; np < 4; ++np) {
        s16x8 B0[4], B1[4];
#pragma unroll
        for (int ks = 0; ks < 4; ++ks) { B0[ks] = *(LAS s16x8*)(kb + (2 * np) * 16 * RT_KSTR + ks * 32); B1[ks] = *(LAS s16x8*)(kb + (2 * np + 1) * 16 * RT_KSTR + ks * 32); }
        __builtin_amdgcn_sched_barrier(0);
        fx4 acc0 = {0.f, 0.f, 0.f, 0.f}, acc1 = {0.f, 0.f, 0.f, 0.f};
#pragma unroll
        for (int ks = 0; ks < 4; ++ks) {
          acc0 = __builtin_amdgcn_mfma_f32_16x16x32_bf16(A[ks], B0[ks], acc0, 0, 0, 0);
          acc1 = __builtin_amdgcn_mfma_f32_16x16x32_bf16(A[ks], B1[ks], acc1, 0, 0, 0);
        }
        __builtin_amdgcn_sched_barrier(0);
        const unsigned tag0 = 127u - (unsigned)((2 * np) * 16 + fr), tag1 = 127u - (unsigned)((2 * np + 1) * 16 + fr);
#pragma unroll
        for (int r = 0; r < 4; ++r) { val[2 * np][r] = (f2sort(acc0[r]) & ~0x7Fu) | tag0; val[2 * np + 1][r] = (f2sort(acc1[r]) & ~0x7Fu) | tag1; }
      }
      RT_LOADA(item + 1)
#define CE(a, b) do { const unsigned hi_ = max(a, b), lo_ = min(a, b); a = hi_; b = lo_; } while (0)
#pragma unroll
      for (int r = 0; r < 4; ++r) {
        CE(val[0][r], val[1][r]); CE(val[2][r], val[3][r]); CE(val[4][r], val[5][r]); CE(val[6][r], val[7][r]);
        CE(val[0][r], val[2][r]); CE(val[1][r], val[3][r]); CE(val[4][r], val[6][r]); CE(val[5][r], val[7][r]);
        CE(val[1][r], val[2][r]); CE(val[5][r], val[6][r]);
        CE(val[0][r], val[4][r]); CE(val[1][r], val[5][r]); CE(val[2][r], val[6][r]); CE(val[3][r], val[7][r]);
        CE(val[2][r], val[4][r]); CE(val[3][r], val[5][r]);
        CE(val[1][r], val[2][r]); CE(val[3][r], val[4][r]); CE(val[5][r], val[6][r]);
      }
#undef CE
      unsigned mine[4] = {0u, 0u, 0u, 0u};
#pragma unroll 1
      for (int i = 0; i < 16; ++i) {
        unsigned m[4];
#pragma unroll
        for (int r = 0; r < 4; ++r) m[r] = max(val[0][r], DPP_U(val[0][r], 0xB1));
#pragma unroll
        for (int r = 0; r < 4; ++r) m[r] = max(m[r], DPP_U(m[r], 0x4E));
#pragma unroll
        for (int r = 0; r < 4; ++r) m[r] = max(m[r], DPP_U(m[r], 0x141));
#pragma unroll
        for (int r = 0; r < 4; ++r) m[r] = max(m[r], DPP_U(m[r], 0x140));
#pragma unroll
        for (int r = 0; r < 4; ++r) {
          const bool win = (val[0][r] == m[r]);
#pragma unroll
          for (int q = 0; q < 7; ++q) val[q][r] = win ? val[q + 1][r] : val[q][r];
          val[7][r] = win ? 0u : val[7][r];
          if (fr == i) mine[r] = m[r];
        }
      }
#pragma unroll
      for (int r = 0; r < 4; ++r) topk[((mt * 16 + 4 * g + r) * 2 + side) * 16 + fr] = mine[r];
    }
    __syncthreads();
#pragma unroll 1
    for (int rd = 0; rd < 2; ++rd) {
      const int tl = wid * 8 + rd * 4 + g;
      LAS unsigned* t1 = topk + (tl * 2 + 0) * 16;
      LAS unsigned* t2 = topk + (tl * 2 + 1) * 16;
      unsigned cv[4];
#pragma unroll
      for (int j = 0; j < 4; ++j) {
        const int s = fr + 16 * j;
        int a, bb;
        if (s < 16) { a = 0; bb = s; } else if (s < 24) { a = 1; bb = s - 16; } else if (s < 29) { a = 2; bb = s - 24; } else if (s < 33) { a = 3; bb = s - 29; }
        else if (s < 36) { a = 4; bb = s - 33; } else if (s < 38) { a = 5; bb = s - 36; } else if (s < 40) { a = 6; bb = s - 38; } else if (s < 42) { a = 7; bb = s - 40; }
        else if (s < 50) { a = 8 + (s - 42); bb = 0; } else { a = -1; bb = 0; }
        unsigned key = 0u;
        if (a >= 0) {
          const float sum = sort2f(t1[a] & ~0x7Fu) + sort2f(t2[bb] & ~0x7Fu);
          key = (f2sort(sum) & ~0xFFu) | (unsigned)(255 - (a * 16 + bb));
        }
        cv[j] = key;
      }
#define CE2(a, b) do { const unsigned hi_ = max(a, b), lo_ = min(a, b); a = hi_; b = lo_; } while (0)
      CE2(cv[0], cv[1]); CE2(cv[2], cv[3]); CE2(cv[0], cv[2]); CE2(cv[1], cv[3]); CE2(cv[1], cv[2]);
#undef CE2
      unsigned mine = 0u;
#pragma unroll 1
      for (int i = 0; i < 16; ++i) {
        const unsigned m = row16_max_u32(cv[0]);
        const bool win = (cv[0] == m);
        cv[0] = win ? cv[1] : cv[0]; cv[1] = win ? cv[2] : cv[1]; cv[2] = win ? cv[3] : cv[2]; cv[3] = win ? 0u : cv[3];
        if (fr == i) mine = m;
      }
      const int flat = 255 - (int)(mine & 0xFFu);
      const int a = flat >> 4, bb = flat & 15;
      const unsigned k1 = t1[a], k2 = t2[bb];
      const float sum = sort2f(k1 & ~0x7Fu) + sort2f(k2 & ~0x7Fu);
      const unsigned m0 = (unsigned)__shfl((int)mine, lane & 48, 64);
      const int f0 = 255 - (int)(m0 & 0xFFu);
      const float s0 = sort2f(t1[f0 >> 4] & ~0x7Fu) + sort2f(t2[f0 & 15] & ~0x7Fu);
      const float ex = __expf(sum - s0);
      const float den = row16_sum_f32(ex);
      const int e = (127 - (int)(k1 & 0x7Fu)) * 128 + (127 - (int)(k2 & 0x7Fu));
      const size_t t = (size_t)tok0 + tl;
      p.experts[t * 128 + h * 16 + fr] = e;
      p.gates[t * 128 + h * 16 + fr] = ex / den;
    }
    __syncthreads();
  }
}
#define FP8_LO(w) __builtin_amdgcn_cvt_pk_f32_fp8((int)(w), false)
#define FP8_HI(w) __builtin_amdgcn_cvt_pk_f32_fp8((int)(w), true)
#define P5_LIST_WORDS (4 * 128 * 3)
#define P5_WAVE_WORDS (P5_LIST_WORDS + 128)
__device__ __forceinline__ float gelu_erf_fast(float v) {
  const float av = fabsf(v), t = __builtin_amdgcn_rcpf(av * 0.2316418882f + 1.0f);
  float q = t * 0.5307027145f + (-0.7265760135f); q = q * t + 0.7107068705f; q = q * t + (-0.142248368f); q = q * t + 0.127414796f; q = q * t;
  const float e = __builtin_amdgcn_exp2f((v * v) * (-0.72134752044f));
  const float m = v * (q * e);
  return v < 0.f ? m : v - m;
}
__device__ __forceinline__ float dot16_fp8(const uint4 r, const float (&h)[16]) {
  fx2 a; float d;
  a = FP8_LO(r.x); d = a.x * h[0] + a.y * h[1]; a = FP8_HI(r.x); d += a.x * h[2] + a.y * h[3];
  a = FP8_LO(r.y); d += a.x * h[4] + a.y * h[5]; a = FP8_HI(r.y); d += a.x * h[6] + a.y * h[7];
  a = FP8_LO(r.z); d += a.x * h[8] + a.y * h[9]; a = FP8_HI(r.z); d += a.x * h[10] + a.y * h[11];
  a = FP8_LO(r.w); d += a.x * h[12] + a.y * h[13]; a = FP8_HI(r.w); d += a.x * h[14] + a.y * h[15];
  return d;
}
typedef _Float16 hx2 __attribute__((ext_vector_type(2)));
#define FP4_H(w, b) __builtin_bit_cast(hx2, __builtin_amdgcn_cvt_scalef32_pk_f16_fp4((w), 1.0f, (b)))
__device__ __forceinline__ void axpy16_fp8(const hx2 c, const uint2 r, hx2 (&acc)[8]) {
  acc[0] = __builtin_elementwise_fma(c, FP4_H(r.x, 0), acc[0]); acc[1] = __builtin_elementwise_fma(c, FP4_H(r.x, 1), acc[1]);
  acc[2] = __builtin_elementwise_fma(c, FP4_H(r.x, 2), acc[2]); acc[3] = __builtin_elementwise_fma(c, FP4_H(r.x, 3), acc[3]);
  acc[4] = __builtin_elementwise_fma(c, FP4_H(r.y, 0), acc[4]); acc[5] = __builtin_elementwise_fma(c, FP4_H(r.y, 1), acc[5]);
  acc[6] = __builtin_elementwise_fma(c, FP4_H(r.y, 2), acc[6]); acc[7] = __builtin_elementwise_fma(c, FP4_H(r.y, 3), acc[7]);
}
#define DPPF(x, ctrl) __uint_as_float((unsigned)__builtin_amdgcn_update_dpp(0, (int)__float_as_uint(x), (ctrl), 0xF, 0xF, true))
typedef __bf16 bf16x2_t __attribute__((ext_vector_type(2)));
__device__ __forceinline__ float dot16_fp8_bf16(const uint2 r, const unsigned (&h)[8]) {
  float d;
  d = __builtin_amdgcn_fdot2_f32_bf16(__builtin_amdgcn_cvt_scalef32_pk_bf16_fp4(r.x, 1.0f, 0), __builtin_bit_cast(bf16x2_t, h[0]), 0.f, false);
  d = __builtin_amdgcn_fdot2_f32_bf16(__builtin_amdgcn_cvt_scalef32_pk_bf16_fp4(r.x, 1.0f, 1), __builtin_bit_cast(bf16x2_t, h[1]), d, false);
  d = __builtin_amdgcn_fdot2_f32_bf16(__builtin_amdgcn_cvt_scalef32_pk_bf16_fp4(r.x, 1.0f, 2), __builtin_bit_cast(bf16x2_t, h[2]), d, false);
  d = __builtin_amdgcn_fdot2_f32_bf16(__builtin_amdgcn_cvt_scalef32_pk_bf16_fp4(r.x, 1.0f, 3), __builtin_bit_cast(bf16x2_t, h[3]), d, false);
  d = __builtin_amdgcn_fdot2_f32_bf16(__builtin_amdgcn_cvt_scalef32_pk_bf16_fp4(r.y, 1.0f, 0), __builtin_bit_cast(bf16x2_t, h[4]), d, false);
  d = __builtin_amdgcn_fdot2_f32_bf16(__builtin_amdgcn_cvt_scalef32_pk_bf16_fp4(r.y, 1.0f, 1), __builtin_bit_cast(bf16x2_t, h[5]), d, false);
  d = __builtin_amdgcn_fdot2_f32_bf16(__builtin_amdgcn_cvt_scalef32_pk_bf16_fp4(r.y, 1.0f, 2), __builtin_bit_cast(bf16x2_t, h[6]), d, false);
  d = __builtin_amdgcn_fdot2_f32_bf16(__builtin_amdgcn_cvt_scalef32_pk_bf16_fp4(r.y, 1.0f, 3), __builtin_bit_cast(bf16x2_t, h[7]), d, false);
  return d;
}
struct P5Set { uint2 ru0, ru1, ru2, ru3, ru4, ru5, ru6, ru7, rv0, rv1, rv2, rv3, rv4, rv5, rv6, rv7; float sume, cgme; };
struct P5Meta { unsigned e; float su, cg; };
__device__ __forceinline__ P5Meta p5_meta(LAS unsigned* wl, int bid, int lane) {
  LAS unsigned* lst = wl + (bid >> 4) * 384 + 3 * ((bid & 15) * 8 + (lane & 7));
  P5Meta m; m.e = lst[0]; m.su = __uint_as_float(lst[1]); m.cg = __uint_as_float(lst[2]); return m;
}
__device__ __forceinline__ void p5_issue(const P& p, P5Set& S, const P5Meta mt, int lane, __amdgpu_buffer_rsrc_t rsU, __amdgpu_buffer_rsrc_t rsV) {
  S.sume = mt.su; S.cgme = mt.cg;
  const int l8 = 8 * lane;
  typedef unsigned v2u_ __attribute__((ext_vector_type(2)));
  const int o0 = __builtin_amdgcn_readlane((int)mt.e, 0) * 512, o1 = __builtin_amdgcn_readlane((int)mt.e, 1) * 512, o2 = __builtin_amdgcn_readlane((int)mt.e, 2) * 512, o3 = __builtin_amdgcn_readlane((int)mt.e, 3) * 512;
  const int o4 = __builtin_amdgcn_readlane((int)mt.e, 4) * 512, o5 = __builtin_amdgcn_readlane((int)mt.e, 5) * 512, o6 = __builtin_amdgcn_readlane((int)mt.e, 6) * 512, o7 = __builtin_amdgcn_readlane((int)mt.e, 7) * 512;
  __builtin_amdgcn_sched_group_barrier(0x004, 8, 0);
#define P5_LD2(e_, RU, RV) do { \
    const v2u_ a_ = __builtin_amdgcn_raw_buffer_load_b64(rsU, l8, e_, 0); RU = make_uint2(a_.x, a_.y); \
    const v2u_ b_ = __builtin_amdgcn_raw_buffer_load_b64(rsV, l8, e_, 0); RV = make_uint2(b_.x, b_.y); } while (0)
  P5_LD2(o0, S.ru0, S.rv0); P5_LD2(o1, S.ru1, S.rv1); P5_LD2(o2, S.ru2, S.rv2); P5_LD2(o3, S.ru3, S.rv3);
  P5_LD2(o4, S.ru4, S.rv4); P5_LD2(o5, S.ru5, S.rv5); P5_LD2(o6, S.ru6, S.rv6); P5_LD2(o7, S.ru7, S.rv7);
#undef P5_LD2
}
__device__ __forceinline__ int dot16_i4(const uint2 r, const unsigned (&h)[2]) {
  return __builtin_amdgcn_sdot8((int)r.y, (int)h[1], __builtin_amdgcn_sdot8((int)r.x, (int)h[0], 0, false), false);
}
#define DPPI(x, ctrl) __builtin_amdgcn_update_dpp(0, (x), (ctrl), 0xF, 0xF, true)
__device__ __forceinline__ int isum32(int x) { const auto r = __builtin_amdgcn_permlane32_swap((unsigned)x, (unsigned)x, false, false); return (int)(r[0] + r[1]); }
__device__ __forceinline__ int isum16(int x) { const auto r = __builtin_amdgcn_permlane16_swap((unsigned)x, (unsigned)x, false, false); return (int)(r[0] + r[1]); }
__device__ __forceinline__ void p5_compute(const P5Set& S, const unsigned (&hfp)[2], hx2 (&acc)[8], int lane) {
  const int d0 = dot16_i4(S.ru0, hfp), d1 = dot16_i4(S.ru1, hfp), d2 = dot16_i4(S.ru2, hfp), d3 = dot16_i4(S.ru3, hfp);
  const int d4 = dot16_i4(S.ru4, hfp), d5 = dot16_i4(S.ru5, hfp), d6 = dot16_i4(S.ru6, hfp), d7 = dot16_i4(S.ru7, hfp);
  const bool up1 = (lane & 1) != 0, up2 = (lane & 2) != 0, up4 = (lane & 4) != 0;
  const int a0 = (up1 ? d1 : d0) + DPPI(up1 ? d0 : d1, 0xB1), a1 = (up1 ? d3 : d2) + DPPI(up1 ? d2 : d3, 0xB1);
  const int a2 = (up1 ? d5 : d4) + DPPI(up1 ? d4 : d5, 0xB1), a3 = (up1 ? d7 : d6) + DPPI(up1 ? d6 : d7, 0xB1);
  const int b0 = (up2 ? a1 : a0) + DPPI(up2 ? a0 : a1, 0x4E), b1 = (up2 ? a3 : a2) + DPPI(up2 ? a2 : a3, 0x4E);
  const int snd = up4 ? b0 : b1;
  const int rcv = DPPI(DPPI(snd, 0x141), 0x1B);
  int toti = (up4 ? b1 : b0) + rcv;
  toti += DPPI(toti, 0x128);
  toti = isum16(toti); toti = isum32(toti);
  const float tot = (float)toti;
  const float cme = gelu_erf_fast(tot * S.sume) * S.cgme;
  const _Float16 ch = (_Float16)cme;
  const unsigned cpk = (unsigned)__builtin_bit_cast(unsigned short, ch) * 0x10001u;
  const unsigned k0 = (unsigned)__builtin_amdgcn_readlane((int)cpk, 0), k1 = (unsigned)__builtin_amdgcn_readlane((int)cpk, 1), k2 = (unsigned)__builtin_amdgcn_readlane((int)cpk, 2), k3 = (unsigned)__builtin_amdgcn_readlane((int)cpk, 3);
  const unsigned k4 = (unsigned)__builtin_amdgcn_readlane((int)cpk, 4), k5 = (unsigned)__builtin_amdgcn_readlane((int)cpk, 5), k6 = (unsigned)__builtin_amdgcn_readlane((int)cpk, 6), k7 = (unsigned)__builtin_amdgcn_readlane((int)cpk, 7);
  __builtin_amdgcn_sched_barrier(0);
#define P5_AX(K, RV) axpy16_fp8(__builtin_bit_cast(hx2, K), RV, acc)
  P5_AX(k0, S.rv0); P5_AX(k1, S.rv1); P5_AX(k2, S.rv2); P5_AX(k3, S.rv3); P5_AX(k4, S.rv4); P5_AX(k5, S.rv5); P5_AX(k6, S.rv6); P5_AX(k7, S.rv7);
#undef P5_AX
}

__device__ __forceinline__ void rank128(int k0, int k1, int lane, int& r0, int& r1) {
  r0 = 0; r1 = 0;
#pragma unroll 8
  for (int i = 0; i < 64; ++i) {
    const int a = __builtin_amdgcn_readlane(k0, i), b = __builtin_amdgcn_readlane(k1, i);
    r0 += ((a < k0) || (a == k0 && i < lane)) ? 1 : 0;
    r0 += (b < k0) ? 1 : 0;
    r1 += (a <= k1) ? 1 : 0;
    r1 += ((b < k1) || (b == k1 && i < lane)) ? 1 : 0;
  }
}

__device__ void phase5_experts(const P& p, LAS unsigned char* lds, int wid_s) {
  const int tid = mk_tid(wid_s), lane_in = tid & 63, wid = wid_s;
  const int gw = blockIdx.x * 8 + wid;
  LAS unsigned* wl = (LAS unsigned*)lds + wid * P5_WAVE_WORDS;
  const __amdgpu_buffer_rsrc_t rsU = __builtin_amdgcn_make_buffer_rsrc(p.U8, 0, 8 << 20, 0x00020000), rsV = __builtin_amdgcn_make_buffer_rsrc(p.V8, 0, 8 << 20, 0x00020000);
  LAS unsigned* ord = wl + P5_LIST_WORDS;
#pragma unroll 1
  for (int sweep = 0; sweep < 2; ++sweep) {
    const int tb = (sweep * 2048 + gw) * 4;
    int lane = lane_in; asm volatile("" : "+v"(lane));
    unsigned hfp[4][2];
    hx2 acc[4][8];
#pragma unroll
    for (int j = 0; j < 4; ++j) {
      const size_t t = (size_t)tb + j;
      const u16* x1r = p.x1b + t * DM;
      const float rs = rsqrtf(p.ss_ffn[t] * (1.f / DM) + 1e-6f);
      float hv[16]; float ss = 0.f;
#pragma unroll
      for (int i = 0; i < 4; ++i) { const uint2 xw = *(const uint2*)(x1r + 256 * i + 4 * lane); const float4 g = *(const float4*)(p.g_ffn + 256 * i + 4 * lane);
        hv[4 * i] = bflo(xw.x) * rs * g.x; hv[4 * i + 1] = bfhi(xw.x) * rs * g.y; hv[4 * i + 2] = bflo(xw.y) * rs * g.z; hv[4 * i + 3] = bfhi(xw.y) * rs * g.w;
        ss += hv[4 * i] * hv[4 * i] + hv[4 * i + 1] * hv[4 * i + 1] + hv[4 * i + 2] * hv[4 * i + 2] + hv[4 * i + 3] * hv[4 * i + 3]; }
      ss = wave_sum(ss);
      const float steph = fmaxf(__builtin_amdgcn_sqrtf(ss * (1.f / DM)) * (2.5f / 7.5f), 1e-30f), invh = __builtin_amdgcn_rcpf(steph);
      if (lane == 0) ord[j] = __float_as_uint(steph);
#define Q4H(x) ((unsigned)((int)__builtin_rintf(__builtin_amdgcn_fmed3f((x) * invh, -8.f, 7.f)) & 15))
      hfp[j][0] = Q4H(hv[0]) | (Q4H(hv[1]) << 4) | (Q4H(hv[2]) << 8) | (Q4H(hv[3]) << 12) | (Q4H(hv[4]) << 16) | (Q4H(hv[5]) << 20) | (Q4H(hv[6]) << 24) | (Q4H(hv[7]) << 28);
      hfp[j][1] = Q4H(hv[8]) | (Q4H(hv[9]) << 4) | (Q4H(hv[10]) << 8) | (Q4H(hv[11]) << 12) | (Q4H(hv[12]) << 16) | (Q4H(hv[13]) << 20) | (Q4H(hv[14]) << 24) | (Q4H(hv[15]) << 28);
#undef Q4H
#pragma unroll
      for (int i = 0; i < 8; ++i) acc[j][i] = (hx2){(_Float16)0.f, (_Float16)0.f};
    }
    {
      int e0[4], e1[4], r0[4], r1[4];
#pragma unroll
      for (int j = 0; j < 4; ++j) { const size_t t = (size_t)tb + j; e0[j] = p.experts[t * 128 + lane]; e1[j] = p.experts[t * 128 + 64 + lane]; r0[j] = 0; r1[j] = 0; }
      float gq0[4], gq1[4], suq0[4], suq1[4], svq0[4], svq1[4];
#pragma unroll
      for (int j = 0; j < 4; ++j) { const size_t t = (size_t)tb + j;
        gq0[j] = p.gates[t * 128 + lane]; gq1[j] = p.gates[t * 128 + 64 + lane];
        suq0[j] = p.su[e0[j]]; suq1[j] = p.su[e1[j]]; svq0[j] = p.sv[e0[j]]; svq1[j] = p.sv[e1[j]]; }
#pragma unroll
      for (int j = 0; j < 4; ++j) {
        const int b0 = e0[j] >> 10, b1 = e1[j] >> 10;
        int base = 0;
#pragma unroll 1
        for (int bk = 0; bk < 16; ++bk) {
          const unsigned long long m0 = __ballot(b0 == bk), m1 = __ballot(b1 == bk);
          const int c0 = __popcll(m0), c1 = __popcll(m1);
          const int p0 = (int)__builtin_amdgcn_mbcnt_hi((unsigned)(m0 >> 32), __builtin_amdgcn_mbcnt_lo((unsigned)m0, 0u));
          const int p1 = (int)__builtin_amdgcn_mbcnt_hi((unsigned)(m1 >> 32), __builtin_amdgcn_mbcnt_lo((unsigned)m1, 0u));
          r0[j] = (b0 == bk) ? base + p0 : r0[j];
          r1[j] = (b1 == bk) ? base + c0 + p1 : r1[j];
          base += c0 + c1;
        }
        __builtin_amdgcn_sched_barrier(0);
      }
#pragma unroll
      for (int j = 0; j < 4; ++j) {
        const size_t t = (size_t)tb + j;
        const float g0 = gq0[j], g1 = gq1[j];
        const float su0 = suq0[j], su1 = suq1[j], sv0 = svq0[j], sv1 = svq1[j];
        LAS unsigned* lst = wl + j * 384;
        const float shj = __uint_as_float(ord[j]);
        lst[3 * r0[j]] = (unsigned)e0[j]; lst[3 * r0[j] + 1] = __float_as_uint(su0 * shj); lst[3 * r0[j] + 2] = __float_as_uint(g0 * sv0);
        lst[3 * r1[j]] = (unsigned)e1[j]; lst[3 * r1[j] + 1] = __float_as_uint(su1 * shj); lst[3 * r1[j] + 2] = __float_as_uint(g1 * sv1);
      }
    }
    asm volatile("s_waitcnt lgkmcnt(0)" ::: "memory");
    if (!(p.pad1 & 1)) {
      P5Set A, B, C, D;
      p5_issue(p, A, p5_meta(wl, 0 * 16 + 0, lane), lane, rsU, rsV);
      p5_issue(p, B, p5_meta(wl, 1 * 16 + 0, lane), lane, rsU, rsV);
      P5Meta mC = p5_meta(wl, 2 * 16 + 0, lane), mD = p5_meta(wl, 3 * 16 + 0, lane), mA = p5_meta(wl, 0 * 16 + 1, lane), mB = p5_meta(wl, 1 * 16 + 1, lane);
#pragma unroll 1
      for (int c = 0; c < 16; ++c) {
        const int c1 = min(c + 1, 15), c2 = min(c + 2, 15);
        p5_issue(p, C, mC, lane, rsU, rsV);
        p5_compute(A, hfp[0], acc[0], lane);
        p5_issue(p, D, mD, lane, rsU, rsV);
        p5_compute(B, hfp[1], acc[1], lane);
        p5_issue(p, A, mA, lane, rsU, rsV);
        p5_compute(C, hfp[2], acc[2], lane);
        p5_issue(p, B, mB, lane, rsU, rsV);
        mC = p5_meta(wl, 2 * 16 + c1, lane); mD = p5_meta(wl, 3 * 16 + c1, lane); mA = p5_meta(wl, 0 * 16 + c2, lane); mB = p5_meta(wl, 1 * 16 + c2, lane);
        p5_compute(D, hfp[3], acc[3], lane);
      }
      asm volatile("s_waitcnt vmcnt(0)" ::: "memory");
    }
    int lane_e = lane; asm volatile("" : "+v"(lane_e));
#pragma unroll
    for (int j = 0; j < 4; ++j) {
      const u16* x1r = p.x1b + ((size_t)tb + j) * DM;
      u16* x2r = p.x2b + ((size_t)tb + j) * DM;
#pragma unroll
      for (int i = 0; i < 4; ++i) {
        const uint2 xw = *(const uint2*)(x1r + 256 * i + 4 * lane_e);
        const float o0 = bflo(xw.x) + (float)acc[j][2 * i][0], o1 = bfhi(xw.x) + (float)acc[j][2 * i][1];
        const float o2 = bflo(xw.y) + (float)acc[j][2 * i + 1][0], o3 = bfhi(xw.y) + (float)acc[j][2 * i + 1][1];
        *(uint2*)(x2r + 256 * i + 4 * lane_e) = make_uint2(pack_bf2(o0, o1), pack_bf2(o2, o3));
      }
    }
  }
}

struct Epi6a {
  static constexpr bool PERM = true, AFTER_DRAIN = false;
  P p;
  __device__ __forceinline__ void operator()(const pg8::f32x4 (&acc)[2][2][4][2], const pg8::Unit& u, int wr, int wc, int fr_in, int fq_in) const {
    int fr = fr_in, fq = fq_in; asm volatile("" : "+v"(fr), "+v"(fq));
    const int rowb = u.pm * 256 + wr * 64 + fr;
    const int colb = u.pn * 256 + wc * 32 + 8 * fq;
#pragma unroll
    for (int ai = 0; ai < 2; ++ai)
#pragma unroll
      for (int m = 0; m < 4; ++m) { const int row = rowb + ai * 128 + m * 16;
#pragma unroll
        for (int bj = 0; bj < 2; ++bj) { const int col = colb + bj * 128;
          const pg8::f32x4 v = acc[ai][bj][m][0], w = acc[ai][bj][m][1];
          *(uint4*)(p.pple + (size_t)row * DM + col) = make_uint4(pack_bf2(v[0], v[1]), pack_bf2(v[2], v[3]), pack_bf2(w[0], w[1]), pack_bf2(w[2], w[3])); } }
  }
};
struct Epi6b {
  static constexpr bool PERM = true, AFTER_DRAIN = true;
  P p;
  __device__ __forceinline__ void operator()(const pg8::f32x4 (&)[2][2][4][2], const pg8::Unit&, int, int, int, int) const {}
  __device__ __forceinline__ void fused(pg8::f32x4 (&acc)[2][2][4][2], const pg8::Unit& u, int wr, int wc, int fr_in, int fq_in, LAS unsigned char* lds, int wid, int lane) const {
    int fr = fr_in, fq = fq_in; asm volatile("" : "+v"(fr), "+v"(fq));
    const int rowb = u.pm * 256 + wr * 64 + fr;
    const int colb = u.pn * 256 + wc * 32 + 8 * fq;
#pragma unroll
    for (int ai = 0; ai < 2; ++ai)
#pragma unroll
      for (int m = 0; m < 4; ++m) { const int row = rowb + ai * 128 + m * 16;
        float s = 0.f;
#pragma unroll
        for (int bj = 0; bj < 2; ++bj) { const int col = colb + bj * 128;
          const uint4 xw = *(const uint4*)(p.x2b + (size_t)row * DM + col);
          const uint4 pw = *(const uint4*)(p.pple + (size_t)row * DM + col);
          pg8::f32x4 a = acc[ai][bj][m][0], c = acc[ai][bj][m][1];
          a[0] = bflo(xw.x) + sigmoidf_(a[0]) * bflo(pw.x); a[1] = bfhi(xw.x) + sigmoidf_(a[1]) * bfhi(pw.x);
          a[2] = bflo(xw.y) + sigmoidf_(a[2]) * bflo(pw.y); a[3] = bfhi(xw.y) + sigmoidf_(a[3]) * bfhi(pw.y);
          c[0] = bflo(xw.z) + sigmoidf_(c[0]) * bflo(pw.z); c[1] = bfhi(xw.z) + sigmoidf_(c[1]) * bfhi(pw.z);
          c[2] = bflo(xw.w) + sigmoidf_(c[2]) * bflo(pw.w); c[3] = bfhi(xw.w) + sigmoidf_(c[3]) * bfhi(pw.w);
          s += a[0] * a[0] + a[1] * a[1] + a[2] * a[2] + a[3] * a[3] + c[0] * c[0] + c[1] * c[1] + c[2] * c[2] + c[3] * c[3];
          acc[ai][bj][m][0] = a; acc[ai][bj][m][1] = c; }
        s = xsum32(xsum16(s));
        if (fq == 0) atomicAdd(p.ss_fin + row, s);
        asm volatile("" ::: "memory"); }
    asm volatile("s_waitcnt vmcnt(0)" ::: "memory");
    __syncthreads();
    if (wid == 0 && lane == 0) {
      unsigned* cnt = p.ctr + 64 + u.pm;
      __hip_atomic_fetch_add(cnt, 1u, __ATOMIC_RELAXED, __HIP_MEMORY_SCOPE_AGENT);
      unsigned spins = 0;
      while (__hip_atomic_load(cnt, __ATOMIC_RELAXED, __HIP_MEMORY_SCOPE_AGENT) < 4u) { __builtin_amdgcn_s_sleep(2); if (++spins > (1u << 24)) break; }
    }
    __syncthreads();
#pragma unroll
    for (int ai = 0; ai < 2; ++ai)
#pragma unroll
      for (int m = 0; m < 4; ++m) { const int row = rowb + ai * 128 + m * 16;
        const float tot = __hip_atomic_load(p.ss_fin + row, __ATOMIC_RELAXED, __HIP_MEMORY_SCOPE_AGENT);
        const float rs = rsqrtf(tot * (1.f / DM) + 1e-6f);
#pragma unroll
        for (int bj = 0; bj < 2; ++bj) { const int col = colb + bj * 128;
          const float4 g0 = *(const float4*)(p.g_final + col), g1 = *(const float4*)(p.g_final + col + 4);
          const pg8::f32x4 a = acc[ai][bj][m][0], c = acc[ai][bj][m][1];
          float* o = p.out + (size_t)row * DM + col;
          *(float4*)o = make_float4(a[0] * rs * g0.x, a[1] * rs * g0.y, a[2] * rs * g0.z, a[3] * rs * g0.w);
          *(float4*)(o + 4) = make_float4(c[0] * rs * g1.x, c[1] * rs * g1.y, c[2] * rs * g1.z, c[3] * rs * g1.w); }
        asm volatile("" ::: "memory"); }
    (void)lds;
  }
};
__device__ void phase6_ple(const P& p, LAS unsigned char* lds, int wid_s) {
  { pg8::Gemm g; g.A = p.p16; g.Bt = p.WpleT; g.M = T_TOK; g.N = 1024; g.K = p.k256;
    pg8::StaticOrder S; S.init(T_TOK, 1024, gridDim.x, blockIdx.x);
    Epi6a E; E.p = p;
    pg8::gemm_phase<Epi6a, pg8::StaticOrder>(lds, g, S, E, nullptr, wid_s); }
  { pg8::Gemm g; g.A = p.x2b; g.Bt = p.WgT; g.M = T_TOK; g.N = 1024; g.K = p.k1024;
    pg8::StaticOrder S; S.init(T_TOK, 1024, gridDim.x, blockIdx.x);
    Epi6b E; E.p = p;
    pg8::gemm_phase<Epi6b, pg8::StaticOrder>(lds, g, S, E, nullptr, wid_s); }
}
__device__ void phase7_final(const P& p, int wid_s) {
  const int gt = blockIdx.x * 512 + mk_tid(wid_s), nt = gridDim.x * 512;
  for (int i = gt; i < T_TOK * DM / 4; i += nt) {
    const int row = i >> 8, c4 = i & 255;
    const float rs = rsqrtf(p.ss_fin[row] * (1.f / DM) + 1e-6f);
    const float4 v = ((const float4*)p.out)[i];
    const float4 g = ((const float4*)p.g_final)[c4];
    ((float4*)p.out)[i] = make_float4(v.x * rs * g.x, v.y * rs * g.y, v.z * rs * g.z, v.w * rs * g.w);
  }
}
#define XB_TMO      128
#define XB_XCNT(j)  (256  + 64 * (j))
#define XB_XSUB(j)  (1280 + 64 * (j))
#define XB_XGEN(j)  (2304 + 64 * (j))
#define XB_TOP      3328
#define XB_TOPGEN   3392
#define XCD_BAR_WORDS 3456
#define XB_SPIN_CAP (1u << 22)
__device__ __forceinline__ unsigned xb_ld(unsigned* p)              { return __hip_atomic_load(p, __ATOMIC_RELAXED, __HIP_MEMORY_SCOPE_AGENT); }
__device__ __forceinline__ unsigned xb_add(unsigned* p, unsigned v) { return __hip_atomic_fetch_add(p, v, __ATOMIC_RELAXED, __HIP_MEMORY_SCOPE_AGENT); }
__device__ __forceinline__ unsigned xb_xcc_id() { return (unsigned)__builtin_amdgcn_s_getreg((3 << 11) | 20) & 0xFu; }
#define XB_SPIN(cond, bar) do { unsigned _sp = 0; while (cond) { __builtin_amdgcn_s_sleep(1); \
    if ((++_sp & 255u) == 0u) { if (xb_ld(&(bar)[XB_TMO])) break; if (_sp > XB_SPIN_CAP) { atomicAdd(&(bar)[XB_TMO], 1u); break; } } } } while (0)
struct XcdBarrier { unsigned* bar; unsigned x; volatile LAS unsigned* st; };
__device__ __forceinline__ XcdBarrier xcd_barrier_post(unsigned* bar, volatile LAS unsigned* st, int wid_s) {
    XcdBarrier b; b.bar = bar; b.x = xb_xcc_id(); b.st = st;
    if (mk_tid(wid_s) == 0) (void)xb_add(&bar[XB_XCNT(b.x)], 1u);
    return b;
}
__device__ __forceinline__ void xcd_barrier_complete(unsigned* bar, unsigned x, unsigned& nloc, unsigned& nx) {
    const unsigned G = gridDim.x * gridDim.y * gridDim.z;
    unsigned sum, cnt, mine, sp = 0u;
    for (;;) {
        sum = 0u; cnt = 0u; mine = 0u;
#pragma unroll
        for (unsigned j = 0; j < 16; ++j) { const unsigned c = xb_ld(&bar[XB_XCNT(j)]); sum += c; cnt += (c > 0u) ? 1u : 0u; mine = (j == x) ? c : mine; }
        if (sum == G) break;
        __builtin_amdgcn_s_sleep(1);
        if ((++sp & 255u) == 0u) { if (xb_ld(&bar[XB_TMO])) break; if (sp > XB_SPIN_CAP) { atomicAdd(&bar[XB_TMO], 1u); break; } }
    }
    nloc = mine > 0u ? mine : 1u; nx = cnt > 0u ? cnt : 1u;
}
__device__ __forceinline__ void xcd_barrier2(unsigned* bar_, volatile LAS unsigned* st_, int wid_s) {
    XcdBarrier b; b.bar = bar_; b.st = st_; b.x = xb_xcc_id();
    asm volatile("s_waitcnt vmcnt(0)" ::: "memory");
    __syncthreads();
    if (mk_tid(wid_s) == 0) {
        unsigned* bar = b.bar;
        __builtin_amdgcn_s_waitcnt(0);
        unsigned nloc = b.st[0], nx = b.st[1];
        if (nloc == 0u) { xcd_barrier_complete(bar, b.x, nloc, nx); b.st[0] = nloc; b.st[1] = nx; }
        const unsigned old = xb_add(&bar[XB_XSUB(b.x)], 1u);
        const unsigned gen = old / nloc;
        if (old + 1u == (gen + 1u) * nloc) {
            __builtin_amdgcn_fence(__ATOMIC_RELEASE, "agent");
            asm volatile("s_waitcnt vmcnt(0)" ::: "memory");
            const unsigned og = xb_add(&bar[XB_TOP], 1u);
            const unsigned tg = og / nx;
            if (og + 1u == (tg + 1u) * nx) xb_add(&bar[XB_TOPGEN], 1u);
            else XB_SPIN(xb_ld(&bar[XB_TOPGEN]) == tg, bar);
            __builtin_amdgcn_fence(__ATOMIC_ACQUIRE, "agent");
            xb_add(&bar[XB_XGEN(b.x)], 1u);
            asm volatile("s_waitcnt vmcnt(0)" ::: "memory");
        } else {
            XB_SPIN(xb_ld(&bar[XB_XGEN(b.x)]) == gen, bar);
            __builtin_amdgcn_fence(__ATOMIC_ACQUIRE, "agent");
            asm volatile("s_waitcnt vmcnt(0)" ::: "memory");
        }
    }
    __syncthreads();
}
static void fill_params(P& p, void* const* d_in, void* d_out, void* d_ws, size_t ws_size, size_t* used) {
  p.x = (const float*)d_in[0]; p.p = (const float*)d_in[1]; p.pos = (const int*)d_in[2]; p.g_mix = (const float*)d_in[3];
  p.w_in = (const float*)d_in[4]; p.g_kv = (const float*)d_in[5]; p.w_uk = (const float*)d_in[6]; p.w_uv = (const float*)d_in[7];
  p.conv_w = (const float*)d_in[8]; p.conv_b = (const float*)d_in[9]; p.w_rg = (const float*)d_in[10]; p.b_rg = (const float*)d_in[11];
  p.w_ig = (const float*)d_in[12]; p.b_ig = (const float*)d_in[13]; p.lam = (const float*)d_in[14]; p.w_out = (const float*)d_in[15];
  p.g_ffn = (const float*)d_in[16]; p.w_pq = (const float*)d_in[17]; p.k1 = (const float*)d_in[18]; p.k2 = (const float*)d_in[19];
  p.u_tab = (const float*)d_in[20]; p.v_tab = (const float*)d_in[21]; p.w_ple = (const float*)d_in[22]; p.w_gate = (const float*)d_in[23];
  p.g_final = (const float*)d_in[24];
  p.out = (float*)d_out; p.k1024 = 1024; p.k256 = 256; p.pad0 = 0; p.pad1 = 0;
  char* ws = (char*)d_ws; size_t off = 0;
  auto alloc = [&](size_t bytes) { void* r = ws + off; off += (bytes + 255) & ~(size_t)255; return r; };
  const size_t T = T_TOK;
  p.bar = (unsigned*)alloc(16384);
  p.ctr = (unsigned*)alloc(1024);
  p.rstd_mix = (float*)alloc(T * 4); p.ss_ffn = (float*)alloc(T * 4); p.ss_fin = (float*)alloc(T * 4);
  p.ropeA = (float*)alloc(T * 32 * 4); p.ropeI = (float*)alloc(T * 16 * 4);
  p.W1t = (u16*)alloc((size_t)N1 * 1024 * 2); p.WoutT = (u16*)alloc(1024 * 1024 * 2); p.WpqT = (u16*)alloc(2048 * 1024 * 2);
  p.WgT = (u16*)alloc(1024 * 1024 * 2); p.WpleT = (u16*)alloc(1024 * 256 * 2);
  p.K1b = (u16*)alloc(8 * 128 * 128 * 2); p.K2b = (u16*)alloc(8 * 128 * 128 * 2);
  p.WrgT = (u16*)alloc(8 * 64 * 64 * 2); p.WigT = (u16*)alloc(8 * 64 * 64 * 2);
  p.U8 = (unsigned char*)alloc((size_t)16384 * 1024); p.V8 = (unsigned char*)alloc((size_t)16384 * 1024); p.su = (float*)alloc(16384 * 4); p.sv = (float*)alloc(16384 * 4);
  p.p16 = (u16*)alloc(T * 256 * 2);
  p.experts = (int*)alloc(T * 128 * 4); p.gates = (float*)alloc(T * 128 * 4);
  p.xb16 = (u16*)alloc(T * 1024 * 2); p.x2b = p.xb16; p.mix = (u16*)alloc(T * 1024 * 2);
  char* rb = ws + off; size_t rboff = 0;
  auto allocB = [&](size_t bytes) { void* r = rb + rboff; rboff += (bytes + 255) & ~(size_t)255; return r; };
  p.qcat = (u16*)allocB(T * 640 * 2); p.kv = (u16*)allocB(T * 160 * 2); p.iqh = (u16*)allocB(T * 512 * 2); p.ikh = (u16*)allocB(T * 64 * 2);
  p.iw = (float*)allocB(T * 8 * 4); p.xbr = (u16*)allocB(T * 512 * 2); p.gate = (u16*)allocB(T * 512 * 2);
  size_t b1 = rboff; rboff = 0;
  p.x1b = (u16*)allocB(T * 1024 * 2); p.pq = (u16*)allocB(T * 2048 * 2); p.pple = p.x1b;
  size_t b2 = rboff;
  off += (b1 > b2 ? b1 : b2);
  *used = off;
}
namespace cg = cooperative_groups;
#ifndef USE_XCD_BARRIER
#define USE_XCD_BARRIER 0
#endif
__global__ void __launch_bounds__(512, 2) mega(P p) {
  extern __shared__ __attribute__((aligned(16))) unsigned char smem[];
  LAS unsigned char* lds = (LAS unsigned char*)smem;
  const int wid_s = __builtin_amdgcn_readfirstlane((int)(threadIdx.x >> 6));
  const int kstop = (p.pad1 >> 8) - 1;
  cg::grid_group grid = cg::this_grid();
#if USE_XCD_BARRIER
  volatile LAS unsigned* xst = (volatile LAS unsigned*)(lds + LDS_BYTES - 16);
  if (mk_tid(wid_s) == 0) { xst[0] = 0u; xst[1] = 0u; xst[2] = 0u; xst[3] = 0u; }
  __syncthreads();
  (void)xcd_barrier_post(p.bar, xst, wid_s);
#define GRID_SYNC() xcd_barrier2(p.bar, (volatile LAS unsigned*)(lds + LDS_BYTES - 16), wid_s)
#else
#define GRID_SYNC() grid.sync()
#endif
  phase0_prep(p, lds, wid_s);
#if USE_XCD_BARRIER
  if (p.k256 == 257) grid.sync();
  GRID_SYNC();
#else
  grid.sync();
#endif
  if (kstop == 0) return;
  phase1_gemm1(p, lds, wid_s);
  GRID_SYNC();
  if (kstop == 1) return;
  phase2(p, lds, wid_s);
  GRID_SYNC();
  if (kstop == 2) return;
  phase3_outproj(p, lds, wid_s);
  GRID_SYNC();
  if (kstop == 3) return;
  phase4_pq(p, lds, wid_s);
  asm volatile("s_waitcnt vmcnt(0)" ::: "memory"); __syncthreads();
  phase4b_route(p, lds, wid_s);
  GRID_SYNC();
  if (kstop == 4) return;
  phase5_experts(p, lds, wid_s);
  GRID_SYNC();
  if (kstop == 5) return;
  phase6_ple(p, lds, wid_s);
}

extern "C" void kernel_launch(void* const* d_in, const int* in_sizes, int n_in, void* d_out, int out_size, void* d_ws,
                              size_t ws_size, hipStream_t stream) {
  P p; memset(&p, 0, sizeof(p));
  size_t used = 0;
  fill_params(p, d_in, d_out, d_ws, ws_size, &used);
  static int grid_blocks = 0;
  if (!grid_blocks) {
    (void)hipFuncSetAttribute((const void*)mega, hipFuncAttributeMaxDynamicSharedMemorySize, LDS_BYTES);
    int dev = 0, cus = 0, per_cu = 0;
    (void)hipGetDevice(&dev);
    (void)hipDeviceGetAttribute(&cus, hipDeviceAttributeMultiprocessorCount, dev);
    (void)hipOccupancyMaxActiveBlocksPerMultiprocessor(&per_cu, mega, 512, LDS_BYTES);
    if (per_cu > 1) per_cu = 1;
    grid_blocks = 256;
    (void)cus;
  }
#if USE_XCD_BARRIER
  (void)hipMemsetAsync(p.bar, 0, 16384, stream);
#endif
  void* args[] = {&p};
#ifdef MEGA_PREFIX_K
  { P pp = p; pp.pad1 = ((MEGA_PREFIX_K + 1) << 8)
#ifdef P5FLAGS
      | P5FLAGS
#endif
      ;
#ifdef P2FLAGS
    pp.pad0 = P2FLAGS;
#endif
    void* args2[] = {&pp};
    (void)hipLaunchCooperativeKernel((void*)mega, dim3(grid_blocks), dim3(512), args2, LDS_BYTES, stream);
    (void)hipMemsetAsync(p.bar, 0, 16384, stream); }
#endif
  (void)hipLaunchCooperativeKernel((void*)mega, dim3(grid_blocks), dim3(512), args, LDS_BYTES, stream);
}
```
